# Optimizing an MI355X kernel written in HIP

```python
import jax, jax.numpy as jnp
from jax import lax
import numpy as np

D_MODEL = 1024
BATCH = 1
SEQ = 16384
DEPTH = 1

CHUNK = 64
Q_BLOCK = 128
N_MEM = 256
EPS = 1e-6

GLA_HEADS = 4
GLA_DK = D_MODEL // 16
GLA_DV = D_MODEL // 8
GLA_LOWRANK = 16
GLA_TAU = 16.0
FOX_HEADS = 8
FOX_DH = D_MODEL // 16
MEM_HEADS = 4
MEM_DH = D_MODEL // 8
D_FF = 4 * D_MODEL
N_BRANCH = 3

GLA_K = GLA_HEADS * GLA_DK
GLA_V = GLA_HEADS * GLA_DV
FOX_W = FOX_HEADS * FOX_DH
MEM_W = MEM_HEADS * MEM_DH
PROJ_SIZES = (GLA_K, GLA_K, GLA_V, GLA_V, GLA_LOWRANK, FOX_W, FOX_W, FOX_W, FOX_HEADS, MEM_W, N_BRANCH * D_MODEL)
D_IN = 2 * GLA_K + 2 * GLA_V + GLA_LOWRANK + 3 * FOX_W + FOX_HEADS + MEM_W + N_BRANCH * D_MODEL

kernel_name = "hybrid_gla_fox_memory_gated_block"


def rmsnorm(x, g):
    xf = x.astype(jnp.float32)
    r = lax.rsqrt(jnp.mean(xf * xf, axis=-1, keepdims=True) + EPS)
    return (xf * r).astype(x.dtype) * g


def split_cols(t, sizes):
    offs = np.cumsum(np.array(sizes))[:-1].tolist()
    return jnp.split(t, offs, axis=-1)


def gla_chunk_causal(q, k, v, log_a):
    B, S, H, DK = q.shape
    DV = v.shape[-1]
    N = S // CHUNK
    f32 = jnp.float32
    qc = q.reshape(B, N, CHUNK, H, DK).astype(f32)
    kc = k.reshape(B, N, CHUNK, H, DK).astype(f32)
    vc = v.reshape(B, N, CHUNK, H, DV).astype(f32)
    b = jnp.cumsum(log_a.reshape(B, N, CHUNK, H, DK).astype(f32), axis=2)
    b_last = b[:, :, -1:]
    e_pos = jnp.exp(b)
    e_neg = jnp.exp(-b)
    q_pos = qc * e_pos
    a_causal = jnp.einsum('bnthd,bnshd->bnhts', q_pos, kc * e_neg)
    a_anti = jnp.einsum('bnthd,bnshd->bnhts', qc * e_neg, kc * e_pos)
    t_idx = jnp.arange(CHUNK)
    lower = t_idx[:, None] >= t_idx[None, :]
    attn = jnp.where(lower, a_causal, a_anti)
    o_intra = jnp.einsum('bnhts,bnshv->bnthv', attn, vc)
    chunk_kv = jnp.einsum('bnshd,bnshv->bnhdv', kc * jnp.exp(b_last - b), vc)
    chunk_decay = jnp.exp(b_last[:, :, 0])

    def step(state, inp):
        kv, dec = inp
        return state * dec[..., None] + kv, state

    init = jnp.zeros((B, H, DK, DV), f32)
    _, prev = lax.scan(step, init, (jnp.moveaxis(chunk_kv, 1, 0), jnp.moveaxis(chunk_decay, 1, 0)))
    prev = jnp.moveaxis(prev, 0, 1)
    o_inter = jnp.einsum('bnthd,bnhdv->bnthv', q_pos, prev)
    return (o_intra + o_inter).reshape(B, S, H, DV).astype(v.dtype)


def forgetting_attention(q, k, v, log_f):
    B, S, H, Dh = q.shape
    nb = S // Q_BLOCK
    scale = Dh ** -0.5
    F = jnp.cumsum(log_f.astype(jnp.float32), axis=1).transpose(0, 2, 1)
    kh = k.transpose(0, 2, 1, 3)
    vh = v.transpose(0, 2, 1, 3)
    qb = q.reshape(B, nb, Q_BLOCK, H, Dh).transpose(1, 0, 3, 2, 4)
    Fq = F.reshape(B, H, nb, Q_BLOCK).transpose(2, 0, 1, 3)
    k_pos = jnp.arange(S)

    def block(args):
        qi, Fi, i = args
        s = jnp.einsum('bhqd,bhkd->bhqk', qi, kh).astype(jnp.float32) * scale
        s = s + Fi[..., None] - F[:, :, None, :]
        q_pos = i * Q_BLOCK + jnp.arange(Q_BLOCK)
        mask = k_pos[None, :] <= q_pos[:, None]
        p = jax.nn.softmax(jnp.where(mask, s, -jnp.inf), axis=-1)
        return jnp.einsum('bhqk,bhkd->bhqd', p.astype(vh.dtype), vh)

    out = lax.map(block, (qb, Fq, jnp.arange(nb)))
    return out.transpose(1, 0, 3, 2, 4).reshape(B, S, H, Dh)


def memory_attention(q, mk, mv):
    scale = q.shape[-1] ** -0.5
    s = jnp.einsum('bshd,bmhd->bhsm', q, mk).astype(jnp.float32) * scale
    p = jax.nn.softmax(s, axis=-1)
    return jnp.einsum('bhsm,bmhd->bshd', p.astype(mv.dtype), mv)


def setup_inputs(seed: int = 0) -> dict:
    key = jax.random.key(seed)
    ks = jax.random.split(key, 20)
    f32 = jnp.float32

    def nrm(k, shape, fan_in):
        return jax.random.normal(k, shape, f32) * (fan_in ** -0.5)

    def gain(k, shape):
        return 1.0 + 0.02 * jax.random.normal(k, shape, f32)

    L = DEPTH
    return {
        "x": jax.random.normal(ks[0], (BATCH, SEQ, D_MODEL), f32),
        "mem": jax.random.normal(ks[1], (BATCH, N_MEM, D_MODEL), f32),
        "g_mix": gain(ks[2], (L, D_MODEL)),
        "w_in": nrm(ks[3], (L, D_MODEL, D_IN), D_MODEL),
        "w_alpha_up": nrm(ks[4], (L, GLA_LOWRANK, GLA_K), GLA_LOWRANK),
        "b_alpha": 0.02 * jax.random.normal(ks[5], (L, GLA_K), f32),
        "b_forget": jax.random.uniform(ks[6], (L, FOX_HEADS), f32, 1.0, 5.0),
        "g_gla_head": gain(ks[7], (L, GLA_HEADS, GLA_DV)),
        "g_mem": gain(ks[8], (L, D_MODEL)),
        "w_mem_kv": nrm(ks[9], (L, D_MODEL, 2 * MEM_W), D_MODEL),
        "w_gla_o": nrm(ks[10], (L, GLA_V, D_MODEL), GLA_V),
        "w_fox_o": nrm(ks[11], (L, FOX_W, D_MODEL), FOX_W),
        "w_mem_o": nrm(ks[12], (L, MEM_W, D_MODEL), MEM_W),
        "w_out": nrm(ks[13], (L, D_MODEL, D_MODEL), D_MODEL),
        "g_ffn": gain(ks[14], (L, D_MODEL)),
        "w_ff1": nrm(ks[15], (L, D_MODEL, D_FF), D_MODEL),
        "w_ff2": nrm(ks[16], (L, D_FF, D_MODEL), D_FF),
        "g_final": gain(ks[17], (D_MODEL,)),
    }


def reference(x, mem, g_mix, w_in, w_alpha_up, b_alpha, b_forget, g_gla_head, g_mem, w_mem_kv,
              w_gla_o, w_fox_o, w_mem_o, w_out, g_ffn, w_ff1, w_ff2, g_final):
    B, S, D = x.shape
    M = mem.shape[1]
    h = x
    for l in range(DEPTH):
        u = rmsnorm(h, g_mix[l])
        proj = u @ w_in[l]
        (gq, gk, gv, gg, ga, fq, fk, fv, ff, mq, gates) = split_cols(proj, PROJ_SIZES)

        log_a = jax.nn.log_sigmoid(ga @ w_alpha_up[l] + b_alpha[l]) / GLA_TAU
        o_gla = gla_chunk_causal(
            gq.reshape(B, S, GLA_HEADS, GLA_DK) * (GLA_DK ** -0.5),
            gk.reshape(B, S, GLA_HEADS, GLA_DK),
            gv.reshape(B, S, GLA_HEADS, GLA_DV),
            log_a.reshape(B, S, GLA_HEADS, GLA_DK))
        o_gla = rmsnorm(o_gla, g_gla_head[l]) * jax.nn.silu(gg.reshape(B, S, GLA_HEADS, GLA_DV))
        y_gla = o_gla.reshape(B, S, GLA_V) @ w_gla_o[l]

        log_f = jax.nn.log_sigmoid(ff + b_forget[l])
        o_fox = forgetting_attention(
            fq.reshape(B, S, FOX_HEADS, FOX_DH),
            fk.reshape(B, S, FOX_HEADS, FOX_DH),
            fv.reshape(B, S, FOX_HEADS, FOX_DH),
            log_f)
        y_fox = o_fox.reshape(B, S, FOX_W) @ w_fox_o[l]

        mkv = rmsnorm(mem, g_mem[l]) @ w_mem_kv[l]
        mk, mv = jnp.split(mkv, 2, axis=-1)
        o_mem = memory_attention(
            mq.reshape(B, S, MEM_HEADS, MEM_DH),
            mk.reshape(B, M, MEM_HEADS, MEM_DH),
            mv.reshape(B, M, MEM_HEADS, MEM_DH))
        y_mem = o_mem.reshape(B, S, MEM_W) @ w_mem_o[l]

        gt = jax.nn.sigmoid(gates.reshape(B, S, N_BRANCH, D))
        merged = gt[:, :, 0] * y_gla + gt[:, :, 1] * y_fox + gt[:, :, 2] * y_mem
        h = h + merged @ w_out[l]

        u2 = rmsnorm(h, g_ffn[l])
        h = h + jnp.square(jax.nn.relu(u2 @ w_ff1[l])) @ w_ff2[l]
    return rmsnorm(h, g_final)
```

```cpp
#include <hip/hip_runtime.h>
#include <hip/hip_cooperative_groups.h>
#include <hip/hip_bf16.h>
#include <cstdio>
#include <cstdint>
#include <cmath>
namespace cg = cooperative_groups;
__device__ __forceinline__ int fresh_tid(int wv) { int lane_; asm volatile("v_mbcnt_lo_u32_b32 %0, -1, 0\n\tv_mbcnt_hi_u32_b32 %0, -1, %0" : "=v"(lane_)); return wv * 64 + lane_; }
namespace pg8 {
#define PG8_LAS __attribute__((address_space(3)))
typedef unsigned short bf16_t;
typedef short bf16x8 __attribute__((ext_vector_type(8)));
typedef float f32x4 __attribute__((ext_vector_type(4)));
typedef unsigned u32x4 __attribute__((ext_vector_type(4)));
constexpr int BM = 256, BK = 64, HALF = 128, HTB = HALF * BK * 2  , STAGE_BYTES = 8 * HTB, NXCD = 8, WGM = 8;

__host__ __device__ __forceinline__ int lds_byte(int r, int c) { const int st = (r >> 4) * 2 + (c >> 5), rr = r & 15, cc = c & 31, ob = rr * 64 + cc * 2; return st * 1024 + (ob ^ (((ob >> 9) & 1) << 5)); }
__host__ __device__ __forceinline__ void stage_rc(int b, int& R, int& C) { const int st = b / 1024, sb = b % 1024, swz = sb ^ (((sb >> 9) & 1) << 5); R = (st >> 1) * 16 + swz / 64; C = (st & 1) * 32 + (swz % 64) / 2; }
__host__ __device__ __forceinline__ int perm32(int rho) { const int n = rho >> 4, i = rho & 15; return 8 * (i >> 2) + 4 * n + (i & 3); }

struct Unit { int pm, pn, z; };
__device__ __forceinline__ unsigned cvt_pk_bf16(float lo, float hi) { unsigned r; asm volatile("v_cvt_pk_bf16_f32 %0, %1, %2" : "=v"(r) : "v"(lo), "v"(hi)); return r; }
__device__ __forceinline__ void map_tile(int L, int nM, int nN, int& pm, int& pn) {
    const int nwg = nM * nN; int wgid = L; { const int q = nwg / NXCD, r = nwg % NXCD, xcd = wgid % NXCD, off = wgid / NXCD; wgid = (xcd < r ? xcd * (q + 1) : r * (q + 1) + (xcd - r) * q) + off; }
    const int nig = WGM * nN, gid = wgid / nig, fm = gid * WGM, gsz = (nM - fm) < WGM ? (nM - fm) : WGM;
    pm = fm + ((wgid % nig) % gsz); pn = (wgid % nig) / gsz;
}
template <class Epi, class Sched, bool ALIGN_EPI = false, bool SP2 = false>
__device__ __forceinline__ void gemm_phase(PG8_LAS unsigned char* lds, const int K, const int lda, const int ldb, const Sched& S, const Epi& E) {
    const int tid = fresh_tid(S.wv), wid = S.wv, lane = tid & 63, wr = wid >> 2, wc = wid & 3, fr = lane & 15, fq = lane >> 4;
    const int nt = K / BK;
    unsigned voffA[2], voffB[2];
#pragma unroll
    for (int i = 0; i < 2; ++i) { int R, C; stage_rc(tid * 16 + i * 8192, R, C); const int Rb = Epi::PERM ? ((R & ~31) + perm32(R & 31)) : R;
        voffA[i] = (unsigned)(R * lda + C) * 2u; voffB[i] = (unsigned)(Rb * ldb + C) * 2u; }
    const size_t kstep = (size_t)(BK * 2);
    const size_t hstepA = (size_t)HALF * lda * 2, hstepB = (size_t)HALF * ldb * 2;
    const unsigned ldsw = (unsigned)wid * 1024u;
    const int aoff = lds_byte(wr * 64 + fr, fq * 8), boff = lds_byte(wc * 32 + fr, fq * 8);
#define PG8_SA(b, h) (((b) * 2 + (h)) * HTB)
#define PG8_SB(b, h) ((4 + (b) * 2 + (h)) * HTB)
#define PG8_STAGE(bufoff, gbase, voff) do { _Pragma("unroll") for (int _i = 0; _i < 2; ++_i) \
        __builtin_amdgcn_global_load_lds((const unsigned*)((const char*)(gbase) + (voff)[_i]), (PG8_LAS unsigned*)(lds + (bufoff) + ldsw + _i * 8192), 16, 0, 0); } while (0)
#define PG8_LDA(dst, b, h) do { _Pragma("unroll") for (int m = 0; m < 4; ++m) _Pragma("unroll") for (int k = 0; k < 2; ++k) dst[m][k] = *(const PG8_LAS bf16x8*)(lds + PG8_SA(b, h) + aoff + m * 2048 + k * 1024); } while (0)
#define PG8_LDB(dst, b, h) do { _Pragma("unroll") for (int n = 0; n < 2; ++n) _Pragma("unroll") for (int k = 0; k < 2; ++k) dst[n][k] = *(const PG8_LAS bf16x8*)(lds + PG8_SB(b, h) + boff + n * 2048 + k * 1024); } while (0)
#define PG8_MMA(ai, bj, At, Bt) do { __builtin_amdgcn_s_setprio(1); _Pragma("unroll") for (int m = 0; m < 4; ++m) _Pragma("unroll") for (int n = 0; n < 2; ++n) _Pragma("unroll") for (int k = 0; k < 2; ++k) \
        acc[ai][bj][m][n] = __builtin_amdgcn_mfma_f32_16x16x32_bf16(Bt[n][k], At[m][k], acc[ai][bj][m][n], 0, 0, 0); __builtin_amdgcn_s_setprio(0); } while (0)
#define PG8_WAIT_V(n) asm volatile("s_waitcnt vmcnt(" #n ")" ::: "memory")
#define PG8_WAIT_L(n) asm volatile("s_waitcnt lgkmcnt(" #n ")" ::: "memory")
#define PG8_BAR __builtin_amdgcn_s_barrier()
#define PG8_SCHED __builtin_amdgcn_sched_barrier(0)
    Unit cur, nxt; int ui = 0;
    if (!S.next(0, cur)) return;
    f32x4 acc[2][2][4][2];
#pragma unroll
    for (int a = 0; a < 2; ++a)
#pragma unroll
        for (int b = 0; b < 2; ++b)
#pragma unroll
            for (int m = 0; m < 4; ++m)
#pragma unroll
                for (int n = 0; n < 2; ++n) acc[a][b][m][n] = (f32x4){0.f, 0.f, 0.f, 0.f};
    bf16x8 At[4][2], B0[2][2], B1[2][2];
    const char* cA = S.aptr(cur); const char* cB = S.bptr(cur);
    S.a_ready(cur);
    if constexpr (SP2) {
        PG8_STAGE(PG8_SB(0, 0), cB, voffB); PG8_STAGE(PG8_SB(0, 1), cB + hstepB, voffB); PG8_STAGE(PG8_SA(0, 0), cA, voffA); PG8_STAGE(PG8_SA(0, 1), cA + hstepA, voffA);
        if (wr == 1) PG8_BAR;
        PG8_WAIT_V(2); PG8_BAR;
        PG8_STAGE(PG8_SB(1, 0), cB + kstep, voffB); PG8_STAGE(PG8_SA(1, 0), cA + kstep, voffA); PG8_STAGE(PG8_SB(1, 1), cB + hstepB + kstep, voffB);
        PG8_WAIT_V(6); PG8_BAR;
    } else {
        PG8_STAGE(PG8_SB(0, 0), cB, voffB); PG8_STAGE(PG8_SA(0, 0), cA, voffA); PG8_STAGE(PG8_SB(0, 1), cB + hstepB, voffB); PG8_STAGE(PG8_SA(0, 1), cA + hstepA, voffA);
        if (wr == 1) PG8_BAR;
        PG8_WAIT_V(4); PG8_BAR;
        PG8_STAGE(PG8_SB(1, 0), cB + kstep, voffB); PG8_STAGE(PG8_SA(1, 0), cA + kstep, voffA); PG8_STAGE(PG8_SB(1, 1), cB + hstepB + kstep, voffB);
        PG8_WAIT_V(6); PG8_BAR;
    }
    for (;;) {
        const bool has_next = S.next(ui + 1, nxt);
        const char* nA = has_next ? S.aptr(nxt) : cA; const char* nB = has_next ? S.bptr(nxt) : cB;
        for (int t = 0; t < nt; t += 2) {
            const bool last = (t == nt - 2);
            const char* a1 = cA + (size_t)(t + 1) * kstep;
            const char* a2 = last ? nA : cA + (size_t)(t + 2) * kstep; const char* b2 = last ? nB : cB + (size_t)(t + 2) * kstep;
            const char* a3 = a2 + kstep; const char* b3 = b2 + kstep;
            if (last && has_next) S.a_ready(nxt);
            if constexpr (SP2) {
            PG8_LDB(B0, 0, 0); PG8_LDB(B1, 0, 1); PG8_SCHED; PG8_LDA(At, 0, 0); PG8_STAGE(PG8_SA(1, 1), a1 + hstepA, voffA);
            PG8_WAIT_V(8); PG8_WAIT_L(0); PG8_BAR; PG8_MMA(0, 0, At, B0); PG8_MMA(0, 1, At, B1); PG8_BAR; PG8_SCHED;
            PG8_LDA(At, 0, 1); PG8_STAGE(PG8_SB(0, 0), b2, voffB); PG8_STAGE(PG8_SB(0, 1), b2 + hstepB, voffB); PG8_STAGE(PG8_SA(0, 0), a2, voffA);
            PG8_WAIT_V(8); PG8_WAIT_L(0); PG8_BAR; PG8_MMA(1, 0, At, B0); PG8_MMA(1, 1, At, B1); PG8_BAR; PG8_SCHED;
            PG8_LDB(B0, 1, 0); PG8_LDB(B1, 1, 1); PG8_SCHED; PG8_LDA(At, 1, 0); PG8_STAGE(PG8_SA(0, 1), a2 + hstepA, voffA);
            PG8_WAIT_V(8); PG8_WAIT_L(0); PG8_BAR; PG8_MMA(0, 0, At, B0); PG8_MMA(0, 1, At, B1); PG8_BAR; PG8_SCHED;
            PG8_LDA(At, 1, 1); PG8_STAGE(PG8_SB(1, 0), b3, voffB); PG8_STAGE(PG8_SB(1, 1), b3 + hstepB, voffB); PG8_STAGE(PG8_SA(1, 0), a3, voffA);
            PG8_WAIT_V(8); PG8_WAIT_L(0); PG8_BAR; PG8_MMA(1, 0, At, B0); PG8_MMA(1, 1, At, B1); PG8_BAR; PG8_SCHED;
            } else {
            PG8_LDB(B0, 0, 0); PG8_SCHED; PG8_LDA(At, 0, 0); PG8_STAGE(PG8_SA(1, 1), a1 + hstepA, voffA);
            PG8_WAIT_L(8); PG8_BAR; PG8_WAIT_L(0); PG8_MMA(0, 0, At, B0); PG8_BAR; PG8_SCHED;
            PG8_LDB(B1, 0, 1); PG8_STAGE(PG8_SB(0, 0), b2, voffB);
            PG8_BAR; PG8_WAIT_L(0); PG8_MMA(0, 1, At, B1); PG8_BAR;
            PG8_LDA(At, 0, 1); PG8_STAGE(PG8_SA(0, 0), a2, voffA);
            PG8_BAR; PG8_WAIT_L(0); PG8_MMA(1, 0, At, B0); PG8_BAR; PG8_SCHED;
            PG8_STAGE(PG8_SB(0, 1), b2 + hstepB, voffB);
            PG8_WAIT_V(6); PG8_BAR; PG8_MMA(1, 1, At, B1); PG8_BAR;
            PG8_LDB(B0, 1, 0); PG8_SCHED; PG8_LDA(At, 1, 0); PG8_STAGE(PG8_SA(0, 1), a2 + hstepA, voffA);
            PG8_WAIT_L(8); PG8_BAR; PG8_WAIT_L(0); PG8_MMA(0, 0, At, B0); PG8_BAR; PG8_SCHED;
            PG8_LDB(B1, 1, 1); PG8_STAGE(PG8_SB(1, 0), b3, voffB);
            PG8_BAR; PG8_WAIT_L(0); PG8_MMA(0, 1, At, B1); PG8_BAR;
            PG8_LDA(At, 1, 1); PG8_STAGE(PG8_SA(1, 0), a3, voffA);
            PG8_BAR; PG8_WAIT_L(0); PG8_MMA(1, 0, At, B0); PG8_BAR; PG8_SCHED;
            PG8_STAGE(PG8_SB(1, 1), b3 + hstepB, voffB);
            PG8_WAIT_V(6); PG8_BAR; PG8_MMA(1, 1, At, B1); PG8_BAR;
            }
        }
        if constexpr (ALIGN_EPI) { if (wr == 0) PG8_BAR; }
        if constexpr (!Epi::AFTER_DRAIN) { E(acc, cur, wr, wc, fr, fq); S.done(cur); }
        if (!has_next) break;
#pragma unroll
        for (int a = 0; a < 2; ++a)
#pragma unroll
            for (int b = 0; b < 2; ++b)
#pragma unroll
                for (int m = 0; m < 4; ++m)
#pragma unroll
                    for (int n = 0; n < 2; ++n) acc[a][b][m][n] = (f32x4){0.f, 0.f, 0.f, 0.f};
        cur = nxt; cA = nA; cB = nB; ++ui;
        if constexpr (ALIGN_EPI) { if (wr == 1) PG8_BAR; }
    }
    PG8_WAIT_V(0);
    if constexpr (!ALIGN_EPI) { if (wr == 0) PG8_BAR; }
    PG8_BAR;
    if constexpr (Epi::AFTER_DRAIN) { E.fused(acc, cur, wr, wc, fr, fq, lds, wid, lane); S.done(cur); }
#undef PG8_SA
#undef PG8_SB
#undef PG8_STAGE
#undef PG8_LDA
#undef PG8_LDB
#undef PG8_MMA
#undef PG8_WAIT_V
#undef PG8_WAIT_L
#undef PG8_BAR
#undef PG8_SCHED
}
}
#include <hip/hip_bf16.h>
namespace attn_body {
using bf16=__hip_bfloat16;
using bf16x8=__attribute__((ext_vector_type(8)))short;
using s16x4=__attribute__((ext_vector_type(4)))short;
using f32x16=__attribute__((ext_vector_type(16)))float;
using u32x4=__attribute__((ext_vector_type(4)))unsigned;
constexpr int BATCH=1,NHEAD=8,SEQ=16384,D=64,DM=NHEAD*D;
constexpr int NW=8,QBLK=32,QB=QBLK*NW,KVBLK=64,NQB=SEQ/QB;
constexpr int ATTN_PITCH=DM, ATTN_UNIT_ROWS=QB;
__device__ __forceinline__ int crow(int r,int hi){return (r&3)+8*(r>>2)+4*hi;}
#define SBAR() __builtin_amdgcn_sched_barrier(0)
__device__ __forceinline__ void cmask(f32x16&p0,f32x16&p1,int jb,int qrel,int hi){
  const float NEG=-INFINITY; int kb=64*jb+4*hi;
  #pragma unroll
  for(int r=0;r<16;++r){int kv=kb+(r&3)+8*(r>>2); if(kv>qrel)p0[r]=NEG; if(kv+32>qrel)p1[r]=NEG;}
}

constexpr int NSLOT=3, SLOTB=8192;
constexpr int LDS_K=0, LDS_V=NSLOT*SLOTB, LDS_WS=2*NSLOT*SLOTB, LDS_OST=LDS_WS+NW*64*4, LDS_BIAS=LDS_OST+NW*4096, LDS_BYTES=LDS_BIAS+SEQ*4+512;
constexpr float C2=0.125f*1.4426950408889634f;
__device__ __forceinline__ void glds16(const void*gsrc,unsigned lds_dst){unsigned keep;
  asm volatile("s_mov_b32 %0, m0\n\ts_mov_b32 m0, %2\n\ts_nop 0\n\tglobal_load_lds_dwordx4 %1, off\n\ts_mov_b32 m0, %0":"=&s"(keep):"v"(gsrc),"s"(lds_dst):"memory");}
__device__ __forceinline__ float max3f(float a,float b,float c){float r;asm("v_max3_f32 %0, %1, %2, %3":"=v"(r):"v"(a),"v"(b),"v"(c));return r;}
__device__ __forceinline__ float max2f(float a,float b){float r;asm("v_max_f32_e32 %0, %1, %2":"=v"(r):"v"(a),"v"(b));return r;}
__device__ __forceinline__ float fadd_s(float a,float b){float r;asm("v_add_f32_e32 %0, %1, %2":"=v"(r):"v"(a),"v"(b));return r;}
__device__ __forceinline__ float fsub_s(float a,float b){float r;asm("v_sub_f32_e32 %0, %1, %2":"=v"(r):"v"(a),"v"(b));return r;}
typedef float f32x2_t __attribute__((ext_vector_type(2))); typedef __bf16 bf16x2_t __attribute__((ext_vector_type(2)));
__device__ __forceinline__ unsigned cvtpk_s(float lo,float hi){f32x2_t v={lo,hi};bf16x2_t b=__builtin_convertvector(v,bf16x2_t);return __builtin_bit_cast(unsigned,b);}
#define WAIT_BAR(N) asm volatile("s_waitcnt vmcnt(" #N ") lgkmcnt(0)\n\ts_barrier":::"memory")

__device__ __forceinline__ void qkt(f32x16&p0,f32x16&p1,const char*Kslot,const bf16x8*qr,int r32,int hi){
  const char*kb=Kslot+hi*1024+r32*16;
  #pragma unroll
  for(int d0=0;d0<4;++d0){
    const bf16x8 b0=*reinterpret_cast<const bf16x8*>(kb+d0*2048);
    const bf16x8 b1=*reinterpret_cast<const bf16x8*>(kb+d0*2048+512);
    p0=__builtin_amdgcn_mfma_f32_32x32x16_bf16(b0,qr[d0],p0,0,0,0);p1=__builtin_amdgcn_mfma_f32_32x32x16_bf16(b1,qr[d0],p1,0,0,0);}
}
typedef __attribute__((address_space(3))) const char* lds_cptr;
typedef short v4i16_t __attribute__((ext_vector_type(4)));
__device__ __forceinline__ void kload8(bf16x8*kf,lds_cptr kp){
  kf[0]=*(const __attribute__((address_space(3))) bf16x8*)(kp);      kf[1]=*(const __attribute__((address_space(3))) bf16x8*)(kp+512);
  kf[2]=*(const __attribute__((address_space(3))) bf16x8*)(kp+2048); kf[3]=*(const __attribute__((address_space(3))) bf16x8*)(kp+2560);
  kf[4]=*(const __attribute__((address_space(3))) bf16x8*)(kp+4096); kf[5]=*(const __attribute__((address_space(3))) bf16x8*)(kp+4608);
  kf[6]=*(const __attribute__((address_space(3))) bf16x8*)(kp+6144); kf[7]=*(const __attribute__((address_space(3))) bf16x8*)(kp+6656);
}
__device__ __forceinline__ void kload2(bf16x8*kf,lds_cptr kp,int j){ kf[2*j]=*(const __attribute__((address_space(3))) bf16x8*)(kp+j*2048); kf[2*j+1]=*(const __attribute__((address_space(3))) bf16x8*)(kp+j*2048+512); }
__device__ __forceinline__ s16x4 vtr(lds_cptr p){ return __builtin_bit_cast(s16x4,__builtin_amdgcn_ds_read_tr16_b64_v4i16((__attribute__((address_space(3))) v4i16_t*)p)); }
__device__ __forceinline__ float rowmax(const f32x16&p0,const f32x16&p1){
  float a=max3f(p0[0],p0[1],p1[0]),b=max3f(p0[2],p0[3],p1[1]);a=max3f(a,p1[2],p1[3]);
  #pragma unroll
  for(int r=4;r<16;r+=4){a=max3f(a,p0[r],p0[r+1]);b=max3f(b,p0[r+2],p0[r+3]);a=max3f(a,p1[r],p1[r+1]);b=max3f(b,p1[r+2],p1[r+3]);}
  const float m=max2f(a,b);
  auto rr=__builtin_amdgcn_permlane32_swap(__float_as_uint(m),__float_as_uint(m),false,false);
  return max2f(__uint_as_float(rr[0]),__uint_as_float(rr[1]));
}
__device__ __forceinline__ void pv(f32x16*o,int vb,bf16x8 pa0,bf16x8 pa1,bf16x8 pa2,bf16x8 pa3){
  #pragma unroll
  for(int d0=0;d0<2;++d0){s16x4 lo[4],hi[4];
    #pragma unroll
    for(int ks=0;ks<4;++ks){
      asm volatile("ds_read_b64_tr_b16 %0,%1 offset:%c2":"=&v"(lo[ks]):"v"(vb),"i"(d0*4096+ks*1024):"memory");
      asm volatile("ds_read_b64_tr_b16 %0,%1 offset:%c2":"=&v"(hi[ks]):"v"(vb),"i"(d0*4096+ks*1024+512):"memory");}
    asm volatile("s_waitcnt lgkmcnt(0)":::"memory");SBAR();
    #define PK(k) (bf16x8){lo[k][0],lo[k][1],lo[k][2],lo[k][3],hi[k][0],hi[k][1],hi[k][2],hi[k][3]}
    o[d0]=__builtin_amdgcn_mfma_f32_32x32x16_bf16(pa0,PK(0),o[d0],0,0,0);
    o[d0]=__builtin_amdgcn_mfma_f32_32x32x16_bf16(pa1,PK(1),o[d0],0,0,0);
    o[d0]=__builtin_amdgcn_mfma_f32_32x32x16_bf16(pa2,PK(2),o[d0],0,0,0);
    o[d0]=__builtin_amdgcn_mfma_f32_32x32x16_bf16(pa3,PK(3),o[d0],0,0,0);
    #undef PK
  }
}

#ifndef ATTN_STORE16
#define ATTN_STORE16(p,v) (*(u32x4*)(p)=(v))
#endif
typedef float f32x4_t __attribute__((ext_vector_type(4)));
template<int THRL> __device__ __forceinline__ void attn_unit(int b,int h,int qb,const bf16*Q,const bf16*__restrict__ K,const bf16*__restrict__ V,bf16*O,const float*__restrict__ Fh,char*shm,int wv){
  const int tid=fresh_tid(wv),lane=tid&63,r32=lane&31,hi=lane>>5; const int wid=wv;
  const long rowbase=(long)b*SEQ; const int q0=qb*QB;
  const bf16*Qw=Q+(rowbase+q0+wid*QBLK)*DM+h*D;
  const bf16*Kh=K+rowbase*DM+h*D,*Vh=V+rowbase*DM+h*D;
  const lds_cptr shm3=(lds_cptr)shm;
  const unsigned lds0=(unsigned)(uintptr_t)shm;
  float*wsf=(float*)(shm+LDS_WS)+wid*64;
  const bf16*ksrc=Kh+(long)lane*DM+wid*8;
  const bf16*vsrc=Vh+(long)(16*(wid&3)+(lane>>2))*DM+(wid>>2)*32+(lane&3)*8;
  const unsigned kdst=lds0+LDS_K+wid*1024, vdst=lds0+LDS_V+wid*1024;
  #define DMA_K(t,slot) glds16(ksrc+(long)(t)*KVBLK*DM,(unsigned)__builtin_amdgcn_readfirstlane(kdst+(slot)))
  #define DMA_V(t,slot) glds16(vsrc+(long)(t)*KVBLK*DM,(unsigned)__builtin_amdgcn_readfirstlane(vdst+(slot)))
  const int vb0=(int)(lds0+LDS_V)+((lane>>4)&1)*32+(lane&3)*8+(4*hi+((lane&15)>>2))*64;
  const char*Kbase=shm+LDS_K; bf16x8 kf[8];
  const lds_cptr kp0=shm3+LDS_K+hi*1024+r32*16; const lds_cptr vp0=shm3+LDS_V+((lane>>4)&1)*32+(lane&3)*8+(4*hi+((lane&15)>>2))*64;
  const int NT=(q0+QB)/KVBLK;
  { const float fref=Fh[q0]; __attribute__((address_space(3))) float* bl=(__attribute__((address_space(3))) float*)(shm3+LDS_BIAS); for(int s=tid;s<q0+QB;s+=NW*64) bl[s]=(fref-Fh[s])*1.4426950408889634f; }
  #define BLOAD(X0,X1,tt) do{ const __attribute__((address_space(3))) f32x4_t* bp_=(const __attribute__((address_space(3))) f32x4_t*)(shm3+LDS_BIAS+((tt)*64+4*hi)*4); \
    _Pragma("unroll") for(int g_=0;g_<4;++g_){ const f32x4_t a_=bp_[2*g_], b_=bp_[8+2*g_]; \
      X0[4*g_]=a_[0];X0[4*g_+1]=a_[1];X0[4*g_+2]=a_[2];X0[4*g_+3]=a_[3]; X1[4*g_]=b_[0];X1[4*g_+1]=b_[1];X1[4*g_+2]=b_[2];X1[4*g_+3]=b_[3]; } }while(0)
  DMA_K(0,0);DMA_V(0,0);DMA_K(1,SLOTB);
  bf16x8 qr[4];
  #pragma unroll
  for(int d0=0;d0<4;++d0)qr[d0]=*reinterpret_cast<const bf16x8*>(&Qw[(long)r32*DM+d0*16+hi*8]);
  float mhat=0.f,l_reg=0.f;f32x16 o[2];o[0]=f32x16{};o[1]=f32x16{};
  const int qrel=wid*QBLK+r32;
  #define CMASK(P0,P1,t) do{int jb_=(t)-(NT-4); if(jb_>=0)cmask(P0,P1,jb_,qrel,hi);}while(0)
  bool resc=false;
  #define START(P0,P1) do{ const float rm=rowmax(P0,P1); resc=false; \
    { const float dl=rm; mhat=fadd_s(mhat,dl); \
      _Pragma("unroll") for(int r=0;r<16;++r){P0[r]=fsub_s(P0[r],dl);P1[r]=fsub_s(P1[r],dl);} \
 } \
    _Pragma("unroll") for(int r=0;r<16;++r)P0[r]=__builtin_amdgcn_exp2f(P0[r]); }while(0)
  #define RESC() do{ if(resc){ asm volatile("s_waitcnt lgkmcnt(0)":::"memory"); \
      _Pragma("unroll") for(int d_=0;d_<2;++d_) _Pragma("unroll") for(int r=0;r<16;++r)o[d_][r]*=wsf[crow(r,hi)]; } }while(0)
  f32x16 pA0,pA1,pB0,pB1;
  int sl_prev=0,sl_cur=0,sl_next=SLOTB;
  #define ROT() do{sl_prev=sl_cur;sl_cur=sl_next;sl_next=(sl_next==(NSLOT-1)*SLOTB)?0:sl_next+SLOTB;}while(0)
  DMA_K(2,2*SLOTB);
  WAIT_BAR(3);
  BLOAD(pA0,pA1,0); BLOAD(pB0,pB1,1);
  qkt(pA0,pA1,Kbase,qr,r32,hi);asm volatile("s_nop 15\n\ts_nop 7":"+v"(pA0),"+v"(pA1));CMASK(pA0,pA1,0);
  START(pA0,pA1);
  _Pragma("unroll") for(int r=0;r<16;++r)pA1[r]=__builtin_amdgcn_exp2f(pA1[r]);
  WAIT_BAR(0);
  DMA_K(3,0);DMA_V(1,SLOTB);
  ROT();
  kload8(kf,kp0+sl_cur);
  WAIT_BAR(2);
  s16x4 vlo[8],vhi[8]; u32x4 pw0,pw1,pw2,pw3;
  #define PKW(P,B) cvtpk_s(P[B],P[B+1])
  #define PAF(k) __builtin_bit_cast(bf16x8,pw##k)
  #define VFR(i) (bf16x8){vlo[i][0],vlo[i][1],vlo[i][2],vlo[i][3],vhi[i][0],vhi[i][1],vhi[i][2],vhi[i][3]}
  #define PIN(x) asm volatile("":"+v"(x))
  #define MX3(a,b,c) __builtin_fmaxf(__builtin_fmaxf((a),(b)),(c))
  #define GAPA(MF,A0,A1,A2,A3,W0,W1,PW) do{ MF; sacc+=A0; sacc+=A1; sacc+=A2; sacc+=A3; PIN(sacc); W0; W1; PIN(PW); SBAR(); }while(0)
  #define EX(v) __builtin_amdgcn_exp2f(v)
  #define GAPB(MF,X,B) do{ MF; X[B]=EX(X[B]); X[B+1]=EX(X[B+1]); X[B+2]=EX(X[B+2]); X[B+3]=EX(X[B+3]); PIN(X); SBAR(); }while(0)
  #define VRD(i) do{ vlo[i]=vtr(vp_+(((i)>>2)*4096+((i)&3)*1024)); vhi[i]=vtr(vp_+(((i)>>2)*4096+((i)&3)*1024+512)); }while(0)
  #define KRD(G,j) do{ if(G){ kload2(kf,kp0+sl_next,j); SBAR(); } }while(0)
  #define STEP(C0,C1,P0,P1,t,GK,GV,GL) do{ SBAR(); \
    _Pragma("unroll") for(int r=0;r<16;++r){C0[r]-=mhat;C1[r]-=mhat;} \
    const lds_cptr vp_=vp0+sl_prev; \
    VRD(0); SBAR(); float sacc=(P0[0]+P0[1]); \
    GAPA(C0=__builtin_amdgcn_mfma_f32_32x32x16_bf16(kf[0],qr[0],C0,0,0,0), P0[2],P0[3],P0[4],P0[5],     pw0[0]=PKW(P0,0), pw0[1]=PKW(P0,2), pw0); \
    VRD(4); SBAR(); GAPA(C1=__builtin_amdgcn_mfma_f32_32x32x16_bf16(kf[1],qr[0],C1,0,0,0), P0[6],P0[7],P0[8],P0[9],     pw0[2]=PKW(P0,4), pw0[3]=PKW(P0,6), pw0); \
    VRD(1); SBAR(); GAPA(C0=__builtin_amdgcn_mfma_f32_32x32x16_bf16(kf[2],qr[1],C0,0,0,0),   P0[10],P0[11],P0[12],P0[13], pw1[0]=PKW(P0,8), pw1[1]=PKW(P0,10), pw1); \
    VRD(5); SBAR(); GAPA(C1=__builtin_amdgcn_mfma_f32_32x32x16_bf16(kf[3],qr[1],C1,0,0,0),   P0[14],P0[15],P1[0],P1[1],   pw1[2]=PKW(P0,12),pw1[3]=PKW(P0,14), pw1); \
    VRD(2); SBAR(); GAPA(C0=__builtin_amdgcn_mfma_f32_32x32x16_bf16(kf[4],qr[2],C0,0,0,0),   P1[2],P1[3],P1[4],P1[5],     pw2[0]=PKW(P1,0), pw2[1]=PKW(P1,2), pw2); \
    VRD(6); SBAR(); GAPA(C1=__builtin_amdgcn_mfma_f32_32x32x16_bf16(kf[5],qr[2],C1,0,0,0),   P1[6],P1[7],P1[8],P1[9],     pw2[2]=PKW(P1,4), pw2[3]=PKW(P1,6), pw2); \
    VRD(3); SBAR(); GAPA(C0=__builtin_amdgcn_mfma_f32_32x32x16_bf16(kf[6],qr[3],C0,0,0,0),   P1[10],P1[11],P1[12],P1[13], pw3[0]=PKW(P1,8), pw3[1]=PKW(P1,10), pw3); \
    VRD(7); SBAR(); GAPA(C1=__builtin_amdgcn_mfma_f32_32x32x16_bf16(kf[7],qr[3],C1,0,0,0),   P1[14],P1[15],0.f,0.f,       pw3[2]=PKW(P1,12),pw3[3]=PKW(P1,14), pw3); \
    l_reg+=sacc; \
    if(GK){DMA_K((t)+3,sl_cur);} if(GV){DMA_V((t)+1,sl_next);} \
    CMASK(C0,C1,t); \
    { float a=MX3(C0[0],C0[1],C1[0]),b=MX3(C0[2],C0[3],C1[1]); a=MX3(a,C1[2],C1[3]); \
      _Pragma("unroll") for(int r=4;r<16;r+=4){a=MX3(a,C0[r],C0[r+1]);b=MX3(b,C0[r+2],C0[r+3]);a=MX3(a,C1[r],C1[r+1]);b=MX3(b,C1[r+2],C1[r+3]);} \
      float rm=__builtin_fmaxf(a,b); { auto rr=__builtin_amdgcn_permlane32_swap(__float_as_uint(rm),__float_as_uint(rm),false,false); rm=__builtin_fmaxf(__uint_as_float(rr[0]),__uint_as_float(rr[1])); } \
      resc=false; \
      if(__builtin_expect(__any(rm>(float)THRL),0)){ const float dl=__builtin_fmaxf(rm,0.f); mhat+=dl; \
        _Pragma("unroll") for(int r=0;r<16;++r){C0[r]-=dl;C1[r]-=dl;} \
        const float f=__builtin_amdgcn_exp2f(-dl); l_reg*=f; if(hi==0)wsf[r32]=f; resc=true; } } \
    SBAR(); \
    GAPB(o[0]=__builtin_amdgcn_mfma_f32_32x32x16_bf16(PAF(0),VFR(0),o[0],0,0,0), C0,0); \
    GAPB(o[1]=__builtin_amdgcn_mfma_f32_32x32x16_bf16(PAF(0),VFR(4),o[1],0,0,0), C0,4); \
    KRD(GL,0); GAPB(o[0]=__builtin_amdgcn_mfma_f32_32x32x16_bf16(PAF(1),VFR(1),o[0],0,0,0), C0,8); \
    KRD(GL,1); GAPB(o[1]=__builtin_amdgcn_mfma_f32_32x32x16_bf16(PAF(1),VFR(5),o[1],0,0,0), C0,12); \
    KRD(GL,2); GAPB(o[0]=__builtin_amdgcn_mfma_f32_32x32x16_bf16(PAF(2),VFR(2),o[0],0,0,0), C1,0); \
    KRD(GL,3); GAPB(o[1]=__builtin_amdgcn_mfma_f32_32x32x16_bf16(PAF(2),VFR(6),o[1],0,0,0), C1,4); \
    GAPB(o[0]=__builtin_amdgcn_mfma_f32_32x32x16_bf16(PAF(3),VFR(3),o[0],0,0,0), C1,8); \
    GAPB(o[1]=__builtin_amdgcn_mfma_f32_32x32x16_bf16(PAF(3),VFR(7),o[1],0,0,0), C1,12); \
    if(GL){BLOAD(P0,P1,(t)+1);} SBAR(); \
    }while(0)
  int t=1;
  #undef CMASK
  #define CMASK(P0,P1,t) do{}while(0)
  for(;t+5<NT;t+=2){
    STEP(pB0,pB1,pA0,pA1,t,true,true,true);     WAIT_BAR(2); RESC(); ROT();
    STEP(pA0,pA1,pB0,pB1,t+1,true,true,true);   WAIT_BAR(2); RESC(); ROT();
  }
  #undef CMASK
  #define CMASK(P0,P1,t) do{int jb_=(t)-(NT-4); if(jb_>=0)cmask(P0,P1,jb_,qrel,hi);}while(0)
  #define ENDW(tt) do{ if((tt)+3<NT){WAIT_BAR(2);} else if((tt)+2<NT){WAIT_BAR(1);} else {WAIT_BAR(0);} }while(0)
  for(;t+1<NT;t+=2){
    STEP(pB0,pB1,pA0,pA1,t,(t+3<NT),(t+1<NT),(t+1<NT));       ENDW(t);   RESC(); ROT();
    STEP(pA0,pA1,pB0,pB1,t+1,(t+4<NT),(t+2<NT),(t+2<NT));     ENDW(t+1); RESC(); ROT();
  }
  STEP(pB0,pB1,pA0,pA1,NT-1,false,false,false); RESC();
  { float sacc=pB0[0]+pB0[1]; _Pragma("unroll") for(int r=2;r<16;++r)sacc+=pB0[r]; _Pragma("unroll") for(int r=0;r<16;++r)sacc+=pB1[r]; l_reg+=sacc;
    pw0=(u32x4){PKW(pB0,0),PKW(pB0,2),PKW(pB0,4),PKW(pB0,6)};pw1=(u32x4){PKW(pB0,8),PKW(pB0,10),PKW(pB0,12),PKW(pB0,14)};pw2=(u32x4){PKW(pB1,0),PKW(pB1,2),PKW(pB1,4),PKW(pB1,6)};pw3=(u32x4){PKW(pB1,8),PKW(pB1,10),PKW(pB1,12),PKW(pB1,14)};
    SBAR(); pv(o,vb0+sl_cur,PAF(0),PAF(1),PAF(2),PAF(3)); }
  #undef PKW
  #undef PAF
  #undef VFR
  #undef PIN
  #undef MX3
  #undef GAPA
  #undef GAPB
  #undef EX
  #undef VRD
  #undef KRD
  #undef STEP
  #undef ENDW
  {auto rr=__builtin_amdgcn_permlane32_swap(__float_as_uint(l_reg),__float_as_uint(l_reg),false,false);l_reg=__uint_as_float(rr[0])+__uint_as_float(rr[1]);}
  if(hi==0)wsf[32+r32]=l_reg;asm volatile("s_waitcnt lgkmcnt(0)":::"memory");
  float rli[16];
  #pragma unroll
  for(int r=0;r<16;++r)rli[r]=__builtin_amdgcn_rcpf(wsf[32+crow(r,hi)]);
  bf16*Ow=O+(rowbase+q0+wid*QBLK)*DM+h*D;
  { bf16*stg=(bf16*)(shm+LDS_OST)+wid*2048;
    #pragma unroll
    for(int r=0;r<16;++r){const int orow=crow(r,hi);
      #pragma unroll
      for(int d0=0;d0<2;++d0)stg[orow*64+d0*32+r32]=__float2bfloat16(o[d0][r]*rli[r]);}
    asm volatile("s_waitcnt lgkmcnt(0)":::"memory");
    #pragma unroll
    for(int i=0;i<4;++i){const int row=i*8+(lane>>3),ch=lane&7; const u32x4 v=*(const u32x4*)(stg+row*64+ch*8); ATTN_STORE16(Ow+(long)row*DM+ch*8,v);} }
  asm volatile("s_waitcnt lgkmcnt(0)\n\ts_barrier":::"memory");
  #undef DMA_K
  #undef BLOAD
  #undef DMA_V
  #undef CMASK
  #undef START
  #undef RESC
  #undef ROT
}
constexpr int ATTN_LDS_BYTES=LDS_BYTES;
struct AttnTensors { const bf16* Q; const bf16* K; const bf16* V; bf16* O; const float* F; };
struct AttnUnit { int bh; int qb; };
struct StaticOrder {
  int vcu;
  __device__ __forceinline__ explicit StaticOrder(int grid,int block):vcu((block%8)*(grid/8)+block/8){}
  __device__ __forceinline__ bool next(int i,AttnUnit&u)const{ if(i>=2)return false; const int s=vcu&31; u.bh=vcu>>5; u.qb=(i==0)?63-s:s; return true; }
  __device__ __forceinline__ void a_ready(const AttnUnit&)const{}
  __device__ __forceinline__ void done(const AttnUnit&)const{}
};
template<class Sched,int THRL=8> __device__ __forceinline__ void attn_phase(char*lds,const AttnTensors&T,const Sched&S,int wv){
  AttnUnit u;
  for(int i=0;S.next(i,u);++i){ S.a_ready(u); attn_unit<THRL>(u.bh/NHEAD,u.bh%NHEAD,u.qb,T.Q,T.K,T.V,T.O,T.F+(size_t)(u.bh%NHEAD)*SEQ,lds,wv); S.done(u); }
}
#undef SBAR
#undef WAIT_BAR
}
#define GAS __attribute__((address_space(1)))
#define LAS __attribute__((address_space(3)))
typedef unsigned short bf16;
typedef unsigned v4u __attribute__((ext_vector_type(4)));
typedef unsigned v2u __attribute__((ext_vector_type(2)));
typedef float f32x4 __attribute__((ext_vector_type(4)));
typedef float f32x16 __attribute__((ext_vector_type(16)));
typedef short bf16x8 __attribute__((ext_vector_type(8)));
typedef short s16x4 __attribute__((ext_vector_type(4)));

constexpr int NWAVES = 8;
constexpr int S_ = 16384, DM_ = 1024, DIN_ = 6680, FF_ = 4096, NMEM_ = 256;
constexpr float EPS_ = 1e-6f;
constexpr float LOG2E_ = 1.4426950408889634f;
constexpr size_t MiB = 1u << 20;
constexpr size_t WS_WIN = 1 * MiB;
constexpr size_t WS_WGLAO = 17 * MiB, WS_WFOXO = 18 * MiB, WS_WMEMO = 19 * MiB;
constexpr size_t WS_WOUT = 20 * MiB;
constexpr size_t WS_WFF1 = 22 * MiB;
constexpr size_t WS_WFF2 = 30 * MiB;
constexpr size_t WS_GA = 38 * MiB;
constexpr size_t WS_LOGF = 39 * MiB;
constexpr size_t WS_F = 39 * MiB + 512 * 1024;
constexpr size_t WS_MK = 40 * MiB;
constexpr size_t WS_MVT = 40 * MiB + 256 * 1024;
constexpr size_t WS_DEC = 40 * MiB + 512 * 1024;
constexpr size_t WS_MEMN = 40 * MiB + 768 * 1024;
constexpr size_t WS_GQ = 42 * MiB, WS_GK = 50 * MiB, WS_GV = 58 * MiB;
constexpr size_t WS_MG = 42 * MiB;
constexpr size_t WS_GG = 74 * MiB, WS_FQ = 90 * MiB;
constexpr size_t WS_U2 = 74 * MiB;
constexpr size_t WS_MQ = 106 * MiB, WS_FK = 122 * MiB, WS_FV = 138 * MiB;
constexpr size_t WS_GT = 154 * MiB;
constexpr size_t WS_HID = 122 * MiB;
constexpr size_t WS_SS1 = 250 * MiB, WS_SS2 = 251 * MiB;
constexpr size_t WS_END = 252 * MiB;
constexpr size_t OUT_U = 0, OUT_STATE = 32 * MiB;

constexpr int LDS_BYTES = 155648;

#define LDS_WAIT() asm volatile("s_waitcnt lgkmcnt(0)" ::: "memory")
__device__ __forceinline__ unsigned f2bf(float f) { unsigned u = __builtin_bit_cast(unsigned, f); return (u + 0x7fffu + ((u >> 16) & 1u)) >> 16; }
__device__ __forceinline__ unsigned pk2(float lo, float hi) { return f2bf(lo) | (f2bf(hi) << 16); }
__device__ __forceinline__ float bf2f(unsigned b) { return __builtin_bit_cast(float, (b & 0xffffu) << 16); }
__device__ __forceinline__ float bflo(unsigned w) { return __builtin_bit_cast(float, w << 16); }
__device__ __forceinline__ float bfhi(unsigned w) { return __builtin_bit_cast(float, w & 0xffff0000u); }
__device__ __forceinline__ float sigmoidf_(float x) { return __builtin_amdgcn_rcpf(1.f + __expf(-x)); }
__device__ __forceinline__ float logsigmoidf_(float z) { return -(fmaxf(-z, 0.f) + log1pf(__expf(-fabsf(z)))); }
__device__ __forceinline__ int crow_(int r, int hi) { return (r & 3) + 8 * (r >> 2) + 4 * hi; }
__device__ __forceinline__ float wave_sum(float v) {
#pragma unroll
    for (int o = 1; o < 64; o <<= 1) v += __shfl_xor(v, o);
    return v;
}
#define MFMA32(a, b, c) __builtin_amdgcn_mfma_f32_32x32x16_bf16((a), (b), (c), 0, 0, 0)
__device__ __forceinline__ bf16x8 ldfrag(const LAS unsigned char* base, int row, int pitchB, int kbyte) { return *(const LAS bf16x8*)(base + row * pitchB + kbyte); }

struct Ptrs {
    const float *x, *mem, *g_mix, *w_in, *w_alpha_up, *b_alpha, *b_forget, *g_gla_head, *g_mem, *w_mem_kv, *w_gla_o, *w_fox_o, *w_mem_o, *w_out, *g_ffn, *w_ff1, *w_ff2, *g_final;
    float* out; unsigned char* ws;
};

__device__ __forceinline__ void p0_transpose_item(const float* W, int ldw, int srccol0, int k0, bf16* WT, int ldt, int dstrow0, LAS float* scr, int lane) {
#pragma unroll 8
    for (int i = 0; i < 32; ++i) { const int kk = 2 * i + (lane >> 5); scr[kk * 33 + (lane & 31)] = W[(size_t)(k0 + kk) * ldw + srccol0 + (lane & 31)]; }
    LDS_WAIT(); asm volatile("" ::: "memory");
    const int c = lane & 7;
#pragma unroll
    for (int j = 0; j < 4; ++j) { const int n = (lane >> 3) + 8 * j; const LAS float* s = scr + (8 * c) * 33 + n;
        v4u o; o.x = pk2(s[0 * 33], s[1 * 33]); o.y = pk2(s[2 * 33], s[3 * 33]); o.z = pk2(s[4 * 33], s[5 * 33]); o.w = pk2(s[6 * 33], s[7 * 33]);
        *(v4u*)(WT + (size_t)(dstrow0 + n) * ldt + k0 + 8 * c) = o; }
    LDS_WAIT(); asm volatile("" ::: "memory");
}
__device__ __forceinline__ void rms_row_to_bf16(const float* xrow, const float* gain, bf16* orow, int lane) {
    const f32x4* xr = (const f32x4*)xrow + lane; const f32x4* gr = (const f32x4*)gain + lane;
    f32x4 v[4]; float s = 0.f;
#pragma unroll
    for (int j = 0; j < 4; ++j) { v[j] = xr[64 * j]; s += (v[j].x * v[j].x + v[j].y * v[j].y) + (v[j].z * v[j].z + v[j].w * v[j].w); }
    const float r = rsqrtf(wave_sum(s) * (1.f / 1024.f) + EPS_);
    unsigned long long* o8 = (unsigned long long*)orow + lane;
#pragma unroll
    for (int j = 0; j < 4; ++j) { const f32x4 g = gr[64 * j]; o8[64 * j] = (unsigned long long)pk2(v[j].x * r * g.x, v[j].y * r * g.y) | ((unsigned long long)pk2(v[j].z * r * g.z, v[j].w * r * g.w) << 32); }
}
__device__ __forceinline__ void p0_prologue(const Ptrs& P, LAS unsigned char* lds, int vcu, int G, int wv) {
    const int tid = fresh_tid(wv), lane = tid & 63, wave = wv;
    LAS float* scr = (LAS float*)(lds + wave * 16384);
    const int gw = vcu * NWAVES + wave, NGW = G * NWAVES;
    bf16* WIN = (bf16*)(P.ws + WS_WIN);
    constexpr int I_IN = 16 * 208, I_KV = 16 * 32, I_GO = 8 * 32, I_WO = 16 * 32, I_F1 = 16 * 128, I_F2 = 64 * 32;
    constexpr int NITEMS = I_IN + I_KV + 3 * I_GO + I_WO + I_F1 + I_F2;
    for (int it = gw; it < NITEMS; it += NGW) {
        int r = it;
        if (r < I_IN) { const int kb = r / 208, nb = r % 208, d0 = 32 * nb; const int src = d0 < 1536 ? d0 : (d0 < 3072 ? d0 + 16 : d0 + 24);
            p0_transpose_item(P.w_in, DIN_, src, 64 * kb, WIN, 1024, d0, scr, lane); continue; } r -= I_IN;
        if (r < I_KV) { const int kb = r / 32, nb = r % 32; p0_transpose_item(P.w_mem_kv, 1024, 32 * nb, 64 * kb, WIN, 1024, 6912 + 32 * nb, scr, lane); continue; } r -= I_KV;
        if (r < I_GO) { const int kb = r / 32, nb = r % 32; p0_transpose_item(P.w_gla_o, 1024, 32 * nb, 64 * kb, (bf16*)(P.ws + WS_WGLAO), 512, 32 * nb, scr, lane); continue; } r -= I_GO;
        if (r < I_GO) { const int kb = r / 32, nb = r % 32; p0_transpose_item(P.w_fox_o, 1024, 32 * nb, 64 * kb, (bf16*)(P.ws + WS_WFOXO), 512, 32 * nb, scr, lane); continue; } r -= I_GO;
        if (r < I_GO) { const int kb = r / 32, nb = r % 32; p0_transpose_item(P.w_mem_o, 1024, 32 * nb, 64 * kb, (bf16*)(P.ws + WS_WMEMO), 512, 32 * nb, scr, lane); continue; } r -= I_GO;
        if (r < I_WO) { const int kb = r / 32, nb = r % 32; p0_transpose_item(P.w_out, 1024, 32 * nb, 64 * kb, (bf16*)(P.ws + WS_WOUT), 1024, 32 * nb, scr, lane); continue; } r -= I_WO;
        if (r < I_F1) { const int kb = r / 128, nb = r % 128; p0_transpose_item(P.w_ff1, FF_, 32 * nb, 64 * kb, (bf16*)(P.ws + WS_WFF1), 1024, 32 * nb, scr, lane); continue; } r -= I_F1;
        { const int kb = r / 32, nb = r % 32; p0_transpose_item(P.w_ff2, 1024, 32 * nb, 64 * kb, (bf16*)(P.ws + WS_WFF2), FF_, 32 * nb, scr, lane); }
    }
    for (int idx = vcu * 512 + tid; idx < 256 * 128; idx += G * 512) {
        const int row = idx >> 7, kc = idx & 127; const int src = row < 16 ? 1536 + row : (row < 24 ? 3088 + (row - 16) : -1);
        v4u o = (v4u){0u, 0u, 0u, 0u};
        if (src >= 0) { const float* wp = P.w_in + (size_t)(8 * kc) * DIN_ + src;
            o.x = pk2(wp[0], wp[DIN_]); o.y = pk2(wp[2 * DIN_], wp[3 * DIN_]); o.z = pk2(wp[4 * DIN_], wp[5 * DIN_]); o.w = pk2(wp[6 * DIN_], wp[7 * DIN_]); }
        *(v4u*)(WIN + (size_t)(6656 + row) * 1024 + 8 * kc) = o;
    }
    bf16* U = (bf16*)((unsigned char*)P.out + OUT_U); bf16* MEMN = (bf16*)(P.ws + WS_MEMN);
    for (int m = gw; m < S_ + NMEM_; m += NGW) {
        if (m < S_) rms_row_to_bf16(P.x + (size_t)m * DM_, P.g_mix, U + (size_t)m * DM_, lane);
        else rms_row_to_bf16(P.mem + (size_t)(m - S_) * DM_, P.g_mem, MEMN + (size_t)(m - S_) * DM_, lane);
    }
}

struct GemmSched {
    const char* A; const char* B; int nM, nN, lda, ldb, G, c, wv;
    __device__ __forceinline__ bool next(int i, pg8::Unit& u) const { const long L = (long)i * G + c; if (L >= nM * nN) return false; pg8::map_tile((int)L, nM, nN, u.pm, u.pn); u.z = 0; return true; }
    __device__ __forceinline__ const char* aptr(const pg8::Unit& u) const { return A + (size_t)u.pm * 256 * lda * 2; }
    __device__ __forceinline__ const char* bptr(const pg8::Unit& u) const { return B + (size_t)u.pn * 256 * ldb * 2; }
    __device__ __forceinline__ void a_ready(const pg8::Unit&) const {}
    __device__ __forceinline__ void done(const pg8::Unit&) const {}
};
struct ProjSched {
    const char* U; const char* MEMN; const char* W; int G, c, wv;
    __device__ __forceinline__ bool next(int i, pg8::Unit& u) const { const int L = i * G + c; u.z = 0;
        if (L < 1728) { pg8::map_tile(L, 64, 27, u.pm, u.pn); return true; }
        if (L < 1732) { u.pm = 64; u.pn = 27 + (L - 1728); return true; } return false; }
    __device__ __forceinline__ const char* aptr(const pg8::Unit& u) const { return u.pm < 64 ? U + (size_t)u.pm * (256 * 1024 * 2) : MEMN; }
    __device__ __forceinline__ const char* bptr(const pg8::Unit& u) const { return W + (size_t)u.pn * (256 * 1024 * 2); }
    __device__ __forceinline__ void a_ready(const pg8::Unit&) const {}
    __device__ __forceinline__ void done(const pg8::Unit&) const {}
};
struct MergeSched {
    const char *A0, *B0; int G, c, wv;
    __device__ __forceinline__ bool next(int i, pg8::Unit& u) const { const int T = c + G * (i / 3); if (T >= 256) return false; pg8::map_tile(T, 64, 4, u.pm, u.pn); u.z = i % 3; return true; }
    __device__ __forceinline__ const char* aptr(const pg8::Unit& u) const { return A0 + (size_t)u.z * (16 * MiB) + (size_t)u.pm * (256 * 512 * 2); }
    __device__ __forceinline__ const char* bptr(const pg8::Unit& u) const { return B0 + (size_t)u.z * MiB + (size_t)u.pn * (256 * 512 * 2); }
    __device__ __forceinline__ void a_ready(const pg8::Unit&) const {}
    __device__ __forceinline__ void done(const pg8::Unit&) const {}
};
typedef pg8::f32x4 accv;
__device__ __forceinline__ void store_bf16_tile(const accv (&acc)[2][2][4][2], bf16* base, int ldc, int row0, int col0, float sc, bool sig) {
#pragma unroll
    for (int ai = 0; ai < 2; ++ai)
#pragma unroll
        for (int m = 0; m < 4; ++m) { bf16* rowp = base + (size_t)(row0 + ai * 128 + m * 16) * ldc + col0;
#pragma unroll
            for (int bj = 0; bj < 2; ++bj) { accv v0 = acc[ai][bj][m][0] * sc, v1 = acc[ai][bj][m][1] * sc;
                if (sig) { v0 = (accv){sigmoidf_(v0[0]), sigmoidf_(v0[1]), sigmoidf_(v0[2]), sigmoidf_(v0[3])}; v1 = (accv){sigmoidf_(v1[0]), sigmoidf_(v1[1]), sigmoidf_(v1[2]), sigmoidf_(v1[3])}; }
                v4u w; w.x = pg8::cvt_pk_bf16(v0[0], v0[1]); w.y = pg8::cvt_pk_bf16(v0[2], v0[3]); w.z = pg8::cvt_pk_bf16(v1[0], v1[1]); w.w = pg8::cvt_pk_bf16(v1[2], v1[3]);
                *(v4u*)(rowp + bj * 128) = w; } }
}
struct EpiProj {
    static constexpr bool PERM = true, AFTER_DRAIN = false;
    unsigned char* ws; const float* b_forget;
    __device__ __forceinline__ void operator()(const accv (&acc)[2][2][4][2], const pg8::Unit& u, int wr, int wc, int fr, int fq) const {
        const int pn = u.pn;
        if (pn != 26) {
            size_t off; int ldc, colt, prow = u.pm * 256; float sc = 1.f; bool sig = false;
            if (pn == 0) { off = WS_GQ; ldc = 256; colt = 0; sc = 0.125f; }
            else if (pn == 1) { off = WS_GK; ldc = 256; colt = 0; }
            else if (pn < 4) { off = WS_GV; ldc = 512; colt = (pn - 2) * 256; }
            else if (pn < 6) { off = WS_GG; ldc = 512; colt = (pn - 4) * 256; }
            else if (pn < 8) { off = WS_FQ; ldc = 512; colt = (pn - 6) * 256; sc = 0.125f * LOG2E_; }
            else if (pn < 10) { off = WS_FK; ldc = 512; colt = (pn - 8) * 256; }
            else if (pn < 12) { off = WS_FV; ldc = 512; colt = (pn - 10) * 256; }
            else if (pn < 14) { off = WS_MQ; ldc = 512; colt = (pn - 12) * 256; sc = 0.08838834764831845f * LOG2E_; }
            else if (pn < 26) { off = WS_GT; ldc = 3072; colt = (pn - 14) * 256; sig = true; }
            else if (pn < 29) { off = WS_MK; ldc = 512; colt = (pn - 27) * 256; prow = 0; }
            else { off = WS_MVT; ldc = 512; colt = (pn - 29) * 256; prow = 0; }
            store_bf16_tile(acc, (bf16*)(ws + off), ldc, prow + wr * 64 + fr, colt + wc * 32 + 8 * fq, sc, sig);
        } else {
            if (wc == 0 && fq < 3) {
                float* GA = (float*)(ws + WS_GA); float* LF = (float*)(ws + WS_LOGF);
                accv bf0 = (accv){0.f, 0.f, 0.f, 0.f}, bf1 = bf0;
                if (fq == 2) { bf0 = *(const accv*)(b_forget); bf1 = *(const accv*)(b_forget + 4); }
#pragma unroll
                for (int ai = 0; ai < 2; ++ai)
#pragma unroll
                    for (int m = 0; m < 4; ++m) { const size_t row = (size_t)(u.pm * 256 + wr * 64 + fr + ai * 128 + m * 16);
                        const accv v0 = acc[ai][0][m][0], v1 = acc[ai][0][m][1];
                        if (fq < 2) { *(accv*)(GA + row * 16 + 8 * fq) = v0; *(accv*)(GA + row * 16 + 8 * fq + 4) = v1; }
                        else { const accv a = v0 + bf0, b = v1 + bf1;
                            *(accv*)(LF + row * 8) = (accv){logsigmoidf_(a[0]), logsigmoidf_(a[1]), logsigmoidf_(a[2]), logsigmoidf_(a[3])};
                            *(accv*)(LF + row * 8 + 4) = (accv){logsigmoidf_(b[0]), logsigmoidf_(b[1]), logsigmoidf_(b[2]), logsigmoidf_(b[3])}; } }
            }
        }
    }
};
struct EpiMerge {
    static constexpr bool PERM = true, AFTER_DRAIN = false;
    bf16* MG; const bf16* GT;
    __device__ __forceinline__ void operator()(const accv (&acc)[2][2][4][2], const pg8::Unit& u, int wr, int wc, int fr, int fq) const {
        const int row0 = u.pm * 256 + wr * 64 + fr, col0 = u.pn * 256 + wc * 32 + 8 * fq;
#pragma unroll
        for (int ai = 0; ai < 2; ++ai)
#pragma unroll
            for (int m = 0; m < 4; ++m) { const size_t row = (size_t)(row0 + ai * 128 + m * 16);
#pragma unroll
                for (int bj = 0; bj < 2; ++bj) { const int col = col0 + bj * 128;
                    const v4u g = *(const v4u*)(GT + row * 3072 + u.z * 1024 + col);
                    accv v0 = acc[ai][bj][m][0], v1 = acc[ai][bj][m][1];
                    v0 = v0 * (accv){bflo(g.x), bfhi(g.x), bflo(g.y), bfhi(g.y)}; v1 = v1 * (accv){bflo(g.z), bfhi(g.z), bflo(g.w), bfhi(g.w)};
                    if (u.z > 0) { const v4u o = *(const v4u*)(MG + row * 1024 + col); v0 = v0 + (accv){bflo(o.x), bfhi(o.x), bflo(o.y), bfhi(o.y)}; v1 = v1 + (accv){bflo(o.z), bfhi(o.z), bflo(o.w), bfhi(o.w)}; }
                    v4u w; w.x = pg8::cvt_pk_bf16(v0[0], v0[1]); w.y = pg8::cvt_pk_bf16(v0[2], v0[3]); w.z = pg8::cvt_pk_bf16(v1[0], v1[1]); w.w = pg8::cvt_pk_bf16(v1[2], v1[3]);
                    *(v4u*)(MG + row * 1024 + col) = w; } }
    }
};
template <bool WRITE_U2> struct EpiResid {
    static constexpr bool PERM = true, AFTER_DRAIN = false;
    const float* base; float* H; bf16* U2; const float* gain; float* SS;
    __device__ __forceinline__ void operator()(const accv (&acc)[2][2][4][2], const pg8::Unit& u, int wr, int wc, int fr, int fq) const {
        const int row0 = u.pm * 256 + wr * 64 + fr, col0 = u.pn * 256 + wc * 32 + 8 * fq;
#pragma unroll
        for (int ai = 0; ai < 2; ++ai)
#pragma unroll
            for (int m = 0; m < 4; ++m) { const size_t row = (size_t)(row0 + ai * 128 + m * 16); float ssq = 0.f;
#pragma unroll
                for (int bj = 0; bj < 2; ++bj) { const int col = col0 + bj * 128; const size_t o = row * 1024 + col;
                    const accv h0 = *(const accv*)(base + o) + acc[ai][bj][m][0], h1 = *(const accv*)(base + o + 4) + acc[ai][bj][m][1];
                    *(accv*)(H + o) = h0; *(accv*)(H + o + 4) = h1;
                    ssq += (h0[0] * h0[0] + h0[1] * h0[1]) + (h0[2] * h0[2] + h0[3] * h0[3]) + (h1[0] * h1[0] + h1[1] * h1[1]) + (h1[2] * h1[2] + h1[3] * h1[3]);
                    if (WRITE_U2) { const accv g0 = *(const accv*)(gain + col), g1 = *(const accv*)(gain + col + 4); const accv a = h0 * g0, b = h1 * g1;
                        v4u w; w.x = pg8::cvt_pk_bf16(a[0], a[1]); w.y = pg8::cvt_pk_bf16(a[2], a[3]); w.z = pg8::cvt_pk_bf16(b[0], b[1]); w.w = pg8::cvt_pk_bf16(b[2], b[3]);
                        *(v4u*)(U2 + o) = w; } }
                ssq += __shfl_xor(ssq, 16); ssq += __shfl_xor(ssq, 32);
                if (fq == 0) SS[row * 16 + u.pn * 4 + wc] = ssq; }
    }
};
struct EpiFfn1 {
    static constexpr bool PERM = true, AFTER_DRAIN = false;
    bf16* HID; const float* SS;
    __device__ __forceinline__ void operator()(const accv (&acc)[2][2][4][2], const pg8::Unit& u, int wr, int wc, int fr, int fq) const {
        const int row0 = u.pm * 256 + wr * 64 + fr, col0 = u.pn * 256 + wc * 32 + 8 * fq;
#pragma unroll
        for (int ai = 0; ai < 2; ++ai)
#pragma unroll
            for (int m = 0; m < 4; ++m) { const size_t row = (size_t)(row0 + ai * 128 + m * 16);
                const accv s0 = *(const accv*)(SS + row * 16), s1 = *(const accv*)(SS + row * 16 + 4), s2 = *(const accv*)(SS + row * 16 + 8), s3 = *(const accv*)(SS + row * 16 + 12);
                const float tot = ((s0[0] + s0[1]) + (s0[2] + s0[3])) + ((s1[0] + s1[1]) + (s1[2] + s1[3])) + ((s2[0] + s2[1]) + (s2[2] + s2[3])) + ((s3[0] + s3[1]) + (s3[2] + s3[3]));
                const float r = rsqrtf(tot * (1.f / 1024.f) + EPS_);
#pragma unroll
                for (int bj = 0; bj < 2; ++bj) { accv v0 = acc[ai][bj][m][0] * r, v1 = acc[ai][bj][m][1] * r;
#pragma unroll
                    for (int j = 0; j < 4; ++j) { const float a = fmaxf(v0[j], 0.f), b = fmaxf(v1[j], 0.f); v0[j] = a * a; v1[j] = b * b; }
                    v4u w; w.x = pg8::cvt_pk_bf16(v0[0], v0[1]); w.y = pg8::cvt_pk_bf16(v0[2], v0[3]); w.z = pg8::cvt_pk_bf16(v1[0], v1[1]); w.w = pg8::cvt_pk_bf16(v1[2], v1[3]);
                    *(v4u*)(HID + row * 4096 + col0 + bj * 128) = w; } }
    }
};

constexpr int GP = 144;
__device__ __forceinline__ void gla_a_unit(const Ptrs& P, LAS unsigned char* lds, int n, int h, int wv) {
    const int tid = fresh_tid(wv), lane = tid & 63, g = wv, r32 = lane & 31, hh = lane >> 5;
    LAS unsigned char* QP = lds; LAS unsigned char* QN = lds + 9216; LAS unsigned char* KN = lds + 18432; LAS unsigned char* KP = lds + 27648;
    LAS unsigned char* KLT = lds + 36864; LAS unsigned char* AT = lds + 46080; LAS unsigned char* VT = lds + 55296; LAS float* TOT = (LAS float*)(lds + 73728);
    bf16* GQ = (bf16*)(P.ws + WS_GQ); const bf16* GK = (const bf16*)(P.ws + WS_GK); bf16* GV = (bf16*)(P.ws + WS_GV);
    const float* GA = (const float*)(P.ws + WS_GA); float* DEC = (float*)(P.ws + WS_DEC); float* STATE = (float*)((unsigned char*)P.out + OUT_STATE);
    const int c = h * 64 + lane, t0 = n * 64;
    float wup[16];
#pragma unroll
    for (int j = 0; j < 16; ++j) wup[j] = P.w_alpha_up[j * 256 + c];
    const float ba = P.b_alpha[c];
    float bl[8]; float run = 0.f;
#pragma unroll
    for (int i = 0; i < 8; ++i) { const f32x4* gar = (const f32x4*)(GA + (size_t)(t0 + 8 * g + i) * 16); float z = ba;
#pragma unroll
        for (int j4 = 0; j4 < 4; ++j4) { const f32x4 a = gar[j4]; z += a[0] * wup[4 * j4] + a[1] * wup[4 * j4 + 1] + a[2] * wup[4 * j4 + 2] + a[3] * wup[4 * j4 + 3]; }
        run += logsigmoidf_(z) * (1.f / 16.f); bl[i] = run; }
    TOT[g * 64 + lane] = run;
    { const int s = tid >> 3, vc = tid & 7; const v4u a = *(const v4u*)(GV + (size_t)(t0 + s) * 512 + h * 128 + vc * 16), b = *(const v4u*)(GV + (size_t)(t0 + s) * 512 + h * 128 + vc * 16 + 8);
      LAS bf16* vt = (LAS bf16*)VT; const unsigned w[8] = {a.x, a.y, a.z, a.w, b.x, b.y, b.z, b.w};
#pragma unroll
      for (int j = 0; j < 8; ++j) { vt[(vc * 16 + 2 * j) * 72 + s] = (bf16)(w[j] & 0xffffu); vt[(vc * 16 + 2 * j + 1) * 72 + s] = (bf16)(w[j] >> 16); } }
    __syncthreads();
    float off = 0.f, blast = 0.f;
#pragma unroll
    for (int gg = 0; gg < 8; ++gg) { const float tv = TOT[gg * 64 + lane]; if (gg < g) off += tv; blast += tv; }
    unsigned kl[8];
#pragma unroll
    for (int i = 0; i < 8; ++i) { const int t = 8 * g + i; const float b = off + bl[i]; const size_t gi = (size_t)(t0 + t) * 256 + c;
        const float q = bf2f(GQ[gi]), k = bf2f(GK[gi]); const float ep = __expf(b), en = __expf(-b), el = __expf(blast - b);
        const unsigned qp = f2bf(q * ep); GQ[gi] = (bf16)qp;
        ((LAS bf16*)QP)[t * 72 + lane] = (bf16)qp; ((LAS bf16*)QN)[t * 72 + lane] = (bf16)f2bf(q * en);
        ((LAS bf16*)KN)[t * 72 + lane] = (bf16)f2bf(k * en); ((LAS bf16*)KP)[t * 72 + lane] = (bf16)f2bf(k * ep); kl[i] = f2bf(k * el); }
    *(LAS v4u*)(KLT + lane * GP + 16 * g) = (v4u){kl[0] | (kl[1] << 16), kl[2] | (kl[3] << 16), kl[4] | (kl[5] << 16), kl[6] | (kl[7] << 16)};
    if (g == 0) DEC[(n * 4 + h) * 64 + lane] = __expf(blast);
    __syncthreads();
    const f32x16 zero = {};
    if (g < 4) {
        const int ti = g >> 1, si = g & 1; f32x16 ac = zero, an = zero;
        if (ti >= si) {
#pragma unroll
            for (int ks = 0; ks < 4; ++ks) ac = MFMA32(ldfrag(QP, 32 * ti + r32, GP, 32 * ks + 16 * hh), ldfrag(KN, 32 * si + r32, GP, 32 * ks + 16 * hh), ac); }
        if (ti <= si) {
#pragma unroll
            for (int ks = 0; ks < 4; ++ks) an = MFMA32(ldfrag(QN, 32 * ti + r32, GP, 32 * ks + 16 * hh), ldfrag(KP, 32 * si + r32, GP, 32 * ks + 16 * hh), an); }
#pragma unroll
        for (int i = 0; i < 16; ++i) { const int t = 32 * ti + crow_(i, hh), s = 32 * si + r32; ((LAS bf16*)AT)[t * 72 + s] = (bf16)f2bf(t >= s ? ac[i] : an[i]); }
    } else {
        const int vi = g - 4;
#pragma unroll
        for (int dj = 0; dj < 2; ++dj) { f32x16 st = zero;
#pragma unroll
            for (int ks = 0; ks < 4; ++ks) st = MFMA32(ldfrag(VT, 32 * vi + r32, GP, 32 * ks + 16 * hh), ldfrag(KLT, 32 * dj + r32, GP, 32 * ks + 16 * hh), st);
#pragma unroll
            for (int i = 0; i < 16; ++i) STATE[((size_t)(n * 4 + h) * 128 + 32 * vi + crow_(i, hh)) * 64 + 32 * dj + r32] = st[i]; }
    }
    __syncthreads();
    { const int ti = g >> 2, vj = g & 3; f32x16 oi = zero;
#pragma unroll
      for (int ks = 0; ks < 4; ++ks) oi = MFMA32(ldfrag(AT, 32 * ti + r32, GP, 32 * ks + 16 * hh), ldfrag(VT, 32 * vj + r32, GP, 32 * ks + 16 * hh), oi);
#pragma unroll
      for (int i = 0; i < 16; ++i) GV[(size_t)(t0 + 32 * ti + crow_(i, hh)) * 512 + h * 128 + 32 * vj + r32] = (bf16)f2bf(oi[i]); }
    __syncthreads();
}
__device__ __forceinline__ void gla_scan_unit(const Ptrs& P, LAS unsigned char* lds, int u, int wv) {
    const int tid = fresh_tid(wv), lane = tid & 63, w = wv;
    const int h = u >> 7, v = u & 127;
    float* STATE = (float*)((unsigned char*)P.out + OUT_STATE); const float* DEC = (const float*)(P.ws + WS_DEC);
    LAS float* segS = (LAS float*)lds; LAS float* segP = (LAS float*)(lds + 2048);
    float kv[32], dc[32];
#pragma unroll
    for (int i = 0; i < 32; ++i) { const int n = 32 * w + i; kv[i] = STATE[((size_t)(n * 4 + h) * 128 + v) * 64 + lane]; dc[i] = DEC[(n * 4 + h) * 64 + lane]; }
    float s = 0.f, pr = 1.f;
#pragma unroll
    for (int i = 0; i < 32; ++i) { const float pv = s; s = s * dc[i] + kv[i]; kv[i] = pv; pr *= dc[i]; }
    segS[w * 64 + lane] = s; segP[w * 64 + lane] = pr;
    __syncthreads();
    float sin_ = 0.f;
#pragma unroll
    for (int ww = 0; ww < 8; ++ww) { const float a = segS[ww * 64 + lane], b = segP[ww * 64 + lane]; if (ww < w) sin_ = sin_ * b + a; }
    float cp = 1.f;
#pragma unroll
    for (int i = 0; i < 32; ++i) { const int n = 32 * w + i; STATE[((size_t)(n * 4 + h) * 128 + v) * 64 + lane] = kv[i] + cp * sin_; cp *= dc[i]; }
    __syncthreads();
}
__device__ __forceinline__ void gla_b_unit(const Ptrs& P, LAS unsigned char* lds, int n, int h, int wv) {
    const int tid = fresh_tid(wv), lane = tid & 63, g = wv, r32 = lane & 31, hh = lane >> 5;
    LAS unsigned char* QP = lds; LAS unsigned char* PT = lds + 9216; LAS float* SSQ = (LAS float*)(lds + 27648);
    const bf16* GQ = (const bf16*)(P.ws + WS_GQ); const bf16* GV = (const bf16*)(P.ws + WS_GV); bf16* GG = (bf16*)(P.ws + WS_GG);
    const float* STATE = (const float*)((unsigned char*)P.out + OUT_STATE);
    const int t0 = n * 64;
    { const int t = tid >> 3, c8 = tid & 7; *(LAS v4u*)(QP + t * GP + 16 * c8) = *(const v4u*)(GQ + (size_t)(t0 + t) * 256 + h * 64 + 8 * c8); }
    { const int v = tid >> 2, d16 = (tid & 3) * 16; const f32x4* sp = (const f32x4*)(STATE + ((size_t)(n * 4 + h) * 128 + v) * 64 + d16);
      const f32x4 a = sp[0], b = sp[1], c = sp[2], d = sp[3];
      *(LAS v4u*)(PT + v * GP + d16 * 2) = (v4u){pk2(a[0], a[1]), pk2(a[2], a[3]), pk2(b[0], b[1]), pk2(b[2], b[3])};
      *(LAS v4u*)(PT + v * GP + d16 * 2 + 16) = (v4u){pk2(c[0], c[1]), pk2(c[2], c[3]), pk2(d[0], d[1]), pk2(d[2], d[3])}; }
    __syncthreads();
    const int ti = g >> 2, vj = g & 3; f32x16 o = {};
#pragma unroll
    for (int ks = 0; ks < 4; ++ks) o = MFMA32(ldfrag(QP, 32 * ti + r32, GP, 32 * ks + 16 * hh), ldfrag(PT, 32 * vj + r32, GP, 32 * ks + 16 * hh), o);
    const int vcol = h * 128 + 32 * vj + r32;
#pragma unroll
    for (int i = 0; i < 16; ++i) { const int t = 32 * ti + crow_(i, hh); o[i] += bf2f(GV[(size_t)(t0 + t) * 512 + vcol]);
        float q = o[i] * o[i]; q += __shfl_xor(q, 1); q += __shfl_xor(q, 2); q += __shfl_xor(q, 4); q += __shfl_xor(q, 8); q += __shfl_xor(q, 16);
        if (r32 == 0) SSQ[t * 4 + vj] = q; }
    __syncthreads();
    const float gain = P.g_gla_head[vcol];
#pragma unroll
    for (int i = 0; i < 16; ++i) { const int t = 32 * ti + crow_(i, hh); const LAS f32x4* sq = (const LAS f32x4*)(SSQ + t * 4); const f32x4 s4 = sq[0];
        const float r = rsqrtf(((s4[0] + s4[1]) + (s4[2] + s4[3])) * (1.f / 128.f) + EPS_);
        const size_t gi = (size_t)(t0 + t) * 512 + vcol; const float gg = bf2f(GG[gi]);
        GG[gi] = (bf16)f2bf(o[i] * r * gain * (gg * sigmoidf_(gg))); }
    __syncthreads();
}
__device__ __forceinline__ void memattn_unit(const Ptrs& P, LAS unsigned char* lds, int hm, int qb, int wv) {
    const int tid = fresh_tid(wv), lane = tid & 63, w = wv, r32 = lane & 31, hh = lane >> 5;
    constexpr int KPB = 272, VPB = 528;
    LAS unsigned char* KM = lds; LAS unsigned char* VTM = lds + 69632; LAS float* LSUM = (LAS float*)(lds + 137216);
    const bf16* MK = (const bf16*)(P.ws + WS_MK); const bf16* MVT = (const bf16*)(P.ws + WS_MVT); bf16* MQ = (bf16*)(P.ws + WS_MQ);
#pragma unroll
    for (int j = 0; j < 8; ++j) { const int idx = tid + 512 * j; { const int key = idx >> 4, ch = idx & 15; *(LAS v4u*)(KM + key * KPB + ch * 16) = *(const v4u*)(MK + (size_t)key * 512 + hm * 128 + ch * 8); }
        { const int key = idx >> 4, ch = idx & 15; const v4u vv = *(const v4u*)(MVT + (size_t)key * 512 + hm * 128 + ch * 8); const unsigned wv[4] = {vv.x, vv.y, vv.z, vv.w};
#pragma unroll
          for (int e = 0; e < 4; ++e) { *(LAS bf16*)(VTM + (8 * ch + 2 * e) * VPB + key * 2) = (bf16)(wv[e] & 0xffffu); *(LAS bf16*)(VTM + (8 * ch + 2 * e + 1) * VPB + key * 2) = (bf16)(wv[e] >> 16); } } }
    const size_t qrow = (size_t)qb * 256 + 32 * w + r32;
    bf16x8 qr[8];
#pragma unroll
    for (int ks = 0; ks < 8; ++ks) qr[ks] = *(const bf16x8*)(MQ + qrow * 512 + hm * 128 + 16 * ks + 8 * hh);
    __syncthreads();
    f32x16 p[8];
#pragma unroll
    for (int kb = 0; kb < 8; ++kb) { p[kb] = (f32x16){};
#pragma unroll
        for (int ks = 0; ks < 8; ++ks) p[kb] = MFMA32(ldfrag(KM, 32 * kb + r32, KPB, 32 * ks + 16 * hh), qr[ks], p[kb]); }
    float mx = -INFINITY;
#pragma unroll
    for (int kb = 0; kb < 8; ++kb)
#pragma unroll
        for (int i = 0; i < 16; ++i) mx = fmaxf(mx, p[kb][i]);
    mx = fmaxf(mx, __shfl_xor(mx, 32));
    float l = 0.f; v4u pk[8][2];
#pragma unroll
    for (int kb = 0; kb < 8; ++kb) {
#pragma unroll
        for (int i = 0; i < 16; ++i) { p[kb][i] = __builtin_amdgcn_exp2f(p[kb][i] - mx); l += p[kb][i]; }
#pragma unroll
        for (int s = 0; s < 2; ++s) pk[kb][s] = (v4u){pk2(p[kb][8 * s], p[kb][8 * s + 1]), pk2(p[kb][8 * s + 2], p[kb][8 * s + 3]), pk2(p[kb][8 * s + 4], p[kb][8 * s + 5]), pk2(p[kb][8 * s + 6], p[kb][8 * s + 7])}; }
    l += __shfl_xor(l, 32);
    if (hh == 0) LSUM[w * 32 + r32] = l;
    f32x16 o[4];
#pragma unroll
    for (int db = 0; db < 4; ++db) { o[db] = (f32x16){};
#pragma unroll
        for (int kb = 0; kb < 8; ++kb)
#pragma unroll
            for (int s = 0; s < 2; ++s) { const LAS unsigned char* vp = VTM + (32 * db + r32) * VPB + 64 * kb + 32 * s + 8 * hh;
                const s16x4 lo = *(const LAS s16x4*)vp, hi = *(const LAS s16x4*)(vp + 16);
                const bf16x8 bfr = (bf16x8){lo[0], lo[1], lo[2], lo[3], hi[0], hi[1], hi[2], hi[3]};
                o[db] = MFMA32(__builtin_bit_cast(bf16x8, pk[kb][s]), bfr, o[db]); } }
    LDS_WAIT(); asm volatile("" ::: "memory");
#pragma unroll
    for (int i = 0; i < 16; ++i) { const int ql = crow_(i, hh); const float rl = __builtin_amdgcn_rcpf(LSUM[w * 32 + ql]);
#pragma unroll
        for (int db = 0; db < 4; ++db) MQ[((size_t)qb * 256 + 32 * w + ql) * 512 + hm * 128 + 32 * db + r32] = (bf16)f2bf(o[db][i] * rl); }
    __syncthreads();
}
__device__ __forceinline__ void fcumsum_unit(const Ptrs& P, LAS unsigned char* lds, int hf, int wv) {
    const int tid = fresh_tid(wv), lane = tid & 63, w = wv;
    const float* LF = (const float*)(P.ws + WS_LOGF); float* F = (float*)(P.ws + WS_F); LAS float* WT = (LAS float*)lds;
    const int t0 = tid * 32; float loc[32]; float s = 0.f;
#pragma unroll
    for (int i = 0; i < 32; ++i) { s += LF[(size_t)(t0 + i) * 8 + hf]; loc[i] = s; }
    float incl = s;
#pragma unroll
    for (int o = 1; o < 64; o <<= 1) { const float y = __shfl_up(incl, o); if (lane >= o) incl += y; }
    if (lane == 63) WT[w] = incl;
    __syncthreads();
    float woff = 0.f;
#pragma unroll
    for (int ww = 0; ww < 8; ++ww) { const float a = WT[ww]; if (ww < w) woff += a; }
    const float off = woff + incl - s;
#pragma unroll
    for (int i = 0; i < 32; ++i) F[(size_t)hf * S_ + t0 + i] = off + loc[i];
    __syncthreads();
}

struct Args { const float* in[18]; float* out; unsigned char* ws; int ph_lo, ph_hi; };
constexpr int N_PHASES = 10;
__global__ void __launch_bounds__(NWAVES * 64, 2) hybrid_fwd(Args args) {
    extern __shared__ __attribute__((aligned(16))) unsigned char lds_raw[];
    cg::grid_group grid = cg::this_grid();
    LAS unsigned char* lds = (LAS unsigned char*)lds_raw;
    const int wv = __builtin_amdgcn_readfirstlane((int)(threadIdx.x >> 6));
    const int G = gridDim.x, bx = blockIdx.x; const int vcu = (G % 8 == 0) ? (bx % 8) * (G / 8) + bx / 8 : bx;
    Ptrs P;
    P.x = args.in[0]; P.mem = args.in[1]; P.g_mix = args.in[2]; P.w_in = args.in[3]; P.w_alpha_up = args.in[4]; P.b_alpha = args.in[5]; P.b_forget = args.in[6]; P.g_gla_head = args.in[7];
    P.g_mem = args.in[8]; P.w_mem_kv = args.in[9]; P.w_gla_o = args.in[10]; P.w_fox_o = args.in[11]; P.w_mem_o = args.in[12]; P.w_out = args.in[13]; P.g_ffn = args.in[14]; P.w_ff1 = args.in[15];
    P.w_ff2 = args.in[16]; P.g_final = args.in[17]; P.out = args.out; P.ws = args.ws;
    unsigned char* ws = args.ws;
    const int lo = args.ph_lo, hi = args.ph_hi;
#ifndef PH_MASK
#define PH_MASK 0x3ff
#endif
#define IN(k) ((((PH_MASK) >> (k)) & 1) && lo <= (k) && (k) < hi)
#define SEAM(k) do { if (lo <= (k) && (k) + 1 < hi) grid.sync(); } while (0)

    if (IN(0)) { p0_prologue(P, lds, vcu, G, wv); __syncthreads(); }
    SEAM(0);
    if (IN(1)) {
        ProjSched S{(const char*)P.out + OUT_U, (const char*)(ws + WS_MEMN), (const char*)(ws + WS_WIN), G, bx, wv};
        EpiProj E{ws, P.b_forget};
        pg8::gemm_phase<EpiProj, ProjSched, true, true>(lds, 1024, 1024, 1024, S, E);
    }
    SEAM(1);
    if (IN(2)) {
        for (int u = bx; u < 1288; u += G) {
            if (u < 1024) gla_a_unit(P, lds, u >> 2, u & 3, wv);
            else if (u < 1280) memattn_unit(P, lds, (u - 1024) & 3, (u - 1024) >> 2, wv);
            else fcumsum_unit(P, lds, u - 1280, wv);
        }
    }
    SEAM(2);
    if (IN(3)) {
        for (int u = bx; u < 512; u += G) gla_scan_unit(P, lds, u, wv);
        const attn_body::AttnTensors AT{(const attn_body::bf16*)(ws + WS_FQ), (const attn_body::bf16*)(ws + WS_FK), (const attn_body::bf16*)(ws + WS_FV), (attn_body::bf16*)(ws + WS_FQ), (const float*)(ws + WS_F)};
        const attn_body::StaticOrder S(G, bx);
        attn_body::attn_phase<attn_body::StaticOrder>((char*)lds_raw, AT, S, wv);
    }
    SEAM(3);
    if (IN(4)) { for (int u = bx; u < 1024; u += G) gla_b_unit(P, lds, u >> 2, u & 3, wv); }
    SEAM(4);
    if (IN(5)) {
        static_assert(WS_FQ - WS_GG == 16 * MiB && WS_MQ - WS_FQ == 16 * MiB && WS_WFOXO - WS_WGLAO == MiB && WS_WMEMO - WS_WFOXO == MiB, "merge operand spacing");
        MergeSched S{(const char*)(ws + WS_GG), (const char*)(ws + WS_WGLAO), G, bx, wv};
        EpiMerge E{(bf16*)(ws + WS_MG), (const bf16*)(ws + WS_GT)};
        pg8::gemm_phase<EpiMerge, MergeSched, true, true>(lds, 512, 512, 512, S, E);
    }
    SEAM(5);
    if (IN(6)) {
        GemmSched S{(const char*)(ws + WS_MG), (const char*)(ws + WS_WOUT), 64, 4, 1024, 1024, G, bx, wv};
        EpiResid<true> E{P.x, P.out, (bf16*)(ws + WS_U2), P.g_ffn, (float*)(ws + WS_SS1)};
        pg8::gemm_phase<EpiResid<true>, GemmSched, true, true>(lds, 1024, 1024, 1024, S, E);
    }
    SEAM(6);
    if (IN(7)) {
        GemmSched S{(const char*)(ws + WS_U2), (const char*)(ws + WS_WFF1), 64, 16, 1024, 1024, G, bx, wv};
        EpiFfn1 E{(bf16*)(ws + WS_HID), (const float*)(ws + WS_SS1)};
        pg8::gemm_phase<EpiFfn1, GemmSched, true, true>(lds, 1024, 1024, 1024, S, E);
    }
    SEAM(7);
    if (IN(8)) {
        GemmSched S{(const char*)(ws + WS_HID), (const char*)(ws + WS_WFF2), 64, 4, 4096, 4096, G, bx, wv};
        EpiResid<false> E{P.out, P.out, nullptr, nullptr, (float*)(ws + WS_SS2)};
        pg8::gemm_phase<EpiResid<false>, GemmSched, true, true>(lds, 4096, 4096, 4096, S, E);
    }
    SEAM(8);
    if (IN(9)) {
        const float* SS = (const float*)(ws + WS_SS2); const int lane = fresh_tid(wv) & 63, wave = wv;
        for (int m = vcu * NWAVES + wave; m < S_; m += G * NWAVES) {
            const f32x4* sp = (const f32x4*)(SS + (size_t)m * 16); const f32x4 s0 = sp[0], s1 = sp[1], s2 = sp[2], s3 = sp[3];
            const float tot = ((s0[0] + s0[1]) + (s0[2] + s0[3])) + ((s1[0] + s1[1]) + (s1[2] + s1[3])) + ((s2[0] + s2[1]) + (s2[2] + s2[3])) + ((s3[0] + s3[1]) + (s3[2] + s3[3]));
            const float r = rsqrtf(tot * (1.f / 1024.f) + EPS_);
            f32x4* xr = (f32x4*)(P.out + (size_t)m * 1024) + lane; const f32x4* gr = (const f32x4*)P.g_final + lane;
#pragma unroll
            for (int j = 0; j < 4; ++j) { const f32x4 v = xr[64 * j], g = gr[64 * j]; xr[64 * j] = v * r * g; }
        }
    }
#undef IN
#undef SEAM
}

extern "C" void kernel_launch(void* const* d_in, const int* in_sizes, int n_in, void* d_out, int out_size, void* d_ws, size_t ws_size, hipStream_t stream) {
    static int grid = 0;
    if (grid == 0) {
        if (n_in != 18 || out_size != S_ * DM_ || ws_size < WS_END) { fprintf(stderr, "kernel_launch: unexpected shapes (n_in %d out %d ws %zu)\n", n_in, out_size, ws_size); grid = -1; return; }
        int dev = 0, cus = 0, per_cu = 0;
        (void)hipGetDevice(&dev); (void)hipDeviceGetAttribute(&cus, hipDeviceAttributeMultiprocessorCount, dev);
        (void)hipFuncSetAttribute((const void*)hybrid_fwd, hipFuncAttributeMaxDynamicSharedMemorySize, LDS_BYTES);
        (void)hipOccupancyMaxActiveBlocksPerMultiprocessor(&per_cu, (const void*)hybrid_fwd, NWAVES * 64, LDS_BYTES);
        (void)hipGetLastError();
        grid = 256;
        if (cus != 256 || per_cu < 1) fprintf(stderr, "kernel_launch: note: cus %d per_cu %d (built for 256 CUs, one workgroup each)\n", cus, per_cu);
    }
    if (grid < 0) return;
    Args a{};
    for (int i = 0; i < 18; ++i) a.in[i] = (const float*)d_in[i];
    a.out = (float*)d_out; a.ws = (unsigned char*)d_ws;
#ifndef MK_PER_PHASE
    a.ph_lo = 0; a.ph_hi = N_PHASES;
    { void* kargs[] = {&a}; hipError_t e = hipLaunchCooperativeKernel((const void*)hybrid_fwd, dim3(grid), dim3(NWAVES * 64), kargs, LDS_BYTES, stream);
      if (e != hipSuccess) fprintf(stderr, "cooperative launch failed: %s\n", hipGetErrorString(e)); }
#else
    for (int k = 0; k < N_PHASES; ++k) { a.ph_lo = k; a.ph_hi = k + 1; void* kargs[] = {&a};
        hipError_t e = hipLaunchCooperativeKernel((const void*)hybrid_fwd, dim3(grid), dim3(NWAVES * 64), kargs, LDS_BYTES, stream);
        if (e != hipSuccess) { fprintf(stderr, "cooperative launch %d failed: %s\n", k, hipGetErrorString(e)); break; } }
#endif
}
```

```cpp
#include <hip/hip_runtime.h>
#include <hip/hip_cooperative_groups.h>
#include <hip/hip_bf16.h>
#include <cstdio>
#include <cstdint>
#include <cmath>
namespace cg = cooperative_groups;
__device__ __forceinline__ int fresh_tid(int wv) { int lane_; asm volatile("v_mbcnt_lo_u32_b32 %0, -1, 0\n\tv_mbcnt_hi_u32_b32 %0, -1, %0" : "=v"(lane_)); return wv * 64 + lane_; }
namespace pg8 {
#define PG8_LAS __attribute__((address_space(3)))
typedef unsigned short bf16_t;
typedef short bf16x8 __attribute__((ext_vector_type(8)));
typedef float f32x4 __attribute__((ext_vector_type(4)));
typedef unsigned u32x4 __attribute__((ext_vector_type(4)));
constexpr int BM = 256, BK = 64, HALF = 128, HTB = HALF * BK * 2  , STAGE_BYTES = 8 * HTB, NXCD = 8, WGM = 8;

__host__ __device__ __forceinline__ int lds_byte(int r, int c) { const int st = (r >> 4) * 2 + (c >> 5), rr = r & 15, cc = c & 31, ob = rr * 64 + cc * 2; return st * 1024 + (ob ^ (((ob >> 9) & 1) << 5)); }
__host__ __device__ __forceinline__ void stage_rc(int b, int& R, int& C) { const int st = b / 1024, sb = b % 1024, swz = sb ^ (((sb >> 9) & 1) << 5); R = (st >> 1) * 16 + swz / 64; C = (st & 1) * 32 + (swz % 64) / 2; }
__host__ __device__ __forceinline__ int perm32(int rho) { const int n = rho >> 4, i = rho & 15; return 8 * (i >> 2) + 4 * n + (i & 3); }

struct Unit { int pm, pn, z; };
__device__ __forceinline__ unsigned cvt_pk_bf16(float lo, float hi) { unsigned r; asm volatile("v_cvt_pk_bf16_f32 %0, %1, %2" : "=v"(r) : "v"(lo), "v"(hi)); return r; }
__device__ __forceinline__ void map_tile(int L, int nM, int nN, int& pm, int& pn) {
    const int nwg = nM * nN; int wgid = L; { const int q = nwg / NXCD, r = nwg % NXCD, xcd = wgid % NXCD, off = wgid / NXCD; wgid = (xcd < r ? xcd * (q + 1) : r * (q + 1) + (xcd - r) * q) + off; }
    const int nig = WGM * nN, gid = wgid / nig, fm = gid * WGM, gsz = (nM - fm) < WGM ? (nM - fm) : WGM;
    pm = fm + ((wgid % nig) % gsz); pn = (wgid % nig) / gsz;
}
template <class Epi, class Sched, bool ALIGN_EPI = false, bool SP2 = false, int SEGT = 0>
__device__ __forceinline__ void gemm_phase(PG8_LAS unsigned char* lds, const int K, const int lda, const int ldb, const Sched& S, const Epi& E) {
    const int tid = fresh_tid(S.wv), wid = S.wv, lane = tid & 63, wr = wid >> 2, wc = wid & 3, fr = lane & 15, fq = lane >> 4;
    const int nt = K / BK;
    unsigned voffA[2], voffB[2];
#pragma unroll
    for (int i = 0; i < 2; ++i) { int R, C; stage_rc(tid * 16 + i * 8192, R, C); const int Rb = Epi::PERM ? ((R & ~31) + perm32(R & 31)) : R;
        voffA[i] = (unsigned)(R * lda + C) * 2u; voffB[i] = (unsigned)(Rb * ldb + C) * 2u; }
    const size_t kstep = (size_t)(BK * 2);
    const size_t hstepA = (size_t)HALF * lda * 2, hstepB = (size_t)HALF * ldb * 2;
    const unsigned ldsw = (unsigned)wid * 1024u;
    const int aoff = lds_byte(wr * 64 + fr, fq * 8), boff = lds_byte(wc * 32 + fr, fq * 8);
#define PG8_SA(b, h) (((b) * 2 + (h)) * HTB)
#define PG8_SB(b, h) ((4 + (b) * 2 + (h)) * HTB)
#define PG8_STAGE(bufoff, gbase, voff) do { _Pragma("unroll") for (int _i = 0; _i < 2; ++_i) \
        __builtin_amdgcn_global_load_lds((const unsigned*)((const char*)(gbase) + (voff)[_i]), (PG8_LAS unsigned*)(lds + (bufoff) + ldsw + _i * 8192), 16, 0, 0); } while (0)
#define PG8_LDA(dst, b, h) do { _Pragma("unroll") for (int m = 0; m < 4; ++m) _Pragma("unroll") for (int k = 0; k < 2; ++k) dst[m][k] = *(const PG8_LAS bf16x8*)(lds + PG8_SA(b, h) + aoff + m * 2048 + k * 1024); } while (0)
#define PG8_LDB(dst, b, h) do { _Pragma("unroll") for (int n = 0; n < 2; ++n) _Pragma("unroll") for (int k = 0; k < 2; ++k) dst[n][k] = *(const PG8_LAS bf16x8*)(lds + PG8_SB(b, h) + boff + n * 2048 + k * 1024); } while (0)
#define PG8_MMA(ai, bj, At, Bt) do { __builtin_amdgcn_s_setprio(1); _Pragma("unroll") for (int m = 0; m < 4; ++m) _Pragma("unroll") for (int n = 0; n < 2; ++n) _Pragma("unroll") for (int k = 0; k < 2; ++k) \
        acc[ai][bj][m][n] = __builtin_amdgcn_mfma_f32_16x16x32_bf16(Bt[n][k], At[m][k], acc[ai][bj][m][n], 0, 0, 0); __builtin_amdgcn_s_setprio(0); } while (0)
#define PG8_WAIT_V(n) asm volatile("s_waitcnt vmcnt(" #n ")" ::: "memory")
#define PG8_WAIT_L(n) asm volatile("s_waitcnt lgkmcnt(" #n ")" ::: "memory")
#define PG8_BAR __builtin_amdgcn_s_barrier()
#define PG8_SCHED __builtin_amdgcn_sched_barrier(0)
    Unit cur, nxt; int ui = 0;
    if (!S.next(0, cur)) return;
    f32x4 acc[2][2][4][2];
#pragma unroll
    for (int a = 0; a < 2; ++a)
#pragma unroll
        for (int b = 0; b < 2; ++b)
#pragma unroll
            for (int m = 0; m < 4; ++m)
#pragma unroll
                for (int n = 0; n < 2; ++n) acc[a][b][m][n] = (f32x4){0.f, 0.f, 0.f, 0.f};
    bf16x8 At[4][2], B0[2][2], B1[2][2];
    const char* cA = S.aptr(cur); const char* cB = S.bptr(cur);
    S.a_ready(cur);
    if constexpr (SP2) {
        PG8_STAGE(PG8_SB(0, 0), cB, voffB); PG8_STAGE(PG8_SB(0, 1), cB + hstepB, voffB); PG8_STAGE(PG8_SA(0, 0), cA, voffA); PG8_STAGE(PG8_SA(0, 1), cA + hstepA, voffA);
        if (wr == 1) PG8_BAR;
        PG8_WAIT_V(2); PG8_BAR;
        PG8_STAGE(PG8_SB(1, 0), cB + kstep, voffB); PG8_STAGE(PG8_SA(1, 0), cA + kstep, voffA); PG8_STAGE(PG8_SB(1, 1), cB + hstepB + kstep, voffB);
        PG8_WAIT_V(6); PG8_BAR;
    } else {
        PG8_STAGE(PG8_SB(0, 0), cB, voffB); PG8_STAGE(PG8_SA(0, 0), cA, voffA); PG8_STAGE(PG8_SB(0, 1), cB + hstepB, voffB); PG8_STAGE(PG8_SA(0, 1), cA + hstepA, voffA);
        if (wr == 1) PG8_BAR;
        PG8_WAIT_V(4); PG8_BAR;
        PG8_STAGE(PG8_SB(1, 0), cB + kstep, voffB); PG8_STAGE(PG8_SA(1, 0), cA + kstep, voffA); PG8_STAGE(PG8_SB(1, 1), cB + hstepB + kstep, voffB);
        PG8_WAIT_V(6); PG8_BAR;
    }
    for (;;) {
        const bool has_next = S.next(ui + 1, nxt);
        const char* nA = has_next ? S.aptr(nxt) : cA; const char* nB = has_next ? S.bptr(nxt) : cB;
        for (int t = 0; t < nt; t += 2) {
            const bool last = (t == nt - 2);
            size_t sa1 = 0, sa2 = 0, sb2 = 0;
            if constexpr (SEGT > 0) { if (t > 0 && (t % SEGT) == 0) E.mid(acc, cur, t / SEGT, wr, wc, fr, fq);
                sa1 = (size_t)(t / SEGT) * S.segA; sa2 = (size_t)((t + 2) / SEGT) * S.segA; sb2 = (size_t)((t + 2) / SEGT) * S.segB; }
            const char* a1 = cA + (size_t)(t + 1) * kstep + sa1;
            const char* a2 = last ? nA : cA + (size_t)(t + 2) * kstep + sa2; const char* b2 = last ? nB : cB + (size_t)(t + 2) * kstep + sb2;
            const char* a3 = a2 + kstep; const char* b3 = b2 + kstep;
            if (last && has_next) S.a_ready(nxt);
            if constexpr (SP2) {
            PG8_LDB(B0, 0, 0); PG8_LDB(B1, 0, 1); PG8_SCHED; PG8_LDA(At, 0, 0); PG8_STAGE(PG8_SA(1, 1), a1 + hstepA, voffA);
            PG8_WAIT_V(8); PG8_WAIT_L(0); PG8_BAR; PG8_MMA(0, 0, At, B0); PG8_MMA(0, 1, At, B1); PG8_BAR; PG8_SCHED;
            PG8_LDA(At, 0, 1); PG8_STAGE(PG8_SB(0, 0), b2, voffB); PG8_STAGE(PG8_SB(0, 1), b2 + hstepB, voffB); PG8_STAGE(PG8_SA(0, 0), a2, voffA);
            PG8_WAIT_V(8); PG8_WAIT_L(0); PG8_BAR; PG8_MMA(1, 0, At, B0); PG8_MMA(1, 1, At, B1); PG8_BAR; PG8_SCHED;
            PG8_LDB(B0, 1, 0); PG8_LDB(B1, 1, 1); PG8_SCHED; PG8_LDA(At, 1, 0); PG8_STAGE(PG8_SA(0, 1), a2 + hstepA, voffA);
            PG8_WAIT_V(8); PG8_WAIT_L(0); PG8_BAR; PG8_MMA(0, 0, At, B0); PG8_MMA(0, 1, At, B1); PG8_BAR; PG8_SCHED;
            PG8_LDA(At, 1, 1); PG8_STAGE(PG8_SB(1, 0), b3, voffB); PG8_STAGE(PG8_SB(1, 1), b3 + hstepB, voffB); PG8_STAGE(PG8_SA(1, 0), a3, voffA);
            PG8_WAIT_V(8); PG8_WAIT_L(0); PG8_BAR; PG8_MMA(1, 0, At, B0); PG8_MMA(1, 1, At, B1); PG8_BAR; PG8_SCHED;
            } else {
            PG8_LDB(B0, 0, 0); PG8_SCHED; PG8_LDA(At, 0, 0); PG8_STAGE(PG8_SA(1, 1), a1 + hstepA, voffA);
            PG8_WAIT_L(8); PG8_BAR; PG8_WAIT_L(0); PG8_MMA(0, 0, At, B0); PG8_BAR; PG8_SCHED;
            PG8_LDB(B1, 0, 1); PG8_STAGE(PG8_SB(0, 0), b2, voffB);
            PG8_BAR; PG8_WAIT_L(0); PG8_MMA(0, 1, At, B1); PG8_BAR;
            PG8_LDA(At, 0, 1); PG8_STAGE(PG8_SA(0, 0), a2, voffA);
            PG8_BAR; PG8_WAIT_L(0); PG8_MMA(1, 0, At, B0); PG8_BAR; PG8_SCHED;
            PG8_STAGE(PG8_SB(0, 1), b2 + hstepB, voffB);
            PG8_WAIT_V(6); PG8_BAR; PG8_MMA(1, 1, At, B1); PG8_BAR;
            PG8_LDB(B0, 1, 0); PG8_SCHED; PG8_LDA(At, 1, 0); PG8_STAGE(PG8_SA(0, 1), a2 + hstepA, voffA);
            PG8_WAIT_L(8); PG8_BAR; PG8_WAIT_L(0); PG8_MMA(0, 0, At, B0); PG8_BAR; PG8_SCHED;
            PG8_LDB(B1, 1, 1); PG8_STAGE(PG8_SB(1, 0), b3, voffB);
            PG8_BAR; PG8_WAIT_L(0); PG8_MMA(0, 1, At, B1); PG8_BAR;
            PG8_LDA(At, 1, 1); PG8_STAGE(PG8_SA(1, 0), a3, voffA);
            PG8_BAR; PG8_WAIT_L(0); PG8_MMA(1, 0, At, B0); PG8_BAR; PG8_SCHED;
            PG8_STAGE(PG8_SB(1, 1), b3 + hstepB, voffB);
            PG8_WAIT_V(6); PG8_BAR; PG8_MMA(1, 1, At, B1); PG8_BAR;
            }
        }
        if constexpr (ALIGN_EPI) { if (wr == 0) PG8_BAR; }
        if constexpr (!Epi::AFTER_DRAIN) { E(acc, cur, wr, wc, fr, fq); S.done(cur); }
        if (!has_next) break;
#pragma unroll
        for (int a = 0; a < 2; ++a)
#pragma unroll
            for (int b = 0; b < 2; ++b)
#pragma unroll
                for (int m = 0; m < 4; ++m)
#pragma unroll
                    for (int n = 0; n < 2; ++n) acc[a][b][m][n] = (f32x4){0.f, 0.f, 0.f, 0.f};
        cur = nxt; cA = nA; cB = nB; ++ui;
        if constexpr (ALIGN_EPI) { if (wr == 1) PG8_BAR; }
    }
    PG8_WAIT_V(0);
    if constexpr (!ALIGN_EPI) { if (wr == 0) PG8_BAR; }
    PG8_BAR;
    if constexpr (Epi::AFTER_DRAIN) { E.fused(acc, cur, wr, wc, fr, fq, lds, wid, lane); S.done(cur); }
#undef PG8_SA
#undef PG8_SB
#undef PG8_STAGE
#undef PG8_LDA
#undef PG8_LDB
#undef PG8_MMA
#undef PG8_WAIT_V
#undef PG8_WAIT_L
#undef PG8_BAR
#undef PG8_SCHED
}
}
#include <hip/hip_bf16.h>
namespace attn_body {
using bf16=__hip_bfloat16;
using bf16x8=__attribute__((ext_vector_type(8)))short;
using s16x4=__attribute__((ext_vector_type(4)))short;
using f32x16=__attribute__((ext_vector_type(16)))float;
using u32x4=__attribute__((ext_vector_type(4)))unsigned;
constexpr int BATCH=1,NHEAD=8,SEQ=16384,D=64,DM=NHEAD*D;
constexpr int NW=8,QBLK=32,QB=QBLK*NW,KVBLK=64,NQB=SEQ/QB;
constexpr int ATTN_PITCH=DM, ATTN_UNIT_ROWS=QB;
__device__ __forceinline__ int crow(int r,int hi){return (r&3)+8*(r>>2)+4*hi;}
#define SBAR() __builtin_amdgcn_sched_barrier(0)
__device__ __forceinline__ void cmask(f32x16&p0,f32x16&p1,int jb,int qrel,int hi){
  const float NEG=-INFINITY; int kb=64*jb+4*hi;
  #pragma unroll
  for(int r=0;r<16;++r){int kv=kb+(r&3)+8*(r>>2); if(kv>qrel)p0[r]=NEG; if(kv+32>qrel)p1[r]=NEG;}
}

constexpr int NSLOT=3, SLOTB=8192;
constexpr int LDS_K=0, LDS_V=NSLOT*SLOTB, LDS_WS=2*NSLOT*SLOTB, LDS_OST=LDS_WS+NW*64*4, LDS_BIAS=LDS_OST+NW*4096, LDS_BYTES=LDS_BIAS+SEQ*4+512;
constexpr float C2=0.125f*1.4426950408889634f;
__device__ __forceinline__ void glds16(const void*gsrc,unsigned lds_dst){unsigned keep;
  asm volatile("s_mov_b32 %0, m0\n\ts_mov_b32 m0, %2\n\ts_nop 0\n\tglobal_load_lds_dwordx4 %1, off\n\ts_mov_b32 m0, %0":"=&s"(keep):"v"(gsrc),"s"(lds_dst):"memory");}
__device__ __forceinline__ float max3f(float a,float b,float c){float r;asm("v_max3_f32 %0, %1, %2, %3":"=v"(r):"v"(a),"v"(b),"v"(c));return r;}
__device__ __forceinline__ float max2f(float a,float b){float r;asm("v_max_f32_e32 %0, %1, %2":"=v"(r):"v"(a),"v"(b));return r;}
__device__ __forceinline__ float fadd_s(float a,float b){float r;asm("v_add_f32_e32 %0, %1, %2":"=v"(r):"v"(a),"v"(b));return r;}
__device__ __forceinline__ float fsub_s(float a,float b){float r;asm("v_sub_f32_e32 %0, %1, %2":"=v"(r):"v"(a),"v"(b));return r;}
typedef float f32x2_t __attribute__((ext_vector_type(2))); typedef __bf16 bf16x2_t __attribute__((ext_vector_type(2)));
__device__ __forceinline__ unsigned cvtpk_s(float lo,float hi){f32x2_t v={lo,hi};bf16x2_t b=__builtin_convertvector(v,bf16x2_t);return __builtin_bit_cast(unsigned,b);}
#define WAIT_BAR(N) asm volatile("s_waitcnt vmcnt(" #N ") lgkmcnt(0)\n\ts_barrier":::"memory")

__device__ __forceinline__ void qkt(f32x16&p0,f32x16&p1,const char*Kslot,const bf16x8*qr,int r32,int hi){
  const char*kb=Kslot+hi*1024+r32*16;
  #pragma unroll
  for(int d0=0;d0<4;++d0){
    const bf16x8 b0=*reinterpret_cast<const bf16x8*>(kb+d0*2048);
    const bf16x8 b1=*reinterpret_cast<const bf16x8*>(kb+d0*2048+512);
    p0=__builtin_amdgcn_mfma_f32_32x32x16_bf16(b0,qr[d0],p0,0,0,0);p1=__builtin_amdgcn_mfma_f32_32x32x16_bf16(b1,qr[d0],p1,0,0,0);}
}
typedef __attribute__((address_space(3))) const char* lds_cptr;
typedef short v4i16_t __attribute__((ext_vector_type(4)));
__device__ __forceinline__ void kload8(bf16x8*kf,lds_cptr kp){
  kf[0]=*(const __attribute__((address_space(3))) bf16x8*)(kp);      kf[1]=*(const __attribute__((address_space(3))) bf16x8*)(kp+512);
  kf[2]=*(const __attribute__((address_space(3))) bf16x8*)(kp+2048); kf[3]=*(const __attribute__((address_space(3))) bf16x8*)(kp+2560);
  kf[4]=*(const __attribute__((address_space(3))) bf16x8*)(kp+4096); kf[5]=*(const __attribute__((address_space(3))) bf16x8*)(kp+4608);
  kf[6]=*(const __attribute__((address_space(3))) bf16x8*)(kp+6144); kf[7]=*(const __attribute__((address_space(3))) bf16x8*)(kp+6656);
}
__device__ __forceinline__ void kload2(bf16x8*kf,lds_cptr kp,int j){ kf[2*j]=*(const __attribute__((address_space(3))) bf16x8*)(kp+j*2048); kf[2*j+1]=*(const __attribute__((address_space(3))) bf16x8*)(kp+j*2048+512); }
__device__ __forceinline__ s16x4 vtr(lds_cptr p){ return __builtin_bit_cast(s16x4,__builtin_amdgcn_ds_read_tr16_b64_v4i16((__attribute__((address_space(3))) v4i16_t*)p)); }
__device__ __forceinline__ float rowmax(const f32x16&p0,const f32x16&p1){
  float a=max3f(p0[0],p0[1],p1[0]),b=max3f(p0[2],p0[3],p1[1]);a=max3f(a,p1[2],p1[3]);
  #pragma unroll
  for(int r=4;r<16;r+=4){a=max3f(a,p0[r],p0[r+1]);b=max3f(b,p0[r+2],p0[r+3]);a=max3f(a,p1[r],p1[r+1]);b=max3f(b,p1[r+2],p1[r+3]);}
  const float m=max2f(a,b);
  auto rr=__builtin_amdgcn_permlane32_swap(__float_as_uint(m),__float_as_uint(m),false,false);
  return max2f(__uint_as_float(rr[0]),__uint_as_float(rr[1]));
}
__device__ __forceinline__ void pv(f32x16*o,int vb,bf16x8 pa0,bf16x8 pa1,bf16x8 pa2,bf16x8 pa3){
  #pragma unroll
  for(int d0=0;d0<2;++d0){s16x4 lo[4],hi[4];
    #pragma unroll
    for(int ks=0;ks<4;++ks){
      asm volatile("ds_read_b64_tr_b16 %0,%1 offset:%c2":"=&v"(lo[ks]):"v"(vb),"i"(d0*4096+ks*1024):"memory");
      asm volatile("ds_read_b64_tr_b16 %0,%1 offset:%c2":"=&v"(hi[ks]):"v"(vb),"i"(d0*4096+ks*1024+512):"memory");}
    asm volatile("s_waitcnt lgkmcnt(0)":::"memory");SBAR();
    #define PK(k) (bf16x8){lo[k][0],lo[k][1],lo[k][2],lo[k][3],hi[k][0],hi[k][1],hi[k][2],hi[k][3]}
    o[d0]=__builtin_amdgcn_mfma_f32_32x32x16_bf16(pa0,PK(0),o[d0],0,0,0);
    o[d0]=__builtin_amdgcn_mfma_f32_32x32x16_bf16(pa1,PK(1),o[d0],0,0,0);
    o[d0]=__builtin_amdgcn_mfma_f32_32x32x16_bf16(pa2,PK(2),o[d0],0,0,0);
    o[d0]=__builtin_amdgcn_mfma_f32_32x32x16_bf16(pa3,PK(3),o[d0],0,0,0);
    #undef PK
  }
}

#ifndef ATTN_STORE16
#define ATTN_STORE16(p,v) (*(u32x4*)(p)=(v))
#endif
typedef float f32x4_t __attribute__((ext_vector_type(4)));
template<int THRL> __device__ __forceinline__ void attn_unit(int b,int h,int qb,const bf16*Q,const bf16*__restrict__ K,const bf16*__restrict__ V,bf16*O,const float*__restrict__ Fh,const float*__restrict__ Lh,float thrb,char*shm,int wv){
  const int tid=fresh_tid(wv),lane=tid&63,r32=lane&31,hi=lane>>5; const int wid=wv;
  const long rowbase=(long)b*SEQ; const int q0=qb*QB;
  const bf16*Qw=Q+(rowbase+q0+wid*QBLK)*DM+h*D;
  const lds_cptr shm3=(lds_cptr)shm;
  const float fref=Fh[q0];
  int T0; { __attribute__((address_space(3))) float* pb=(__attribute__((address_space(3))) float*)(shm3+LDS_WS);
    if(tid<2*qb) pb[tid]=Lh[tid]+fref*1.4426950408889634f;
    asm volatile("s_waitcnt lgkmcnt(0)\n\ts_barrier":::"memory");
    int lo_=0,hi_=2*qb; while(lo_<hi_){ const int mid=(lo_+hi_)>>1; if(!(pb[mid]<=thrb)) hi_=mid; else lo_=mid+1; } T0=__builtin_amdgcn_readfirstlane(2*lo_); }
  { __attribute__((address_space(3))) float* bl=(__attribute__((address_space(3))) float*)(shm3+LDS_BIAS);
    #pragma unroll 4
    for(int s=64*T0+tid;s<q0+QB;s+=NW*64) bl[s]=(fref-Fh[s])*1.4426950408889634f; }
  const bf16*Kh=K+(rowbase+(long)T0*KVBLK)*DM+h*D,*Vh=V+(rowbase+(long)T0*KVBLK)*DM+h*D;
  const unsigned lds0=(unsigned)(uintptr_t)shm;
  float*wsf=(float*)(shm+LDS_WS)+wid*64;
  const bf16*ksrc=Kh+(long)lane*DM+wid*8;
  const bf16*vsrc=Vh+(long)(16*(wid&3)+(lane>>2))*DM+(wid>>2)*32+(lane&3)*8;
  const unsigned kdst=lds0+LDS_K+wid*1024, vdst=lds0+LDS_V+wid*1024;
  #define DMA_K(t,slot) glds16(ksrc+(long)(t)*KVBLK*DM,(unsigned)__builtin_amdgcn_readfirstlane(kdst+(slot)))
  #define DMA_V(t,slot) glds16(vsrc+(long)(t)*KVBLK*DM,(unsigned)__builtin_amdgcn_readfirstlane(vdst+(slot)))
  const int vb0=(int)(lds0+LDS_V)+((lane>>4)&1)*32+(lane&3)*8+(4*hi+((lane&15)>>2))*64;
  const char*Kbase=shm+LDS_K; bf16x8 kf[8];
  const lds_cptr kp0=shm3+LDS_K+hi*1024+r32*16; const lds_cptr vp0=shm3+LDS_V+((lane>>4)&1)*32+(lane&3)*8+(4*hi+((lane&15)>>2))*64;
  const int NT=(q0+QB)/KVBLK-T0;
  #define BLOAD(X0,X1,tt) do{ const __attribute__((address_space(3))) f32x4_t* bp_=(const __attribute__((address_space(3))) f32x4_t*)(shm3+LDS_BIAS+(((tt)+T0)*64+4*hi)*4); \
    _Pragma("unroll") for(int g_=0;g_<4;++g_){ const f32x4_t a_=bp_[2*g_], b_=bp_[8+2*g_]; \
      X0[4*g_]=a_[0];X0[4*g_+1]=a_[1];X0[4*g_+2]=a_[2];X0[4*g_+3]=a_[3]; X1[4*g_]=b_[0];X1[4*g_+1]=b_[1];X1[4*g_+2]=b_[2];X1[4*g_+3]=b_[3]; } }while(0)
  DMA_K(0,0);DMA_V(0,0);DMA_K(1,SLOTB);
  bf16x8 qr[4];
  #pragma unroll
  for(int d0=0;d0<4;++d0)qr[d0]=*reinterpret_cast<const bf16x8*>(&Qw[(long)r32*DM+d0*16+hi*8]);
  float mhat=0.f,l_reg=0.f;f32x16 o[2];o[0]=f32x16{};o[1]=f32x16{};
  const int qrel=wid*QBLK+r32;
  #define CMASK(P0,P1,t) do{int jb_=(t)-(NT-4); if(jb_>=0)cmask(P0,P1,jb_,qrel,hi);}while(0)
  bool resc=false;
    \
  #define START(P0,P1) do{ const float rm=rowmax(P0,P1); resc=false; \
    { const float dl=__builtin_fmaxf(rm,((const __attribute__((address_space(3))) float*)(shm3+LDS_BIAS))[q0+qrel]+10.f); mhat=fadd_s(mhat,dl); \
      _Pragma("unroll") for(int r=0;r<16;++r){P0[r]=fsub_s(P0[r],dl);P1[r]=fsub_s(P1[r],dl);} \
 } \
    _Pragma("unroll") for(int r=0;r<16;++r)P0[r]=__builtin_amdgcn_exp2f(P0[r]); }while(0)
  #define RESC() do{ if(resc){ asm volatile("s_waitcnt lgkmcnt(0)":::"memory"); \
      _Pragma("unroll") for(int d_=0;d_<2;++d_) _Pragma("unroll") for(int r=0;r<16;++r)o[d_][r]*=wsf[crow(r,hi)]; } }while(0)
  f32x16 pA0,pA1,pB0,pB1;
  int sl_prev=0,sl_cur=0,sl_next=SLOTB;
  #define ROT() do{sl_prev=sl_cur;sl_cur=sl_next;sl_next=(sl_next==(NSLOT-1)*SLOTB)?0:sl_next+SLOTB;}while(0)
  DMA_K(2,2*SLOTB);
  WAIT_BAR(3);
  BLOAD(pA0,pA1,0); BLOAD(pB0,pB1,1);
  qkt(pA0,pA1,Kbase,qr,r32,hi);asm volatile("s_nop 15\n\ts_nop 7":"+v"(pA0),"+v"(pA1));CMASK(pA0,pA1,0);
  START(pA0,pA1);
  _Pragma("unroll") for(int r=0;r<16;++r)pA1[r]=__builtin_amdgcn_exp2f(pA1[r]);
  WAIT_BAR(0);
  DMA_K(3,0);DMA_V(1,SLOTB);
  ROT();
  kload8(kf,kp0+sl_cur);
  WAIT_BAR(2);
  s16x4 vlo[8],vhi[8]; u32x4 pw0,pw1,pw2,pw3;
  #define PKW(P,B) cvtpk_s(P[B],P[B+1])
  #define PAF(k) __builtin_bit_cast(bf16x8,pw##k)
  #define VFR(i) (bf16x8){vlo[i][0],vlo[i][1],vlo[i][2],vlo[i][3],vhi[i][0],vhi[i][1],vhi[i][2],vhi[i][3]}
  #define PIN(x) asm volatile("":"+v"(x))
  #define MX3(a,b,c) __builtin_fmaxf(__builtin_fmaxf((a),(b)),(c))
  #define GAPA(MF,A0,A1,A2,A3,W0,W1,PW) do{ MF; sacc+=A0; sacc+=A1; sacc+=A2; sacc+=A3; PIN(sacc); W0; W1; PIN(PW); SBAR(); }while(0)
  #define EX(v) __builtin_amdgcn_exp2f(v)
  #define GAPB(MF,X,B) do{ MF; X[B]=EX(X[B]); X[B+1]=EX(X[B+1]); X[B+2]=EX(X[B+2]); X[B+3]=EX(X[B+3]); PIN(X); SBAR(); }while(0)
  #define VRD(i) do{ vlo[i]=vtr(vp_+(((i)>>2)*4096+((i)&3)*1024)); vhi[i]=vtr(vp_+(((i)>>2)*4096+((i)&3)*1024+512)); }while(0)
  #define KRD(G,j) do{ if(G){ kload2(kf,kp0+sl_next,j); SBAR(); } }while(0)
  #define STEP(C0,C1,P0,P1,t,GK,GV,GL) do{ SBAR(); \
    _Pragma("unroll") for(int r=0;r<16;++r){C0[r]-=mhat;C1[r]-=mhat;} \
    const lds_cptr vp_=vp0+sl_prev; \
    VRD(0); SBAR(); float sacc=(P0[0]+P0[1]); \
    GAPA(C0=__builtin_amdgcn_mfma_f32_32x32x16_bf16(kf[0],qr[0],C0,0,0,0), P0[2],P0[3],P0[4],P0[5],     pw0[0]=PKW(P0,0), pw0[1]=PKW(P0,2), pw0); \
    VRD(4); SBAR(); GAPA(C1=__builtin_amdgcn_mfma_f32_32x32x16_bf16(kf[1],qr[0],C1,0,0,0), P0[6],P0[7],P0[8],P0[9],     pw0[2]=PKW(P0,4), pw0[3]=PKW(P0,6), pw0); \
    VRD(1); SBAR(); GAPA(C0=__builtin_amdgcn_mfma_f32_32x32x16_bf16(kf[2],qr[1],C0,0,0,0),   P0[10],P0[11],P0[12],P0[13], pw1[0]=PKW(P0,8), pw1[1]=PKW(P0,10), pw1); \
    VRD(5); SBAR(); GAPA(C1=__builtin_amdgcn_mfma_f32_32x32x16_bf16(kf[3],qr[1],C1,0,0,0),   P0[14],P0[15],P1[0],P1[1],   pw1[2]=PKW(P0,12),pw1[3]=PKW(P0,14), pw1); \
    VRD(2); SBAR(); GAPA(C0=__builtin_amdgcn_mfma_f32_32x32x16_bf16(kf[4],qr[2],C0,0,0,0),   P1[2],P1[3],P1[4],P1[5],     pw2[0]=PKW(P1,0), pw2[1]=PKW(P1,2), pw2); \
    VRD(6); SBAR(); GAPA(C1=__builtin_amdgcn_mfma_f32_32x32x16_bf16(kf[5],qr[2],C1,0,0,0),   P1[6],P1[7],P1[8],P1[9],     pw2[2]=PKW(P1,4), pw2[3]=PKW(P1,6), pw2); \
    VRD(3); SBAR(); GAPA(C0=__builtin_amdgcn_mfma_f32_32x32x16_bf16(kf[6],qr[3],C0,0,0,0),   P1[10],P1[11],P1[12],P1[13], pw3[0]=PKW(P1,8), pw3[1]=PKW(P1,10), pw3); \
    VRD(7); SBAR(); GAPA(C1=__builtin_amdgcn_mfma_f32_32x32x16_bf16(kf[7],qr[3],C1,0,0,0),   P1[14],P1[15],0.f,0.f,       pw3[2]=PKW(P1,12),pw3[3]=PKW(P1,14), pw3); \
    l_reg+=sacc; \
    if(GK){DMA_K((t)+3,sl_cur);} if(GV){DMA_V((t)+1,sl_next);} \
    CMASK(C0,C1,t); \
    { float a=MX3(C0[0],C0[1],C1[0]),b=MX3(C0[2],C0[3],C1[1]); a=MX3(a,C1[2],C1[3]); \
      _Pragma("unroll") for(int r=4;r<16;r+=4){a=MX3(a,C0[r],C0[r+1]);b=MX3(b,C0[r+2],C0[r+3]);a=MX3(a,C1[r],C1[r+1]);b=MX3(b,C1[r+2],C1[r+3]);} \
      float rm=__builtin_fmaxf(a,b); { auto rr=__builtin_amdgcn_permlane32_swap(__float_as_uint(rm),__float_as_uint(rm),false,false); rm=__builtin_fmaxf(__uint_as_float(rr[0]),__uint_as_float(rr[1])); } \
      resc=false; \
      if(__builtin_expect(__any(rm>(float)THRL),0)){ const float dl=__builtin_fmaxf(rm,0.f); mhat+=dl; \
        _Pragma("unroll") for(int r=0;r<16;++r){C0[r]-=dl;C1[r]-=dl;} \
        const float f=__builtin_amdgcn_exp2f(-dl); l_reg*=f; if(hi==0)wsf[r32]=f; resc=true; } } \
    SBAR(); \
    GAPB(o[0]=__builtin_amdgcn_mfma_f32_32x32x16_bf16(PAF(0),VFR(0),o[0],0,0,0), C0,0); \
    GAPB(o[1]=__builtin_amdgcn_mfma_f32_32x32x16_bf16(PAF(0),VFR(4),o[1],0,0,0), C0,4); \
    KRD(GL,0); GAPB(o[0]=__builtin_amdgcn_mfma_f32_32x32x16_bf16(PAF(1),VFR(1),o[0],0,0,0), C0,8); \
    KRD(GL,1); GAPB(o[1]=__builtin_amdgcn_mfma_f32_32x32x16_bf16(PAF(1),VFR(5),o[1],0,0,0), C0,12); \
    KRD(GL,2); GAPB(o[0]=__builtin_amdgcn_mfma_f32_32x32x16_bf16(PAF(2),VFR(2),o[0],0,0,0), C1,0); \
    KRD(GL,3); GAPB(o[1]=__builtin_amdgcn_mfma_f32_32x32x16_bf16(PAF(2),VFR(6),o[1],0,0,0), C1,4); \
    GAPB(o[0]=__builtin_amdgcn_mfma_f32_32x32x16_bf16(PAF(3),VFR(3),o[0],0,0,0), C1,8); \
    GAPB(o[1]=__builtin_amdgcn_mfma_f32_32x32x16_bf16(PAF(3),VFR(7),o[1],0,0,0), C1,12); \
    if(GL){BLOAD(P0,P1,(t)+1);} SBAR(); \
    }while(0)
  int t=1;
  #undef CMASK
  #define CMASK(P0,P1,t) do{}while(0)
  for(;t+5<NT;t+=2){
    STEP(pB0,pB1,pA0,pA1,t,true,true,true);     WAIT_BAR(2); RESC(); ROT();
    STEP(pA0,pA1,pB0,pB1,t+1,true,true,true);   WAIT_BAR(2); RESC(); ROT();
  }
  #undef CMASK
  #define CMASK(P0,P1,t) do{int jb_=(t)-(NT-4); if(jb_>=0)cmask(P0,P1,jb_,qrel,hi);}while(0)
  #define ENDW(tt) do{ if((tt)+3<NT){WAIT_BAR(2);} else if((tt)+2<NT){WAIT_BAR(1);} else {WAIT_BAR(0);} }while(0)
  for(;t+1<NT;t+=2){
    STEP(pB0,pB1,pA0,pA1,t,(t+3<NT),(t+1<NT),(t+1<NT));       ENDW(t);   RESC(); ROT();
    STEP(pA0,pA1,pB0,pB1,t+1,(t+4<NT),(t+2<NT),(t+2<NT));     ENDW(t+1); RESC(); ROT();
  }
  STEP(pB0,pB1,pA0,pA1,NT-1,false,false,false); RESC();
  { float sacc=pB0[0]+pB0[1]; _Pragma("unroll") for(int r=2;r<16;++r)sacc+=pB0[r]; _Pragma("unroll") for(int r=0;r<16;++r)sacc+=pB1[r]; l_reg+=sacc;
    pw0=(u32x4){PKW(pB0,0),PKW(pB0,2),PKW(pB0,4),PKW(pB0,6)};pw1=(u32x4){PKW(pB0,8),PKW(pB0,10),PKW(pB0,12),PKW(pB0,14)};pw2=(u32x4){PKW(pB1,0),PKW(pB1,2),PKW(pB1,4),PKW(pB1,6)};pw3=(u32x4){PKW(pB1,8),PKW(pB1,10),PKW(pB1,12),PKW(pB1,14)};
    SBAR(); pv(o,vb0+sl_cur,PAF(0),PAF(1),PAF(2),PAF(3)); }
  #undef PKW
  #undef PAF
  #undef VFR
  #undef PIN
  #undef MX3
  #undef GAPA
  #undef GAPB
  #undef EX
  #undef VRD
  #undef KRD
  #undef STEP
  #undef ENDW
  {auto rr=__builtin_amdgcn_permlane32_swap(__float_as_uint(l_reg),__float_as_uint(l_reg),false,false);l_reg=__uint_as_float(rr[0])+__uint_as_float(rr[1]);}
  if(hi==0)wsf[32+r32]=l_reg;asm volatile("s_waitcnt lgkmcnt(0)":::"memory");
  float rli[16];
  #pragma unroll
  for(int r=0;r<16;++r)rli[r]=__builtin_amdgcn_rcpf(wsf[32+crow(r,hi)]);
  bf16*Ow=O+(rowbase+q0+wid*QBLK)*DM+h*D;
  { bf16*stg=(bf16*)(shm+LDS_OST)+wid*2048;
    #pragma unroll
    for(int r=0;r<16;++r){const int orow=crow(r,hi);
      #pragma unroll
      for(int d0=0;d0<2;++d0)stg[orow*64+d0*32+r32]=__float2bfloat16(o[d0][r]*rli[r]);}
    asm volatile("s_waitcnt lgkmcnt(0)":::"memory");
    #pragma unroll
    for(int i=0;i<4;++i){const int row=i*8+(lane>>3),ch=lane&7; const u32x4 v=*(const u32x4*)(stg+row*64+ch*8); ATTN_STORE16(Ow+(long)row*DM+ch*8,v);} }
  asm volatile("s_waitcnt lgkmcnt(0)\n\ts_barrier":::"memory");
  #undef DMA_K
  #undef BLOAD
  #undef DMA_V
  #undef CMASK
  #undef START
  #undef RESC
  #undef ROT
}
constexpr int ATTN_LDS_BYTES=LDS_BYTES;
struct AttnTensors { const bf16* Q; const bf16* K; const bf16* V; bf16* O; const float* F; };
struct AttnUnit { int bh; int qb; };
template<int THRL=8> __device__ __forceinline__ void attn_phase(char*lds,const AttnTensors&T,unsigned*qctr,const __attribute__((address_space(3))) float*thr8,volatile __attribute__((address_space(3))) unsigned*qslot,int wv){
  for(;;){
    if(fresh_tid(wv)==0){ qslot[0]=__hip_atomic_fetch_add(qctr,1u,__ATOMIC_RELAXED,__HIP_MEMORY_SCOPE_AGENT); }
    asm volatile("s_waitcnt vmcnt(0) lgkmcnt(0)\n\ts_barrier":::"memory");
    const int idx=__builtin_amdgcn_readfirstlane((int)qslot[0]);
    if(idx>=NHEAD*NQB)break;
    const int h=idx%NHEAD, qb=NQB-1-idx/NHEAD;
    attn_unit<THRL>(0,h,qb,T.Q,T.K,T.V,T.O,T.F+(size_t)h*SEQ,thr8[h],lds,wv);
  }
}
#undef SBAR
#undef WAIT_BAR
}
#define GAS __attribute__((address_space(1)))
#define LAS __attribute__((address_space(3)))
typedef unsigned short bf16;
typedef unsigned v4u __attribute__((ext_vector_type(4)));
typedef unsigned v2u __attribute__((ext_vector_type(2)));
typedef float f32x4 __attribute__((ext_vector_type(4)));
typedef float f32x16 __attribute__((ext_vector_type(16)));
typedef short bf16x8 __attribute__((ext_vector_type(8)));
typedef short s16x4 __attribute__((ext_vector_type(4)));

constexpr int NWAVES = 8;
constexpr int S_ = 16384, DM_ = 1024, DIN_ = 6680, FF_ = 4096, NMEM_ = 256;
constexpr float EPS_ = 1e-6f;
constexpr float LOG2E_ = 1.4426950408889634f;
constexpr size_t MiB = 1u << 20;
constexpr size_t WS_WIN = 1 * MiB;
constexpr size_t WS_WGLAO = 17 * MiB, WS_WFOXO = 18 * MiB, WS_WMEMO = 19 * MiB;
constexpr size_t WS_WOUT = 20 * MiB;
constexpr size_t WS_WFF1 = 22 * MiB;
constexpr size_t WS_WFF2 = 30 * MiB;
constexpr size_t WS_GA = 38 * MiB;
constexpr size_t WS_LOGF = 39 * MiB;
constexpr size_t WS_F = 39 * MiB + 512 * 1024;
constexpr size_t WS_MK = 40 * MiB;
constexpr size_t WS_MVT = 40 * MiB + 256 * 1024;
constexpr size_t WS_DEC = 40 * MiB + 512 * 1024;
constexpr size_t WS_MEMN = 40 * MiB + 768 * 1024;
constexpr size_t WS_GQ = 42 * MiB, WS_GK = 50 * MiB, WS_GV = 58 * MiB;
constexpr size_t WS_MG = 42 * MiB;
constexpr size_t WS_GG = 74 * MiB, WS_FQ = 90 * MiB;
constexpr size_t WS_U2 = 74 * MiB;
constexpr size_t WS_MQ = 106 * MiB, WS_FK = 122 * MiB, WS_FV = 138 * MiB;
constexpr size_t WS_GT = 154 * MiB;
constexpr size_t WS_HID = 122 * MiB;
constexpr size_t WS_SS1 = 250 * MiB, WS_SS2 = 251 * MiB;
constexpr size_t WS_END = 253 * MiB;
constexpr size_t WS_LSEF = 252 * MiB;
constexpr size_t WS_QB2 = 251 * MiB + 512 * 1024, WS_NDOT = 251 * MiB + 544 * 1024;
constexpr size_t WS_H0 = 106 * MiB, WS_H1 = 1 * MiB;
constexpr int CW_PANEL = 8192;
constexpr size_t OUT_U = 0, OUT_STATE = 32 * MiB;

constexpr int LDS_BYTES = 155648;

#define LDS_WAIT() asm volatile("s_waitcnt lgkmcnt(0)" ::: "memory")
__device__ __forceinline__ unsigned f2bf(float f) { unsigned u = __builtin_bit_cast(unsigned, f); return (u + 0x7fffu + ((u >> 16) & 1u)) >> 16; }
__device__ __forceinline__ unsigned pk2(float lo, float hi) { return f2bf(lo) | (f2bf(hi) << 16); }
__device__ __forceinline__ float bf2f(unsigned b) { return __builtin_bit_cast(float, (b & 0xffffu) << 16); }
__device__ __forceinline__ float bflo(unsigned w) { return __builtin_bit_cast(float, w << 16); }
__device__ __forceinline__ float bfhi(unsigned w) { return __builtin_bit_cast(float, w & 0xffff0000u); }
__device__ __forceinline__ float sigmoidf_(float x) { return __builtin_amdgcn_rcpf(1.f + __expf(-x)); }
__device__ __forceinline__ float logsigmoidf_(float z) { return -(fmaxf(-z, 0.f) + log1pf(__expf(-fabsf(z)))); }
__device__ __forceinline__ float logsigmoid_fast(float z) { return -(fmaxf(-z, 0.f) + __logf(1.f + __expf(-fabsf(z)))); }
__device__ __forceinline__ int crow_(int r, int hi) { return (r & 3) + 8 * (r >> 2) + 4 * hi; }
__device__ __forceinline__ float wave_sum(float v) {
#pragma unroll
    for (int o = 1; o < 64; o <<= 1) v += __shfl_xor(v, o);
    return v;
}
#define LBAR() asm volatile("s_waitcnt lgkmcnt(0)\n\ts_barrier" ::: "memory")
#define MFMA32(a, b, c) __builtin_amdgcn_mfma_f32_32x32x16_bf16((a), (b), (c), 0, 0, 0)
__device__ __forceinline__ bf16x8 ldfrag(const LAS unsigned char* base, int row, int pitchB, int kbyte) { return *(const LAS bf16x8*)(base + row * pitchB + kbyte); }

struct Ptrs {
    const float *x, *mem, *g_mix, *w_in, *w_alpha_up, *b_alpha, *b_forget, *g_gla_head, *g_mem, *w_mem_kv, *w_gla_o, *w_fox_o, *w_mem_o, *w_out, *g_ffn, *w_ff1, *w_ff2, *g_final;
    float* out; unsigned char* ws;
};

__device__ __forceinline__ void p0_transpose_item(const float* W, int ldw, int srccol0, int k0, bf16* WT, int ldt, int dstrow0, LAS float* scr, int lane) {
#pragma unroll 8
    for (int i = 0; i < 32; ++i) { const int kk = 2 * i + (lane >> 5); scr[kk * 33 + (lane & 31)] = W[(size_t)(k0 + kk) * ldw + srccol0 + (lane & 31)]; }
    LDS_WAIT(); asm volatile("" ::: "memory");
    const int c = lane & 7;
#pragma unroll
    for (int j = 0; j < 4; ++j) { const int n = (lane >> 3) + 8 * j; const LAS float* s = scr + (8 * c) * 33 + n;
        v4u o; o.x = pk2(s[0 * 33], s[1 * 33]); o.y = pk2(s[2 * 33], s[3 * 33]); o.z = pk2(s[4 * 33], s[5 * 33]); o.w = pk2(s[6 * 33], s[7 * 33]);
        *(v4u*)(WT + (size_t)(dstrow0 + n) * ldt + k0 + 8 * c) = o; }
    LDS_WAIT(); asm volatile("" ::: "memory");
}
__device__ __forceinline__ void rms_row_to_bf16(const float* xrow, const float* gain, bf16* orow, int lane) {
    const f32x4* xr = (const f32x4*)xrow + lane; const f32x4* gr = (const f32x4*)gain + lane;
    f32x4 v[4]; float s = 0.f;
#pragma unroll
    for (int j = 0; j < 4; ++j) { v[j] = xr[64 * j]; s += (v[j].x * v[j].x + v[j].y * v[j].y) + (v[j].z * v[j].z + v[j].w * v[j].w); }
    const float r = rsqrtf(wave_sum(s) * (1.f / 1024.f) + EPS_);
    unsigned long long* o8 = (unsigned long long*)orow + lane;
#pragma unroll
    for (int j = 0; j < 4; ++j) { const f32x4 g = gr[64 * j]; o8[64 * j] = (unsigned long long)pk2(v[j].x * r * g.x, v[j].y * r * g.y) | ((unsigned long long)pk2(v[j].z * r * g.z, v[j].w * r * g.w) << 32); }
}
__device__ __forceinline__ void p0_prologue(const Ptrs& P, LAS unsigned char* lds, int vcu, int G, int wv) {
    const int tid = fresh_tid(wv), lane = tid & 63, wave = wv;
    LAS float* scr = (LAS float*)(lds + wave * 16384);
    const int gw = vcu * NWAVES + wave, NGW = G * NWAVES;
    bf16* WIN = (bf16*)(P.ws + WS_WIN);
    constexpr int I_IN = 16 * 208, I_KV = 16 * 32, I_GO = 8 * 32, I_WO = 16 * 32, I_F1 = 16 * 128, I_F2 = 64 * 32;
    constexpr int NITEMS = I_IN + I_KV + 3 * I_GO + I_WO + I_F1 + I_F2;
    for (int it = gw; it < NITEMS; it += NGW) {
        int r = it;
        if (r < I_IN) { const int kb = r / 208, nb = r % 208, d0 = 32 * nb; const int src = d0 < 1536 ? d0 : (d0 < 3072 ? d0 + 16 : d0 + 24);
            p0_transpose_item(P.w_in, DIN_, src, 64 * kb, WIN, 1024, d0, scr, lane); continue; } r -= I_IN;
        if (r < I_KV) { const int kb = r / 32, nb = r % 32; p0_transpose_item(P.w_mem_kv, 1024, 32 * nb, 64 * kb, WIN, 1024, 6912 + 32 * nb, scr, lane); continue; } r -= I_KV;
        if (r < I_GO) { const int kb = r / 32, nb = r % 32; p0_transpose_item(P.w_gla_o, 1024, 32 * nb, 64 * kb, (bf16*)(P.ws + WS_WGLAO), 512, 32 * nb, scr, lane); continue; } r -= I_GO;
        if (r < I_GO) { const int kb = r / 32, nb = r % 32; p0_transpose_item(P.w_fox_o, 1024, 32 * nb, 64 * kb, (bf16*)(P.ws + WS_WFOXO), 512, 32 * nb, scr, lane); continue; } r -= I_GO;
        if (r < I_GO) { const int kb = r / 32, nb = r % 32; p0_transpose_item(P.w_mem_o, 1024, 32 * nb, 64 * kb, (bf16*)(P.ws + WS_WMEMO), 512, 32 * nb, scr, lane); continue; } r -= I_GO;
        if (r < I_WO) { const int kb = r / 32, nb = r % 32; p0_transpose_item(P.w_out, 1024, 32 * nb, 64 * kb, (bf16*)(P.ws + WS_WOUT), 1024, 32 * nb, scr, lane); continue; } r -= I_WO;
        if (r < I_F1) { const int kb = r / 128, nb = r % 128; p0_transpose_item(P.w_ff1, FF_, 32 * nb, 64 * kb, (bf16*)(P.ws + WS_WFF1), 1024, 32 * nb, scr, lane); continue; } r -= I_F1;
        { const int kb = r / 32, nb = r % 32; p0_transpose_item(P.w_ff2, 1024, 32 * nb, 64 * kb, (bf16*)(P.ws + WS_WFF2), FF_, 32 * nb, scr, lane); }
    }
    for (int idx = vcu * 512 + tid; idx < 256 * 128; idx += G * 512) {
        const int row = idx >> 7, kc = idx & 127; const int src = row < 16 ? 1536 + row : (row < 24 ? 3088 + (row - 16) : -1);
        v4u o = (v4u){0u, 0u, 0u, 0u};
        if (src >= 0) { const float* wp = P.w_in + (size_t)(8 * kc) * DIN_ + src;
            o.x = pk2(wp[0], wp[DIN_]); o.y = pk2(wp[2 * DIN_], wp[3 * DIN_]); o.z = pk2(wp[4 * DIN_], wp[5 * DIN_]); o.w = pk2(wp[6 * DIN_], wp[7 * DIN_]); }
        *(v4u*)(WIN + (size_t)(6656 + row) * 1024 + 8 * kc) = o;
    }
    bf16* U = (bf16*)((unsigned char*)P.out + OUT_U); bf16* MEMN = (bf16*)(P.ws + WS_MEMN);
    for (int m = gw; m < S_ + NMEM_; m += NGW) {
        if (m < S_) rms_row_to_bf16(P.x + (size_t)m * DM_, P.g_mix, U + (size_t)m * DM_, lane);
        else rms_row_to_bf16(P.mem + (size_t)(m - S_) * DM_, P.g_mem, MEMN + (size_t)(m - S_) * DM_, lane);
    }
}

struct GemmSched {
    const char* A; const char* B; int nM, nN, lda, ldb, G, c, wv;
    __device__ __forceinline__ bool next(int i, pg8::Unit& u) const { const long L = (long)i * G + c; if (L >= nM * nN) return false; pg8::map_tile((int)L, nM, nN, u.pm, u.pn); u.z = 0; return true; }
    __device__ __forceinline__ const char* aptr(const pg8::Unit& u) const { return A + (size_t)u.pm * 256 * lda * 2; }
    __device__ __forceinline__ const char* bptr(const pg8::Unit& u) const { return B + (size_t)u.pn * 256 * ldb * 2; }
    __device__ __forceinline__ void a_ready(const pg8::Unit&) const {}
    __device__ __forceinline__ void done(const pg8::Unit&) const {}
};
struct ProjSched {
    const char* U; const char* MEMN; const char* W; int G, c, wv;
    __device__ __forceinline__ bool next(int i, pg8::Unit& u) const { const int L = i * G + c; u.z = 0;
        if (L < 1728) { pg8::map_tile(L, 64, 27, u.pm, u.pn); return true; }
        if (L < 1732) { u.pm = 64; u.pn = 27 + (L - 1728); return true; } return false; }
    __device__ __forceinline__ const char* aptr(const pg8::Unit& u) const { return u.pm < 64 ? U + (size_t)u.pm * (256 * 1024 * 2) : MEMN; }
    __device__ __forceinline__ const char* bptr(const pg8::Unit& u) const { return W + (size_t)u.pn * (256 * 1024 * 2); }
    __device__ __forceinline__ void a_ready(const pg8::Unit&) const {}
    __device__ __forceinline__ void done(const pg8::Unit&) const {}
};
struct MergeSched {
    const char *A0, *B0; int G, c, wv; size_t segA, segB;
    __device__ __forceinline__ bool next(int i, pg8::Unit& u) const { const int T = c + G * i; if (T >= 256) return false; pg8::map_tile(T, 64, 4, u.pm, u.pn); u.z = 0; return true; }
    __device__ __forceinline__ const char* aptr(const pg8::Unit& u) const { return A0 + (size_t)u.pm * (256 * 512 * 2); }
    __device__ __forceinline__ const char* bptr(const pg8::Unit& u) const { return B0 + (size_t)u.pn * (256 * 512 * 2); }
    __device__ __forceinline__ void a_ready(const pg8::Unit&) const {}
    __device__ __forceinline__ void done(const pg8::Unit&) const {}
};
typedef pg8::f32x4 accv;
__device__ __forceinline__ void store_bf16_tile(const accv (&acc)[2][2][4][2], bf16* base, int ldc, int row0, int col0, float sc, bool sig) {
#pragma unroll
    for (int ai = 0; ai < 2; ++ai)
#pragma unroll
        for (int m = 0; m < 4; ++m) { bf16* rowp = base + (size_t)(row0 + ai * 128 + m * 16) * ldc + col0;
#pragma unroll
            for (int bj = 0; bj < 2; ++bj) { accv v0 = acc[ai][bj][m][0] * sc, v1 = acc[ai][bj][m][1] * sc;
                if (sig) { v0 = (accv){sigmoidf_(v0[0]), sigmoidf_(v0[1]), sigmoidf_(v0[2]), sigmoidf_(v0[3])}; v1 = (accv){sigmoidf_(v1[0]), sigmoidf_(v1[1]), sigmoidf_(v1[2]), sigmoidf_(v1[3])}; }
                v4u w; w.x = pg8::cvt_pk_bf16(v0[0], v0[1]); w.y = pg8::cvt_pk_bf16(v0[2], v0[3]); w.z = pg8::cvt_pk_bf16(v1[0], v1[1]); w.w = pg8::cvt_pk_bf16(v1[2], v1[3]);
                *(v4u*)(rowp + bj * 128) = w; } }
}
struct EpiProj {
    static constexpr bool PERM = true, AFTER_DRAIN = false;
    unsigned char* ws; const float* b_forget;
    __device__ __forceinline__ void operator()(const accv (&acc)[2][2][4][2], const pg8::Unit& u, int wr, int wc, int fr, int fq) const {
        const int pn = u.pn;
        if (pn != 26) {
            size_t off; int ldc, colt, prow = u.pm * 256; float sc = 1.f; bool sig = false;
            if (pn == 0) { off = WS_GQ; ldc = 256; colt = 0; sc = 0.125f; }
            else if (pn == 1) { off = WS_GK; ldc = 256; colt = 0; }
            else if (pn < 4) { off = WS_GV; ldc = 512; colt = (pn - 2) * 256; }
            else if (pn < 6) { off = WS_GG; ldc = 512; colt = (pn - 4) * 256; }
            else if (pn < 8) { off = WS_FQ; ldc = 512; colt = (pn - 6) * 256; sc = 0.125f * LOG2E_; }
            else if (pn < 10) { off = WS_FK; ldc = 512; colt = (pn - 8) * 256; }
            else if (pn < 12) { off = WS_FV; ldc = 512; colt = (pn - 10) * 256; }
            else if (pn < 14) { off = WS_MQ; ldc = 512; colt = (pn - 12) * 256; sc = 0.08838834764831845f * LOG2E_; }
            else if (pn < 26) { off = WS_GT; ldc = 3072; colt = (pn - 14) * 256; sig = true; }
            else if (pn < 29) { off = WS_MK; ldc = 512; colt = (pn - 27) * 256; prow = 0; }
            else { off = WS_MVT; ldc = 512; colt = (pn - 29) * 256; prow = 0; }
            store_bf16_tile(acc, (bf16*)(ws + off), ldc, prow + wr * 64 + fr, colt + wc * 32 + 8 * fq, sc, sig);
        } else {
            if (wc == 0 && fq < 3) {
                float* GA = (float*)(ws + WS_GA); float* LF = (float*)(ws + WS_LOGF);
                accv bf0 = (accv){0.f, 0.f, 0.f, 0.f}, bf1 = bf0;
                if (fq == 2) { bf0 = *(const accv*)(b_forget); bf1 = *(const accv*)(b_forget + 4); }
#pragma unroll
                for (int ai = 0; ai < 2; ++ai)
#pragma unroll
                    for (int m = 0; m < 4; ++m) { const size_t row = (size_t)(u.pm * 256 + wr * 64 + fr + ai * 128 + m * 16);
                        const accv v0 = acc[ai][0][m][0], v1 = acc[ai][0][m][1];
                        if (fq < 2) { *(accv*)(GA + row * 16 + 8 * fq) = v0; *(accv*)(GA + row * 16 + 8 * fq + 4) = v1; }
                        else { const accv a = v0 + bf0, b = v1 + bf1;
#pragma unroll
                            for (int j = 0; j < 4; ++j) { LF[(size_t)j * S_ + row] = logsigmoidf_(a[j]); LF[(size_t)(4 + j) * S_ + row] = logsigmoidf_(b[j]); } } }
            }
        }
    }
};
struct EpiMerge {
    static constexpr bool PERM = true, AFTER_DRAIN = false;
    bf16* MG; const bf16* GT;
    __device__ __forceinline__ void mid(accv (&acc)[2][2][4][2], const pg8::Unit& u, int s, int wr, int wc, int fr, int fq) const {
        const int row0 = u.pm * 256 + wr * 64 + fr, col0 = u.pn * 256 + wc * 32 + 8 * fq;
#pragma unroll
        for (int ai = 0; ai < 2; ++ai)
#pragma unroll
            for (int m = 0; m < 4; ++m) { const size_t row = (size_t)(row0 + ai * 128 + m * 16);
#pragma unroll
                for (int bj = 0; bj < 2; ++bj) { const int col = col0 + bj * 128;
                    const v4u a = *(const v4u*)(GT + row * 3072 + (s - 1) * 1024 + col), b = *(const v4u*)(GT + row * 3072 + s * 1024 + col);
                    const accv r0 = (accv){bflo(a.x) * __builtin_amdgcn_rcpf(fmaxf(bflo(b.x), 1e-30f)), bfhi(a.x) * __builtin_amdgcn_rcpf(fmaxf(bfhi(b.x), 1e-30f)), bflo(a.y) * __builtin_amdgcn_rcpf(fmaxf(bflo(b.y), 1e-30f)), bfhi(a.y) * __builtin_amdgcn_rcpf(fmaxf(bfhi(b.y), 1e-30f))};
                    const accv r1 = (accv){bflo(a.z) * __builtin_amdgcn_rcpf(fmaxf(bflo(b.z), 1e-30f)), bfhi(a.z) * __builtin_amdgcn_rcpf(fmaxf(bfhi(b.z), 1e-30f)), bflo(a.w) * __builtin_amdgcn_rcpf(fmaxf(bflo(b.w), 1e-30f)), bfhi(a.w) * __builtin_amdgcn_rcpf(fmaxf(bfhi(b.w), 1e-30f))};
                    acc[ai][bj][m][0] = acc[ai][bj][m][0] * r0; acc[ai][bj][m][1] = acc[ai][bj][m][1] * r1; } }
    }
    __device__ __forceinline__ void operator()(const accv (&acc)[2][2][4][2], const pg8::Unit& u, int wr, int wc, int fr, int fq) const {
        const int row0 = u.pm * 256 + wr * 64 + fr, col0 = u.pn * 256 + wc * 32 + 8 * fq;
#pragma unroll
        for (int ai = 0; ai < 2; ++ai)
#pragma unroll
            for (int m = 0; m < 4; ++m) { const size_t row = (size_t)(row0 + ai * 128 + m * 16);
#pragma unroll
                for (int bj = 0; bj < 2; ++bj) { const int col = col0 + bj * 128;
                    const v4u g = *(const v4u*)(GT + row * 3072 + 2 * 1024 + col);
                    accv v0 = acc[ai][bj][m][0], v1 = acc[ai][bj][m][1];
                    v0 = v0 * (accv){bflo(g.x), bfhi(g.x), bflo(g.y), bfhi(g.y)}; v1 = v1 * (accv){bflo(g.z), bfhi(g.z), bflo(g.w), bfhi(g.w)};
                    v4u w; w.x = pg8::cvt_pk_bf16(v0[0], v0[1]); w.y = pg8::cvt_pk_bf16(v0[2], v0[3]); w.z = pg8::cvt_pk_bf16(v1[0], v1[1]); w.w = pg8::cvt_pk_bf16(v1[2], v1[3]);
                    *(v4u*)(MG + row * 1024 + col) = w; } }
    }
};
template <bool WRITE_U2, bool BASE_BF16> struct EpiResid {
    static constexpr bool PERM = true, AFTER_DRAIN = false;
    const void* base; bf16* H0; bf16* H1; bf16* U2; const float* gain; float* SS;
    __device__ __forceinline__ void operator()(const accv (&acc)[2][2][4][2], const pg8::Unit& u, int wr, int wc, int fr, int fq) const {
        bf16* HB = u.pm < 32 ? H0 : H1;
        const int row0 = u.pm * 256 + wr * 64 + fr, col0 = u.pn * 256 + wc * 32 + 8 * fq;
#pragma unroll
        for (int ai = 0; ai < 2; ++ai)
#pragma unroll
            for (int m = 0; m < 4; ++m) { const size_t row = (size_t)(row0 + ai * 128 + m * 16); float ssq = 0.f;
#pragma unroll
                for (int bj = 0; bj < 2; ++bj) { const int col = col0 + bj * 128; const size_t o = row * 1024 + col;
                    accv b0, b1;
                    if (BASE_BF16) { const v4u bw = *(const v4u*)((const bf16*)base + o); b0 = (accv){bflo(bw.x), bfhi(bw.x), bflo(bw.y), bfhi(bw.y)}; b1 = (accv){bflo(bw.z), bfhi(bw.z), bflo(bw.w), bfhi(bw.w)}; }
                    else { b0 = *(const accv*)((const float*)base + o); b1 = *(const accv*)((const float*)base + o + 4); }
                    const accv h0 = b0 + acc[ai][bj][m][0], h1 = b1 + acc[ai][bj][m][1];
                    { v4u w; w.x = pg8::cvt_pk_bf16(h0[0], h0[1]); w.y = pg8::cvt_pk_bf16(h0[2], h0[3]); w.z = pg8::cvt_pk_bf16(h1[0], h1[1]); w.w = pg8::cvt_pk_bf16(h1[2], h1[3]); *(v4u*)(HB + o) = w; }
                    ssq += (h0[0] * h0[0] + h0[1] * h0[1]) + (h0[2] * h0[2] + h0[3] * h0[3]) + (h1[0] * h1[0] + h1[1] * h1[1]) + (h1[2] * h1[2] + h1[3] * h1[3]);
                    if (WRITE_U2) { const accv g0 = *(const accv*)(gain + col), g1 = *(const accv*)(gain + col + 4); const accv a = h0 * g0, b = h1 * g1;
                        v4u w; w.x = pg8::cvt_pk_bf16(a[0], a[1]); w.y = pg8::cvt_pk_bf16(a[2], a[3]); w.z = pg8::cvt_pk_bf16(b[0], b[1]); w.w = pg8::cvt_pk_bf16(b[2], b[3]);
                        *(v4u*)(U2 + o) = w; } }
                ssq += __shfl_xor(ssq, 16); ssq += __shfl_xor(ssq, 32);
                if (fq == 0) SS[row * 16 + u.pn * 4 + wc] = ssq; }
    }
};
struct EpiFinal {
    static constexpr bool PERM = true, AFTER_DRAIN = true;
    const bf16* H0; const bf16* H1; float* out; const float* gain; float* xbuf; unsigned* cnt;
    __device__ __forceinline__ void fused(accv (&acc)[2][2][4][2], const pg8::Unit& u, int wr, int wc, int fr, int fq, LAS unsigned char* lds, int wid, int lane) const {
        const bf16* HB = u.pm < 32 ? H0 : H1;
        LAS float* Pl = (LAS float*)lds; LAS float* Sl = (LAS float*)(lds + 4096);
        const int row0 = u.pm * 256 + wr * 64 + fr, col0 = u.pn * 256 + wc * 32 + 8 * fq;
#pragma unroll
        for (int ai = 0; ai < 2; ++ai)
#pragma unroll
            for (int m = 0; m < 4; ++m) { const size_t row = (size_t)(row0 + ai * 128 + m * 16); float ssq = 0.f;
#pragma unroll
                for (int bj = 0; bj < 2; ++bj) { const size_t o = row * 1024 + col0 + bj * 128; const v4u bw = *(const v4u*)(HB + o);
                    const accv h0 = acc[ai][bj][m][0] + (accv){bflo(bw.x), bfhi(bw.x), bflo(bw.y), bfhi(bw.y)}, h1 = acc[ai][bj][m][1] + (accv){bflo(bw.z), bfhi(bw.z), bflo(bw.w), bfhi(bw.w)};
                    acc[ai][bj][m][0] = h0; acc[ai][bj][m][1] = h1;
                    ssq += (h0[0] * h0[0] + h0[1] * h0[1]) + (h0[2] * h0[2] + h0[3] * h0[3]) + (h1[0] * h1[0] + h1[1] * h1[1]) + (h1[2] * h1[2] + h1[3] * h1[3]); }
                ssq += __shfl_xor(ssq, 16); ssq += __shfl_xor(ssq, 32);
                if (fq == 0) Pl[(ai * 128 + wr * 64 + m * 16 + fr) * 4 + wc] = ssq; }
        asm volatile("s_waitcnt lgkmcnt(0)" ::: "memory"); __builtin_amdgcn_s_barrier(); asm volatile("" ::: "memory");
        const int rowl = wid * 32 + (lane & 31);
        if (lane < 32) { const float s = (Pl[rowl * 4] + Pl[rowl * 4 + 1]) + (Pl[rowl * 4 + 2] + Pl[rowl * 4 + 3]);
            __hip_atomic_store(xbuf + ((size_t)(u.pm * 256 + rowl) * 4 + u.pn), s, __ATOMIC_RELAXED, __HIP_MEMORY_SCOPE_AGENT); }
        asm volatile("s_waitcnt vmcnt(0)" ::: "memory");
        if (lane == 0) __hip_atomic_fetch_add(cnt + 64 * u.pm, 1u, __ATOMIC_RELAXED, __HIP_MEMORY_SCOPE_AGENT);
        if (wid == 0) { unsigned sp = 0;
            while ((unsigned)__builtin_amdgcn_readfirstlane(__hip_atomic_load(cnt + 64 * u.pm, __ATOMIC_RELAXED, __HIP_MEMORY_SCOPE_AGENT)) < 32u) { __builtin_amdgcn_s_sleep(2); if (++sp > (1u << 22)) break; }
            __builtin_amdgcn_fence(__ATOMIC_ACQUIRE, "agent"); }
        asm volatile("s_waitcnt vmcnt(0) lgkmcnt(0)" ::: "memory"); __builtin_amdgcn_s_barrier(); asm volatile("" ::: "memory");
        if (lane < 32) { const float* sl = xbuf + (size_t)(u.pm * 256 + rowl) * 4;
            const float a = __hip_atomic_load(sl, __ATOMIC_RELAXED, __HIP_MEMORY_SCOPE_AGENT), b = __hip_atomic_load(sl + 1, __ATOMIC_RELAXED, __HIP_MEMORY_SCOPE_AGENT),
                        c = __hip_atomic_load(sl + 2, __ATOMIC_RELAXED, __HIP_MEMORY_SCOPE_AGENT), d = __hip_atomic_load(sl + 3, __ATOMIC_RELAXED, __HIP_MEMORY_SCOPE_AGENT);
            Sl[rowl] = rsqrtf(((a + b) + (c + d)) * (1.f / 1024.f) + EPS_); }
        asm volatile("s_waitcnt vmcnt(0) lgkmcnt(0)" ::: "memory"); __builtin_amdgcn_s_barrier(); asm volatile("" ::: "memory");
#pragma unroll
        for (int ai = 0; ai < 2; ++ai)
#pragma unroll
            for (int m = 0; m < 4; ++m) { const int rl = ai * 128 + wr * 64 + m * 16 + fr; const float r = Sl[rl]; const size_t row = (size_t)(u.pm * 256 + rl);
#pragma unroll
                for (int bj = 0; bj < 2; ++bj) { const int col = col0 + bj * 128; const accv g0 = *(const accv*)(gain + col), g1 = *(const accv*)(gain + col + 4);
                    *(accv*)(out + row * 1024 + col) = acc[ai][bj][m][0] * r * g0; *(accv*)(out + row * 1024 + col + 4) = acc[ai][bj][m][1] * r * g1; } }
    }
};
struct EpiFfn1 {
    static constexpr bool PERM = true, AFTER_DRAIN = false;
    bf16* HID; const float* SS;
    __device__ __forceinline__ void operator()(const accv (&acc)[2][2][4][2], const pg8::Unit& u, int wr, int wc, int fr, int fq) const {
        const int row0 = u.pm * 256 + wr * 64 + fr, col0 = u.pn * 256 + wc * 32 + 8 * fq;
#pragma unroll
        for (int ai = 0; ai < 2; ++ai)
#pragma unroll
            for (int m = 0; m < 4; ++m) { const size_t row = (size_t)(row0 + ai * 128 + m * 16);
                const accv s0 = *(const accv*)(SS + row * 16), s1 = *(const accv*)(SS + row * 16 + 4), s2 = *(const accv*)(SS + row * 16 + 8), s3 = *(const accv*)(SS + row * 16 + 12);
                const float tot = ((s0[0] + s0[1]) + (s0[2] + s0[3])) + ((s1[0] + s1[1]) + (s1[2] + s1[3])) + ((s2[0] + s2[1]) + (s2[2] + s2[3])) + ((s3[0] + s3[1]) + (s3[2] + s3[3]));
                const float r = rsqrtf(tot * (1.f / 1024.f) + EPS_);
#pragma unroll
                for (int bj = 0; bj < 2; ++bj) { accv v0 = acc[ai][bj][m][0] * r, v1 = acc[ai][bj][m][1] * r;
#pragma unroll
                    for (int j = 0; j < 4; ++j) { const float a = fmaxf(v0[j], 0.f), b = fmaxf(v1[j], 0.f); v0[j] = a * a; v1[j] = b * b; }
                    v4u w; w.x = pg8::cvt_pk_bf16(v0[0], v0[1]); w.y = pg8::cvt_pk_bf16(v0[2], v0[3]); w.z = pg8::cvt_pk_bf16(v1[0], v1[1]); w.w = pg8::cvt_pk_bf16(v1[2], v1[3]);
                    *(v4u*)(HID + row * 4096 + col0 + bj * 128) = w; } }
    }
};

constexpr int GP = 144;
__device__ __forceinline__ void gla_a_unit(const Ptrs& P, LAS unsigned char* lds, int n, int h, int wv) {
    const int tid = fresh_tid(wv), lane = tid & 63, g = wv, r32 = lane & 31, hh = lane >> 5;
    LAS unsigned char* QP = lds; LAS unsigned char* QN = lds + 9216; LAS unsigned char* KN = lds + 18432; LAS unsigned char* KP = lds + 27648;
    LAS unsigned char* KLT = lds + 36864; LAS unsigned char* AT = lds + 46080; LAS unsigned char* VT = lds + 55296; LAS float* TOT = (LAS float*)(lds + 73728);
    bf16* GQ = (bf16*)(P.ws + WS_GQ); const bf16* GK = (const bf16*)(P.ws + WS_GK); bf16* GV = (bf16*)(P.ws + WS_GV);
    const float* GA = (const float*)(P.ws + WS_GA); float* DEC = (float*)(P.ws + WS_DEC); bf16* STATE = (bf16*)((unsigned char*)P.out + OUT_STATE);
    const int c = h * 64 + lane, t0 = n * 64;
#ifdef PROBE_PHASE
#define GSTAMP(k) do { if (n == 64 && h == 0 && tid == 0) ((unsigned long long*)(P.ws + 253 * MiB))[(k)] = __builtin_amdgcn_s_memrealtime(); } while (0)
#else
#define GSTAMP(k) do {} while (0)
#endif
    GSTAMP(60);
    float wup[16];
#pragma unroll
    for (int j = 0; j < 16; ++j) wup[j] = P.w_alpha_up[j * 256 + c];
    const float ba = P.b_alpha[c];
    unsigned short qraw[8], kraw[8];
#pragma unroll
    for (int i = 0; i < 8; ++i) { const size_t gi = (size_t)(t0 + 8 * g + i) * 256 + c; qraw[i] = GQ[gi]; kraw[i] = GK[gi]; }
    float bl[8]; float run = 0.f;
#pragma unroll
    for (int i = 0; i < 8; ++i) { const f32x4* gar = (const f32x4*)(GA + (size_t)(t0 + 8 * g + i) * 16); float z = ba;
#pragma unroll
        for (int j4 = 0; j4 < 4; ++j4) { const f32x4 a = gar[j4]; z += a[0] * wup[4 * j4] + a[1] * wup[4 * j4 + 1] + a[2] * wup[4 * j4 + 2] + a[3] * wup[4 * j4 + 3]; }
        run += logsigmoid_fast(z) * (1.f / 16.f); bl[i] = run; }
    TOT[g * 64 + lane] = run;
    { const int s = tid >> 3, vc = tid & 7; const v4u a = *(const v4u*)(GV + (size_t)(t0 + s) * 512 + h * 128 + vc * 16), b = *(const v4u*)(GV + (size_t)(t0 + s) * 512 + h * 128 + vc * 16 + 8);
      LAS bf16* vt = (LAS bf16*)VT; const unsigned w[8] = {a.x, a.y, a.z, a.w, b.x, b.y, b.z, b.w};
#pragma unroll
      for (int j = 0; j < 8; ++j) { vt[(vc * 16 + 2 * j) * 72 + s] = (bf16)(w[j] & 0xffffu); vt[(vc * 16 + 2 * j + 1) * 72 + s] = (bf16)(w[j] >> 16); } }
    LBAR(); GSTAMP(61);
    float off = 0.f, blast = 0.f;
#pragma unroll
    for (int gg = 0; gg < 8; ++gg) { const float tv = TOT[gg * 64 + lane]; if (gg < g) off += tv; blast += tv; }
    unsigned kl[8];
#pragma unroll
    for (int i = 0; i < 8; ++i) { const int t = 8 * g + i; const float b = off + bl[i]; const size_t gi = (size_t)(t0 + t) * 256 + c;
        const float q = bf2f(qraw[i]), k = bf2f(kraw[i]); const float ep = __expf(b), en = __expf(-b), el = __expf(blast - b);
        const unsigned qp = f2bf(q * ep); GQ[gi] = (bf16)qp;
        ((LAS bf16*)QP)[t * 72 + lane] = (bf16)qp; ((LAS bf16*)QN)[t * 72 + lane] = (bf16)f2bf(q * en);
        ((LAS bf16*)KN)[t * 72 + lane] = (bf16)f2bf(k * en); ((LAS bf16*)KP)[t * 72 + lane] = (bf16)f2bf(k * ep); kl[i] = f2bf(k * el); }
    *(LAS v4u*)(KLT + lane * GP + 16 * g) = (v4u){kl[0] | (kl[1] << 16), kl[2] | (kl[3] << 16), kl[4] | (kl[5] << 16), kl[6] | (kl[7] << 16)};
    if (g == 0) DEC[(n * 4 + h) * 64 + lane] = __expf(blast);
    LBAR(); GSTAMP(62);
    const f32x16 zero = {};
    if (g < 4) {
        const int ti = g >> 1, si = g & 1; f32x16 ac = zero, an = zero;
        if (ti >= si) {
#pragma unroll
            for (int ks = 0; ks < 4; ++ks) ac = MFMA32(ldfrag(QP, 32 * ti + r32, GP, 32 * ks + 16 * hh), ldfrag(KN, 32 * si + r32, GP, 32 * ks + 16 * hh), ac); }
        if (ti <= si) {
#pragma unroll
            for (int ks = 0; ks < 4; ++ks) an = MFMA32(ldfrag(QN, 32 * ti + r32, GP, 32 * ks + 16 * hh), ldfrag(KP, 32 * si + r32, GP, 32 * ks + 16 * hh), an); }
#pragma unroll
        for (int i = 0; i < 16; ++i) { const int t = 32 * ti + crow_(i, hh), s = 32 * si + r32; ((LAS bf16*)AT)[t * 72 + s] = (bf16)f2bf(t >= s ? ac[i] : an[i]); }
    } else {
        const int vi = g - 4;
#pragma unroll
        for (int dj = 0; dj < 2; ++dj) { f32x16 st = zero;
#pragma unroll
            for (int ks = 0; ks < 4; ++ks) st = MFMA32(ldfrag(KLT, 32 * dj + r32, GP, 32 * ks + 16 * hh), ldfrag(VT, 32 * vi + r32, GP, 32 * ks + 16 * hh), st);
#pragma unroll
            for (int i4 = 0; i4 < 4; ++i4) *(v2u*)(STATE + (size_t)(n * 4 + h) * 8192 + (size_t)(((vi * 4 + 2 * dj + (i4 >> 1)) * 64 + r32 + 32 * (i4 & 1)) * 8 + 4 * hh)) = (v2u){pk2(st[4 * i4], st[4 * i4 + 1]), pk2(st[4 * i4 + 2], st[4 * i4 + 3])}; }
    }
    LBAR(); GSTAMP(63);
    { const int ti = g >> 2, vj = g & 3; f32x16 oi = zero;
#pragma unroll
      for (int ks = 0; ks < 4; ++ks) oi = MFMA32(ldfrag(AT, 32 * ti + r32, GP, 32 * ks + 16 * hh), ldfrag(VT, 32 * vj + r32, GP, 32 * ks + 16 * hh), oi);
#pragma unroll
      for (int i = 0; i < 16; ++i) GV[(size_t)(t0 + 32 * ti + crow_(i, hh)) * 512 + h * 128 + 32 * vj + r32] = (bf16)f2bf(oi[i]); }
    LBAR(); GSTAMP(64);
}
__device__ __forceinline__ void gla_scan_unit(const Ptrs& P, LAS unsigned char* lds, int u, int wv) {
    const int tid = fresh_tid(wv), lane = tid & 63, w = wv;
    const int h = u >> 6, e0 = (u & 63) * 128;
    const int dch = 16 * ((e0 >> 9) & 3) + 8 * ((e0 >> 8) & 1) + ((2 * lane) & 7);
    unsigned* STATE = (unsigned*)((unsigned char*)P.out + OUT_STATE); const float* DEC = (const float*)(P.ws + WS_DEC);
    LAS float* segS = (LAS float*)lds; LAS float* segP = (LAS float*)(lds + 8192);
    float kv[2][32], dc[2][32];
#pragma unroll
    for (int i = 0; i < 32; ++i) { const int n = 32 * w + i; const unsigned wd = STATE[((size_t)(n * 4 + h) * 8192 + e0) / 2 + lane]; kv[0][i] = bflo(wd); kv[1][i] = bfhi(wd);
        const float2 d2 = *(const float2*)(DEC + (n * 4 + h) * 64 + dch); dc[0][i] = d2.x; dc[1][i] = d2.y; }
    float s[2] = {0.f, 0.f}, pr[2] = {1.f, 1.f};
#pragma unroll
    for (int i = 0; i < 32; ++i) {
#pragma unroll
        for (int e = 0; e < 2; ++e) { const float pv = s[e]; s[e] = s[e] * dc[e][i] + kv[e][i]; kv[e][i] = pv; pr[e] *= dc[e][i]; } }
    segS[w * 64 + lane] = s[0]; segS[512 + w * 64 + lane] = s[1]; segP[w * 64 + lane] = pr[0]; segP[512 + w * 64 + lane] = pr[1];
    LBAR();
    float sin_[2] = {0.f, 0.f};
#pragma unroll
    for (int ww = 0; ww < 8; ++ww) { const float a0 = segS[ww * 64 + lane], a1 = segS[512 + ww * 64 + lane], b0 = segP[ww * 64 + lane], b1 = segP[512 + ww * 64 + lane]; if (ww < w) { sin_[0] = sin_[0] * b0 + a0; sin_[1] = sin_[1] * b1 + a1; } }
    float cp[2] = {1.f, 1.f};
#pragma unroll
    for (int i = 0; i < 32; ++i) { const int n = 32 * w + i;
        STATE[((size_t)(n * 4 + h) * 8192 + e0) / 2 + lane] = pk2(kv[0][i] + cp[0] * sin_[0], kv[1][i] + cp[1] * sin_[1]);
        cp[0] *= dc[0][i]; cp[1] *= dc[1][i]; }
    LBAR();
}
__device__ __forceinline__ void gla_b_task(const Ptrs& P, int task, int lane) {
    const int r32 = lane & 31, hh = lane >> 5;
    const int ti = task & 1, h = (task >> 1) & 3, n = task >> 3;
    const bf16* GQ = (const bf16*)(P.ws + WS_GQ); const bf16* GV = (const bf16*)(P.ws + WS_GV); bf16* GG = (bf16*)(P.ws + WS_GG);
    const bf16* SB = (const bf16*)((unsigned char*)P.out + OUT_STATE) + (size_t)(n * 4 + h) * 8192;
    const size_t t = (size_t)n * 64 + 32 * ti + r32;
    bf16x8 qf[4];
#pragma unroll
    for (int ks = 0; ks < 4; ++ks) qf[ks] = *(const bf16x8*)(GQ + t * 256 + h * 64 + 16 * ks + 8 * hh);
    f32x16 o[4];
#pragma unroll
    for (int vj = 0; vj < 4; ++vj) { o[vj] = (f32x16){};
#pragma unroll
        for (int ks = 0; ks < 4; ++ks) { const bf16x8 af = *(const bf16x8*)(SB + ((vj * 4 + ks) * 64 + lane) * 8);
            o[vj] = MFMA32(af, qf[ks], o[vj]); }
        asm volatile("" ::: "memory"); }
    float ov[64]; float ss = 0.f;
#pragma unroll
    for (int vj = 0; vj < 4; ++vj) {
#pragma unroll
        for (int g4 = 0; g4 < 4; ++g4) { const v2u w = *(const v2u*)(GV + t * 512 + h * 128 + 32 * vj + 8 * g4 + 4 * hh);
            const float a0 = o[vj][4 * g4] + bflo(w.x), a1 = o[vj][4 * g4 + 1] + bfhi(w.x), a2 = o[vj][4 * g4 + 2] + bflo(w.y), a3 = o[vj][4 * g4 + 3] + bfhi(w.y);
            ov[16 * vj + 4 * g4] = a0; ov[16 * vj + 4 * g4 + 1] = a1; ov[16 * vj + 4 * g4 + 2] = a2; ov[16 * vj + 4 * g4 + 3] = a3;
            ss += (a0 * a0 + a1 * a1) + (a2 * a2 + a3 * a3); } }
    ss += __shfl_xor(ss, 32);
    const float r = rsqrtf(ss * (1.f / 128.f) + EPS_);
#pragma unroll
    for (int vj = 0; vj < 4; ++vj) {
#pragma unroll
        for (int g4 = 0; g4 < 4; ++g4) { const int vc = h * 128 + 32 * vj + 8 * g4 + 4 * hh; const v2u gw = *(const v2u*)(GG + t * 512 + vc); const f32x4 gn = *(const f32x4*)(P.g_gla_head + vc);
            const float g0 = bflo(gw.x), g1 = bfhi(gw.x), g2 = bflo(gw.y), g3 = bfhi(gw.y);
            v2u ow; ow.x = pk2(ov[16 * vj + 4 * g4] * r * gn[0] * (g0 * sigmoidf_(g0)), ov[16 * vj + 4 * g4 + 1] * r * gn[1] * (g1 * sigmoidf_(g1)));
            ow.y = pk2(ov[16 * vj + 4 * g4 + 2] * r * gn[2] * (g2 * sigmoidf_(g2)), ov[16 * vj + 4 * g4 + 3] * r * gn[3] * (g3 * sigmoidf_(g3)));
            *(v2u*)(GG + t * 512 + vc) = ow; }
        asm volatile("" ::: "memory"); }
}
__device__ __forceinline__ void memattn_unit(const Ptrs& P, LAS unsigned char* lds, int hm, int qb, int wv) {
    const int tid = fresh_tid(wv), lane = tid & 63, w = wv, r32 = lane & 31, hh = lane >> 5;
    constexpr int KPB = 272, VPB = 528;
    LAS unsigned char* KM = lds; LAS unsigned char* VTM = lds + 69632; LAS float* LSUM = (LAS float*)(lds + 137216);
    const bf16* MK = (const bf16*)(P.ws + WS_MK); const bf16* MVT = (const bf16*)(P.ws + WS_MVT); bf16* MQ = (bf16*)(P.ws + WS_MQ);
#pragma unroll
    for (int j = 0; j < 8; ++j) { const int idx = tid + 512 * j; const int key = idx >> 4, ch = idx & 15; *(LAS v4u*)(KM + key * KPB + ch * 16) = *(const v4u*)(MK + (size_t)key * 512 + hm * 128 + ch * 8);
    }
    { const int dc = tid & 15, key0 = (tid >> 4) * 8; v4u in[8];
#pragma unroll
      for (int k = 0; k < 8; ++k) in[k] = *(const v4u*)(MVT + (size_t)(key0 + k) * 512 + hm * 128 + dc * 8);
#pragma unroll
      for (int jp = 0; jp < 4; ++jp) {
          unsigned e[8];
#pragma unroll
          for (int k = 0; k < 8; ++k) e[k] = jp == 0 ? in[k].x : (jp == 1 ? in[k].y : (jp == 2 ? in[k].z : in[k].w));
          const v4u lo = (v4u){(e[0] & 0xffffu) | (e[1] << 16), (e[2] & 0xffffu) | (e[3] << 16), (e[4] & 0xffffu) | (e[5] << 16), (e[6] & 0xffffu) | (e[7] << 16)};
          const v4u hi = (v4u){(e[0] >> 16) | (e[1] & 0xffff0000u), (e[2] >> 16) | (e[3] & 0xffff0000u), (e[4] >> 16) | (e[5] & 0xffff0000u), (e[6] >> 16) | (e[7] & 0xffff0000u)};
          *(LAS v4u*)(VTM + (8 * dc + 2 * jp) * VPB + key0 * 2) = lo; *(LAS v4u*)(VTM + (8 * dc + 2 * jp + 1) * VPB + key0 * 2) = hi; } }
    const size_t qrow = (size_t)qb * 256 + 32 * w + r32;
    bf16x8 qr[8];
#pragma unroll
    for (int ks = 0; ks < 8; ++ks) qr[ks] = *(const bf16x8*)(MQ + qrow * 512 + hm * 128 + 16 * ks + 8 * hh);
    LBAR();
    f32x16 p[8];
#pragma unroll
    for (int kb = 0; kb < 8; ++kb) { p[kb] = (f32x16){};
#pragma unroll
        for (int ks = 0; ks < 8; ++ks) p[kb] = MFMA32(ldfrag(KM, 32 * kb + r32, KPB, 32 * ks + 16 * hh), qr[ks], p[kb]); }
    float mx = -INFINITY;
#pragma unroll
    for (int kb = 0; kb < 8; ++kb)
#pragma unroll
        for (int i = 0; i < 16; ++i) mx = fmaxf(mx, p[kb][i]);
    mx = fmaxf(mx, __shfl_xor(mx, 32));
    float l = 0.f; v4u pk[8][2];
#pragma unroll
    for (int kb = 0; kb < 8; ++kb) {
#pragma unroll
        for (int i = 0; i < 16; ++i) { p[kb][i] = __builtin_amdgcn_exp2f(p[kb][i] - mx); l += p[kb][i]; }
#pragma unroll
        for (int s = 0; s < 2; ++s) pk[kb][s] = (v4u){pk2(p[kb][8 * s], p[kb][8 * s + 1]), pk2(p[kb][8 * s + 2], p[kb][8 * s + 3]), pk2(p[kb][8 * s + 4], p[kb][8 * s + 5]), pk2(p[kb][8 * s + 6], p[kb][8 * s + 7])}; }
    l += __shfl_xor(l, 32);
    if (hh == 0) LSUM[w * 32 + r32] = l;
    f32x16 o[4];
#pragma unroll
    for (int db = 0; db < 4; ++db) { o[db] = (f32x16){};
#pragma unroll
        for (int kb = 0; kb < 8; ++kb)
#pragma unroll
            for (int s = 0; s < 2; ++s) { const LAS unsigned char* vp = VTM + (32 * db + r32) * VPB + 64 * kb + 32 * s + 8 * hh;
                const s16x4 lo = *(const LAS s16x4*)vp, hi = *(const LAS s16x4*)(vp + 16);
                const bf16x8 bfr = (bf16x8){lo[0], lo[1], lo[2], lo[3], hi[0], hi[1], hi[2], hi[3]};
                o[db] = MFMA32(__builtin_bit_cast(bf16x8, pk[kb][s]), bfr, o[db]); } }
    LDS_WAIT(); asm volatile("" ::: "memory");
#pragma unroll
    for (int i = 0; i < 16; ++i) { const int ql = crow_(i, hh); const float rl = __builtin_amdgcn_rcpf(LSUM[w * 32 + ql]);
#pragma unroll
        for (int db = 0; db < 4; ++db) MQ[((size_t)qb * 256 + 32 * w + ql) * 512 + hm * 128 + 32 * db + r32] = (bf16)f2bf(o[db][i] * rl); }
    LBAR();
}
__device__ __forceinline__ float lse2f(float a, float b) { const float m = fmaxf(a, b), d = fminf(a, b) - m; return (m == -INFINITY) ? m : m + __log2f(1.f + __builtin_amdgcn_exp2f(d)); }
__device__ __forceinline__ void fcumsum_unit(const Ptrs& P, LAS unsigned char* lds, int hf, int wv) {
    const int tid = fresh_tid(wv), lane = tid & 63, w = wv;
    const float* LF = (const float*)(P.ws + WS_LOGF) + (size_t)hf * S_; float* F = (float*)(P.ws + WS_F) + (size_t)hf * S_;
    LAS float* X = (LAS float*)lds; LAS float* WT = (LAS float*)(lds + 69632);
#pragma unroll 8
    for (int j = 0; j < 32; ++j) { const int t = j * 512 + tid; X[t + (t >> 5)] = LF[t]; }
    LBAR();
    float loc[32]; float s = 0.f;
#pragma unroll
    for (int i = 0; i < 32; ++i) { s += X[tid * 33 + i]; loc[i] = s; }
    float incl = s;
#pragma unroll
    for (int o = 1; o < 64; o <<= 1) { const float y = __shfl_up(incl, o); if (lane >= o) incl += y; }
    if (lane == 63) WT[w] = incl;
    LBAR();
    float woff = 0.f;
#pragma unroll
    for (int ww = 0; ww < 8; ++ww) { const float a = WT[ww]; if (ww < w) woff += a; }
    const float off = woff + incl - s;
#pragma unroll
    for (int i = 0; i < 32; ++i) { loc[i] = off + loc[i]; X[tid * 33 + i] = loc[i]; }
    LBAR();
#pragma unroll 8
    for (int j = 0; j < 32; ++j) { const int t = j * 512 + tid; F[t] = X[t + (t >> 5)]; }
    LBAR();
    const float ref = loc[0]; float accl = 0.f;
#pragma unroll
    for (int i = 0; i < 32; ++i) accl += __builtin_amdgcn_exp2f((ref - loc[i]) * LOG2E_);
    float linc = __log2f(accl) - ref * LOG2E_;
#pragma unroll
    for (int o = 1; o < 64; o <<= 1) { const float y = __shfl_up(linc, o); if (lane >= o) linc = lse2f(linc, y); }
    if (lane == 63) WT[w] = linc;
    LBAR();
    float wpre = -INFINITY;
#pragma unroll
    for (int ww = 0; ww < 8; ++ww) { const float a = WT[ww]; if (ww < w) wpre = lse2f(wpre, a); }
    if ((tid & 3) == 3) ((float*)(P.ws + WS_LSEF))[hf * 128 + (tid >> 2)] = lse2f(wpre, linc);
    LBAR();
}

__device__ __forceinline__ void normmax_unit(const Ptrs& P, LAS unsigned char* lds, int j, int wv) {
    const int tid = fresh_tid(wv), r = tid >> 3, h = tid & 7;
    const bf16* FQ = (const bf16*)(P.ws + WS_FQ); const bf16* FK = (const bf16*)(P.ws + WS_FK); LAS float* RED = (LAS float*)lds;
    const v4u* qp = (const v4u*)(FQ + (size_t)(64 * j + r) * 512 + h * 64); const v4u* kp = (const v4u*)(FK + (size_t)(64 * j + r) * 512 + h * 64);
    float sq = 0.f, sk = 0.f, sd = 0.f;
#pragma unroll
    for (int c = 0; c < 8; ++c) { const v4u a = qp[c], b = kp[c];
        sq += bflo(a.x) * bflo(a.x) + bfhi(a.x) * bfhi(a.x) + bflo(a.y) * bflo(a.y) + bfhi(a.y) * bfhi(a.y) + bflo(a.z) * bflo(a.z) + bfhi(a.z) * bfhi(a.z) + bflo(a.w) * bflo(a.w) + bfhi(a.w) * bfhi(a.w);
        sk += bflo(b.x) * bflo(b.x) + bfhi(b.x) * bfhi(b.x) + bflo(b.y) * bflo(b.y) + bfhi(b.y) * bfhi(b.y) + bflo(b.z) * bflo(b.z) + bfhi(b.z) * bfhi(b.z) + bflo(b.w) * bflo(b.w) + bfhi(b.w) * bfhi(b.w);
        sd += bflo(a.x) * bflo(b.x) + bfhi(a.x) * bfhi(b.x) + bflo(a.y) * bflo(b.y) + bfhi(a.y) * bfhi(b.y) + bflo(a.z) * bflo(b.z) + bfhi(a.z) * bfhi(b.z) + bflo(a.w) * bflo(b.w) + bfhi(a.w) * bfhi(b.w); }
    RED[tid] = sq; RED[512 + tid] = sk; RED[1024 + tid] = -sd;
    LBAR();
    if (tid < 16) { const int hh = tid & 7, which = tid >> 3; float m = 0.f;
        for (int rr = 0; rr < 64; ++rr) m = fmaxf(m, RED[which * 512 + rr * 8 + hh]);
        atomicMax((unsigned*)P.ws + which * 8 + hh, __float_as_uint(m));
        if (which == 0) ((float*)(P.ws + WS_QB2))[j * 8 + hh] = m; }
    else if (tid < 24) { const int hh = tid & 7; float m = -INFINITY;
        for (int rr = 0; rr < 64; ++rr) m = fmaxf(m, RED[1024 + rr * 8 + hh]);
        ((float*)(P.ws + WS_NDOT))[j * 8 + hh] = m; }
    LBAR();
}
#define RLX_AGENT __ATOMIC_RELAXED, __HIP_MEMORY_SCOPE_AGENT
#define XB_TMO      128
#define XB_XCNT(j)  (256  + 64 * (j))
#define XB_XSUB(j)  (1280 + 64 * (j))
#define XB_XGEN(j)  (2304 + 64 * (j))
#define XB_TOP      3328
#define XB_TOPGEN   3392
#define XCD_BAR_WORDS 3456
#define XB_SPIN_CAP (1u << 18)

__device__ __forceinline__ unsigned xb_ld(unsigned* p)              { return __hip_atomic_load(p, __ATOMIC_RELAXED, __HIP_MEMORY_SCOPE_AGENT); }
__device__ __forceinline__ unsigned xb_add(unsigned* p, unsigned v) { return __hip_atomic_fetch_add(p, v, __ATOMIC_RELAXED, __HIP_MEMORY_SCOPE_AGENT); }
__device__ __forceinline__ unsigned xb_xcc_id() { return (unsigned)__builtin_amdgcn_s_getreg((3 << 11) | 20) & 0xFu; }
#define XB_SPIN(cond, bar) do { unsigned _sp = 0; while (cond) { __builtin_amdgcn_s_sleep(1); \
    if ((++_sp & 255u) == 0u) { if (xb_ld(&(bar)[XB_TMO])) break; if (_sp > XB_SPIN_CAP) { atomicAdd(&(bar)[XB_TMO], 1u); break; } } } } while (0)

struct XcdBarrier {
    unsigned* bar; unsigned x;
    volatile LAS unsigned* st;
};

__device__ __forceinline__ XcdBarrier xcd_barrier_post(unsigned* bar, volatile LAS unsigned* st, int wv) {
    XcdBarrier b; b.bar = bar; b.x = xb_xcc_id(); b.st = st;
    if (fresh_tid(wv) == 0) (void)xb_add(&bar[XB_XCNT(b.x)], 1u);
    return b;
}
__device__ __forceinline__ void xcd_barrier_complete(unsigned* bar, unsigned x, unsigned& nloc, unsigned& nx) {
    const unsigned G = gridDim.x * gridDim.y * gridDim.z;
    unsigned sum, cnt, mine, sp = 0u;
    for (;;) {
        sum = 0u; cnt = 0u; mine = 0u;
#pragma unroll
        for (unsigned j = 0; j < 16; ++j) { const unsigned c = xb_ld(&bar[XB_XCNT(j)]); sum += c; cnt += (c > 0u) ? 1u : 0u; mine = (j == x) ? c : mine; }
        if (sum == G) break;
        __builtin_amdgcn_s_sleep(1);
        if ((++sp & 255u) == 0u) { if (xb_ld(&bar[XB_TMO])) break; if (sp > XB_SPIN_CAP) { atomicAdd(&bar[XB_TMO], 1u); break; } }
    }
    nloc = mine > 0u ? mine : 1u; nx = cnt > 0u ? cnt : 1u;
}

__device__ __forceinline__ void xcd_barrier(const XcdBarrier& b, int wv) {
    asm volatile("s_waitcnt vmcnt(0)" ::: "memory");
    __syncthreads();
    if (fresh_tid(wv) == 0) {
        unsigned* bar = b.bar;
        __builtin_amdgcn_s_waitcnt(0);
        unsigned nloc = b.st[0], nx = b.st[1];
        if (nloc == 0u) { xcd_barrier_complete(bar, b.x, nloc, nx); b.st[0] = nloc; b.st[1] = nx; }
        const unsigned old = xb_add(&bar[XB_XSUB(b.x)], 1u);
        const unsigned gen = old / nloc;
        if (old + 1u == (gen + 1u) * nloc) {
            __builtin_amdgcn_fence(__ATOMIC_RELEASE, "agent");
            asm volatile("s_waitcnt vmcnt(0)" ::: "memory");
            const unsigned og = xb_add(&bar[XB_TOP], 1u);
            const unsigned tg = og / nx;
            if (og + 1u == (tg + 1u) * nx) xb_add(&bar[XB_TOPGEN], 1u);
            else XB_SPIN(xb_ld(&bar[XB_TOPGEN]) == tg, bar);
            __builtin_amdgcn_fence(__ATOMIC_ACQUIRE, "agent");
            xb_add(&bar[XB_XGEN(b.x)], 1u);
            asm volatile("s_waitcnt vmcnt(0)" ::: "memory");
        } else {
            XB_SPIN(xb_ld(&bar[XB_XGEN(b.x)]) == gen, bar);
            __builtin_amdgcn_fence(__ATOMIC_ACQUIRE, "agent");
            asm volatile("s_waitcnt vmcnt(0)" ::: "memory");
        }
    }
    __syncthreads();
}

constexpr int CW_BAR = 4096;
constexpr size_t CTL_ZERO_BYTES = 65536;
constexpr int MISC_OFF = 151552;
struct Args { const float* in[18]; float* out; unsigned char* ws; int ph_lo, ph_hi; };
constexpr int N_PHASES = 9;
__global__ void __launch_bounds__(NWAVES * 64, 2) hybrid_fwd(Args args) {
    extern __shared__ __attribute__((aligned(16))) unsigned char lds_raw[];
    cg::grid_group grid = cg::this_grid();
    LAS unsigned char* lds = (LAS unsigned char*)lds_raw;
    const int wv = __builtin_amdgcn_readfirstlane((int)(threadIdx.x >> 6));
    const int G = gridDim.x, bx = blockIdx.x; const int vcu = (G % 8 == 0) ? (bx % 8) * (G / 8) + bx / 8 : bx;
    Ptrs P;
    P.x = args.in[0]; P.mem = args.in[1]; P.g_mix = args.in[2]; P.w_in = args.in[3]; P.w_alpha_up = args.in[4]; P.b_alpha = args.in[5]; P.b_forget = args.in[6]; P.g_gla_head = args.in[7];
    P.g_mem = args.in[8]; P.w_mem_kv = args.in[9]; P.w_gla_o = args.in[10]; P.w_fox_o = args.in[11]; P.w_mem_o = args.in[12]; P.w_out = args.in[13]; P.g_ffn = args.in[14]; P.w_ff1 = args.in[15];
    P.w_ff2 = args.in[16]; P.g_final = args.in[17]; P.out = args.out; P.ws = args.ws;
    unsigned char* ws = args.ws;
    const int lo = args.ph_lo, hi = args.ph_hi;
    if (hi > 1000) grid.sync();
    volatile LAS unsigned* MISC = (volatile LAS unsigned*)(lds + MISC_OFF);
    { const int t_ = fresh_tid(wv); if (t_ < 2) MISC[t_] = 0u; }
    __syncthreads();
    const XcdBarrier bar = xcd_barrier_post((unsigned*)ws + CW_BAR, MISC, wv);
#ifndef PH_MASK
#define PH_MASK 0x3ff
#endif
#define IN(k) ((((PH_MASK) >> (k)) & 1) && lo <= (k) && (k) < hi)
#ifdef PROBE_PHASE
#define STAMP(k) do { if (bx == 0 && fresh_tid(wv) == 0) ((unsigned long long*)(ws + 253 * MiB))[(k)] = __builtin_amdgcn_s_memrealtime(); } while (0)
#else
#define STAMP(k) do {} while (0)
#endif
#define SEAM(k) do { if (lo <= (k) && (k) + 1 < hi) xcd_barrier(bar, wv); STAMP((k) + 1); } while (0)

    STAMP(0);
#define STAGGER() do { const int grp_ = (bx >> 3) & 3; for (int i_ = 0; i_ < grp_; ++i_) __builtin_amdgcn_s_sleep(127); } while (0)
    if (IN(0)) { p0_prologue(P, lds, vcu, G, wv); __syncthreads(); }
    SEAM(0);
    if (IN(1)) {
        ProjSched S{(const char*)P.out + OUT_U, (const char*)(ws + WS_MEMN), (const char*)(ws + WS_WIN), G, bx, wv};
        EpiProj E{ws, P.b_forget};
        STAGGER();
        pg8::gemm_phase<EpiProj, ProjSched, true, true>(lds, 1024, 1024, 1024, S, E);
    }
    SEAM(1);
    if (IN(2)) {
        if (bx < 8) fcumsum_unit(P, lds, bx, wv);
        else for (int u = bx - 8; u < 256; u += G - 8) normmax_unit(P, lds, u, wv);
    }
    SEAM(2);
    if (IN(3)) {
        const attn_body::AttnTensors AT{(const attn_body::bf16*)(ws + WS_FQ), (const attn_body::bf16*)(ws + WS_FK), (const attn_body::bf16*)(ws + WS_FV), (attn_body::bf16*)(ws + WS_FQ), (const float*)(ws + WS_F)};
        LAS float* THRU = (LAS float*)(lds + MISC_OFF + 128); volatile LAS unsigned* qslot = (volatile LAS unsigned*)(lds + MISC_OFF + 32);
        { const int i_ = fresh_tid(wv); const int h_ = i_ & 7, qb_ = i_ >> 3;
          const float* QB2 = (const float*)(ws + WS_QB2); const float* NDOT = (const float*)(ws + WS_NDOT); const float k2 = __uint_as_float(((const unsigned*)ws)[8 + h_]);
          float a2 = 0.f, b = -INFINITY;
#pragma unroll
          for (int bb = 0; bb < 4; ++bb) { a2 = fmaxf(a2, QB2[(4 * qb_ + bb) * 8 + h_]); b = fmaxf(b, NDOT[(4 * qb_ + bb) * 8 + h_]); }
          THRU[qb_ * 8 + h_] = -(26.1f + 1.01f * sqrtf(a2 * k2) + b); }
        __syncthreads();
        for (;;) {
            if (fresh_tid(wv) == 0) qslot[0] = __hip_atomic_fetch_add((unsigned*)ws + 64, 1u, __ATOMIC_RELAXED, __HIP_MEMORY_SCOPE_AGENT);
            asm volatile("s_waitcnt vmcnt(0) lgkmcnt(0)\n\ts_barrier" ::: "memory");
            const int idx = __builtin_amdgcn_readfirstlane((int)qslot[0]);
            if (idx >= 1792) break;
            if (idx < 512) { const int h = idx & 7, qb = 63 - (idx >> 3); attn_body::attn_unit<8>(0, h, qb, AT.Q, AT.K, AT.V, AT.O, AT.F + (size_t)h * S_, (const float*)(ws + WS_LSEF) + h * 128, THRU[qb * 8 + h], (char*)lds_raw, wv); }
            else if (idx < 1536) gla_a_unit(P, lds, (idx - 512) >> 2, (idx - 512) & 3, wv);
            else memattn_unit(P, lds, (idx - 1536) & 3, (idx - 1536) >> 2, wv);
        }
    }
    SEAM(3);
    if (IN(3)) { for (int u = bx; u < 256; u += G) gla_scan_unit(P, lds, u, wv); }
    if (lo <= 3 && 4 < hi) xcd_barrier(bar, wv);
    STAMP(40);

    if (IN(4)) { for (int task = bx * NWAVES + wv; task < 2048; task += G * NWAVES) { const int lane_ = fresh_tid(wv) & 63; gla_b_task(P, task, lane_); } }
    SEAM(4);
    if (IN(5)) {
        static_assert(WS_FQ - WS_GG == 16 * MiB && WS_MQ - WS_FQ == 16 * MiB && WS_WFOXO - WS_WGLAO == MiB && WS_WMEMO - WS_WFOXO == MiB, "merge operand spacing");
        MergeSched S{(const char*)(ws + WS_GG), (const char*)(ws + WS_WGLAO), G, bx, wv, 16 * MiB - 1024, MiB - 1024};
        EpiMerge E{(bf16*)(ws + WS_MG), (const bf16*)(ws + WS_GT)};
        pg8::gemm_phase<EpiMerge, MergeSched, true, true, 8>(lds, 1536, 512, 512, S, E);
    }
    SEAM(5);
    if (IN(6)) {
        GemmSched S{(const char*)(ws + WS_MG), (const char*)(ws + WS_WOUT), 64, 4, 1024, 1024, G, bx, wv};
        EpiResid<true, false> E{P.x, (bf16*)(ws + WS_H0), (bf16*)(ws + WS_H1) - (size_t)8192 * 1024, (bf16*)(ws + WS_U2), P.g_ffn, (float*)(ws + WS_SS1)};
        pg8::gemm_phase<EpiResid<true, false>, GemmSched, true, true>(lds, 1024, 1024, 1024, S, E);
    }
    SEAM(6);
    if (IN(7)) {
        GemmSched S{(const char*)(ws + WS_U2), (const char*)(ws + WS_WFF1), 64, 16, 1024, 1024, G, bx, wv};
        EpiFfn1 E{(bf16*)(ws + WS_HID), (const float*)(ws + WS_SS1)};
        STAGGER();
        pg8::gemm_phase<EpiFfn1, GemmSched, true, true>(lds, 1024, 1024, 1024, S, E);
    }
    SEAM(7);
    if (IN(8)) {
        GemmSched S{(const char*)(ws + WS_HID), (const char*)(ws + WS_WFF2), 64, 4, 4096, 4096, G, bx, wv};
        EpiFinal E{(const bf16*)(ws + WS_H0), (const bf16*)(ws + WS_H1) - (size_t)8192 * 1024, P.out, P.g_final, (float*)(ws + WS_SS2), (unsigned*)ws + CW_PANEL};
        pg8::gemm_phase<EpiFinal, GemmSched, false, true>(lds, 4096, 4096, 4096, S, E);
    }
    STAMP(9);
#ifdef PROBE_PHASE
    __syncthreads(); xcd_barrier(bar, wv); STAMP(10);
    if (PROBE_PHASE == 200) { xcd_barrier(bar, wv); xcd_barrier(bar, wv); xcd_barrier(bar, wv); xcd_barrier(bar, wv); STAMP(11); }
    if (bx == 0) { __syncthreads(); const unsigned long long* ts = (const unsigned long long*)(ws + 253 * MiB);
        long K = (PROBE_PHASE < 0) ? 100000 : (PROBE_PHASE == 200) ? (long)(ts[11] - ts[10]) * 10 : (PROBE_PHASE == 777) ? (long)((ts[61] - ts[60]) / 5 + 540 * ((ts[62] - ts[61]) / 5)) : (PROBE_PHASE == 778) ? (long)((ts[63] - ts[62]) / 5 + 540 * ((ts[64] - ts[63]) / 5)) : (PROBE_PHASE >= 1000) ? (long)(ts[PROBE_PHASE % 1000] - ts[PROBE_PHASE / 1000]) : (PROBE_PHASE >= 100 ? (long)(ts[10] - ts[0]) / 10 : (long)(ts[PROBE_PHASE + 1] - ts[PROBE_PHASE]));
        if (K > 300000) K = 300000;
        for (long i = fresh_tid(wv); i < K; i += 512) P.out[i] += 0.1f; }
#endif
#undef IN
#undef SEAM
}

extern "C" void kernel_launch(void* const* d_in, const int* in_sizes, int n_in, void* d_out, int out_size, void* d_ws, size_t ws_size, hipStream_t stream) {
    static int grid = 0;
    if (grid == 0) {
        if (n_in != 18 || out_size != S_ * DM_ || ws_size < WS_END) { fprintf(stderr, "kernel_launch: unexpected shapes (n_in %d out %d ws %zu)\n", n_in, out_size, ws_size); grid = -1; return; }
        int dev = 0, cus = 0, per_cu = 0;
        (void)hipGetDevice(&dev); (void)hipDeviceGetAttribute(&cus, hipDeviceAttributeMultiprocessorCount, dev);
        (void)hipFuncSetAttribute((const void*)hybrid_fwd, hipFuncAttributeMaxDynamicSharedMemorySize, LDS_BYTES);
        (void)hipOccupancyMaxActiveBlocksPerMultiprocessor(&per_cu, (const void*)hybrid_fwd, NWAVES * 64, LDS_BYTES);
        (void)hipGetLastError();
        grid = 256;
        if (cus != 256 || per_cu < 1) fprintf(stderr, "kernel_launch: note: cus %d per_cu %d (built for 256 CUs, one workgroup each)\n", cus, per_cu);
    }
    if (grid < 0) return;
    (void)hipMemsetAsync(d_ws, 0, CTL_ZERO_BYTES, stream);
    Args a{};
    for (int i = 0; i < 18; ++i) a.in[i] = (const float*)d_in[i];
    a.out = (float*)d_out; a.ws = (unsigned char*)d_ws;
#ifndef MK_PER_PHASE
    a.ph_lo = 0; a.ph_hi = N_PHASES;
    { void* kargs[] = {&a}; hipError_t e = hipLaunchCooperativeKernel((const void*)hybrid_fwd, dim3(grid), dim3(NWAVES * 64), kargs, LDS_BYTES, stream);
      if (e != hipSuccess) fprintf(stderr, "cooperative launch failed: %s\n", hipGetErrorString(e)); }
#else
    for (int k = 0; k < N_PHASES; ++k) { a.ph_lo = k; a.ph_hi = k + 1; void* kargs[] = {&a};
        hipError_t e = hipLaunchCooperativeKernel((const void*)hybrid_fwd, dim3(grid), dim3(NWAVES * 64), kargs, LDS_BYTES, stream);
        if (e != hipSuccess) { fprintf(stderr, "cooperative launch %d failed: %s\n", k, hipGetErrorString(e)); break; } }
#endif
}
```

```cpp
#include <hip/hip_runtime.h>
#include <hip/hip_cooperative_groups.h>
#include <hip/hip_bf16.h>
#include <cstdio>
#include <cstdint>
#include <cmath>
namespace cg = cooperative_groups;
__device__ __forceinline__ int fresh_tid(int wv) { int lane_; asm volatile("v_mbcnt_lo_u32_b32 %0, -1, 0\n\tv_mbcnt_hi_u32_b32 %0, -1, %0" : "=v"(lane_)); return wv * 64 + lane_; }
namespace pg8 {
#define PG8_LAS __attribute__((address_space(3)))
typedef unsigned short bf16_t;
typedef short bf16x8 __attribute__((ext_vector_type(8)));
typedef float f32x4 __attribute__((ext_vector_type(4)));
typedef unsigned u32x4 __attribute__((ext_vector_type(4)));
constexpr int BM = 256, BK = 64, HALF = 128, HTB = HALF * BK * 2  , STAGE_BYTES = 8 * HTB, NXCD = 8, WGM = 8;

__host__ __device__ __forceinline__ int lds_byte(int r, int c) { const int st = (r >> 4) * 2 + (c >> 5), rr = r & 15, cc = c & 31, ob = rr * 64 + cc * 2; return st * 1024 + (ob ^ (((ob >> 9) & 1) << 5)); }
__host__ __device__ __forceinline__ void stage_rc(int b, int& R, int& C) { const int st = b / 1024, sb = b % 1024, swz = sb ^ (((sb >> 9) & 1) << 5); R = (st >> 1) * 16 + swz / 64; C = (st & 1) * 32 + (swz % 64) / 2; }
__host__ __device__ __forceinline__ int perm32(int rho) { const int n = rho >> 4, i = rho & 15; return 8 * (i >> 2) + 4 * n + (i & 3); }

struct Unit { int pm, pn, z; };
__device__ __forceinline__ unsigned cvt_pk_bf16(float lo, float hi) { unsigned r; asm volatile("v_cvt_pk_bf16_f32 %0, %1, %2" : "=v"(r) : "v"(lo), "v"(hi)); return r; }
__device__ __forceinline__ void map_tile(int L, int nM, int nN, int& pm, int& pn) {
    const int nwg = nM * nN; int wgid = L; { const int q = nwg / NXCD, r = nwg % NXCD, xcd = wgid % NXCD, off = wgid / NXCD; wgid = (xcd < r ? xcd * (q + 1) : r * (q + 1) + (xcd - r) * q) + off; }
    const int nig = WGM * nN, gid = wgid / nig, fm = gid * WGM, gsz = (nM - fm) < WGM ? (nM - fm) : WGM;
    pm = fm + ((wgid % nig) % gsz); pn = (wgid % nig) / gsz;
}
template <class Epi, class Sched, bool ALIGN_EPI = false, bool SP2 = false, int SEGT = 0>
__device__ __forceinline__ void gemm_phase(PG8_LAS unsigned char* lds, const int K, const int lda, const int ldb, const Sched& S, const Epi& E) {
    const int tid = fresh_tid(S.wv), wid = S.wv, lane = tid & 63, wr = wid >> 2, wc = wid & 3, fr = lane & 15, fq = lane >> 4;
    const int nt = K / BK;
    unsigned voffA[2], voffB[2];
#pragma unroll
    for (int i = 0; i < 2; ++i) { int R, C; stage_rc(tid * 16 + i * 8192, R, C); const int Rb = Epi::PERM ? ((R & ~31) + perm32(R & 31)) : R;
        voffA[i] = (unsigned)(R * lda + C) * 2u; voffB[i] = (unsigned)(Rb * ldb + C) * 2u; }
    const size_t kstep = (size_t)(BK * 2);
    const size_t hstepA = (size_t)HALF * lda * 2, hstepB = (size_t)HALF * ldb * 2;
    const unsigned ldsw = (unsigned)wid * 1024u;
    const int aoff = lds_byte(wr * 64 + fr, fq * 8), boff = lds_byte(wc * 32 + fr, fq * 8);
#define PG8_SA(b, h) (((b) * 2 + (h)) * HTB)
#define PG8_SB(b, h) ((4 + (b) * 2 + (h)) * HTB)
#define PG8_STAGE(bufoff, gbase, voff) do { _Pragma("unroll") for (int _i = 0; _i < 2; ++_i) \
        __builtin_amdgcn_global_load_lds((const unsigned*)((const char*)(gbase) + (voff)[_i]), (PG8_LAS unsigned*)(lds + (bufoff) + ldsw + _i * 8192), 16, 0, 0); } while (0)
#define PG8_LDA(dst, b, h) do { _Pragma("unroll") for (int m = 0; m < 4; ++m) _Pragma("unroll") for (int k = 0; k < 2; ++k) dst[m][k] = *(const PG8_LAS bf16x8*)(lds + PG8_SA(b, h) + aoff + m * 2048 + k * 1024); } while (0)
#define PG8_LDB(dst, b, h) do { _Pragma("unroll") for (int n = 0; n < 2; ++n) _Pragma("unroll") for (int k = 0; k < 2; ++k) dst[n][k] = *(const PG8_LAS bf16x8*)(lds + PG8_SB(b, h) + boff + n * 2048 + k * 1024); } while (0)
#define PG8_MMA(ai, bj, At, Bt) do { __builtin_amdgcn_s_setprio(1); _Pragma("unroll") for (int m = 0; m < 4; ++m) _Pragma("unroll") for (int n = 0; n < 2; ++n) _Pragma("unroll") for (int k = 0; k < 2; ++k) \
        acc[ai][bj][m][n] = __builtin_amdgcn_mfma_f32_16x16x32_bf16(Bt[n][k], At[m][k], acc[ai][bj][m][n], 0, 0, 0); __builtin_amdgcn_s_setprio(0); } while (0)
#define PG8_WAIT_V(n) asm volatile("s_waitcnt vmcnt(" #n ")" ::: "memory")
#define PG8_WAIT_L(n) asm volatile("s_waitcnt lgkmcnt(" #n ")" ::: "memory")
#define PG8_BAR __builtin_amdgcn_s_barrier()
#define PG8_SCHED __builtin_amdgcn_sched_barrier(0)
    Unit cur, nxt; int ui = 0;
    if (!S.next(0, cur)) return;
    f32x4 acc[2][2][4][2];
#pragma unroll
    for (int a = 0; a < 2; ++a)
#pragma unroll
        for (int b = 0; b < 2; ++b)
#pragma unroll
            for (int m = 0; m < 4; ++m)
#pragma unroll
                for (int n = 0; n < 2; ++n) acc[a][b][m][n] = (f32x4){0.f, 0.f, 0.f, 0.f};
    bf16x8 At[4][2], B0[2][2], B1[2][2];
    const char* cA = S.aptr(cur); const char* cB = S.bptr(cur);
    S.a_ready(cur);
    if constexpr (SP2) {
        PG8_STAGE(PG8_SB(0, 0), cB, voffB); PG8_STAGE(PG8_SB(0, 1), cB + hstepB, voffB); PG8_STAGE(PG8_SA(0, 0), cA, voffA); PG8_STAGE(PG8_SA(0, 1), cA + hstepA, voffA);
        if (wr == 1) PG8_BAR;
        PG8_WAIT_V(2); PG8_BAR;
        PG8_STAGE(PG8_SB(1, 0), cB + kstep, voffB); PG8_STAGE(PG8_SA(1, 0), cA + kstep, voffA); PG8_STAGE(PG8_SB(1, 1), cB + hstepB + kstep, voffB);
        PG8_WAIT_V(6); PG8_BAR;
    } else {
        PG8_STAGE(PG8_SB(0, 0), cB, voffB); PG8_STAGE(PG8_SA(0, 0), cA, voffA); PG8_STAGE(PG8_SB(0, 1), cB + hstepB, voffB); PG8_STAGE(PG8_SA(0, 1), cA + hstepA, voffA);
        if (wr == 1) PG8_BAR;
        PG8_WAIT_V(4); PG8_BAR;
        PG8_STAGE(PG8_SB(1, 0), cB + kstep, voffB); PG8_STAGE(PG8_SA(1, 0), cA + kstep, voffA); PG8_STAGE(PG8_SB(1, 1), cB + hstepB + kstep, voffB);
        PG8_WAIT_V(6); PG8_BAR;
    }
    for (;;) {
        const bool has_next = S.next(ui + 1, nxt);
        const char* nA = has_next ? S.aptr(nxt) : cA; const char* nB = has_next ? S.bptr(nxt) : cB;
        for (int t = 0; t < nt; t += 2) {
            const bool last = (t == nt - 2);
            size_t sa1 = 0, sa2 = 0, sb2 = 0;
            if constexpr (SEGT > 0) { if (t > 0 && (t % SEGT) == 0) E.mid(acc, cur, t / SEGT, wr, wc, fr, fq);
                sa1 = (size_t)(t / SEGT) * S.segA; sa2 = (size_t)((t + 2) / SEGT) * S.segA; sb2 = (size_t)((t + 2) / SEGT) * S.segB; }
            const char* a1 = cA + (size_t)(t + 1) * kstep + sa1;
            const char* a2 = last ? nA : cA + (size_t)(t + 2) * kstep + sa2; const char* b2 = last ? nB : cB + (size_t)(t + 2) * kstep + sb2;
            const char* a3 = a2 + kstep; const char* b3 = b2 + kstep;
            if (last && has_next) S.a_ready(nxt);
            if constexpr (SP2) {
            PG8_LDB(B0, 0, 0); PG8_LDB(B1, 0, 1); PG8_SCHED; PG8_LDA(At, 0, 0); PG8_STAGE(PG8_SA(1, 1), a1 + hstepA, voffA);
            PG8_WAIT_V(8); PG8_WAIT_L(0); PG8_BAR; PG8_MMA(0, 0, At, B0); PG8_MMA(0, 1, At, B1); PG8_BAR; PG8_SCHED;
            PG8_LDA(At, 0, 1); PG8_STAGE(PG8_SB(0, 0), b2, voffB); PG8_STAGE(PG8_SB(0, 1), b2 + hstepB, voffB); PG8_STAGE(PG8_SA(0, 0), a2, voffA);
            PG8_WAIT_V(8); PG8_WAIT_L(0); PG8_BAR; PG8_MMA(1, 0, At, B0); PG8_MMA(1, 1, At, B1); PG8_BAR; PG8_SCHED;
            PG8_LDB(B0, 1, 0); PG8_LDB(B1, 1, 1); PG8_SCHED; PG8_LDA(At, 1, 0); PG8_STAGE(PG8_SA(0, 1), a2 + hstepA, voffA);
            PG8_WAIT_V(8); PG8_WAIT_L(0); PG8_BAR; PG8_MMA(0, 0, At, B0); PG8_MMA(0, 1, At, B1); PG8_BAR; PG8_SCHED;
            PG8_LDA(At, 1, 1); PG8_STAGE(PG8_SB(1, 0), b3, voffB); PG8_STAGE(PG8_SB(1, 1), b3 + hstepB, voffB); PG8_STAGE(PG8_SA(1, 0), a3, voffA);
            PG8_WAIT_V(8); PG8_WAIT_L(0); PG8_BAR; PG8_MMA(1, 0, At, B0); PG8_MMA(1, 1, At, B1); PG8_BAR; PG8_SCHED;
            } else {
            PG8_LDB(B0, 0, 0); PG8_SCHED; PG8_LDA(At, 0, 0); PG8_STAGE(PG8_SA(1, 1), a1 + hstepA, voffA);
            PG8_WAIT_L(8); PG8_BAR; PG8_WAIT_L(0); PG8_MMA(0, 0, At, B0); PG8_BAR; PG8_SCHED;
            PG8_LDB(B1, 0, 1); PG8_STAGE(PG8_SB(0, 0), b2, voffB);
            PG8_BAR; PG8_WAIT_L(0); PG8_MMA(0, 1, At, B1); PG8_BAR;
            PG8_LDA(At, 0, 1); PG8_STAGE(PG8_SA(0, 0), a2, voffA);
            PG8_BAR; PG8_WAIT_L(0); PG8_MMA(1, 0, At, B0); PG8_BAR; PG8_SCHED;
            PG8_STAGE(PG8_SB(0, 1), b2 + hstepB, voffB);
            PG8_WAIT_V(6); PG8_BAR; PG8_MMA(1, 1, At, B1); PG8_BAR;
            PG8_LDB(B0, 1, 0); PG8_SCHED; PG8_LDA(At, 1, 0); PG8_STAGE(PG8_SA(0, 1), a2 + hstepA, voffA);
            PG8_WAIT_L(8); PG8_BAR; PG8_WAIT_L(0); PG8_MMA(0, 0, At, B0); PG8_BAR; PG8_SCHED;
            PG8_LDB(B1, 1, 1); PG8_STAGE(PG8_SB(1, 0), b3, voffB);
            PG8_BAR; PG8_WAIT_L(0); PG8_MMA(0, 1, At, B1); PG8_BAR;
            PG8_LDA(At, 1, 1); PG8_STAGE(PG8_SA(1, 0), a3, voffA);
            PG8_BAR; PG8_WAIT_L(0); PG8_MMA(1, 0, At, B0); PG8_BAR; PG8_SCHED;
            PG8_STAGE(PG8_SB(1, 1), b3 + hstepB, voffB);
            PG8_WAIT_V(6); PG8_BAR; PG8_MMA(1, 1, At, B1); PG8_BAR;
            }
        }
        if constexpr (ALIGN_EPI) { if (wr == 0) PG8_BAR; }
        if constexpr (!Epi::AFTER_DRAIN) { E(acc, cur, wr, wc, fr, fq); S.done(cur); }
        if (!has_next) break;
#pragma unroll
        for (int a = 0; a < 2; ++a)
#pragma unroll
            for (int b = 0; b < 2; ++b)
#pragma unroll
                for (int m = 0; m < 4; ++m)
#pragma unroll
                    for (int n = 0; n < 2; ++n) acc[a][b][m][n] = (f32x4){0.f, 0.f, 0.f, 0.f};
        cur = nxt; cA = nA; cB = nB; ++ui;
        if constexpr (ALIGN_EPI) { if (wr == 1) PG8_BAR; }
    }
    PG8_WAIT_V(0);
    if constexpr (!ALIGN_EPI) { if (wr == 0) PG8_BAR; }
    PG8_BAR;
    if constexpr (Epi::AFTER_DRAIN) { E.fused(acc, cur, wr, wc, fr, fq, lds, wid, lane); S.done(cur); }
#undef PG8_SA
#undef PG8_SB
#undef PG8_STAGE
#undef PG8_LDA
#undef PG8_LDB
#undef PG8_MMA
#undef PG8_WAIT_V
#undef PG8_WAIT_L
#undef PG8_BAR
#undef PG8_SCHED
}
}
#include <hip/hip_bf16.h>
namespace attn_body {
using bf16=__hip_bfloat16;
using bf16x8=__attribute__((ext_vector_type(8)))short;
using s16x4=__attribute__((ext_vector_type(4)))short;
using f32x16=__attribute__((ext_vector_type(16)))float;
using u32x4=__attribute__((ext_vector_type(4)))unsigned;
constexpr int BATCH=1,NHEAD=8,SEQ=16384,D=64,DM=NHEAD*D;
constexpr int NW=8,QBLK=32,QB=QBLK*NW,KVBLK=64,NQB=SEQ/QB;
constexpr int ATTN_PITCH=DM, ATTN_UNIT_ROWS=QB;
__device__ __forceinline__ int crow(int r,int hi){return (r&3)+8*(r>>2)+4*hi;}
#define SBAR() __builtin_amdgcn_sched_barrier(0)
__device__ __forceinline__ void cmask(f32x16&p0,f32x16&p1,int jb,int qrel,int hi){
  const float NEG=-INFINITY; int kb=64*jb+4*hi;
  #pragma unroll
  for(int r=0;r<16;++r){int kv=kb+(r&3)+8*(r>>2); if(kv>qrel)p0[r]=NEG; if(kv+32>qrel)p1[r]=NEG;}
}

constexpr int NSLOT=3, SLOTB=8192;
constexpr int LDS_K=0, LDS_V=NSLOT*SLOTB, LDS_WS=2*NSLOT*SLOTB, LDS_OST=LDS_WS+NW*64*4, LDS_BIAS=LDS_OST+NW*4096, LDS_BYTES=LDS_BIAS+SEQ*4+512;
constexpr float C2=0.125f*1.4426950408889634f;
__device__ __forceinline__ void glds16(const void*gsrc,unsigned lds_dst){unsigned keep;
  asm volatile("s_mov_b32 %0, m0\n\ts_mov_b32 m0, %2\n\ts_nop 0\n\tglobal_load_lds_dwordx4 %1, off\n\ts_mov_b32 m0, %0":"=&s"(keep):"v"(gsrc),"s"(lds_dst):"memory");}
__device__ __forceinline__ float max3f(float a,float b,float c){float r;asm("v_max3_f32 %0, %1, %2, %3":"=v"(r):"v"(a),"v"(b),"v"(c));return r;}
__device__ __forceinline__ float max2f(float a,float b){float r;asm("v_max_f32_e32 %0, %1, %2":"=v"(r):"v"(a),"v"(b));return r;}
__device__ __forceinline__ float fadd_s(float a,float b){float r;asm("v_add_f32_e32 %0, %1, %2":"=v"(r):"v"(a),"v"(b));return r;}
__device__ __forceinline__ float fsub_s(float a,float b){float r;asm("v_sub_f32_e32 %0, %1, %2":"=v"(r):"v"(a),"v"(b));return r;}
typedef float f32x2_t __attribute__((ext_vector_type(2))); typedef __bf16 bf16x2_t __attribute__((ext_vector_type(2)));
__device__ __forceinline__ unsigned cvtpk_s(float lo,float hi){f32x2_t v={lo,hi};bf16x2_t b=__builtin_convertvector(v,bf16x2_t);return __builtin_bit_cast(unsigned,b);}
#define WAIT_BAR(N) asm volatile("s_waitcnt vmcnt(" #N ") lgkmcnt(0)\n\ts_barrier":::"memory")

__device__ __forceinline__ void qkt(f32x16&p0,f32x16&p1,const char*Kslot,const bf16x8*qr,int r32,int hi){
  const char*kb=Kslot+hi*1024+r32*16;
  #pragma unroll
  for(int d0=0;d0<4;++d0){
    const bf16x8 b0=*reinterpret_cast<const bf16x8*>(kb+d0*2048);
    const bf16x8 b1=*reinterpret_cast<const bf16x8*>(kb+d0*2048+512);
    p0=__builtin_amdgcn_mfma_f32_32x32x16_bf16(b0,qr[d0],p0,0,0,0);p1=__builtin_amdgcn_mfma_f32_32x32x16_bf16(b1,qr[d0],p1,0,0,0);}
}
typedef __attribute__((address_space(3))) const char* lds_cptr;
typedef short v4i16_t __attribute__((ext_vector_type(4)));
__device__ __forceinline__ void kload8(bf16x8*kf,lds_cptr kp){
  kf[0]=*(const __attribute__((address_space(3))) bf16x8*)(kp);      kf[1]=*(const __attribute__((address_space(3))) bf16x8*)(kp+512);
  kf[2]=*(const __attribute__((address_space(3))) bf16x8*)(kp+2048); kf[3]=*(const __attribute__((address_space(3))) bf16x8*)(kp+2560);
  kf[4]=*(const __attribute__((address_space(3))) bf16x8*)(kp+4096); kf[5]=*(const __attribute__((address_space(3))) bf16x8*)(kp+4608);
  kf[6]=*(const __attribute__((address_space(3))) bf16x8*)(kp+6144); kf[7]=*(const __attribute__((address_space(3))) bf16x8*)(kp+6656);
}
__device__ __forceinline__ void kload2(bf16x8*kf,lds_cptr kp,int j){ kf[2*j]=*(const __attribute__((address_space(3))) bf16x8*)(kp+j*2048); kf[2*j+1]=*(const __attribute__((address_space(3))) bf16x8*)(kp+j*2048+512); }
__device__ __forceinline__ s16x4 vtr(lds_cptr p){ return __builtin_bit_cast(s16x4,__builtin_amdgcn_ds_read_tr16_b64_v4i16((__attribute__((address_space(3))) v4i16_t*)p)); }
__device__ __forceinline__ float rowmax(const f32x16&p0,const f32x16&p1){
  float a=max3f(p0[0],p0[1],p1[0]),b=max3f(p0[2],p0[3],p1[1]);a=max3f(a,p1[2],p1[3]);
  #pragma unroll
  for(int r=4;r<16;r+=4){a=max3f(a,p0[r],p0[r+1]);b=max3f(b,p0[r+2],p0[r+3]);a=max3f(a,p1[r],p1[r+1]);b=max3f(b,p1[r+2],p1[r+3]);}
  const float m=max2f(a,b);
  auto rr=__builtin_amdgcn_permlane32_swap(__float_as_uint(m),__float_as_uint(m),false,false);
  return max2f(__uint_as_float(rr[0]),__uint_as_float(rr[1]));
}
__device__ __forceinline__ void pv(f32x16*o,int vb,bf16x8 pa0,bf16x8 pa1,bf16x8 pa2,bf16x8 pa3){
  #pragma unroll
  for(int d0=0;d0<2;++d0){s16x4 lo[4],hi[4];
    #pragma unroll
    for(int ks=0;ks<4;++ks){
      asm volatile("ds_read_b64_tr_b16 %0,%1 offset:%c2":"=&v"(lo[ks]):"v"(vb),"i"(d0*4096+ks*1024):"memory");
      asm volatile("ds_read_b64_tr_b16 %0,%1 offset:%c2":"=&v"(hi[ks]):"v"(vb),"i"(d0*4096+ks*1024+512):"memory");}
    asm volatile("s_waitcnt lgkmcnt(0)":::"memory");SBAR();
    #define PK(k) (bf16x8){lo[k][0],lo[k][1],lo[k][2],lo[k][3],hi[k][0],hi[k][1],hi[k][2],hi[k][3]}
    o[d0]=__builtin_amdgcn_mfma_f32_32x32x16_bf16(pa0,PK(0),o[d0],0,0,0);
    o[d0]=__builtin_amdgcn_mfma_f32_32x32x16_bf16(pa1,PK(1),o[d0],0,0,0);
    o[d0]=__builtin_amdgcn_mfma_f32_32x32x16_bf16(pa2,PK(2),o[d0],0,0,0);
    o[d0]=__builtin_amdgcn_mfma_f32_32x32x16_bf16(pa3,PK(3),o[d0],0,0,0);
    #undef PK
  }
}

#ifndef ATTN_STORE16
#define ATTN_STORE16(p,v) (*(u32x4*)(p)=(v))
#endif
typedef float f32x4_t __attribute__((ext_vector_type(4)));
template<int THRL> __device__ __forceinline__ void attn_unit(int b,int h,int qb,const bf16*Q,const bf16*__restrict__ K,const bf16*__restrict__ V,bf16*O,const float*__restrict__ Fh,const float*__restrict__ Lh,float thrb,char*shm,int wv){
  const int tid=fresh_tid(wv),lane=tid&63,r32=lane&31,hi=lane>>5; const int wid=wv;
  const long rowbase=(long)b*SEQ; const int q0=qb*QB;
  const bf16*Qw=Q+(rowbase+q0+wid*QBLK)*DM+h*D;
  const lds_cptr shm3=(lds_cptr)shm;
  const float fref=Fh[q0];
  int T0; { __attribute__((address_space(3))) float* pb=(__attribute__((address_space(3))) float*)(shm3+LDS_WS);
    if(tid<2*qb) pb[tid]=Lh[tid]+fref*1.4426950408889634f;
    asm volatile("s_waitcnt lgkmcnt(0)\n\ts_barrier":::"memory");
    int lo_=0,hi_=2*qb; while(lo_<hi_){ const int mid=(lo_+hi_)>>1; if(!(pb[mid]<=thrb)) hi_=mid; else lo_=mid+1; } T0=__builtin_amdgcn_readfirstlane(2*lo_); }
  { __attribute__((address_space(3))) float* bl=(__attribute__((address_space(3))) float*)(shm3+LDS_BIAS);
    #pragma unroll 4
    for(int s=64*T0+tid;s<q0+QB;s+=NW*64) bl[s]=(fref-Fh[s])*1.4426950408889634f; }
  const bf16*Kh=K+(rowbase+(long)T0*KVBLK)*DM+h*D,*Vh=V+(rowbase+(long)T0*KVBLK)*DM+h*D;
  const unsigned lds0=(unsigned)(uintptr_t)shm;
  float*wsf=(float*)(shm+LDS_WS)+wid*64;
  const bf16*ksrc=Kh+(long)lane*DM+wid*8;
  const bf16*vsrc=Vh+(long)(16*(wid&3)+(lane>>2))*DM+(wid>>2)*32+(lane&3)*8;
  const unsigned kdst=lds0+LDS_K+wid*1024, vdst=lds0+LDS_V+wid*1024;
  #define DMA_K(t,slot) glds16(ksrc+(long)(t)*KVBLK*DM,(unsigned)__builtin_amdgcn_readfirstlane(kdst+(slot)))
  #define DMA_V(t,slot) glds16(vsrc+(long)(t)*KVBLK*DM,(unsigned)__builtin_amdgcn_readfirstlane(vdst+(slot)))
  const int vb0=(int)(lds0+LDS_V)+((lane>>4)&1)*32+(lane&3)*8+(4*hi+((lane&15)>>2))*64;
  const char*Kbase=shm+LDS_K; bf16x8 kf[8];
  const lds_cptr kp0=shm3+LDS_K+hi*1024+r32*16; const lds_cptr vp0=shm3+LDS_V+((lane>>4)&1)*32+(lane&3)*8+(4*hi+((lane&15)>>2))*64;
  const int NT=(q0+QB)/KVBLK-T0;
  #define BLOAD(X0,X1,tt) do{ const __attribute__((address_space(3))) f32x4_t* bp_=(const __attribute__((address_space(3))) f32x4_t*)(shm3+LDS_BIAS+(((tt)+T0)*64+4*hi)*4); \
    _Pragma("unroll") for(int g_=0;g_<4;++g_){ const f32x4_t a_=bp_[2*g_], b_=bp_[8+2*g_]; \
      X0[4*g_]=a_[0];X0[4*g_+1]=a_[1];X0[4*g_+2]=a_[2];X0[4*g_+3]=a_[3]; X1[4*g_]=b_[0];X1[4*g_+1]=b_[1];X1[4*g_+2]=b_[2];X1[4*g_+3]=b_[3]; } }while(0)
  DMA_K(0,0);DMA_V(0,0);DMA_K(1,SLOTB);
  bf16x8 qr[4];
  #pragma unroll
  for(int d0=0;d0<4;++d0)qr[d0]=*reinterpret_cast<const bf16x8*>(&Qw[(long)r32*DM+d0*16+hi*8]);
  float mhat=0.f,l_reg=0.f;f32x16 o[2];o[0]=f32x16{};o[1]=f32x16{};
  const int qrel=wid*QBLK+r32;
  #define CMASK(P0,P1,t) do{int jb_=(t)-(NT-4); if(jb_>=0)cmask(P0,P1,jb_,qrel,hi);}while(0)
  bool resc=false;
    \
  #define START(P0,P1) do{ const float rm=rowmax(P0,P1); resc=false; \
    { const float dl=__builtin_fmaxf(rm,((const __attribute__((address_space(3))) float*)(shm3+LDS_BIAS))[q0+qrel]+10.f); mhat=fadd_s(mhat,dl); \
      _Pragma("unroll") for(int r=0;r<16;++r){P0[r]=fsub_s(P0[r],dl);P1[r]=fsub_s(P1[r],dl);} \
 } \
    _Pragma("unroll") for(int r=0;r<16;++r)P0[r]=__builtin_amdgcn_exp2f(P0[r]); }while(0)
  #define RESC() do{ if(resc){ asm volatile("s_waitcnt lgkmcnt(0)":::"memory"); \
      _Pragma("unroll") for(int d_=0;d_<2;++d_) _Pragma("unroll") for(int r=0;r<16;++r)o[d_][r]*=wsf[crow(r,hi)]; } }while(0)
  f32x16 pA0,pA1,pB0,pB1;
  int sl_prev=0,sl_cur=0,sl_next=SLOTB;
  #define ROT() do{sl_prev=sl_cur;sl_cur=sl_next;sl_next=(sl_next==(NSLOT-1)*SLOTB)?0:sl_next+SLOTB;}while(0)
  DMA_K(2,2*SLOTB);
  WAIT_BAR(3);
  BLOAD(pA0,pA1,0); BLOAD(pB0,pB1,1);
  qkt(pA0,pA1,Kbase,qr,r32,hi);asm volatile("s_nop 15\n\ts_nop 7":"+v"(pA0),"+v"(pA1));CMASK(pA0,pA1,0);
  START(pA0,pA1);
  _Pragma("unroll") for(int r=0;r<16;++r)pA1[r]=__builtin_amdgcn_exp2f(pA1[r]);
  WAIT_BAR(0);
  DMA_K(3,0);DMA_V(1,SLOTB);
  ROT();
  kload8(kf,kp0+sl_cur);
  WAIT_BAR(2);
  s16x4 vlo[8],vhi[8]; u32x4 pw0,pw1,pw2,pw3;
  #define PKW(P,B) cvtpk_s(P[B],P[B+1])
  #define PAF(k) __builtin_bit_cast(bf16x8,pw##k)
  #define VFR(i) (bf16x8){vlo[i][0],vlo[i][1],vlo[i][2],vlo[i][3],vhi[i][0],vhi[i][1],vhi[i][2],vhi[i][3]}
  #define PIN(x) asm volatile("":"+v"(x))
  #define MX3(a,b,c) __builtin_fmaxf(__builtin_fmaxf((a),(b)),(c))
  #define GAPA(MF,A0,A1,A2,A3,W0,W1,PW) do{ MF; sacc+=A0; sacc+=A1; sacc+=A2; sacc+=A3; PIN(sacc); W0; W1; PIN(PW); SBAR(); }while(0)
  #define EX(v) __builtin_amdgcn_exp2f(v)
  #define GAPB(MF,X,B) do{ MF; X[B]=EX(X[B]); X[B+1]=EX(X[B+1]); X[B+2]=EX(X[B+2]); X[B+3]=EX(X[B+3]); PIN(X); SBAR(); }while(0)
  #define VRD(i) do{ vlo[i]=vtr(vp_+(((i)>>2)*4096+((i)&3)*1024)); vhi[i]=vtr(vp_+(((i)>>2)*4096+((i)&3)*1024+512)); }while(0)
  #define KRD(G,j) do{ if(G){ kload2(kf,kp0+sl_next,j); SBAR(); } }while(0)
  #define STEP(C0,C1,P0,P1,t,GK,GV,GL) do{ SBAR(); \
    _Pragma("unroll") for(int r=0;r<16;++r){C0[r]-=mhat;C1[r]-=mhat;} \
    const lds_cptr vp_=vp0+sl_prev; \
    VRD(0); SBAR(); float sacc=(P0[0]+P0[1]); \
    GAPA(C0=__builtin_amdgcn_mfma_f32_32x32x16_bf16(kf[0],qr[0],C0,0,0,0), P0[2],P0[3],P0[4],P0[5],     pw0[0]=PKW(P0,0), pw0[1]=PKW(P0,2), pw0); \
    VRD(4); SBAR(); GAPA(C1=__builtin_amdgcn_mfma_f32_32x32x16_bf16(kf[1],qr[0],C1,0,0,0), P0[6],P0[7],P0[8],P0[9],     pw0[2]=PKW(P0,4), pw0[3]=PKW(P0,6), pw0); \
    VRD(1); SBAR(); GAPA(C0=__builtin_amdgcn_mfma_f32_32x32x16_bf16(kf[2],qr[1],C0,0,0,0),   P0[10],P0[11],P0[12],P0[13], pw1[0]=PKW(P0,8), pw1[1]=PKW(P0,10), pw1); \
    VRD(5); SBAR(); GAPA(C1=__builtin_amdgcn_mfma_f32_32x32x16_bf16(kf[3],qr[1],C1,0,0,0),   P0[14],P0[15],P1[0],P1[1],   pw1[2]=PKW(P0,12),pw1[3]=PKW(P0,14), pw1); \
    VRD(2); SBAR(); GAPA(C0=__builtin_amdgcn_mfma_f32_32x32x16_bf16(kf[4],qr[2],C0,0,0,0),   P1[2],P1[3],P1[4],P1[5],     pw2[0]=PKW(P1,0), pw2[1]=PKW(P1,2), pw2); \
    VRD(6); SBAR(); GAPA(C1=__builtin_amdgcn_mfma_f32_32x32x16_bf16(kf[5],qr[2],C1,0,0,0),   P1[6],P1[7],P1[8],P1[9],     pw2[2]=PKW(P1,4), pw2[3]=PKW(P1,6), pw2); \
    VRD(3); SBAR(); GAPA(C0=__builtin_amdgcn_mfma_f32_32x32x16_bf16(kf[6],qr[3],C0,0,0,0),   P1[10],P1[11],P1[12],P1[13], pw3[0]=PKW(P1,8), pw3[1]=PKW(P1,10), pw3); \
    VRD(7); SBAR(); GAPA(C1=__builtin_amdgcn_mfma_f32_32x32x16_bf16(kf[7],qr[3],C1,0,0,0),   P1[14],P1[15],0.f,0.f,       pw3[2]=PKW(P1,12),pw3[3]=PKW(P1,14), pw3); \
    l_reg+=sacc; \
    if(GK){DMA_K((t)+3,sl_cur);} if(GV){DMA_V((t)+1,sl_next);} \
    CMASK(C0,C1,t); \
    { float a=MX3(C0[0],C0[1],C1[0]),b=MX3(C0[2],C0[3],C1[1]); a=MX3(a,C1[2],C1[3]); \
      _Pragma("unroll") for(int r=4;r<16;r+=4){a=MX3(a,C0[r],C0[r+1]);b=MX3(b,C0[r+2],C0[r+3]);a=MX3(a,C1[r],C1[r+1]);b=MX3(b,C1[r+2],C1[r+3]);} \
      float rm=__builtin_fmaxf(a,b); { auto rr=__builtin_amdgcn_permlane32_swap(__float_as_uint(rm),__float_as_uint(rm),false,false); rm=__builtin_fmaxf(__uint_as_float(rr[0]),__uint_as_float(rr[1])); } \
      resc=false; \
      if(__builtin_expect(__any(rm>(float)THRL),0)){ const float dl=__builtin_fmaxf(rm,0.f); mhat+=dl; \
        _Pragma("unroll") for(int r=0;r<16;++r){C0[r]-=dl;C1[r]-=dl;} \
        const float f=__builtin_amdgcn_exp2f(-dl); l_reg*=f; if(hi==0)wsf[r32]=f; resc=true; } } \
    SBAR(); \
    GAPB(o[0]=__builtin_amdgcn_mfma_f32_32x32x16_bf16(PAF(0),VFR(0),o[0],0,0,0), C0,0); \
    GAPB(o[1]=__builtin_amdgcn_mfma_f32_32x32x16_bf16(PAF(0),VFR(4),o[1],0,0,0), C0,4); \
    KRD(GL,0); GAPB(o[0]=__builtin_amdgcn_mfma_f32_32x32x16_bf16(PAF(1),VFR(1),o[0],0,0,0), C0,8); \
    KRD(GL,1); GAPB(o[1]=__builtin_amdgcn_mfma_f32_32x32x16_bf16(PAF(1),VFR(5),o[1],0,0,0), C0,12); \
    KRD(GL,2); GAPB(o[0]=__builtin_amdgcn_mfma_f32_32x32x16_bf16(PAF(2),VFR(2),o[0],0,0,0), C1,0); \
    KRD(GL,3); GAPB(o[1]=__builtin_amdgcn_mfma_f32_32x32x16_bf16(PAF(2),VFR(6),o[1],0,0,0), C1,4); \
    GAPB(o[0]=__builtin_amdgcn_mfma_f32_32x32x16_bf16(PAF(3),VFR(3),o[0],0,0,0), C1,8); \
    GAPB(o[1]=__builtin_amdgcn_mfma_f32_32x32x16_bf16(PAF(3),VFR(7),o[1],0,0,0), C1,12); \
    if(GL){BLOAD(P0,P1,(t)+1);} SBAR(); \
    }while(0)
  int t=1;
  #undef CMASK
  #define CMASK(P0,P1,t) do{}while(0)
  for(;t+5<NT;t+=2){
    STEP(pB0,pB1,pA0,pA1,t,true,true,true);     WAIT_BAR(2); RESC(); ROT();
    STEP(pA0,pA1,pB0,pB1,t+1,true,true,true);   WAIT_BAR(2); RESC(); ROT();
  }
  #undef CMASK
  #define CMASK(P0,P1,t) do{int jb_=(t)-(NT-4); if(jb_>=0)cmask(P0,P1,jb_,qrel,hi);}while(0)
  #define ENDW(tt) do{ if((tt)+3<NT){WAIT_BAR(2);} else if((tt)+2<NT){WAIT_BAR(1);} else {WAIT_BAR(0);} }while(0)
  for(;t+1<NT;t+=2){
    STEP(pB0,pB1,pA0,pA1,t,(t+3<NT),(t+1<NT),(t+1<NT));       ENDW(t);   RESC(); ROT();
    STEP(pA0,pA1,pB0,pB1,t+1,(t+4<NT),(t+2<NT),(t+2<NT));     ENDW(t+1); RESC(); ROT();
  }
  STEP(pB0,pB1,pA0,pA1,NT-1,false,false,false); RESC();
  { float sacc=pB0[0]+pB0[1]; _Pragma("unroll") for(int r=2;r<16;++r)sacc+=pB0[r]; _Pragma("unroll") for(int r=0;r<16;++r)sacc+=pB1[r]; l_reg+=sacc;
    pw0=(u32x4){PKW(pB0,0),PKW(pB0,2),PKW(pB0,4),PKW(pB0,6)};pw1=(u32x4){PKW(pB0,8),PKW(pB0,10),PKW(pB0,12),PKW(pB0,14)};pw2=(u32x4){PKW(pB1,0),PKW(pB1,2),PKW(pB1,4),PKW(pB1,6)};pw3=(u32x4){PKW(pB1,8),PKW(pB1,10),PKW(pB1,12),PKW(pB1,14)};
    SBAR(); pv(o,vb0+sl_cur,PAF(0),PAF(1),PAF(2),PAF(3)); }
  #undef PKW
  #undef PAF
  #undef VFR
  #undef PIN
  #undef MX3
  #undef GAPA
  #undef GAPB
  #undef EX
  #undef VRD
  #undef KRD
  #undef STEP
  #undef ENDW
  {auto rr=__builtin_amdgcn_permlane32_swap(__float_as_uint(l_reg),__float_as_uint(l_reg),false,false);l_reg=__uint_as_float(rr[0])+__uint_as_float(rr[1]);}
  if(hi==0)wsf[32+r32]=l_reg;asm volatile("s_waitcnt lgkmcnt(0)":::"memory");
  float rli[16];
  #pragma unroll
  for(int r=0;r<16;++r)rli[r]=__builtin_amdgcn_rcpf(wsf[32+crow(r,hi)]);
  bf16*Ow=O+(rowbase+q0+wid*QBLK)*DM+h*D;
  { bf16*stg=(bf16*)(shm+LDS_OST)+wid*2048;
    #pragma unroll
    for(int r=0;r<16;++r){const int orow=crow(r,hi);
      #pragma unroll
      for(int d0=0;d0<2;++d0)stg[orow*64+d0*32+r32]=__float2bfloat16(o[d0][r]*rli[r]);}
    asm volatile("s_waitcnt lgkmcnt(0)":::"memory");
    #pragma unroll
    for(int i=0;i<4;++i){const int row=i*8+(lane>>3),ch=lane&7; const u32x4 v=*(const u32x4*)(stg+row*64+ch*8); ATTN_STORE16(Ow+(long)row*DM+ch*8,v);} }
  asm volatile("s_waitcnt lgkmcnt(0)\n\ts_barrier":::"memory");
  #undef DMA_K
  #undef BLOAD
  #undef DMA_V
  #undef CMASK
  #undef START
  #undef RESC
  #undef ROT
}
constexpr int ATTN_LDS_BYTES=LDS_BYTES;
struct AttnTensors { const bf16* Q; const bf16* K; const bf16* V; bf16* O; const float* F; };
struct AttnUnit { int bh; int qb; };
template<int THRL=8> __device__ __forceinline__ void attn_phase(char*lds,const AttnTensors&T,unsigned*qctr,const __attribute__((address_space(3))) float*thr8,volatile __attribute__((address_space(3))) unsigned*qslot,int wv){
  for(;;){
    if(fresh_tid(wv)==0){ qslot[0]=__hip_atomic_fetch_add(qctr,1u,__ATOMIC_RELAXED,__HIP_MEMORY_SCOPE_AGENT); }
    asm volatile("s_waitcnt vmcnt(0) lgkmcnt(0)\n\ts_barrier":::"memory");
    const int idx=__builtin_amdgcn_readfirstlane((int)qslot[0]);
    if(idx>=NHEAD*NQB)break;
    const int h=idx%NHEAD, qb=NQB-1-idx/NHEAD;
    attn_unit<THRL>(0,h,qb,T.Q,T.K,T.V,T.O,T.F+(size_t)h*SEQ,thr8[h],lds,wv);
  }
}
#undef SBAR
#undef WAIT_BAR
}
#define GAS __attribute__((address_space(1)))
#define LAS __attribute__((address_space(3)))
typedef unsigned short bf16;
typedef unsigned v4u __attribute__((ext_vector_type(4)));
typedef unsigned v2u __attribute__((ext_vector_type(2)));
typedef float f32x4 __attribute__((ext_vector_type(4)));
typedef float f32x16 __attribute__((ext_vector_type(16)));
typedef short bf16x8 __attribute__((ext_vector_type(8)));
typedef short s16x4 __attribute__((ext_vector_type(4)));

constexpr int NWAVES = 8;
constexpr int S_ = 16384, DM_ = 1024, DIN_ = 6680, FF_ = 4096, NMEM_ = 256;
constexpr float EPS_ = 1e-6f;
constexpr float LOG2E_ = 1.4426950408889634f;
constexpr size_t MiB = 1u << 20;
constexpr size_t WS_WIN = 1 * MiB;
constexpr size_t WS_WGLAO = 17 * MiB, WS_WFOXO = 18 * MiB, WS_WMEMO = 19 * MiB;
constexpr size_t WS_WOUT = 20 * MiB;
constexpr size_t WS_WFF1 = 22 * MiB;
constexpr size_t WS_WFF2 = 30 * MiB;
constexpr size_t WS_GA = 38 * MiB;
constexpr size_t WS_LOGF = 39 * MiB;
constexpr size_t WS_F = 39 * MiB + 512 * 1024;
constexpr size_t WS_MK = 40 * MiB;
constexpr size_t WS_MVT = 40 * MiB + 256 * 1024;
constexpr size_t WS_DEC = 40 * MiB + 512 * 1024;
constexpr size_t WS_MEMN = 40 * MiB + 768 * 1024;
constexpr size_t WS_GQ = 42 * MiB, WS_GK = 50 * MiB, WS_GV = 58 * MiB;
constexpr size_t WS_MG = 42 * MiB;
constexpr size_t WS_GG = 74 * MiB, WS_FQ = 90 * MiB;
constexpr size_t WS_U2 = 74 * MiB;
constexpr size_t WS_MQ = 106 * MiB, WS_FK = 122 * MiB, WS_FV = 138 * MiB;
constexpr size_t WS_GT = 154 * MiB;
constexpr size_t WS_HID = 122 * MiB;
constexpr size_t WS_SS1 = 250 * MiB, WS_SS2 = 251 * MiB;
constexpr size_t WS_END = 253 * MiB;
constexpr size_t WS_LSEF = 252 * MiB;
constexpr size_t WS_QB2 = 251 * MiB + 512 * 1024, WS_NDOT = 251 * MiB + 544 * 1024;
constexpr size_t WS_H0 = 106 * MiB, WS_H1 = 1 * MiB;
constexpr int CW_PANEL = 8192;
constexpr size_t OUT_U = 0, OUT_STATE = 32 * MiB;

constexpr int LDS_BYTES = 155648;

#define LDS_WAIT() asm volatile("s_waitcnt lgkmcnt(0)" ::: "memory")
__device__ __forceinline__ unsigned f2bf(float f) { unsigned u = __builtin_bit_cast(unsigned, f); return (u + 0x7fffu + ((u >> 16) & 1u)) >> 16; }
__device__ __forceinline__ unsigned pk2(float lo, float hi) { return f2bf(lo) | (f2bf(hi) << 16); }
__device__ __forceinline__ float bf2f(unsigned b) { return __builtin_bit_cast(float, (b & 0xffffu) << 16); }
__device__ __forceinline__ float bflo(unsigned w) { return __builtin_bit_cast(float, w << 16); }
__device__ __forceinline__ float bfhi(unsigned w) { return __builtin_bit_cast(float, w & 0xffff0000u); }
__device__ __forceinline__ float sigmoidf_(float x) { return __builtin_amdgcn_rcpf(1.f + __expf(-x)); }
__device__ __forceinline__ float logsigmoidf_(float z) { return -(fmaxf(-z, 0.f) + log1pf(__expf(-fabsf(z)))); }
__device__ __forceinline__ float logsigmoid_fast(float z) { return -(fmaxf(-z, 0.f) + __logf(1.f + __expf(-fabsf(z)))); }
__device__ __forceinline__ int crow_(int r, int hi) { return (r & 3) + 8 * (r >> 2) + 4 * hi; }
__device__ __forceinline__ float wave_sum(float v) {
#pragma unroll
    for (int o = 1; o < 64; o <<= 1) v += __shfl_xor(v, o);
    return v;
}
#define LBAR() asm volatile("s_waitcnt lgkmcnt(0)\n\ts_barrier" ::: "memory")
#define MFMA32(a, b, c) __builtin_amdgcn_mfma_f32_32x32x16_bf16((a), (b), (c), 0, 0, 0)
__device__ __forceinline__ bf16x8 ldfrag(const LAS unsigned char* base, int row, int pitchB, int kbyte) { return *(const LAS bf16x8*)(base + row * pitchB + kbyte); }

struct Ptrs {
    const float *x, *mem, *g_mix, *w_in, *w_alpha_up, *b_alpha, *b_forget, *g_gla_head, *g_mem, *w_mem_kv, *w_gla_o, *w_fox_o, *w_mem_o, *w_out, *g_ffn, *w_ff1, *w_ff2, *g_final;
    float* out; unsigned char* ws;
};

__device__ __forceinline__ void p0_transpose_item(const float* W, int ldw, int srccol0, int k0, bf16* WT, int ldt, int dstrow0, LAS float* scr, int lane) {
#pragma unroll 8
    for (int i = 0; i < 32; ++i) { const int kk = 2 * i + (lane >> 5); scr[kk * 33 + (lane & 31)] = W[(size_t)(k0 + kk) * ldw + srccol0 + (lane & 31)]; }
    LDS_WAIT(); asm volatile("" ::: "memory");
    const int c = lane & 7;
#pragma unroll
    for (int j = 0; j < 4; ++j) { const int n = (lane >> 3) + 8 * j; const LAS float* s = scr + (8 * c) * 33 + n;
        v4u o; o.x = pk2(s[0 * 33], s[1 * 33]); o.y = pk2(s[2 * 33], s[3 * 33]); o.z = pk2(s[4 * 33], s[5 * 33]); o.w = pk2(s[6 * 33], s[7 * 33]);
        *(v4u*)(WT + (size_t)(dstrow0 + n) * ldt + k0 + 8 * c) = o; }
    LDS_WAIT(); asm volatile("" ::: "memory");
}
__device__ __forceinline__ void rms_row_to_bf16(const float* xrow, const float* gain, bf16* orow, int lane) {
    const f32x4* xr = (const f32x4*)xrow + lane; const f32x4* gr = (const f32x4*)gain + lane;
    f32x4 v[4]; float s = 0.f;
#pragma unroll
    for (int j = 0; j < 4; ++j) { v[j] = xr[64 * j]; s += (v[j].x * v[j].x + v[j].y * v[j].y) + (v[j].z * v[j].z + v[j].w * v[j].w); }
    const float r = rsqrtf(wave_sum(s) * (1.f / 1024.f) + EPS_);
    unsigned long long* o8 = (unsigned long long*)orow + lane;
#pragma unroll
    for (int j = 0; j < 4; ++j) { const f32x4 g = gr[64 * j]; o8[64 * j] = (unsigned long long)pk2(v[j].x * r * g.x, v[j].y * r * g.y) | ((unsigned long long)pk2(v[j].z * r * g.z, v[j].w * r * g.w) << 32); }
}
__device__ __forceinline__ void p0_prologue(const Ptrs& P, LAS unsigned char* lds, int vcu, int G, int wv) {
    const int tid = fresh_tid(wv), lane = tid & 63, wave = wv;
    LAS float* scr = (LAS float*)(lds + wave * 16384);
    const int gw = vcu * NWAVES + wave, NGW = G * NWAVES;
    bf16* WIN = (bf16*)(P.ws + WS_WIN);
    constexpr int I_IN = 16 * 208, I_KV = 16 * 32, I_GO = 8 * 32, I_WO = 16 * 32, I_F1 = 16 * 128, I_F2 = 64 * 32;
    constexpr int NITEMS = I_IN + I_KV + 3 * I_GO + I_WO + I_F1 + I_F2;
    for (int it = gw; it < NITEMS; it += NGW) {
        int r = it;
        if (r < I_IN) { const int kb = r / 208, nb = r % 208, d0 = 32 * nb; const int src = d0 < 1536 ? d0 : (d0 < 3072 ? d0 + 16 : d0 + 24);
            p0_transpose_item(P.w_in, DIN_, src, 64 * kb, WIN, 1024, d0, scr, lane); continue; } r -= I_IN;
        if (r < I_KV) { const int kb = r / 32, nb = r % 32; p0_transpose_item(P.w_mem_kv, 1024, 32 * nb, 64 * kb, WIN, 1024, 6912 + 32 * nb, scr, lane); continue; } r -= I_KV;
        if (r < I_GO) { const int kb = r / 32, nb = r % 32; p0_transpose_item(P.w_gla_o, 1024, 32 * nb, 64 * kb, (bf16*)(P.ws + WS_WGLAO), 512, 32 * nb, scr, lane); continue; } r -= I_GO;
        if (r < I_GO) { const int kb = r / 32, nb = r % 32; p0_transpose_item(P.w_fox_o, 1024, 32 * nb, 64 * kb, (bf16*)(P.ws + WS_WFOXO), 512, 32 * nb, scr, lane); continue; } r -= I_GO;
        if (r < I_GO) { const int kb = r / 32, nb = r % 32; p0_transpose_item(P.w_mem_o, 1024, 32 * nb, 64 * kb, (bf16*)(P.ws + WS_WMEMO), 512, 32 * nb, scr, lane); continue; } r -= I_GO;
        if (r < I_WO) { const int kb = r / 32, nb = r % 32; p0_transpose_item(P.w_out, 1024, 32 * nb, 64 * kb, (bf16*)(P.ws + WS_WOUT), 1024, 32 * nb, scr, lane); continue; } r -= I_WO;
        if (r < I_F1) { const int kb = r / 128, nb = r % 128; p0_transpose_item(P.w_ff1, FF_, 32 * nb, 64 * kb, (bf16*)(P.ws + WS_WFF1), 1024, 32 * nb, scr, lane); continue; } r -= I_F1;
        { const int kb = r / 32, nb = r % 32; p0_transpose_item(P.w_ff2, 1024, 32 * nb, 64 * kb, (bf16*)(P.ws + WS_WFF2), FF_, 32 * nb, scr, lane); }
    }
    for (int idx = vcu * 512 + tid; idx < 256 * 128; idx += G * 512) {
        const int row = idx >> 7, kc = idx & 127; const int src = row < 16 ? 1536 + row : (row < 24 ? 3088 + (row - 16) : -1);
        v4u o = (v4u){0u, 0u, 0u, 0u};
        if (src >= 0) { const float* wp = P.w_in + (size_t)(8 * kc) * DIN_ + src;
            o.x = pk2(wp[0], wp[DIN_]); o.y = pk2(wp[2 * DIN_], wp[3 * DIN_]); o.z = pk2(wp[4 * DIN_], wp[5 * DIN_]); o.w = pk2(wp[6 * DIN_], wp[7 * DIN_]); }
        *(v4u*)(WIN + (size_t)(6656 + row) * 1024 + 8 * kc) = o;
    }
    bf16* U = (bf16*)((unsigned char*)P.out + OUT_U); bf16* MEMN = (bf16*)(P.ws + WS_MEMN);
    for (int m = gw; m < S_ + NMEM_; m += NGW) {
        if (m < S_) rms_row_to_bf16(P.x + (size_t)m * DM_, P.g_mix, U + (size_t)m * DM_, lane);
        else rms_row_to_bf16(P.mem + (size_t)(m - S_) * DM_, P.g_mem, MEMN + (size_t)(m - S_) * DM_, lane);
    }
}

struct GemmSched {
    const char* A; const char* B; int nM, nN, lda, ldb, G, c, wv;
    __device__ __forceinline__ bool next(int i, pg8::Unit& u) const { const long L = (long)i * G + c; if (L >= nM * nN) return false; pg8::map_tile((int)L, nM, nN, u.pm, u.pn); u.z = 0; return true; }
    __device__ __forceinline__ const char* aptr(const pg8::Unit& u) const { return A + (size_t)u.pm * 256 * lda * 2; }
    __device__ __forceinline__ const char* bptr(const pg8::Unit& u) const { return B + (size_t)u.pn * 256 * ldb * 2; }
    __device__ __forceinline__ void a_ready(const pg8::Unit&) const {}
    __device__ __forceinline__ void done(const pg8::Unit&) const {}
};
struct ProjSched {
    const char* U; const char* MEMN; const char* W; int G, c, wv;
    __device__ __forceinline__ bool next(int i, pg8::Unit& u) const { const int L = i * G + c; u.z = 0;
        if (L < 1728) { pg8::map_tile(L, 64, 27, u.pm, u.pn); return true; }
        if (L < 1732) { u.pm = 64; u.pn = 27 + (L - 1728); return true; } return false; }
    __device__ __forceinline__ const char* aptr(const pg8::Unit& u) const { return u.pm < 64 ? U + (size_t)u.pm * (256 * 1024 * 2) : MEMN; }
    __device__ __forceinline__ const char* bptr(const pg8::Unit& u) const { return W + (size_t)u.pn * (256 * 1024 * 2); }
    __device__ __forceinline__ void a_ready(const pg8::Unit&) const {}
    __device__ __forceinline__ void done(const pg8::Unit&) const {}
};
struct MergeSched {
    const char *A0, *B0; int G, c, wv; size_t segA, segB;
    __device__ __forceinline__ bool next(int i, pg8::Unit& u) const { const int T = c + G * i; if (T >= 256) return false; pg8::map_tile(T, 64, 4, u.pm, u.pn); u.z = 0; return true; }
    __device__ __forceinline__ const char* aptr(const pg8::Unit& u) const { return A0 + (size_t)u.pm * (256 * 512 * 2); }
    __device__ __forceinline__ const char* bptr(const pg8::Unit& u) const { return B0 + (size_t)u.pn * (256 * 512 * 2); }
    __device__ __forceinline__ void a_ready(const pg8::Unit&) const {}
    __device__ __forceinline__ void done(const pg8::Unit&) const {}
};
typedef pg8::f32x4 accv;
__device__ __forceinline__ void store_bf16_tile(const accv (&acc)[2][2][4][2], bf16* base, int ldc, int row0, int col0, float sc, bool sig) {
#pragma unroll
    for (int ai = 0; ai < 2; ++ai)
#pragma unroll
        for (int m = 0; m < 4; ++m) { bf16* rowp = base + (size_t)(row0 + ai * 128 + m * 16) * ldc + col0;
#pragma unroll
            for (int bj = 0; bj < 2; ++bj) { accv v0 = acc[ai][bj][m][0] * sc, v1 = acc[ai][bj][m][1] * sc;
                if (sig) { v0 = (accv){sigmoidf_(v0[0]), sigmoidf_(v0[1]), sigmoidf_(v0[2]), sigmoidf_(v0[3])}; v1 = (accv){sigmoidf_(v1[0]), sigmoidf_(v1[1]), sigmoidf_(v1[2]), sigmoidf_(v1[3])}; }
                v4u w; w.x = pg8::cvt_pk_bf16(v0[0], v0[1]); w.y = pg8::cvt_pk_bf16(v0[2], v0[3]); w.z = pg8::cvt_pk_bf16(v1[0], v1[1]); w.w = pg8::cvt_pk_bf16(v1[2], v1[3]);
                *(v4u*)(rowp + bj * 128) = w; } }
}
struct EpiProj {
    static constexpr bool PERM = true, AFTER_DRAIN = false;
    unsigned char* ws; const float* b_forget;
    __device__ __forceinline__ void operator()(const accv (&acc)[2][2][4][2], const pg8::Unit& u, int wr, int wc, int fr, int fq) const {
        const int pn = u.pn;
        if (pn != 26) {
            size_t off; int ldc, colt, prow = u.pm * 256; float sc = 1.f; bool sig = false;
            if (pn == 0) { off = WS_GQ; ldc = 256; colt = 0; sc = 0.125f; }
            else if (pn == 1) { off = WS_GK; ldc = 256; colt = 0; }
            else if (pn < 4) { off = WS_GV; ldc = 512; colt = (pn - 2) * 256; }
            else if (pn < 6) { off = WS_GG; ldc = 512; colt = (pn - 4) * 256; }
            else if (pn < 8) { off = WS_FQ; ldc = 512; colt = (pn - 6) * 256; sc = 0.125f * LOG2E_; }
            else if (pn < 10) { off = WS_FK; ldc = 512; colt = (pn - 8) * 256; }
            else if (pn < 12) { off = WS_FV; ldc = 512; colt = (pn - 10) * 256; }
            else if (pn < 14) { off = WS_MQ; ldc = 512; colt = (pn - 12) * 256; sc = 0.08838834764831845f * LOG2E_; }
            else if (pn < 26) { off = WS_GT; ldc = 3072; colt = (pn - 14) * 256; sig = true; }
            else if (pn < 29) { off = WS_MK; ldc = 512; colt = (pn - 27) * 256; prow = 0; }
            else { off = WS_MVT; ldc = 512; colt = (pn - 29) * 256; prow = 0; }
            store_bf16_tile(acc, (bf16*)(ws + off), ldc, prow + wr * 64 + fr, colt + wc * 32 + 8 * fq, sc, sig);
        } else {
            if (wc == 0 && fq < 3) {
                float* GA = (float*)(ws + WS_GA); float* LF = (float*)(ws + WS_LOGF);
                accv bf0 = (accv){0.f, 0.f, 0.f, 0.f}, bf1 = bf0;
                if (fq == 2) { bf0 = *(const accv*)(b_forget); bf1 = *(const accv*)(b_forget + 4); }
#pragma unroll
                for (int ai = 0; ai < 2; ++ai)
#pragma unroll
                    for (int m = 0; m < 4; ++m) { const size_t row = (size_t)(u.pm * 256 + wr * 64 + fr + ai * 128 + m * 16);
                        const accv v0 = acc[ai][0][m][0], v1 = acc[ai][0][m][1];
                        if (fq < 2) { *(accv*)(GA + row * 16 + 8 * fq) = v0; *(accv*)(GA + row * 16 + 8 * fq + 4) = v1; }
                        else { const accv a = v0 + bf0, b = v1 + bf1;
#pragma unroll
                            for (int j = 0; j < 4; ++j) { LF[(size_t)j * S_ + row] = logsigmoidf_(a[j]); LF[(size_t)(4 + j) * S_ + row] = logsigmoidf_(b[j]); } } }
            }
        }
    }
};
struct EpiMerge {
    static constexpr bool PERM = true, AFTER_DRAIN = false;
    bf16* MG; const bf16* GT;
    __device__ __forceinline__ void mid(accv (&acc)[2][2][4][2], const pg8::Unit& u, int s, int wr, int wc, int fr, int fq) const {
        const int row0 = u.pm * 256 + wr * 64 + fr, col0 = u.pn * 256 + wc * 32 + 8 * fq;
#pragma unroll
        for (int ai = 0; ai < 2; ++ai)
#pragma unroll
            for (int m = 0; m < 4; ++m) { const size_t row = (size_t)(row0 + ai * 128 + m * 16);
#pragma unroll
                for (int bj = 0; bj < 2; ++bj) { const int col = col0 + bj * 128;
                    const v4u a = *(const v4u*)(GT + row * 3072 + (s - 1) * 1024 + col), b = *(const v4u*)(GT + row * 3072 + s * 1024 + col);
                    const accv r0 = (accv){bflo(a.x) * __builtin_amdgcn_rcpf(fmaxf(bflo(b.x), 1e-30f)), bfhi(a.x) * __builtin_amdgcn_rcpf(fmaxf(bfhi(b.x), 1e-30f)), bflo(a.y) * __builtin_amdgcn_rcpf(fmaxf(bflo(b.y), 1e-30f)), bfhi(a.y) * __builtin_amdgcn_rcpf(fmaxf(bfhi(b.y), 1e-30f))};
                    const accv r1 = (accv){bflo(a.z) * __builtin_amdgcn_rcpf(fmaxf(bflo(b.z), 1e-30f)), bfhi(a.z) * __builtin_amdgcn_rcpf(fmaxf(bfhi(b.z), 1e-30f)), bflo(a.w) * __builtin_amdgcn_rcpf(fmaxf(bflo(b.w), 1e-30f)), bfhi(a.w) * __builtin_amdgcn_rcpf(fmaxf(bfhi(b.w), 1e-30f))};
                    acc[ai][bj][m][0] = acc[ai][bj][m][0] * r0; acc[ai][bj][m][1] = acc[ai][bj][m][1] * r1; } }
    }
    __device__ __forceinline__ void operator()(const accv (&acc)[2][2][4][2], const pg8::Unit& u, int wr, int wc, int fr, int fq) const {
        const int row0 = u.pm * 256 + wr * 64 + fr, col0 = u.pn * 256 + wc * 32 + 8 * fq;
#pragma unroll
        for (int ai = 0; ai < 2; ++ai)
#pragma unroll
            for (int m = 0; m < 4; ++m) { const size_t row = (size_t)(row0 + ai * 128 + m * 16);
#pragma unroll
                for (int bj = 0; bj < 2; ++bj) { const int col = col0 + bj * 128;
                    const v4u g = *(const v4u*)(GT + row * 3072 + 2 * 1024 + col);
                    accv v0 = acc[ai][bj][m][0], v1 = acc[ai][bj][m][1];
                    v0 = v0 * (accv){bflo(g.x), bfhi(g.x), bflo(g.y), bfhi(g.y)}; v1 = v1 * (accv){bflo(g.z), bfhi(g.z), bflo(g.w), bfhi(g.w)};
                    v4u w; w.x = pg8::cvt_pk_bf16(v0[0], v0[1]); w.y = pg8::cvt_pk_bf16(v0[2], v0[3]); w.z = pg8::cvt_pk_bf16(v1[0], v1[1]); w.w = pg8::cvt_pk_bf16(v1[2], v1[3]);
                    *(v4u*)(MG + row * 1024 + col) = w; } }
    }
};
template <bool WRITE_U2, bool BASE_BF16> struct EpiResid {
    static constexpr bool PERM = true, AFTER_DRAIN = false;
    const void* base; bf16* H0; bf16* H1; bf16* U2; const float* gain; float* SS;
    __device__ __forceinline__ void operator()(const accv (&acc)[2][2][4][2], const pg8::Unit& u, int wr, int wc, int fr, int fq) const {
        bf16* HB = u.pm < 32 ? H0 : H1;
        const int row0 = u.pm * 256 + wr * 64 + fr, col0 = u.pn * 256 + wc * 32 + 8 * fq;
#pragma unroll
        for (int ai = 0; ai < 2; ++ai)
#pragma unroll
            for (int m = 0; m < 4; ++m) { const size_t row = (size_t)(row0 + ai * 128 + m * 16); float ssq = 0.f;
#pragma unroll
                for (int bj = 0; bj < 2; ++bj) { const int col = col0 + bj * 128; const size_t o = row * 1024 + col;
                    accv b0, b1;
                    if (BASE_BF16) { const v4u bw = *(const v4u*)((const bf16*)base + o); b0 = (accv){bflo(bw.x), bfhi(bw.x), bflo(bw.y), bfhi(bw.y)}; b1 = (accv){bflo(bw.z), bfhi(bw.z), bflo(bw.w), bfhi(bw.w)}; }
                    else { b0 = *(const accv*)((const float*)base + o); b1 = *(const accv*)((const float*)base + o + 4); }
                    const accv h0 = b0 + acc[ai][bj][m][0], h1 = b1 + acc[ai][bj][m][1];
                    { v4u w; w.x = pg8::cvt_pk_bf16(h0[0], h0[1]); w.y = pg8::cvt_pk_bf16(h0[2], h0[3]); w.z = pg8::cvt_pk_bf16(h1[0], h1[1]); w.w = pg8::cvt_pk_bf16(h1[2], h1[3]); *(v4u*)(HB + o) = w; }
                    ssq += (h0[0] * h0[0] + h0[1] * h0[1]) + (h0[2] * h0[2] + h0[3] * h0[3]) + (h1[0] * h1[0] + h1[1] * h1[1]) + (h1[2] * h1[2] + h1[3] * h1[3]);
                    if (WRITE_U2) { const accv g0 = *(const accv*)(gain + col), g1 = *(const accv*)(gain + col + 4); const accv a = h0 * g0, b = h1 * g1;
                        v4u w; w.x = pg8::cvt_pk_bf16(a[0], a[1]); w.y = pg8::cvt_pk_bf16(a[2], a[3]); w.z = pg8::cvt_pk_bf16(b[0], b[1]); w.w = pg8::cvt_pk_bf16(b[2], b[3]);
                        *(v4u*)(U2 + o) = w; } }
                ssq += __shfl_xor(ssq, 16); ssq += __shfl_xor(ssq, 32);
                if (fq == 0) SS[row * 16 + u.pn * 4 + wc] = ssq; }
    }
};
struct EpiFinal {
    static constexpr bool PERM = true, AFTER_DRAIN = true;
    const bf16* H0; const bf16* H1; float* out; const float* gain; float* xbuf; unsigned* cnt;
    __device__ __forceinline__ void fused(accv (&acc)[2][2][4][2], const pg8::Unit& u, int wr, int wc, int fr, int fq, LAS unsigned char* lds, int wid, int lane) const {
        const bf16* HB = u.pm < 32 ? H0 : H1;
        LAS float* Pl = (LAS float*)lds; LAS float* Sl = (LAS float*)(lds + 4096);
        const int row0 = u.pm * 256 + wr * 64 + fr, col0 = u.pn * 256 + wc * 32 + 8 * fq;
#pragma unroll
        for (int ai = 0; ai < 2; ++ai)
#pragma unroll
            for (int m = 0; m < 4; ++m) { const size_t row = (size_t)(row0 + ai * 128 + m * 16); float ssq = 0.f;
#pragma unroll
                for (int bj = 0; bj < 2; ++bj) { const size_t o = row * 1024 + col0 + bj * 128; const v4u bw = *(const v4u*)(HB + o);
                    const accv h0 = acc[ai][bj][m][0] + (accv){bflo(bw.x), bfhi(bw.x), bflo(bw.y), bfhi(bw.y)}, h1 = acc[ai][bj][m][1] + (accv){bflo(bw.z), bfhi(bw.z), bflo(bw.w), bfhi(bw.w)};
                    acc[ai][bj][m][0] = h0; acc[ai][bj][m][1] = h1;
                    ssq += (h0[0] * h0[0] + h0[1] * h0[1]) + (h0[2] * h0[2] + h0[3] * h0[3]) + (h1[0] * h1[0] + h1[1] * h1[1]) + (h1[2] * h1[2] + h1[3] * h1[3]); }
                ssq += __shfl_xor(ssq, 16); ssq += __shfl_xor(ssq, 32);
                if (fq == 0) Pl[(ai * 128 + wr * 64 + m * 16 + fr) * 4 + wc] = ssq; }
        asm volatile("s_waitcnt lgkmcnt(0)" ::: "memory"); __builtin_amdgcn_s_barrier(); asm volatile("" ::: "memory");
        const int rowl = wid * 32 + (lane & 31);
        if (lane < 32) { const float s = (Pl[rowl * 4] + Pl[rowl * 4 + 1]) + (Pl[rowl * 4 + 2] + Pl[rowl * 4 + 3]);
            __hip_atomic_store(xbuf + ((size_t)(u.pm * 256 + rowl) * 4 + u.pn), s, __ATOMIC_RELAXED, __HIP_MEMORY_SCOPE_AGENT); }
        asm volatile("s_waitcnt vmcnt(0)" ::: "memory");
        if (lane == 0) __hip_atomic_fetch_add(cnt + 64 * u.pm, 1u, __ATOMIC_RELAXED, __HIP_MEMORY_SCOPE_AGENT);
        if (wid == 0) { unsigned sp = 0;
            while ((unsigned)__builtin_amdgcn_readfirstlane(__hip_atomic_load(cnt + 64 * u.pm, __ATOMIC_RELAXED, __HIP_MEMORY_SCOPE_AGENT)) < 32u) { __builtin_amdgcn_s_sleep(2); if (++sp > (1u << 22)) break; }
            __builtin_amdgcn_fence(__ATOMIC_ACQUIRE, "agent"); }
        asm volatile("s_waitcnt vmcnt(0) lgkmcnt(0)" ::: "memory"); __builtin_amdgcn_s_barrier(); asm volatile("" ::: "memory");
        if (lane < 32) { const float* sl = xbuf + (size_t)(u.pm * 256 + rowl) * 4;
            const float a = __hip_atomic_load(sl, __ATOMIC_RELAXED, __HIP_MEMORY_SCOPE_AGENT), b = __hip_atomic_load(sl + 1, __ATOMIC_RELAXED, __HIP_MEMORY_SCOPE_AGENT),
                        c = __hip_atomic_load(sl + 2, __ATOMIC_RELAXED, __HIP_MEMORY_SCOPE_AGENT), d = __hip_atomic_load(sl + 3, __ATOMIC_RELAXED, __HIP_MEMORY_SCOPE_AGENT);
            Sl[rowl] = rsqrtf(((a + b) + (c + d)) * (1.f / 1024.f) + EPS_); }
        asm volatile("s_waitcnt vmcnt(0) lgkmcnt(0)" ::: "memory"); __builtin_amdgcn_s_barrier(); asm volatile("" ::: "memory");
#pragma unroll
        for (int ai = 0; ai < 2; ++ai)
#pragma unroll
            for (int m = 0; m < 4; ++m) { const int rl = ai * 128 + wr * 64 + m * 16 + fr; const float r = Sl[rl]; const size_t row = (size_t)(u.pm * 256 + rl);
#pragma unroll
                for (int bj = 0; bj < 2; ++bj) { const int col = col0 + bj * 128; const accv g0 = *(const accv*)(gain + col), g1 = *(const accv*)(gain + col + 4);
                    *(accv*)(out + row * 1024 + col) = acc[ai][bj][m][0] * r * g0; *(accv*)(out + row * 1024 + col + 4) = acc[ai][bj][m][1] * r * g1; } }
    }
};
struct EpiFfn1 {
    static constexpr bool PERM = true, AFTER_DRAIN = false;
    bf16* HID; const float* SS;
    __device__ __forceinline__ void operator()(const accv (&acc)[2][2][4][2], const pg8::Unit& u, int wr, int wc, int fr, int fq) const {
        const int row0 = u.pm * 256 + wr * 64 + fr, col0 = u.pn * 256 + wc * 32 + 8 * fq;
#pragma unroll
        for (int ai = 0; ai < 2; ++ai)
#pragma unroll
            for (int m = 0; m < 4; ++m) { const size_t row = (size_t)(row0 + ai * 128 + m * 16);
                const accv s0 = *(const accv*)(SS + row * 16), s1 = *(const accv*)(SS + row * 16 + 4), s2 = *(const accv*)(SS + row * 16 + 8), s3 = *(const accv*)(SS + row * 16 + 12);
                const float tot = ((s0[0] + s0[1]) + (s0[2] + s0[3])) + ((s1[0] + s1[1]) + (s1[2] + s1[3])) + ((s2[0] + s2[1]) + (s2[2] + s2[3])) + ((s3[0] + s3[1]) + (s3[2] + s3[3]));
                const float r = rsqrtf(tot * (1.f / 1024.f) + EPS_);
#pragma unroll
                for (int bj = 0; bj < 2; ++bj) { accv v0 = acc[ai][bj][m][0] * r, v1 = acc[ai][bj][m][1] * r;
#pragma unroll
                    for (int j = 0; j < 4; ++j) { const float a = fmaxf(v0[j], 0.f), b = fmaxf(v1[j], 0.f); v0[j] = a * a; v1[j] = b * b; }
                    v4u w; w.x = pg8::cvt_pk_bf16(v0[0], v0[1]); w.y = pg8::cvt_pk_bf16(v0[2], v0[3]); w.z = pg8::cvt_pk_bf16(v1[0], v1[1]); w.w = pg8::cvt_pk_bf16(v1[2], v1[3]);
                    *(v4u*)(HID + row * 4096 + col0 + bj * 128) = w; } }
    }
};

constexpr int GP = 144;
__device__ __forceinline__ void gla_a_unit(const Ptrs& P, LAS unsigned char* lds, int n, int h, int wv) {
    const int tid = fresh_tid(wv), lane = tid & 63, g = wv, r32 = lane & 31, hh = lane >> 5;
    LAS unsigned char* QP = lds; LAS unsigned char* QN = lds + 9216; LAS unsigned char* KN = lds + 18432; LAS unsigned char* KP = lds + 27648;
    LAS unsigned char* KLT = lds + 36864; LAS unsigned char* AT = lds + 46080; LAS unsigned char* VT = lds + 55296; LAS float* TOT = (LAS float*)(lds + 73728);
    bf16* GQ = (bf16*)(P.ws + WS_GQ); const bf16* GK = (const bf16*)(P.ws + WS_GK); bf16* GV = (bf16*)(P.ws + WS_GV);
    const float* GA = (const float*)(P.ws + WS_GA); float* DEC = (float*)(P.ws + WS_DEC); bf16* STATE = (bf16*)((unsigned char*)P.out + OUT_STATE);
    const int c = h * 64 + lane, t0 = n * 64;
#ifdef PROBE_PHASE
#define GSTAMP(k) do { if (n == 64 && h == 0 && tid == 0) ((unsigned long long*)(P.ws + 253 * MiB))[(k)] = __builtin_amdgcn_s_memrealtime(); } while (0)
#else
#define GSTAMP(k) do {} while (0)
#endif
    GSTAMP(60);
    float wup[16];
#pragma unroll
    for (int j = 0; j < 16; ++j) wup[j] = P.w_alpha_up[j * 256 + c];
    const float ba = P.b_alpha[c];
    unsigned short qraw[8], kraw[8];
#pragma unroll
    for (int i = 0; i < 8; ++i) { const size_t gi = (size_t)(t0 + 8 * g + i) * 256 + c; qraw[i] = GQ[gi]; kraw[i] = GK[gi]; }
    float bl[8]; float run = 0.f;
#pragma unroll
    for (int i = 0; i < 8; ++i) { const f32x4* gar = (const f32x4*)(GA + (size_t)(t0 + 8 * g + i) * 16); float z = ba;
#pragma unroll
        for (int j4 = 0; j4 < 4; ++j4) { const f32x4 a = gar[j4]; z += a[0] * wup[4 * j4] + a[1] * wup[4 * j4 + 1] + a[2] * wup[4 * j4 + 2] + a[3] * wup[4 * j4 + 3]; }
        run += logsigmoid_fast(z) * (1.f / 16.f); bl[i] = run; }
    TOT[g * 64 + lane] = run;
    { const int s = tid >> 3, vc = tid & 7; const v4u a = *(const v4u*)(GV + (size_t)(t0 + s) * 512 + h * 128 + vc * 16), b = *(const v4u*)(GV + (size_t)(t0 + s) * 512 + h * 128 + vc * 16 + 8);
      LAS bf16* vt = (LAS bf16*)VT; const unsigned w[8] = {a.x, a.y, a.z, a.w, b.x, b.y, b.z, b.w};
#pragma unroll
      for (int j = 0; j < 8; ++j) { vt[(vc * 16 + 2 * j) * 72 + s] = (bf16)(w[j] & 0xffffu); vt[(vc * 16 + 2 * j + 1) * 72 + s] = (bf16)(w[j] >> 16); } }
    LBAR(); GSTAMP(61);
    float off = 0.f, blast = 0.f;
#pragma unroll
    for (int gg = 0; gg < 8; ++gg) { const float tv = TOT[gg * 64 + lane]; if (gg < g) off += tv; blast += tv; }
    unsigned kl[8];
#pragma unroll
    for (int i = 0; i < 8; ++i) { const int t = 8 * g + i; const float b = off + bl[i]; const size_t gi = (size_t)(t0 + t) * 256 + c;
        const float q = bf2f(qraw[i]), k = bf2f(kraw[i]); const float ep = __expf(b), en = __expf(-b), el = __expf(blast - b);
        const unsigned qp = f2bf(q * ep); GQ[gi] = (bf16)qp;
        ((LAS bf16*)QP)[t * 72 + lane] = (bf16)qp; ((LAS bf16*)QN)[t * 72 + lane] = (bf16)f2bf(q * en);
        ((LAS bf16*)KN)[t * 72 + lane] = (bf16)f2bf(k * en); ((LAS bf16*)KP)[t * 72 + lane] = (bf16)f2bf(k * ep); kl[i] = f2bf(k * el); }
    *(LAS v4u*)(KLT + lane * GP + 16 * g) = (v4u){kl[0] | (kl[1] << 16), kl[2] | (kl[3] << 16), kl[4] | (kl[5] << 16), kl[6] | (kl[7] << 16)};
    if (g == 0) DEC[(n * 4 + h) * 64 + lane] = __expf(blast);
    LBAR(); GSTAMP(62);
    const f32x16 zero = {};
    if (g < 4) {
        const int ti = g >> 1, si = g & 1; f32x16 ac = zero, an = zero;
        if (ti >= si) {
#pragma unroll
            for (int ks = 0; ks < 4; ++ks) ac = MFMA32(ldfrag(QP, 32 * ti + r32, GP, 32 * ks + 16 * hh), ldfrag(KN, 32 * si + r32, GP, 32 * ks + 16 * hh), ac); }
        if (ti <= si) {
#pragma unroll
            for (int ks = 0; ks < 4; ++ks) an = MFMA32(ldfrag(QN, 32 * ti + r32, GP, 32 * ks + 16 * hh), ldfrag(KP, 32 * si + r32, GP, 32 * ks + 16 * hh), an); }
#pragma unroll
        for (int i = 0; i < 16; ++i) { const int t = 32 * ti + crow_(i, hh), s = 32 * si + r32; ((LAS bf16*)AT)[t * 72 + s] = (bf16)f2bf(t >= s ? ac[i] : an[i]); }
    } else {
        const int vi = g - 4;
#pragma unroll
        for (int dj = 0; dj < 2; ++dj) { f32x16 st = zero;
#pragma unroll
            for (int ks = 0; ks < 4; ++ks) st = MFMA32(ldfrag(KLT, 32 * dj + r32, GP, 32 * ks + 16 * hh), ldfrag(VT, 32 * vi + r32, GP, 32 * ks + 16 * hh), st);
#pragma unroll
            for (int i4 = 0; i4 < 4; ++i4) *(v2u*)(STATE + (size_t)(n * 4 + h) * 8192 + (size_t)(((vi * 4 + 2 * dj + (i4 >> 1)) * 64 + r32 + 32 * (i4 & 1)) * 8 + 4 * hh)) = (v2u){pk2(st[4 * i4], st[4 * i4 + 1]), pk2(st[4 * i4 + 2], st[4 * i4 + 3])}; }
    }
    LBAR(); GSTAMP(63);
    { const int ti = g >> 2, vj = g & 3; f32x16 oi = zero;
#pragma unroll
      for (int ks = 0; ks < 4; ++ks) oi = MFMA32(ldfrag(AT, 32 * ti + r32, GP, 32 * ks + 16 * hh), ldfrag(VT, 32 * vj + r32, GP, 32 * ks + 16 * hh), oi);
#pragma unroll
      for (int i = 0; i < 16; ++i) GV[(size_t)(t0 + 32 * ti + crow_(i, hh)) * 512 + h * 128 + 32 * vj + r32] = (bf16)f2bf(oi[i]); }
    LBAR(); GSTAMP(64);
}
__device__ __forceinline__ void gla_scan_unit(const Ptrs& P, LAS unsigned char* lds, int u, int wv) {
    const int tid = fresh_tid(wv), lane = tid & 63, w = wv;
    const int h = u >> 6, e0 = (u & 63) * 128;
    const int dch = 16 * ((e0 >> 9) & 3) + 8 * ((e0 >> 8) & 1) + ((2 * lane) & 7);
    unsigned* STATE = (unsigned*)((unsigned char*)P.out + OUT_STATE); const float* DEC = (const float*)(P.ws + WS_DEC);
    LAS float* segS = (LAS float*)lds; LAS float* segP = (LAS float*)(lds + 8192);
    float kv[2][32], dc[2][32];
#pragma unroll
    for (int i = 0; i < 32; ++i) { const int n = 32 * w + i; const unsigned wd = STATE[((size_t)(n * 4 + h) * 8192 + e0) / 2 + lane]; kv[0][i] = bflo(wd); kv[1][i] = bfhi(wd);
        const float2 d2 = *(const float2*)(DEC + (n * 4 + h) * 64 + dch); dc[0][i] = d2.x; dc[1][i] = d2.y; }
    float s[2] = {0.f, 0.f}, pr[2] = {1.f, 1.f};
#pragma unroll
    for (int i = 0; i < 32; ++i) {
#pragma unroll
        for (int e = 0; e < 2; ++e) { const float pv = s[e]; s[e] = s[e] * dc[e][i] + kv[e][i]; kv[e][i] = pv; pr[e] *= dc[e][i]; } }
    segS[w * 64 + lane] = s[0]; segS[512 + w * 64 + lane] = s[1]; segP[w * 64 + lane] = pr[0]; segP[512 + w * 64 + lane] = pr[1];
    LBAR();
    float sin_[2] = {0.f, 0.f};
#pragma unroll
    for (int ww = 0; ww < 8; ++ww) { const float a0 = segS[ww * 64 + lane], a1 = segS[512 + ww * 64 + lane], b0 = segP[ww * 64 + lane], b1 = segP[512 + ww * 64 + lane]; if (ww < w) { sin_[0] = sin_[0] * b0 + a0; sin_[1] = sin_[1] * b1 + a1; } }
    float cp[2] = {1.f, 1.f};
#pragma unroll
    for (int i = 0; i < 32; ++i) { const int n = 32 * w + i;
        STATE[((size_t)(n * 4 + h) * 8192 + e0) / 2 + lane] = pk2(kv[0][i] + cp[0] * sin_[0], kv[1][i] + cp[1] * sin_[1]);
        cp[0] *= dc[0][i]; cp[1] *= dc[1][i]; }
    LBAR();
}
__device__ __forceinline__ void gla_b_task(const Ptrs& P, int task, int lane) {
    const int r32 = lane & 31, hh = lane >> 5;
    const int ti = task & 1, h = (task >> 1) & 3, n = task >> 3;
    const bf16* GQ = (const bf16*)(P.ws + WS_GQ); const bf16* GV = (const bf16*)(P.ws + WS_GV); bf16* GG = (bf16*)(P.ws + WS_GG);
    const bf16* SB = (const bf16*)((unsigned char*)P.out + OUT_STATE) + (size_t)(n * 4 + h) * 8192;
    const size_t t = (size_t)n * 64 + 32 * ti + r32;
    bf16x8 qf[4];
#pragma unroll
    for (int ks = 0; ks < 4; ++ks) qf[ks] = *(const bf16x8*)(GQ + t * 256 + h * 64 + 16 * ks + 8 * hh);
    f32x16 o[4];
#pragma unroll
    for (int vj = 0; vj < 4; ++vj) { o[vj] = (f32x16){};
#pragma unroll
        for (int ks = 0; ks < 4; ++ks) { const bf16x8 af = *(const bf16x8*)(SB + ((vj * 4 + ks) * 64 + lane) * 8);
            o[vj] = MFMA32(af, qf[ks], o[vj]); }
        asm volatile("" ::: "memory"); }
    float ov[64]; float ss = 0.f;
#pragma unroll
    for (int vj = 0; vj < 4; ++vj) {
#pragma unroll
        for (int g4 = 0; g4 < 4; ++g4) { const v2u w = *(const v2u*)(GV + t * 512 + h * 128 + 32 * vj + 8 * g4 + 4 * hh);
            const float a0 = o[vj][4 * g4] + bflo(w.x), a1 = o[vj][4 * g4 + 1] + bfhi(w.x), a2 = o[vj][4 * g4 + 2] + bflo(w.y), a3 = o[vj][4 * g4 + 3] + bfhi(w.y);
            ov[16 * vj + 4 * g4] = a0; ov[16 * vj + 4 * g4 + 1] = a1; ov[16 * vj + 4 * g4 + 2] = a2; ov[16 * vj + 4 * g4 + 3] = a3;
            ss += (a0 * a0 + a1 * a1) + (a2 * a2 + a3 * a3); } }
    ss += __shfl_xor(ss, 32);
    const float r = rsqrtf(ss * (1.f / 128.f) + EPS_);
#pragma unroll
    for (int vj = 0; vj < 4; ++vj) {
#pragma unroll
        for (int g4 = 0; g4 < 4; ++g4) { const int vc = h * 128 + 32 * vj + 8 * g4 + 4 * hh; const v2u gw = *(const v2u*)(GG + t * 512 + vc); const f32x4 gn = *(const f32x4*)(P.g_gla_head + vc);
            const float g0 = bflo(gw.x), g1 = bfhi(gw.x), g2 = bflo(gw.y), g3 = bfhi(gw.y);
            v2u ow; ow.x = pk2(ov[16 * vj + 4 * g4] * r * gn[0] * (g0 * sigmoidf_(g0)), ov[16 * vj + 4 * g4 + 1] * r * gn[1] * (g1 * sigmoidf_(g1)));
            ow.y = pk2(ov[16 * vj + 4 * g4 + 2] * r * gn[2] * (g2 * sigmoidf_(g2)), ov[16 * vj + 4 * g4 + 3] * r * gn[3] * (g3 * sigmoidf_(g3)));
            *(v2u*)(GG + t * 512 + vc) = ow; }
        asm volatile("" ::: "memory"); }
}
__device__ __forceinline__ void memattn_unit(const Ptrs& P, LAS unsigned char* lds, int hm, int qb, int wv) {
    const int tid = fresh_tid(wv), lane = tid & 63, w = wv, r32 = lane & 31, hh = lane >> 5;
    constexpr int KPB = 272, VPB = 528;
    LAS unsigned char* KM = lds; LAS unsigned char* VTM = lds + 69632; LAS float* LSUM = (LAS float*)(lds + 137216);
    const bf16* MK = (const bf16*)(P.ws + WS_MK); const bf16* MVT = (const bf16*)(P.ws + WS_MVT); bf16* MQ = (bf16*)(P.ws + WS_MQ);
#pragma unroll
    for (int j = 0; j < 8; ++j) { const int idx = tid + 512 * j; const int key = idx >> 4, ch = idx & 15; *(LAS v4u*)(KM + key * KPB + ch * 16) = *(const v4u*)(MK + (size_t)key * 512 + hm * 128 + ch * 8);
    }
    { const int dc = tid & 15, key0 = (tid >> 4) * 8; v4u in[8];
#pragma unroll
      for (int k = 0; k < 8; ++k) in[k] = *(const v4u*)(MVT + (size_t)(key0 + k) * 512 + hm * 128 + dc * 8);
#pragma unroll
      for (int jp = 0; jp < 4; ++jp) {
          unsigned e[8];
#pragma unroll
          for (int k = 0; k < 8; ++k) e[k] = jp == 0 ? in[k].x : (jp == 1 ? in[k].y : (jp == 2 ? in[k].z : in[k].w));
          const v4u lo = (v4u){(e[0] & 0xffffu) | (e[1] << 16), (e[2] & 0xffffu) | (e[3] << 16), (e[4] & 0xffffu) | (e[5] << 16), (e[6] & 0xffffu) | (e[7] << 16)};
          const v4u hi = (v4u){(e[0] >> 16) | (e[1] & 0xffff0000u), (e[2] >> 16) | (e[3] & 0xffff0000u), (e[4] >> 16) | (e[5] & 0xffff0000u), (e[6] >> 16) | (e[7] & 0xffff0000u)};
          *(LAS v4u*)(VTM + (8 * dc + 2 * jp) * VPB + key0 * 2) = lo; *(LAS v4u*)(VTM + (8 * dc + 2 * jp + 1) * VPB + key0 * 2) = hi; } }
    const size_t qrow = (size_t)qb * 256 + 32 * w + r32;
    bf16x8 qr[8];
#pragma unroll
    for (int ks = 0; ks < 8; ++ks) qr[ks] = *(const bf16x8*)(MQ + qrow * 512 + hm * 128 + 16 * ks + 8 * hh);
    LBAR();
    f32x16 p[8];
#pragma unroll
    for (int kb = 0; kb < 8; ++kb) { p[kb] = (f32x16){};
#pragma unroll
        for (int ks = 0; ks < 8; ++ks) p[kb] = MFMA32(ldfrag(KM, 32 * kb + r32, KPB, 32 * ks + 16 * hh), qr[ks], p[kb]); }
    float mx = -INFINITY;
#pragma unroll
    for (int kb = 0; kb < 8; ++kb)
#pragma unroll
        for (int i = 0; i < 16; ++i) mx = fmaxf(mx, p[kb][i]);
    mx = fmaxf(mx, __shfl_xor(mx, 32));
    float l = 0.f; v4u pk[8][2];
#pragma unroll
    for (int kb = 0; kb < 8; ++kb) {
#pragma unroll
        for (int i = 0; i < 16; ++i) { p[kb][i] = __builtin_amdgcn_exp2f(p[kb][i] - mx); l += p[kb][i]; }
#pragma unroll
        for (int s = 0; s < 2; ++s) pk[kb][s] = (v4u){pk2(p[kb][8 * s], p[kb][8 * s + 1]), pk2(p[kb][8 * s + 2], p[kb][8 * s + 3]), pk2(p[kb][8 * s + 4], p[kb][8 * s + 5]), pk2(p[kb][8 * s + 6], p[kb][8 * s + 7])}; }
    l += __shfl_xor(l, 32);
    if (hh == 0) LSUM[w * 32 + r32] = l;
    f32x16 o[4];
#pragma unroll
    for (int db = 0; db < 4; ++db) { o[db] = (f32x16){};
#pragma unroll
        for (int kb = 0; kb < 8; ++kb)
#pragma unroll
            for (int s = 0; s < 2; ++s) { const LAS unsigned char* vp = VTM + (32 * db + r32) * VPB + 64 * kb + 32 * s + 8 * hh;
                const s16x4 lo = *(const LAS s16x4*)vp, hi = *(const LAS s16x4*)(vp + 16);
                const bf16x8 bfr = (bf16x8){lo[0], lo[1], lo[2], lo[3], hi[0], hi[1], hi[2], hi[3]};
                o[db] = MFMA32(__builtin_bit_cast(bf16x8, pk[kb][s]), bfr, o[db]); } }
    LDS_WAIT(); asm volatile("" ::: "memory");
#pragma unroll
    for (int i = 0; i < 16; ++i) { const int ql = crow_(i, hh); const float rl = __builtin_amdgcn_rcpf(LSUM[w * 32 + ql]);
#pragma unroll
        for (int db = 0; db < 4; ++db) MQ[((size_t)qb * 256 + 32 * w + ql) * 512 + hm * 128 + 32 * db + r32] = (bf16)f2bf(o[db][i] * rl); }
    LBAR();
}
__device__ __forceinline__ float lse2f(float a, float b) { const float m = fmaxf(a, b), d = fminf(a, b) - m; return (m == -INFINITY) ? m : m + __log2f(1.f + __builtin_amdgcn_exp2f(d)); }
__device__ __forceinline__ void fcumsum_unit(const Ptrs& P, LAS unsigned char* lds, int hf, int wv) {
    const int tid = fresh_tid(wv), lane = tid & 63, w = wv;
    const float* LF = (const float*)(P.ws + WS_LOGF) + (size_t)hf * S_; float* F = (float*)(P.ws + WS_F) + (size_t)hf * S_;
    LAS float* X = (LAS float*)lds; LAS float* WT = (LAS float*)(lds + 69632);
#pragma unroll 8
    for (int j = 0; j < 32; ++j) { const int t = j * 512 + tid; X[t + (t >> 5)] = LF[t]; }
    LBAR();
    float loc[32]; float s = 0.f;
#pragma unroll
    for (int i = 0; i < 32; ++i) { s += X[tid * 33 + i]; loc[i] = s; }
    float incl = s;
#pragma unroll
    for (int o = 1; o < 64; o <<= 1) { const float y = __shfl_up(incl, o); if (lane >= o) incl += y; }
    if (lane == 63) WT[w] = incl;
    LBAR();
    float woff = 0.f;
#pragma unroll
    for (int ww = 0; ww < 8; ++ww) { const float a = WT[ww]; if (ww < w) woff += a; }
    const float off = woff + incl - s;
#pragma unroll
    for (int i = 0; i < 32; ++i) { loc[i] = off + loc[i]; X[tid * 33 + i] = loc[i]; }
    LBAR();
#pragma unroll 8
    for (int j = 0; j < 32; ++j) { const int t = j * 512 + tid; F[t] = X[t + (t >> 5)]; }
    LBAR();
    const float ref = loc[0]; float accl = 0.f;
#pragma unroll
    for (int i = 0; i < 32; ++i) accl += __builtin_amdgcn_exp2f((ref - loc[i]) * LOG2E_);
    float linc = __log2f(accl) - ref * LOG2E_;
#pragma unroll
    for (int o = 1; o < 64; o <<= 1) { const float y = __shfl_up(linc, o); if (lane >= o) linc = lse2f(linc, y); }
    if (lane == 63) WT[w] = linc;
    LBAR();
    float wpre = -INFINITY;
#pragma unroll
    for (int ww = 0; ww < 8; ++ww) { const float a = WT[ww]; if (ww < w) wpre = lse2f(wpre, a); }
    if ((tid & 3) == 3) ((float*)(P.ws + WS_LSEF))[hf * 128 + (tid >> 2)] = lse2f(wpre, linc);
    LBAR();
}

__device__ __forceinline__ void normmax_unit(const Ptrs& P, LAS unsigned char* lds, int j, int wv) {
    const int tid = fresh_tid(wv), r = tid >> 3, h = tid & 7;
    const bf16* FQ = (const bf16*)(P.ws + WS_FQ); const bf16* FK = (const bf16*)(P.ws + WS_FK); LAS float* RED = (LAS float*)lds;
    const v4u* qp = (const v4u*)(FQ + (size_t)(64 * j + r) * 512 + h * 64); const v4u* kp = (const v4u*)(FK + (size_t)(64 * j + r) * 512 + h * 64);
    float sq = 0.f, sk = 0.f, sd = 0.f;
#pragma unroll
    for (int c = 0; c < 8; ++c) { const v4u a = qp[c], b = kp[c];
        sq += bflo(a.x) * bflo(a.x) + bfhi(a.x) * bfhi(a.x) + bflo(a.y) * bflo(a.y) + bfhi(a.y) * bfhi(a.y) + bflo(a.z) * bflo(a.z) + bfhi(a.z) * bfhi(a.z) + bflo(a.w) * bflo(a.w) + bfhi(a.w) * bfhi(a.w);
        sk += bflo(b.x) * bflo(b.x) + bfhi(b.x) * bfhi(b.x) + bflo(b.y) * bflo(b.y) + bfhi(b.y) * bfhi(b.y) + bflo(b.z) * bflo(b.z) + bfhi(b.z) * bfhi(b.z) + bflo(b.w) * bflo(b.w) + bfhi(b.w) * bfhi(b.w);
        sd += bflo(a.x) * bflo(b.x) + bfhi(a.x) * bfhi(b.x) + bflo(a.y) * bflo(b.y) + bfhi(a.y) * bfhi(b.y) + bflo(a.z) * bflo(b.z) + bfhi(a.z) * bfhi(b.z) + bflo(a.w) * bflo(b.w) + bfhi(a.w) * bfhi(b.w); }
    RED[tid] = sq; RED[512 + tid] = sk; RED[1024 + tid] = -sd;
    LBAR();
    if (tid < 16) { const int hh = tid & 7, which = tid >> 3; float m = 0.f;
        for (int rr = 0; rr < 64; ++rr) m = fmaxf(m, RED[which * 512 + rr * 8 + hh]);
        atomicMax((unsigned*)P.ws + which * 8 + hh, __float_as_uint(m));
        if (which == 0) ((float*)(P.ws + WS_QB2))[j * 8 + hh] = m; }
    else if (tid < 24) { const int hh = tid & 7; float m = -INFINITY;
        for (int rr = 0; rr < 64; ++rr) m = fmaxf(m, RED[1024 + rr * 8 + hh]);
        ((float*)(P.ws + WS_NDOT))[j * 8 + hh] = m; }
    LBAR();
}
#define RLX_AGENT __ATOMIC_RELAXED, __HIP_MEMORY_SCOPE_AGENT
#define XB_TMO      128
#define XB_XCNT(j)  (256  + 64 * (j))
#define XB_XSUB(j)  (1280 + 64 * (j))
#define XB_XGEN(j)  (2304 + 64 * (j))
#define XB_TOP      3328
#define XB_TOPGEN   3392
#define XCD_BAR_WORDS 3456
#define XB_SPIN_CAP (1u << 18)

__device__ __forceinline__ unsigned xb_ld(unsigned* p)              { return __hip_atomic_load(p, __ATOMIC_RELAXED, __HIP_MEMORY_SCOPE_AGENT); }
__device__ __forceinline__ unsigned xb_add(unsigned* p, unsigned v) { return __hip_atomic_fetch_add(p, v, __ATOMIC_RELAXED, __HIP_MEMORY_SCOPE_AGENT); }
__device__ __forceinline__ unsigned xb_xcc_id() { return (unsigned)__builtin_amdgcn_s_getreg((3 << 11) | 20) & 0xFu; }
#define XB_SPIN(cond, bar) do { unsigned _sp = 0; while (cond) { __builtin_amdgcn_s_sleep(1); \
    if ((++_sp & 255u) == 0u) { if (xb_ld(&(bar)[XB_TMO])) break; if (_sp > XB_SPIN_CAP) { atomicAdd(&(bar)[XB_TMO], 1u); break; } } } } while (0)

struct XcdBarrier {
    unsigned* bar; unsigned x;
    volatile LAS unsigned* st;
};

__device__ __forceinline__ XcdBarrier xcd_barrier_post(unsigned* bar, volatile LAS unsigned* st, int wv) {
    XcdBarrier b; b.bar = bar; b.x = xb_xcc_id(); b.st = st;
    if (fresh_tid(wv) == 0) (void)xb_add(&bar[XB_XCNT(b.x)], 1u);
    return b;
}
__device__ __forceinline__ void xcd_barrier_complete(unsigned* bar, unsigned x, unsigned& nloc, unsigned& nx) {
    const unsigned G = gridDim.x * gridDim.y * gridDim.z;
    unsigned sum, cnt, mine, sp = 0u;
    for (;;) {
        sum = 0u; cnt = 0u; mine = 0u;
#pragma unroll
        for (unsigned j = 0; j < 16; ++j) { const unsigned c = xb_ld(&bar[XB_XCNT(j)]); sum += c; cnt += (c > 0u) ? 1u : 0u; mine = (j == x) ? c : mine; }
        if (sum == G) break;
        __builtin_amdgcn_s_sleep(1);
        if ((++sp & 255u) == 0u) { if (xb_ld(&bar[XB_TMO])) break; if (sp > XB_SPIN_CAP) { atomicAdd(&bar[XB_TMO], 1u); break; } }
    }
    nloc = mine > 0u ? mine : 1u; nx = cnt > 0u ? cnt : 1u;
}

__device__ __forceinline__ void xcd_barrier(const XcdBarrier& b, int wv) {
    asm volatile("s_waitcnt vmcnt(0)" ::: "memory");
    __syncthreads();
    if (fresh_tid(wv) == 0) {
        unsigned* bar = b.bar;
        __builtin_amdgcn_s_waitcnt(0);
        unsigned nloc = b.st[0], nx = b.st[1];
        if (nloc == 0u) { xcd_barrier_complete(bar, b.x, nloc, nx); b.st[0] = nloc; b.st[1] = nx; }
        const unsigned old = xb_add(&bar[XB_XSUB(b.x)], 1u);
        const unsigned gen = old / nloc;
        if (old + 1u == (gen + 1u) * nloc) {
            __builtin_amdgcn_fence(__ATOMIC_RELEASE, "agent");
            asm volatile("s_waitcnt vmcnt(0)" ::: "memory");
            const unsigned og = xb_add(&bar[XB_TOP], 1u);
            const unsigned tg = og / nx;
            if (og + 1u == (tg + 1u) * nx) xb_add(&bar[XB_TOPGEN], 1u);
            else XB_SPIN(xb_ld(&bar[XB_TOPGEN]) == tg, bar);
            __builtin_amdgcn_fence(__ATOMIC_ACQUIRE, "agent");
            xb_add(&bar[XB_XGEN(b.x)], 1u);
            asm volatile("s_waitcnt vmcnt(0)" ::: "memory");
        } else {
            XB_SPIN(xb_ld(&bar[XB_XGEN(b.x)]) == gen, bar);
            __builtin_amdgcn_fence(__ATOMIC_ACQUIRE, "agent");
            asm volatile("s_waitcnt vmcnt(0)" ::: "memory");
        }
    }
    __syncthreads();
}

constexpr int CW_BAR = 4096;
constexpr size_t CTL_ZERO_BYTES = 65536;
constexpr int MISC_OFF = 151552;
struct Args { const float* in[18]; float* out; unsigned char* ws; int ph_lo, ph_hi; };
constexpr int N_PHASES = 9;
__global__ void __launch_bounds__(NWAVES * 64, 2) hybrid_fwd(Args args) {
    extern __shared__ __attribute__((aligned(16))) unsigned char lds_raw[];
    cg::grid_group grid = cg::this_grid();
    LAS unsigned char* lds = (LAS unsigned char*)lds_raw;
    const int wv = __builtin_amdgcn_readfirstlane((int)(threadIdx.x >> 6));
    const int G = gridDim.x, bx = blockIdx.x; const int vcu = (G % 8 == 0) ? (bx % 8) * (G / 8) + bx / 8 : bx;
    Ptrs P;
    P.x = args.in[0]; P.mem = args.in[1]; P.g_mix = args.in[2]; P.w_in = args.in[3]; P.w_alpha_up = args.in[4]; P.b_alpha = args.in[5]; P.b_forget = args.in[6]; P.g_gla_head = args.in[7];
    P.g_mem = args.in[8]; P.w_mem_kv = args.in[9]; P.w_gla_o = args.in[10]; P.w_fox_o = args.in[11]; P.w_mem_o = args.in[12]; P.w_out = args.in[13]; P.g_ffn = args.in[14]; P.w_ff1 = args.in[15];
    P.w_ff2 = args.in[16]; P.g_final = args.in[17]; P.out = args.out; P.ws = args.ws;
    unsigned char* ws = args.ws;
    const int lo = args.ph_lo, hi = args.ph_hi;
    if (hi > 1000) grid.sync();
    volatile LAS unsigned* MISC = (volatile LAS unsigned*)(lds + MISC_OFF);
    { const int t_ = fresh_tid(wv); if (t_ < 2) MISC[t_] = 0u; }
    __syncthreads();
    const XcdBarrier bar = xcd_barrier_post((unsigned*)ws + CW_BAR, MISC, wv);
#ifndef PH_MASK
#define PH_MASK 0x3ff
#endif
#define IN(k) ((((PH_MASK) >> (k)) & 1) && lo <= (k) && (k) < hi)
#ifdef PROBE_PHASE
#define STAMP(k) do { if (bx == 0 && fresh_tid(wv) == 0) ((unsigned long long*)(ws + 253 * MiB))[(k)] = __builtin_amdgcn_s_memrealtime(); } while (0)
#else
#define STAMP(k) do {} while (0)
#endif
#define SEAM(k) do { if (lo <= (k) && (k) + 1 < hi) xcd_barrier(bar, wv); STAMP((k) + 1); } while (0)

    STAMP(0);
#define STAGGER() do { const int grp_ = (bx >> 3) & 3; for (int i_ = 0; i_ < grp_; ++i_) __builtin_amdgcn_s_sleep(127); } while (0)
    if (IN(0)) { p0_prologue(P, lds, vcu, G, wv); __syncthreads(); }
    SEAM(0);
    if (IN(1)) {
        ProjSched S{(const char*)P.out + OUT_U, (const char*)(ws + WS_MEMN), (const char*)(ws + WS_WIN), G, bx, wv};
        EpiProj E{ws, P.b_forget};
        STAGGER();
        pg8::gemm_phase<EpiProj, ProjSched, true, true>(lds, 1024, 1024, 1024, S, E);
    }
    SEAM(1);
    if (IN(2)) {
        if (bx < 8) fcumsum_unit(P, lds, bx, wv);
        else for (int u = bx - 8; u < 256; u += G - 8) normmax_unit(P, lds, u, wv);
    }
    SEAM(2);
    if (IN(3)) {
        const attn_body::AttnTensors AT{(const attn_body::bf16*)(ws + WS_FQ), (const attn_body::bf16*)(ws + WS_FK), (const attn_body::bf16*)(ws + WS_FV), (attn_body::bf16*)(ws + WS_FQ), (const float*)(ws + WS_F)};
        LAS float* THRU = (LAS float*)(lds + MISC_OFF + 128); volatile LAS unsigned* qslot = (volatile LAS unsigned*)(lds + MISC_OFF + 32);
        { const int i_ = fresh_tid(wv); const int h_ = i_ & 7, qb_ = i_ >> 3;
          const float* QB2 = (const float*)(ws + WS_QB2); const float* NDOT = (const float*)(ws + WS_NDOT); const float k2 = __uint_as_float(((const unsigned*)ws)[8 + h_]);
          float a2 = 0.f, b = -INFINITY;
#pragma unroll
          for (int bb = 0; bb < 4; ++bb) { a2 = fmaxf(a2, QB2[(4 * qb_ + bb) * 8 + h_]); b = fmaxf(b, NDOT[(4 * qb_ + bb) * 8 + h_]); }
          THRU[qb_ * 8 + h_] = -(24.1f + 1.01f * sqrtf(a2 * k2) + b); }
        __syncthreads();
        for (;;) {
            if (fresh_tid(wv) == 0) qslot[0] = __hip_atomic_fetch_add((unsigned*)ws + 64, 1u, __ATOMIC_RELAXED, __HIP_MEMORY_SCOPE_AGENT);
            asm volatile("s_waitcnt vmcnt(0) lgkmcnt(0)\n\ts_barrier" ::: "memory");
            const int idx = __builtin_amdgcn_readfirstlane((int)qslot[0]);
            if (idx >= 1792) break;
            if (idx < 512) { const int h = idx & 7, qb = 63 - (idx >> 3); attn_body::attn_unit<8>(0, h, qb, AT.Q, AT.K, AT.V, AT.O, AT.F + (size_t)h * S_, (const float*)(ws + WS_LSEF) + h * 128, THRU[qb * 8 + h], (char*)lds_raw, wv); }
            else if (idx < 1536) gla_a_unit(P, lds, (idx - 512) >> 2, (idx - 512) & 3, wv);
            else memattn_unit(P, lds, (idx - 1536) & 3, (idx - 1536) >> 2, wv);
        }
    }
    SEAM(3);
    if (IN(3)) { for (int u = bx; u < 256; u += G) gla_scan_unit(P, lds, u, wv); }
    if (lo <= 3 && 4 < hi) xcd_barrier(bar, wv);
    STAMP(40);

    if (IN(4)) { for (int task = bx * NWAVES + wv; task < 2048; task += G * NWAVES) { const int lane_ = fresh_tid(wv) & 63; gla_b_task(P, task, lane_); } }
    SEAM(4);
    if (IN(5)) {
        static_assert(WS_FQ - WS_GG == 16 * MiB && WS_MQ - WS_FQ == 16 * MiB && WS_WFOXO - WS_WGLAO == MiB && WS_WMEMO - WS_WFOXO == MiB, "merge operand spacing");
        MergeSched S{(const char*)(ws + WS_GG), (const char*)(ws + WS_WGLAO), G, bx, wv, 16 * MiB - 1024, MiB - 1024};
        EpiMerge E{(bf16*)(ws + WS_MG), (const bf16*)(ws + WS_GT)};
        pg8::gemm_phase<EpiMerge, MergeSched, true, true, 8>(lds, 1536, 512, 512, S, E);
    }
    SEAM(5);
    if (IN(6)) {
        GemmSched S{(const char*)(ws + WS_MG), (const char*)(ws + WS_WOUT), 64, 4, 1024, 1024, G, bx, wv};
        EpiResid<true, false> E{P.x, (bf16*)(ws + WS_H0), (bf16*)(ws + WS_H1) - (size_t)8192 * 1024, (bf16*)(ws + WS_U2), P.g_ffn, (float*)(ws + WS_SS1)};
        pg8::gemm_phase<EpiResid<true, false>, GemmSched, true, true>(lds, 1024, 1024, 1024, S, E);
    }
    SEAM(6);
    if (IN(7)) {
        GemmSched S{(const char*)(ws + WS_U2), (const char*)(ws + WS_WFF1), 64, 16, 1024, 1024, G, bx, wv};
        EpiFfn1 E{(bf16*)(ws + WS_HID), (const float*)(ws + WS_SS1)};
        STAGGER();
        pg8::gemm_phase<EpiFfn1, GemmSched, true, true>(lds, 1024, 1024, 1024, S, E);
    }
    SEAM(7);
    if (IN(8)) {
        GemmSched S{(const char*)(ws + WS_HID), (const char*)(ws + WS_WFF2), 64, 4, 4096, 4096, G, bx, wv};
        EpiFinal E{(const bf16*)(ws + WS_H0), (const bf16*)(ws + WS_H1) - (size_t)8192 * 1024, P.out, P.g_final, (float*)(ws + WS_SS2), (unsigned*)ws + CW_PANEL};
        pg8::gemm_phase<EpiFinal, GemmSched, false, true>(lds, 4096, 4096, 4096, S, E);
    }
    STAMP(9);
#ifdef PROBE_PHASE
    __syncthreads(); xcd_barrier(bar, wv); STAMP(10);
    if (PROBE_PHASE == 200) { xcd_barrier(bar, wv); xcd_barrier(bar, wv); xcd_barrier(bar, wv); xcd_barrier(bar, wv); STAMP(11); }
    if (bx == 0) { __syncthreads(); const unsigned long long* ts = (const unsigned long long*)(ws + 253 * MiB);
        long K = (PROBE_PHASE < 0) ? 100000 : (PROBE_PHASE == 200) ? (long)(ts[11] - ts[10]) * 10 : (PROBE_PHASE == 777) ? (long)((ts[61] - ts[60]) / 5 + 540 * ((ts[62] - ts[61]) / 5)) : (PROBE_PHASE == 778) ? (long)((ts[63] - ts[62]) / 5 + 540 * ((ts[64] - ts[63]) / 5)) : (PROBE_PHASE >= 1000) ? (long)(ts[PROBE_PHASE % 1000] - ts[PROBE_PHASE / 1000]) : (PROBE_PHASE >= 100 ? (long)(ts[10] - ts[0]) / 10 : (long)(ts[PROBE_PHASE + 1] - ts[PROBE_PHASE]));
        if (K > 300000) K = 300000;
        for (long i = fresh_tid(wv); i < K; i += 512) P.out[i] += 0.1f; }
#endif
#undef IN
#undef SEAM
}

extern "C" void kernel_launch(void* const* d_in, const int* in_sizes, int n_in, void* d_out, int out_size, void* d_ws, size_t ws_size, hipStream_t stream) {
    static int grid = 0;
    if (grid == 0) {
        if (n_in != 18 || out_size != S_ * DM_ || ws_size < WS_END) { fprintf(stderr, "kernel_launch: unexpected shapes (n_in %d out %d ws %zu)\n", n_in, out_size, ws_size); grid = -1; return; }
        int dev = 0, cus = 0, per_cu = 0;
        (void)hipGetDevice(&dev); (void)hipDeviceGetAttribute(&cus, hipDeviceAttributeMultiprocessorCount, dev);
        (void)hipFuncSetAttribute((const void*)hybrid_fwd, hipFuncAttributeMaxDynamicSharedMemorySize, LDS_BYTES);
        (void)hipOccupancyMaxActiveBlocksPerMultiprocessor(&per_cu, (const void*)hybrid_fwd, NWAVES * 64, LDS_BYTES);
        (void)hipGetLastError();
        grid = 256;
        if (cus != 256 || per_cu < 1) fprintf(stderr, "kernel_launch: note: cus %d per_cu %d (built for 256 CUs, one workgroup each)\n", cus, per_cu);
    }
    if (grid < 0) return;
    (void)hipMemsetAsync(d_ws, 0, CTL_ZERO_BYTES, stream);
    Args a{};
    for (int i = 0; i < 18; ++i) a.in[i] = (const float*)d_in[i];
    a.out = (float*)d_out; a.ws = (unsigned char*)d_ws;
#ifndef MK_PER_PHASE
    a.ph_lo = 0; a.ph_hi = N_PHASES;
    { void* kargs[] = {&a}; hipError_t e = hipLaunchCooperativeKernel((const void*)hybrid_fwd, dim3(grid), dim3(NWAVES * 64), kargs, LDS_BYTES, stream);
      if (e != hipSuccess) fprintf(stderr, "cooperative launch failed: %s\n", hipGetErrorString(e)); }
#else
    for (int k = 0; k < N_PHASES; ++k) { a.ph_lo = k; a.ph_hi = k + 1; void* kargs[] = {&a};
        hipError_t e = hipLaunchCooperativeKernel((const void*)hybrid_fwd, dim3(grid), dim3(NWAVES * 64), kargs, LDS_BYTES, stream);
        if (e != hipSuccess) { fprintf(stderr, "cooperative launch %d failed: %s\n", k, hipGetErrorString(e)); break; } }
#endif
}
```

```cpp
#include <hip/hip_runtime.h>
#include <hip/hip_cooperative_groups.h>
#include <hip/hip_bf16.h>
#include <cstdio>
#include <cstdint>
#include <cmath>
namespace cg = cooperative_groups;
__device__ __forceinline__ int fresh_tid(int wv) { int lane_; asm volatile("v_mbcnt_lo_u32_b32 %0, -1, 0\n\tv_mbcnt_hi_u32_b32 %0, -1, %0" : "=v"(lane_)); return wv * 64 + lane_; }
namespace pg8 {
#define PG8_LAS __attribute__((address_space(3)))
typedef unsigned short bf16_t;
typedef short bf16x8 __attribute__((ext_vector_type(8)));
typedef float f32x4 __attribute__((ext_vector_type(4)));
typedef unsigned u32x4 __attribute__((ext_vector_type(4)));
constexpr int BM = 256, BK = 64, HALF = 128, HTB = HALF * BK * 2  , STAGE_BYTES = 8 * HTB, NXCD = 8, WGM = 8;

__host__ __device__ __forceinline__ int lds_byte(int r, int c) { const int st = (r >> 4) * 2 + (c >> 5), rr = r & 15, cc = c & 31, ob = rr * 64 + cc * 2; return st * 1024 + (ob ^ (((ob >> 9) & 1) << 5)); }
__host__ __device__ __forceinline__ void stage_rc(int b, int& R, int& C) { const int st = b / 1024, sb = b % 1024, swz = sb ^ (((sb >> 9) & 1) << 5); R = (st >> 1) * 16 + swz / 64; C = (st & 1) * 32 + (swz % 64) / 2; }
__host__ __device__ __forceinline__ int perm32(int rho) { const int n = rho >> 4, i = rho & 15; return 8 * (i >> 2) + 4 * n + (i & 3); }

struct Unit { int pm, pn, z; };
__device__ __forceinline__ unsigned cvt_pk_bf16(float lo, float hi) { unsigned r; asm volatile("v_cvt_pk_bf16_f32 %0, %1, %2" : "=v"(r) : "v"(lo), "v"(hi)); return r; }
__device__ __forceinline__ void map_tile(int L, int nM, int nN, int& pm, int& pn) {
    const int nwg = nM * nN; int wgid = L; { const int q = nwg / NXCD, r = nwg % NXCD, xcd = wgid % NXCD, off = wgid / NXCD; wgid = (xcd < r ? xcd * (q + 1) : r * (q + 1) + (xcd - r) * q) + off; }
    const int nig = WGM * nN, gid = wgid / nig, fm = gid * WGM, gsz = (nM - fm) < WGM ? (nM - fm) : WGM;
    pm = fm + ((wgid % nig) % gsz); pn = (wgid % nig) / gsz;
}
template <class Epi, class Sched, bool ALIGN_EPI = false, bool SP2 = false, int SEGT = 0>
__device__ __forceinline__ void gemm_phase(PG8_LAS unsigned char* lds, const int K, const int lda, const int ldb, const Sched& S, const Epi& E) {
    const int tid = fresh_tid(S.wv), wid = S.wv, lane = tid & 63, wr = wid >> 2, wc = wid & 3, fr = lane & 15, fq = lane >> 4;
    const int nt = K / BK;
    unsigned voffA[2], voffB[2];
#pragma unroll
    for (int i = 0; i < 2; ++i) { int R, C; stage_rc(tid * 16 + i * 8192, R, C); const int Rb = Epi::PERM ? ((R & ~31) + perm32(R & 31)) : R;
        voffA[i] = (unsigned)(R * lda + C) * 2u; voffB[i] = (unsigned)(Rb * ldb + C) * 2u; }
    const size_t kstep = (size_t)(BK * 2);
    const size_t hstepA = (size_t)HALF * lda * 2, hstepB = (size_t)HALF * ldb * 2;
    const unsigned ldsw = (unsigned)wid * 1024u;
    const int aoff = lds_byte(wr * 64 + fr, fq * 8), boff = lds_byte(wc * 32 + fr, fq * 8);
#define PG8_SA(b, h) (((b) * 2 + (h)) * HTB)
#define PG8_SB(b, h) ((4 + (b) * 2 + (h)) * HTB)
#define PG8_STAGE(bufoff, gbase, voff) do { _Pragma("unroll") for (int _i = 0; _i < 2; ++_i) \
        __builtin_amdgcn_global_load_lds((const unsigned*)((const char*)(gbase) + (voff)[_i]), (PG8_LAS unsigned*)(lds + (bufoff) + ldsw + _i * 8192), 16, 0, 0); } while (0)
#define PG8_LDA(dst, b, h) do { _Pragma("unroll") for (int m = 0; m < 4; ++m) _Pragma("unroll") for (int k = 0; k < 2; ++k) dst[m][k] = *(const PG8_LAS bf16x8*)(lds + PG8_SA(b, h) + aoff + m * 2048 + k * 1024); } while (0)
#define PG8_LDB(dst, b, h) do { _Pragma("unroll") for (int n = 0; n < 2; ++n) _Pragma("unroll") for (int k = 0; k < 2; ++k) dst[n][k] = *(const PG8_LAS bf16x8*)(lds + PG8_SB(b, h) + boff + n * 2048 + k * 1024); } while (0)
#define PG8_MMA(ai, bj, At, Bt) do { __builtin_amdgcn_s_setprio(1); _Pragma("unroll") for (int m = 0; m < 4; ++m) _Pragma("unroll") for (int n = 0; n < 2; ++n) _Pragma("unroll") for (int k = 0; k < 2; ++k) \
        acc[ai][bj][m][n] = __builtin_amdgcn_mfma_f32_16x16x32_bf16(Bt[n][k], At[m][k], acc[ai][bj][m][n], 0, 0, 0); __builtin_amdgcn_s_setprio(0); } while (0)
#define PG8_WAIT_V(n) asm volatile("s_waitcnt vmcnt(" #n ")" ::: "memory")
#define PG8_WAIT_L(n) asm volatile("s_waitcnt lgkmcnt(" #n ")" ::: "memory")
#define PG8_BAR __builtin_amdgcn_s_barrier()
#define PG8_SCHED __builtin_amdgcn_sched_barrier(0)
    Unit cur, nxt; int ui = 0;
    if (!S.next(0, cur)) return;
    f32x4 acc[2][2][4][2];
#pragma unroll
    for (int a = 0; a < 2; ++a)
#pragma unroll
        for (int b = 0; b < 2; ++b)
#pragma unroll
            for (int m = 0; m < 4; ++m)
#pragma unroll
                for (int n = 0; n < 2; ++n) acc[a][b][m][n] = (f32x4){0.f, 0.f, 0.f, 0.f};
    bf16x8 At[4][2], B0[2][2], B1[2][2];
    const char* cA = S.aptr(cur); const char* cB = S.bptr(cur);
    S.a_ready(cur);
    if constexpr (SP2) {
        PG8_STAGE(PG8_SB(0, 0), cB, voffB); PG8_STAGE(PG8_SB(0, 1), cB + hstepB, voffB); PG8_STAGE(PG8_SA(0, 0), cA, voffA); PG8_STAGE(PG8_SA(0, 1), cA + hstepA, voffA);
        if (wr == 1) PG8_BAR;
        PG8_WAIT_V(2); PG8_BAR;
        PG8_STAGE(PG8_SB(1, 0), cB + kstep, voffB); PG8_STAGE(PG8_SA(1, 0), cA + kstep, voffA); PG8_STAGE(PG8_SB(1, 1), cB + hstepB + kstep, voffB);
        PG8_WAIT_V(6); PG8_BAR;
    } else {
        PG8_STAGE(PG8_SB(0, 0), cB, voffB); PG8_STAGE(PG8_SA(0, 0), cA, voffA); PG8_STAGE(PG8_SB(0, 1), cB + hstepB, voffB); PG8_STAGE(PG8_SA(0, 1), cA + hstepA, voffA);
        if (wr == 1) PG8_BAR;
        PG8_WAIT_V(4); PG8_BAR;
        PG8_STAGE(PG8_SB(1, 0), cB + kstep, voffB); PG8_STAGE(PG8_SA(1, 0), cA + kstep, voffA); PG8_STAGE(PG8_SB(1, 1), cB + hstepB + kstep, voffB);
        PG8_WAIT_V(6); PG8_BAR;
    }
    for (;;) {
        const bool has_next = S.next(ui + 1, nxt);
        const char* nA = has_next ? S.aptr(nxt) : cA; const char* nB = has_next ? S.bptr(nxt) : cB;
        for (int t = 0; t < nt; t += 2) {
            const bool last = (t == nt - 2);
            size_t sa1 = 0, sa2 = 0, sb2 = 0;
            if constexpr (SEGT > 0) { if (t > 0 && (t % SEGT) == 0) E.mid(acc, cur, t / SEGT, wr, wc, fr, fq);
                sa1 = (size_t)(t / SEGT) * S.segA; sa2 = (size_t)((t + 2) / SEGT) * S.segA; sb2 = (size_t)((t + 2) / SEGT) * S.segB; }
            const char* a1 = cA + (size_t)(t + 1) * kstep + sa1;
            const char* a2 = last ? nA : cA + (size_t)(t + 2) * kstep + sa2; const char* b2 = last ? nB : cB + (size_t)(t + 2) * kstep + sb2;
            const char* a3 = a2 + kstep; const char* b3 = b2 + kstep;
            if (last && has_next) S.a_ready(nxt);
            if constexpr (SP2) {
            PG8_LDB(B0, 0, 0); PG8_LDB(B1, 0, 1); PG8_SCHED; PG8_LDA(At, 0, 0); PG8_STAGE(PG8_SA(1, 1), a1 + hstepA, voffA);
            PG8_WAIT_V(8); PG8_WAIT_L(0); PG8_BAR; PG8_MMA(0, 0, At, B0); PG8_MMA(0, 1, At, B1); PG8_BAR; PG8_SCHED;
            PG8_LDA(At, 0, 1); PG8_STAGE(PG8_SB(0, 0), b2, voffB); PG8_STAGE(PG8_SB(0, 1), b2 + hstepB, voffB); PG8_STAGE(PG8_SA(0, 0), a2, voffA);
            PG8_WAIT_V(8); PG8_WAIT_L(0); PG8_BAR; PG8_MMA(1, 0, At, B0); PG8_MMA(1, 1, At, B1); PG8_BAR; PG8_SCHED;
            PG8_LDB(B0, 1, 0); PG8_LDB(B1, 1, 1); PG8_SCHED; PG8_LDA(At, 1, 0); PG8_STAGE(PG8_SA(0, 1), a2 + hstepA, voffA);
            PG8_WAIT_V(8); PG8_WAIT_L(0); PG8_BAR; PG8_MMA(0, 0, At, B0); PG8_MMA(0, 1, At, B1); PG8_BAR; PG8_SCHED;
            PG8_LDA(At, 1, 1); PG8_STAGE(PG8_SB(1, 0), b3, voffB); PG8_STAGE(PG8_SB(1, 1), b3 + hstepB, voffB); PG8_STAGE(PG8_SA(1, 0), a3, voffA);
            PG8_WAIT_V(8); PG8_WAIT_L(0); PG8_BAR; PG8_MMA(1, 0, At, B0); PG8_MMA(1, 1, At, B1); PG8_BAR; PG8_SCHED;
            } else {
            PG8_LDB(B0, 0, 0); PG8_SCHED; PG8_LDA(At, 0, 0); PG8_STAGE(PG8_SA(1, 1), a1 + hstepA, voffA);
            PG8_WAIT_L(8); PG8_BAR; PG8_WAIT_L(0); PG8_MMA(0, 0, At, B0); PG8_BAR; PG8_SCHED;
            PG8_LDB(B1, 0, 1); PG8_STAGE(PG8_SB(0, 0), b2, voffB);
            PG8_BAR; PG8_WAIT_L(0); PG8_MMA(0, 1, At, B1); PG8_BAR;
            PG8_LDA(At, 0, 1); PG8_STAGE(PG8_SA(0, 0), a2, voffA);
            PG8_BAR; PG8_WAIT_L(0); PG8_MMA(1, 0, At, B0); PG8_BAR; PG8_SCHED;
            PG8_STAGE(PG8_SB(0, 1), b2 + hstepB, voffB);
            PG8_WAIT_V(6); PG8_BAR; PG8_MMA(1, 1, At, B1); PG8_BAR;
            PG8_LDB(B0, 1, 0); PG8_SCHED; PG8_LDA(At, 1, 0); PG8_STAGE(PG8_SA(0, 1), a2 + hstepA, voffA);
            PG8_WAIT_L(8); PG8_BAR; PG8_WAIT_L(0); PG8_MMA(0, 0, At, B0); PG8_BAR; PG8_SCHED;
            PG8_LDB(B1, 1, 1); PG8_STAGE(PG8_SB(1, 0), b3, voffB);
            PG8_BAR; PG8_WAIT_L(0); PG8_MMA(0, 1, At, B1); PG8_BAR;
            PG8_LDA(At, 1, 1); PG8_STAGE(PG8_SA(1, 0), a3, voffA);
            PG8_BAR; PG8_WAIT_L(0); PG8_MMA(1, 0, At, B0); PG8_BAR; PG8_SCHED;
            PG8_STAGE(PG8_SB(1, 1), b3 + hstepB, voffB);
            PG8_WAIT_V(6); PG8_BAR; PG8_MMA(1, 1, At, B1); PG8_BAR;
            }
        }
        if constexpr (ALIGN_EPI) { if (wr == 0) PG8_BAR; }
        if constexpr (!Epi::AFTER_DRAIN) { E(acc, cur, wr, wc, fr, fq); S.done(cur); }
        if (!has_next) break;
#pragma unroll
        for (int a = 0; a < 2; ++a)
#pragma unroll
            for (int b = 0; b < 2; ++b)
#pragma unroll
                for (int m = 0; m < 4; ++m)
#pragma unroll
                    for (int n = 0; n < 2; ++n) acc[a][b][m][n] = (f32x4){0.f, 0.f, 0.f, 0.f};
        cur = nxt; cA = nA; cB = nB; ++ui;
        if constexpr (ALIGN_EPI) { if (wr == 1) PG8_BAR; }
    }
    PG8_WAIT_V(0);
    if constexpr (!ALIGN_EPI) { if (wr == 0) PG8_BAR; }
    PG8_BAR;
    if constexpr (Epi::AFTER_DRAIN) { E.fused(acc, cur, wr, wc, fr, fq, lds, wid, lane); S.done(cur); }
#undef PG8_SA
#undef PG8_SB
#undef PG8_STAGE
#undef PG8_LDA
#undef PG8_LDB
#undef PG8_MMA
#undef PG8_WAIT_V
#undef PG8_WAIT_L
#undef PG8_BAR
#undef PG8_SCHED
}
}
#include <hip/hip_bf16.h>
namespace attn_body {
using bf16=__hip_bfloat16;
using bf16x8=__attribute__((ext_vector_type(8)))short;
using s16x4=__attribute__((ext_vector_type(4)))short;
using f32x16=__attribute__((ext_vector_type(16)))float;
using u32x4=__attribute__((ext_vector_type(4)))unsigned;
constexpr int BATCH=1,NHEAD=8,SEQ=16384,D=64,DM=NHEAD*D;
constexpr int NW=8,QBLK=32,QB=QBLK*NW,KVBLK=64,NQB=SEQ/QB;
constexpr int ATTN_PITCH=DM, ATTN_UNIT_ROWS=QB;
__device__ __forceinline__ int crow(int r,int hi){return (r&3)+8*(r>>2)+4*hi;}
#define SBAR() __builtin_amdgcn_sched_barrier(0)
__device__ __forceinline__ void cmask(f32x16&p0,f32x16&p1,int jb,int qrel,int hi){
  const float NEG=-INFINITY; int kb=64*jb+4*hi;
  #pragma unroll
  for(int r=0;r<16;++r){int kv=kb+(r&3)+8*(r>>2); if(kv>qrel)p0[r]=NEG; if(kv+32>qrel)p1[r]=NEG;}
}

constexpr int NSLOT=3, SLOTB=8192;
constexpr int LDS_K=0, LDS_V=NSLOT*SLOTB, LDS_WS=2*NSLOT*SLOTB, LDS_OST=LDS_WS+NW*64*4, LDS_BIAS=LDS_OST+NW*4096, LDS_BYTES=LDS_BIAS+SEQ*4+512;
constexpr float C2=0.125f*1.4426950408889634f;
__device__ __forceinline__ void glds16(const void*gsrc,unsigned lds_dst){unsigned keep;
  asm volatile("s_mov_b32 %0, m0\n\ts_mov_b32 m0, %2\n\ts_nop 0\n\tglobal_load_lds_dwordx4 %1, off\n\ts_mov_b32 m0, %0":"=&s"(keep):"v"(gsrc),"s"(lds_dst):"memory");}
__device__ __forceinline__ float max3f(float a,float b,float c){float r;asm("v_max3_f32 %0, %1, %2, %3":"=v"(r):"v"(a),"v"(b),"v"(c));return r;}
__device__ __forceinline__ float max2f(float a,float b){float r;asm("v_max_f32_e32 %0, %1, %2":"=v"(r):"v"(a),"v"(b));return r;}
__device__ __forceinline__ float fadd_s(float a,float b){float r;asm("v_add_f32_e32 %0, %1, %2":"=v"(r):"v"(a),"v"(b));return r;}
__device__ __forceinline__ float fsub_s(float a,float b){float r;asm("v_sub_f32_e32 %0, %1, %2":"=v"(r):"v"(a),"v"(b));return r;}
typedef float f32x2_t __attribute__((ext_vector_type(2))); typedef __bf16 bf16x2_t __attribute__((ext_vector_type(2)));
__device__ __forceinline__ unsigned cvtpk_s(float lo,float hi){f32x2_t v={lo,hi};bf16x2_t b=__builtin_convertvector(v,bf16x2_t);return __builtin_bit_cast(unsigned,b);}
#define WAIT_BAR(N) asm volatile("s_waitcnt vmcnt(" #N ") lgkmcnt(0)\n\ts_barrier":::"memory")

__device__ __forceinline__ void qkt(f32x16&p0,f32x16&p1,const char*Kslot,const bf16x8*qr,int r32,int hi){
  const char*kb=Kslot+hi*1024+r32*16;
  #pragma unroll
  for(int d0=0;d0<4;++d0){
    const bf16x8 b0=*reinterpret_cast<const bf16x8*>(kb+d0*2048);
    const bf16x8 b1=*reinterpret_cast<const bf16x8*>(kb+d0*2048+512);
    p0=__builtin_amdgcn_mfma_f32_32x32x16_bf16(b0,qr[d0],p0,0,0,0);p1=__builtin_amdgcn_mfma_f32_32x32x16_bf16(b1,qr[d0],p1,0,0,0);}
}
typedef __attribute__((address_space(3))) const char* lds_cptr;
typedef short v4i16_t __attribute__((ext_vector_type(4)));
__device__ __forceinline__ void kload8(bf16x8*kf,lds_cptr kp){
  kf[0]=*(const __attribute__((address_space(3))) bf16x8*)(kp);      kf[1]=*(const __attribute__((address_space(3))) bf16x8*)(kp+512);
  kf[2]=*(const __attribute__((address_space(3))) bf16x8*)(kp+2048); kf[3]=*(const __attribute__((address_space(3))) bf16x8*)(kp+2560);
  kf[4]=*(const __attribute__((address_space(3))) bf16x8*)(kp+4096); kf[5]=*(const __attribute__((address_space(3))) bf16x8*)(kp+4608);
  kf[6]=*(const __attribute__((address_space(3))) bf16x8*)(kp+6144); kf[7]=*(const __attribute__((address_space(3))) bf16x8*)(kp+6656);
}
__device__ __forceinline__ void kload2(bf16x8*kf,lds_cptr kp,int j){ kf[2*j]=*(const __attribute__((address_space(3))) bf16x8*)(kp+j*2048); kf[2*j+1]=*(const __attribute__((address_space(3))) bf16x8*)(kp+j*2048+512); }
__device__ __forceinline__ s16x4 vtr(lds_cptr p){ return __builtin_bit_cast(s16x4,__builtin_amdgcn_ds_read_tr16_b64_v4i16((__attribute__((address_space(3))) v4i16_t*)p)); }
__device__ __forceinline__ float rowmax(const f32x16&p0,const f32x16&p1){
  float a=max3f(p0[0],p0[1],p1[0]),b=max3f(p0[2],p0[3],p1[1]);a=max3f(a,p1[2],p1[3]);
  #pragma unroll
  for(int r=4;r<16;r+=4){a=max3f(a,p0[r],p0[r+1]);b=max3f(b,p0[r+2],p0[r+3]);a=max3f(a,p1[r],p1[r+1]);b=max3f(b,p1[r+2],p1[r+3]);}
  const float m=max2f(a,b);
  auto rr=__builtin_amdgcn_permlane32_swap(__float_as_uint(m),__float_as_uint(m),false,false);
  return max2f(__uint_as_float(rr[0]),__uint_as_float(rr[1]));
}
__device__ __forceinline__ void pv(f32x16*o,int vb,bf16x8 pa0,bf16x8 pa1,bf16x8 pa2,bf16x8 pa3){
  #pragma unroll
  for(int d0=0;d0<2;++d0){s16x4 lo[4],hi[4];
    #pragma unroll
    for(int ks=0;ks<4;++ks){
      asm volatile("ds_read_b64_tr_b16 %0,%1 offset:%c2":"=&v"(lo[ks]):"v"(vb),"i"(d0*4096+ks*1024):"memory");
      asm volatile("ds_read_b64_tr_b16 %0,%1 offset:%c2":"=&v"(hi[ks]):"v"(vb),"i"(d0*4096+ks*1024+512):"memory");}
    asm volatile("s_waitcnt lgkmcnt(0)":::"memory");SBAR();
    #define PK(k) (bf16x8){lo[k][0],lo[k][1],lo[k][2],lo[k][3],hi[k][0],hi[k][1],hi[k][2],hi[k][3]}
    o[d0]=__builtin_amdgcn_mfma_f32_32x32x16_bf16(pa0,PK(0),o[d0],0,0,0);
    o[d0]=__builtin_amdgcn_mfma_f32_32x32x16_bf16(pa1,PK(1),o[d0],0,0,0);
    o[d0]=__builtin_amdgcn_mfma_f32_32x32x16_bf16(pa2,PK(2),o[d0],0,0,0);
    o[d0]=__builtin_amdgcn_mfma_f32_32x32x16_bf16(pa3,PK(3),o[d0],0,0,0);
    #undef PK
  }
}

#ifndef ATTN_STORE16
#define ATTN_STORE16(p,v) (*(u32x4*)(p)=(v))
#endif
typedef float f32x4_t __attribute__((ext_vector_type(4)));
template<int THRL> __device__ __forceinline__ void attn_unit(int b,int h,int qb,const bf16*Q,const bf16*__restrict__ K,const bf16*__restrict__ V,bf16*O,const float*__restrict__ Fh,const float*__restrict__ Lh,float thrb,char*shm,int wv){
  const int tid=fresh_tid(wv),lane=tid&63,r32=lane&31,hi=lane>>5; const int wid=wv;
  const long rowbase=(long)b*SEQ; const int q0=qb*QB;
  const bf16*Qw=Q+(rowbase+q0+wid*QBLK)*DM+h*D;
  const lds_cptr shm3=(lds_cptr)shm;
  const float fref=Fh[q0];
  int T0; { __attribute__((address_space(3))) float* pb=(__attribute__((address_space(3))) float*)(shm3+LDS_WS);
    if(tid<2*qb) pb[tid]=Lh[tid]+fref*1.4426950408889634f;
    asm volatile("s_waitcnt lgkmcnt(0)\n\ts_barrier":::"memory");
    int lo_=0,hi_=2*qb; while(lo_<hi_){ const int mid=(lo_+hi_)>>1; if(!(pb[mid]<=thrb)) hi_=mid; else lo_=mid+1; } T0=__builtin_amdgcn_readfirstlane(2*lo_); }
  { __attribute__((address_space(3))) float* bl=(__attribute__((address_space(3))) float*)(shm3+LDS_BIAS);
    #pragma unroll 4
    for(int s=64*T0+tid;s<q0+QB;s+=NW*64) bl[s]=(fref-Fh[s])*1.4426950408889634f; }
  const bf16*Kh=K+(rowbase+(long)T0*KVBLK)*DM+h*D,*Vh=V+(rowbase+(long)T0*KVBLK)*DM+h*D;
  const unsigned lds0=(unsigned)(uintptr_t)shm;
  float*wsf=(float*)(shm+LDS_WS)+wid*64;
  const bf16*ksrc=Kh+(long)lane*DM+wid*8;
  const bf16*vsrc=Vh+(long)(16*(wid&3)+(lane>>2))*DM+(wid>>2)*32+(lane&3)*8;
  const unsigned kdst=lds0+LDS_K+wid*1024, vdst=lds0+LDS_V+wid*1024;
  #define DMA_K(t,slot) glds16(ksrc+(long)(t)*KVBLK*DM,(unsigned)__builtin_amdgcn_readfirstlane(kdst+(slot)))
  #define DMA_V(t,slot) glds16(vsrc+(long)(t)*KVBLK*DM,(unsigned)__builtin_amdgcn_readfirstlane(vdst+(slot)))
  const int vb0=(int)(lds0+LDS_V)+((lane>>4)&1)*32+(lane&3)*8+(4*hi+((lane&15)>>2))*64;
  const char*Kbase=shm+LDS_K; bf16x8 kf[8];
  const lds_cptr kp0=shm3+LDS_K+hi*1024+r32*16; const lds_cptr vp0=shm3+LDS_V+((lane>>4)&1)*32+(lane&3)*8+(4*hi+((lane&15)>>2))*64;
  const int NT=(q0+QB)/KVBLK-T0;
  #define BLOAD(X0,X1,tt) do{ const __attribute__((address_space(3))) f32x4_t* bp_=(const __attribute__((address_space(3))) f32x4_t*)(shm3+LDS_BIAS+(((tt)+T0)*64+4*hi)*4); \
    _Pragma("unroll") for(int g_=0;g_<4;++g_){ const f32x4_t a_=bp_[2*g_], b_=bp_[8+2*g_]; \
      X0[4*g_]=a_[0];X0[4*g_+1]=a_[1];X0[4*g_+2]=a_[2];X0[4*g_+3]=a_[3]; X1[4*g_]=b_[0];X1[4*g_+1]=b_[1];X1[4*g_+2]=b_[2];X1[4*g_+3]=b_[3]; } }while(0)
  DMA_K(0,0);DMA_V(0,0);DMA_K(1,SLOTB);
  bf16x8 qr[4];
  #pragma unroll
  for(int d0=0;d0<4;++d0)qr[d0]=*reinterpret_cast<const bf16x8*>(&Qw[(long)r32*DM+d0*16+hi*8]);
  float mhat=0.f,l_reg=0.f;f32x16 o[2];o[0]=f32x16{};o[1]=f32x16{};
  const int qrel=wid*QBLK+r32;
  #define CMASK(P0,P1,t) do{int jb_=(t)-(NT-4); if(jb_>=0)cmask(P0,P1,jb_,qrel,hi);}while(0)
  bool resc=false;
    \
  #define START(P0,P1) do{ const float rm=rowmax(P0,P1); resc=false; \
    { const float dl=__builtin_fmaxf(rm,((const __attribute__((address_space(3))) float*)(shm3+LDS_BIAS))[q0+qrel]+10.f); mhat=fadd_s(mhat,dl); \
      _Pragma("unroll") for(int r=0;r<16;++r){P0[r]=fsub_s(P0[r],dl);P1[r]=fsub_s(P1[r],dl);} \
 } \
    _Pragma("unroll") for(int r=0;r<16;++r)P0[r]=__builtin_amdgcn_exp2f(P0[r]); }while(0)
  #define RESC() do{ if(resc){ asm volatile("s_waitcnt lgkmcnt(0)":::"memory"); \
      _Pragma("unroll") for(int d_=0;d_<2;++d_) _Pragma("unroll") for(int r=0;r<16;++r)o[d_][r]*=wsf[crow(r,hi)]; } }while(0)
  f32x16 pA0,pA1,pB0,pB1;
  int sl_prev=0,sl_cur=0,sl_next=SLOTB;
  #define ROT() do{sl_prev=sl_cur;sl_cur=sl_next;sl_next=(sl_next==(NSLOT-1)*SLOTB)?0:sl_next+SLOTB;}while(0)
  DMA_K(2,2*SLOTB);
  WAIT_BAR(3);
  BLOAD(pA0,pA1,0); BLOAD(pB0,pB1,1);
  qkt(pA0,pA1,Kbase,qr,r32,hi);asm volatile("s_nop 15\n\ts_nop 7":"+v"(pA0),"+v"(pA1));CMASK(pA0,pA1,0);
  START(pA0,pA1);
  _Pragma("unroll") for(int r=0;r<16;++r)pA1[r]=__builtin_amdgcn_exp2f(pA1[r]);
  WAIT_BAR(0);
  DMA_K(3,0);DMA_V(1,SLOTB);
  ROT();
  kload8(kf,kp0+sl_cur);
  WAIT_BAR(2);
  s16x4 vlo[8],vhi[8]; u32x4 pw0,pw1,pw2,pw3;
  #define PKW(P,B) cvtpk_s(P[B],P[B+1])
  #define PAF(k) __builtin_bit_cast(bf16x8,pw##k)
  #define VFR(i) (bf16x8){vlo[i][0],vlo[i][1],vlo[i][2],vlo[i][3],vhi[i][0],vhi[i][1],vhi[i][2],vhi[i][3]}
  #define PIN(x) asm volatile("":"+v"(x))
  #define MX3(a,b,c) __builtin_fmaxf(__builtin_fmaxf((a),(b)),(c))
  #define GAPA(MF,A0,A1,A2,A3,W0,W1,PW) do{ MF; sacc+=A0; sacc+=A1; sacc+=A2; sacc+=A3; PIN(sacc); W0; W1; PIN(PW); SBAR(); }while(0)
  #define EX(v) __builtin_amdgcn_exp2f(v)
  #define GAPB(MF,X,B) do{ MF; X[B]=EX(X[B]); X[B+1]=EX(X[B+1]); X[B+2]=EX(X[B+2]); X[B+3]=EX(X[B+3]); PIN(X); SBAR(); }while(0)
  #define VRD(i) do{ vlo[i]=vtr(vp_+(((i)>>2)*4096+((i)&3)*1024)); vhi[i]=vtr(vp_+(((i)>>2)*4096+((i)&3)*1024+512)); }while(0)
  #define KRD(G,j) do{ if(G){ kload2(kf,kp0+sl_next,j); SBAR(); } }while(0)
  #define STEP(C0,C1,P0,P1,t,GK,GV,GL) do{ SBAR(); \
    _Pragma("unroll") for(int r=0;r<16;++r){C0[r]-=mhat;C1[r]-=mhat;} \
    const lds_cptr vp_=vp0+sl_prev; \
    VRD(0); SBAR(); float sacc=(P0[0]+P0[1]); \
    GAPA(C0=__builtin_amdgcn_mfma_f32_32x32x16_bf16(kf[0],qr[0],C0,0,0,0), P0[2],P0[3],P0[4],P0[5],     pw0[0]=PKW(P0,0), pw0[1]=PKW(P0,2), pw0); \
    VRD(4); SBAR(); GAPA(C1=__builtin_amdgcn_mfma_f32_32x32x16_bf16(kf[1],qr[0],C1,0,0,0), P0[6],P0[7],P0[8],P0[9],     pw0[2]=PKW(P0,4), pw0[3]=PKW(P0,6), pw0); \
    VRD(1); SBAR(); GAPA(C0=__builtin_amdgcn_mfma_f32_32x32x16_bf16(kf[2],qr[1],C0,0,0,0),   P0[10],P0[11],P0[12],P0[13], pw1[0]=PKW(P0,8), pw1[1]=PKW(P0,10), pw1); \
    VRD(5); SBAR(); GAPA(C1=__builtin_amdgcn_mfma_f32_32x32x16_bf16(kf[3],qr[1],C1,0,0,0),   P0[14],P0[15],P1[0],P1[1],   pw1[2]=PKW(P0,12),pw1[3]=PKW(P0,14), pw1); \
    VRD(2); SBAR(); GAPA(C0=__builtin_amdgcn_mfma_f32_32x32x16_bf16(kf[4],qr[2],C0,0,0,0),   P1[2],P1[3],P1[4],P1[5],     pw2[0]=PKW(P1,0), pw2[1]=PKW(P1,2), pw2); \
    VRD(6); SBAR(); GAPA(C1=__builtin_amdgcn_mfma_f32_32x32x16_bf16(kf[5],qr[2],C1,0,0,0),   P1[6],P1[7],P1[8],P1[9],     pw2[2]=PKW(P1,4), pw2[3]=PKW(P1,6), pw2); \
    VRD(3); SBAR(); GAPA(C0=__builtin_amdgcn_mfma_f32_32x32x16_bf16(kf[6],qr[3],C0,0,0,0),   P1[10],P1[11],P1[12],P1[13], pw3[0]=PKW(P1,8), pw3[1]=PKW(P1,10), pw3); \
    VRD(7); SBAR(); GAPA(C1=__builtin_amdgcn_mfma_f32_32x32x16_bf16(kf[7],qr[3],C1,0,0,0),   P1[14],P1[15],0.f,0.f,       pw3[2]=PKW(P1,12),pw3[3]=PKW(P1,14), pw3); \
    l_reg+=sacc; \
    if(GK){DMA_K((t)+3,sl_cur);} if(GV){DMA_V((t)+1,sl_next);} \
    CMASK(C0,C1,t); \
    { float a=MX3(C0[0],C0[1],C1[0]),b=MX3(C0[2],C0[3],C1[1]); a=MX3(a,C1[2],C1[3]); \
      _Pragma("unroll") for(int r=4;r<16;r+=4){a=MX3(a,C0[r],C0[r+1]);b=MX3(b,C0[r+2],C0[r+3]);a=MX3(a,C1[r],C1[r+1]);b=MX3(b,C1[r+2],C1[r+3]);} \
      float rm=__builtin_fmaxf(a,b); { auto rr=__builtin_amdgcn_permlane32_swap(__float_as_uint(rm),__float_as_uint(rm),false,false); rm=__builtin_fmaxf(__uint_as_float(rr[0]),__uint_as_float(rr[1])); } \
      resc=false; \
      if(__builtin_expect(__any(rm>(float)THRL),0)){ const float dl=__builtin_fmaxf(rm,0.f); mhat+=dl; \
        _Pragma("unroll") for(int r=0;r<16;++r){C0[r]-=dl;C1[r]-=dl;} \
        const float f=__builtin_amdgcn_exp2f(-dl); l_reg*=f; if(hi==0)wsf[r32]=f; resc=true; } } \
    SBAR(); \
    GAPB(o[0]=__builtin_amdgcn_mfma_f32_32x32x16_bf16(PAF(0),VFR(0),o[0],0,0,0), C0,0); \
    GAPB(o[1]=__builtin_amdgcn_mfma_f32_32x32x16_bf16(PAF(0),VFR(4),o[1],0,0,0), C0,4); \
    KRD(GL,0); GAPB(o[0]=__builtin_amdgcn_mfma_f32_32x32x16_bf16(PAF(1),VFR(1),o[0],0,0,0), C0,8); \
    KRD(GL,1); GAPB(o[1]=__builtin_amdgcn_mfma_f32_32x32x16_bf16(PAF(1),VFR(5),o[1],0,0,0), C0,12); \
    KRD(GL,2); GAPB(o[0]=__builtin_amdgcn_mfma_f32_32x32x16_bf16(PAF(2),VFR(2),o[0],0,0,0), C1,0); \
    KRD(GL,3); GAPB(o[1]=__builtin_amdgcn_mfma_f32_32x32x16_bf16(PAF(2),VFR(6),o[1],0,0,0), C1,4); \
    GAPB(o[0]=__builtin_amdgcn_mfma_f32_32x32x16_bf16(PAF(3),VFR(3),o[0],0,0,0), C1,8); \
    GAPB(o[1]=__builtin_amdgcn_mfma_f32_32x32x16_bf16(PAF(3),VFR(7),o[1],0,0,0), C1,12); \
    if(GL){BLOAD(P0,P1,(t)+1);} SBAR(); \
    }while(0)
  int t=1;
  #undef CMASK
  #define CMASK(P0,P1,t) do{}while(0)
  for(;t+5<NT;t+=2){
    STEP(pB0,pB1,pA0,pA1,t,true,true,true);     WAIT_BAR(2); RESC(); ROT();
    STEP(pA0,pA1,pB0,pB1,t+1,true,true,true);   WAIT_BAR(2); RESC(); ROT();
  }
  #undef CMASK
  #define CMASK(P0,P1,t) do{int jb_=(t)-(NT-4); if(jb_>=0)cmask(P0,P1,jb_,qrel,hi);}while(0)
  #define ENDW(tt) do{ if((tt)+3<NT){WAIT_BAR(2);} else if((tt)+2<NT){WAIT_BAR(1);} else {WAIT_BAR(0);} }while(0)
  for(;t+1<NT;t+=2){
    STEP(pB0,pB1,pA0,pA1,t,(t+3<NT),(t+1<NT),(t+1<NT));       ENDW(t);   RESC(); ROT();
    STEP(pA0,pA1,pB0,pB1,t+1,(t+4<NT),(t+2<NT),(t+2<NT));     ENDW(t+1); RESC(); ROT();
  }
  STEP(pB0,pB1,pA0,pA1,NT-1,false,false,false); RESC();
  { float sacc=pB0[0]+pB0[1]; _Pragma("unroll") for(int r=2;r<16;++r)sacc+=pB0[r]; _Pragma("unroll") for(int r=0;r<16;++r)sacc+=pB1[r]; l_reg+=sacc;
    pw0=(u32x4){PKW(pB0,0),PKW(pB0,2),PKW(pB0,4),PKW(pB0,6)};pw1=(u32x4){PKW(pB0,8),PKW(pB0,10),PKW(pB0,12),PKW(pB0,14)};pw2=(u32x4){PKW(pB1,0),PKW(pB1,2),PKW(pB1,4),PKW(pB1,6)};pw3=(u32x4){PKW(pB1,8),PKW(pB1,10),PKW(pB1,12),PKW(pB1,14)};
    SBAR(); pv(o,vb0+sl_cur,PAF(0),PAF(1),PAF(2),PAF(3)); }
  #undef PKW
  #undef PAF
  #undef VFR
  #undef PIN
  #undef MX3
  #undef GAPA
  #undef GAPB
  #undef EX
  #undef VRD
  #undef KRD
  #undef STEP
  #undef ENDW
  {auto rr=__builtin_amdgcn_permlane32_swap(__float_as_uint(l_reg),__float_as_uint(l_reg),false,false);l_reg=__uint_as_float(rr[0])+__uint_as_float(rr[1]);}
  if(hi==0)wsf[32+r32]=l_reg;asm volatile("s_waitcnt lgkmcnt(0)":::"memory");
  float rli[16];
  #pragma unroll
  for(int r=0;r<16;++r)rli[r]=__builtin_amdgcn_rcpf(wsf[32+crow(r,hi)]);
  bf16*Ow=O+(rowbase+q0+wid*QBLK)*DM+h*D;
  { bf16*stg=(bf16*)(shm+LDS_OST)+wid*2048;
    #pragma unroll
    for(int r=0;r<16;++r){const int orow=crow(r,hi);
      #pragma unroll
      for(int d0=0;d0<2;++d0)stg[orow*64+d0*32+r32]=__float2bfloat16(o[d0][r]*rli[r]);}
    asm volatile("s_waitcnt lgkmcnt(0)":::"memory");
    #pragma unroll
    for(int i=0;i<4;++i){const int row=i*8+(lane>>3),ch=lane&7; const u32x4 v=*(const u32x4*)(stg+row*64+ch*8); ATTN_STORE16(Ow+(long)row*DM+ch*8,v);} }
  asm volatile("s_waitcnt lgkmcnt(0)\n\ts_barrier":::"memory");
  #undef DMA_K
  #undef BLOAD
  #undef DMA_V
  #undef CMASK
  #undef START
  #undef RESC
  #undef ROT
}
constexpr int ATTN_LDS_BYTES=LDS_BYTES;
struct AttnTensors { const bf16* Q; const bf16* K; const bf16* V; bf16* O; const float* F; };
struct AttnUnit { int bh; int qb; };
template<int THRL=8> __device__ __forceinline__ void attn_phase(char*lds,const AttnTensors&T,unsigned*qctr,const __attribute__((address_space(3))) float*thr8,volatile __attribute__((address_space(3))) unsigned*qslot,int wv){
  for(;;){
    if(fresh_tid(wv)==0){ qslot[0]=__hip_atomic_fetch_add(qctr,1u,__ATOMIC_RELAXED,__HIP_MEMORY_SCOPE_AGENT); }
    asm volatile("s_waitcnt vmcnt(0) lgkmcnt(0)\n\ts_barrier":::"memory");
    const int idx=__builtin_amdgcn_readfirstlane((int)qslot[0]);
    if(idx>=NHEAD*NQB)break;
    const int h=idx%NHEAD, qb=NQB-1-idx/NHEAD;
    attn_unit<THRL>(0,h,qb,T.Q,T.K,T.V,T.O,T.F+(size_t)h*SEQ,thr8[h],lds,wv);
  }
}
#undef SBAR
#undef WAIT_BAR
}
#define GAS __attribute__((address_space(1)))
#define LAS __attribute__((address_space(3)))
typedef unsigned short bf16;
typedef unsigned v4u __attribute__((ext_vector_type(4)));
typedef unsigned v2u __attribute__((ext_vector_type(2)));
typedef float f32x4 __attribute__((ext_vector_type(4)));
typedef float f32x16 __attribute__((ext_vector_type(16)));
typedef short bf16x8 __attribute__((ext_vector_type(8)));
typedef short s16x4 __attribute__((ext_vector_type(4)));

constexpr int NWAVES = 8;
constexpr int S_ = 16384, DM_ = 1024, DIN_ = 6680, FF_ = 4096, NMEM_ = 256;
constexpr float EPS_ = 1e-6f;
constexpr float LOG2E_ = 1.4426950408889634f;
constexpr size_t MiB = 1u << 20;
constexpr size_t WS_WIN = 1 * MiB;
constexpr size_t WS_WGLAO = 17 * MiB, WS_WFOXO = 18 * MiB, WS_WMEMO = 19 * MiB;
constexpr size_t WS_WOUT = 20 * MiB;
constexpr size_t WS_WFF1 = 22 * MiB;
constexpr size_t WS_WFF2 = 30 * MiB;
constexpr size_t WS_GA = 38 * MiB;
constexpr size_t WS_LOGF = 39 * MiB;
constexpr size_t WS_F = 39 * MiB + 512 * 1024;
constexpr size_t WS_MK = 40 * MiB;
constexpr size_t WS_MVT = 40 * MiB + 256 * 1024;
constexpr size_t WS_DEC = 40 * MiB + 512 * 1024;
constexpr size_t WS_MEMN = 40 * MiB + 768 * 1024;
constexpr size_t WS_GQ = 42 * MiB, WS_GK = 50 * MiB, WS_GV = 58 * MiB;
constexpr size_t WS_MG = 42 * MiB;
constexpr size_t WS_GG = 74 * MiB, WS_FQ = 90 * MiB;
constexpr size_t WS_U2 = 74 * MiB;
constexpr size_t WS_MQ = 106 * MiB, WS_FK = 122 * MiB, WS_FV = 138 * MiB;
constexpr size_t WS_GT = 154 * MiB;
constexpr size_t WS_HID = 122 * MiB;
constexpr size_t WS_SS1 = 250 * MiB, WS_SS2 = 251 * MiB;
constexpr size_t WS_END = 253 * MiB;
constexpr size_t WS_LSEF = 252 * MiB;
constexpr size_t WS_QB2 = 251 * MiB + 512 * 1024, WS_NDOT = 251 * MiB + 544 * 1024;
constexpr size_t WS_H0 = 106 * MiB, WS_H1 = 1 * MiB;
constexpr int CW_PANEL = 8192;
constexpr size_t OUT_U = 0, OUT_STATE = 32 * MiB;

constexpr int LDS_BYTES = 155648;

#define LDS_WAIT() asm volatile("s_waitcnt lgkmcnt(0)" ::: "memory")
__device__ __forceinline__ unsigned f2bf(float f) { unsigned u = __builtin_bit_cast(unsigned, f); return (u + 0x7fffu + ((u >> 16) & 1u)) >> 16; }
__device__ __forceinline__ unsigned pk2(float lo, float hi) { return f2bf(lo) | (f2bf(hi) << 16); }
__device__ __forceinline__ float bf2f(unsigned b) { return __builtin_bit_cast(float, (b & 0xffffu) << 16); }
__device__ __forceinline__ float bflo(unsigned w) { return __builtin_bit_cast(float, w << 16); }
__device__ __forceinline__ float bfhi(unsigned w) { return __builtin_bit_cast(float, w & 0xffff0000u); }
__device__ __forceinline__ float sigmoidf_(float x) { return __builtin_amdgcn_rcpf(1.f + __expf(-x)); }
__device__ __forceinline__ float logsigmoidf_(float z) { return -(fmaxf(-z, 0.f) + log1pf(__expf(-fabsf(z)))); }
__device__ __forceinline__ float logsigmoid_fast(float z) { return -(fmaxf(-z, 0.f) + __logf(1.f + __expf(-fabsf(z)))); }
__device__ __forceinline__ int crow_(int r, int hi) { return (r & 3) + 8 * (r >> 2) + 4 * hi; }
__device__ __forceinline__ float wave_sum(float v) {
#pragma unroll
    for (int o = 1; o < 64; o <<= 1) v += __shfl_xor(v, o);
    return v;
}
#define LBAR() asm volatile("s_waitcnt lgkmcnt(0)\n\ts_barrier" ::: "memory")
#define MFMA32(a, b, c) __builtin_amdgcn_mfma_f32_32x32x16_bf16((a), (b), (c), 0, 0, 0)
__device__ __forceinline__ bf16x8 ldfrag(const LAS unsigned char* base, int row, int pitchB, int kbyte) { return *(const LAS bf16x8*)(base + row * pitchB + kbyte); }

struct Ptrs {
    const float *x, *mem, *g_mix, *w_in, *w_alpha_up, *b_alpha, *b_forget, *g_gla_head, *g_mem, *w_mem_kv, *w_gla_o, *w_fox_o, *w_mem_o, *w_out, *g_ffn, *w_ff1, *w_ff2, *g_final;
    float* out; unsigned char* ws;
};

__device__ __forceinline__ void p0_transpose_item(const float* W, int ldw, int srccol0, int k0, bf16* WT, int ldt, int dstrow0, LAS float* scr, int lane) {
#pragma unroll 8
    for (int i = 0; i < 32; ++i) { const int kk = 2 * i + (lane >> 5); scr[kk * 33 + (lane & 31)] = W[(size_t)(k0 + kk) * ldw + srccol0 + (lane & 31)]; }
    LDS_WAIT(); asm volatile("" ::: "memory");
    const int c = lane & 7;
#pragma unroll
    for (int j = 0; j < 4; ++j) { const int n = (lane >> 3) + 8 * j; const LAS float* s = scr + (8 * c) * 33 + n;
        v4u o; o.x = pk2(s[0 * 33], s[1 * 33]); o.y = pk2(s[2 * 33], s[3 * 33]); o.z = pk2(s[4 * 33], s[5 * 33]); o.w = pk2(s[6 * 33], s[7 * 33]);
        *(v4u*)(WT + (size_t)(dstrow0 + n) * ldt + k0 + 8 * c) = o; }
    LDS_WAIT(); asm volatile("" ::: "memory");
}
__device__ __forceinline__ void rms_row_to_bf16(const float* xrow, const float* gain, bf16* orow, int lane) {
    const f32x4* xr = (const f32x4*)xrow + lane; const f32x4* gr = (const f32x4*)gain + lane;
    f32x4 v[4]; float s = 0.f;
#pragma unroll
    for (int j = 0; j < 4; ++j) { v[j] = xr[64 * j]; s += (v[j].x * v[j].x + v[j].y * v[j].y) + (v[j].z * v[j].z + v[j].w * v[j].w); }
    const float r = rsqrtf(wave_sum(s) * (1.f / 1024.f) + EPS_);
    unsigned long long* o8 = (unsigned long long*)orow + lane;
#pragma unroll
    for (int j = 0; j < 4; ++j) { const f32x4 g = gr[64 * j]; o8[64 * j] = (unsigned long long)pk2(v[j].x * r * g.x, v[j].y * r * g.y) | ((unsigned long long)pk2(v[j].z * r * g.z, v[j].w * r * g.w) << 32); }
}
__device__ __forceinline__ void p0_prologue(const Ptrs& P, LAS unsigned char* lds, int vcu, int G, int wv) {
    const int tid = fresh_tid(wv), lane = tid & 63, wave = wv;
    LAS float* scr = (LAS float*)(lds + wave * 16384);
    const int gw = vcu * NWAVES + wave, NGW = G * NWAVES;
    bf16* WIN = (bf16*)(P.ws + WS_WIN);
    constexpr int I_IN = 16 * 208, I_KV = 16 * 32, I_GO = 8 * 32, I_WO = 16 * 32, I_F1 = 16 * 128, I_F2 = 64 * 32;
    constexpr int NITEMS = I_IN + I_KV + 3 * I_GO + I_WO + I_F1 + I_F2;
    for (int it = gw; it < NITEMS; it += NGW) {
        int r = it;
        if (r < I_IN) { const int kb = r / 208, nb = r % 208, d0 = 32 * nb; const int src = d0 < 1536 ? d0 : (d0 < 3072 ? d0 + 16 : d0 + 24);
            p0_transpose_item(P.w_in, DIN_, src, 64 * kb, WIN, 1024, d0, scr, lane); continue; } r -= I_IN;
        if (r < I_KV) { const int kb = r / 32, nb = r % 32; p0_transpose_item(P.w_mem_kv, 1024, 32 * nb, 64 * kb, WIN, 1024, 6912 + 32 * nb, scr, lane); continue; } r -= I_KV;
        if (r < I_GO) { const int kb = r / 32, nb = r % 32; p0_transpose_item(P.w_gla_o, 1024, 32 * nb, 64 * kb, (bf16*)(P.ws + WS_WGLAO), 512, 32 * nb, scr, lane); continue; } r -= I_GO;
        if (r < I_GO) { const int kb = r / 32, nb = r % 32; p0_transpose_item(P.w_fox_o, 1024, 32 * nb, 64 * kb, (bf16*)(P.ws + WS_WFOXO), 512, 32 * nb, scr, lane); continue; } r -= I_GO;
        if (r < I_GO) { const int kb = r / 32, nb = r % 32; p0_transpose_item(P.w_mem_o, 1024, 32 * nb, 64 * kb, (bf16*)(P.ws + WS_WMEMO), 512, 32 * nb, scr, lane); continue; } r -= I_GO;
        if (r < I_WO) { const int kb = r / 32, nb = r % 32; p0_transpose_item(P.w_out, 1024, 32 * nb, 64 * kb, (bf16*)(P.ws + WS_WOUT), 1024, 32 * nb, scr, lane); continue; } r -= I_WO;
        if (r < I_F1) { const int kb = r / 128, nb = r % 128; p0_transpose_item(P.w_ff1, FF_, 32 * nb, 64 * kb, (bf16*)(P.ws + WS_WFF1), 1024, 32 * nb, scr, lane); continue; } r -= I_F1;
        { const int kb = r / 32, nb = r % 32; p0_transpose_item(P.w_ff2, 1024, 32 * nb, 64 * kb, (bf16*)(P.ws + WS_WFF2), FF_, 32 * nb, scr, lane); }
    }
    for (int idx = vcu * 512 + tid; idx < 256 * 128; idx += G * 512) {
        const int row = idx >> 7, kc = idx & 127; const int src = row < 16 ? 1536 + row : (row < 24 ? 3088 + (row - 16) : -1);
        v4u o = (v4u){0u, 0u, 0u, 0u};
        if (src >= 0) { const float* wp = P.w_in + (size_t)(8 * kc) * DIN_ + src;
            o.x = pk2(wp[0], wp[DIN_]); o.y = pk2(wp[2 * DIN_], wp[3 * DIN_]); o.z = pk2(wp[4 * DIN_], wp[5 * DIN_]); o.w = pk2(wp[6 * DIN_], wp[7 * DIN_]); }
        *(v4u*)(WIN + (size_t)(6656 + row) * 1024 + 8 * kc) = o;
    }
    bf16* U = (bf16*)((unsigned char*)P.out + OUT_U); bf16* MEMN = (bf16*)(P.ws + WS_MEMN);
    for (int m = gw; m < S_ + NMEM_; m += NGW) {
        if (m < S_) rms_row_to_bf16(P.x + (size_t)m * DM_, P.g_mix, U + (size_t)m * DM_, lane);
        else rms_row_to_bf16(P.mem + (size_t)(m - S_) * DM_, P.g_mem, MEMN + (size_t)(m - S_) * DM_, lane);
    }
}

struct GemmSched {
    const char* A; const char* B; int nM, nN, lda, ldb, G, c, wv;
    __device__ __forceinline__ bool next(int i, pg8::Unit& u) const { const long L = (long)i * G + c; if (L >= nM * nN) return false; pg8::map_tile((int)L, nM, nN, u.pm, u.pn); u.z = 0; return true; }
    __device__ __forceinline__ const char* aptr(const pg8::Unit& u) const { return A + (size_t)u.pm * 256 * lda * 2; }
    __device__ __forceinline__ const char* bptr(const pg8::Unit& u) const { return B + (size_t)u.pn * 256 * ldb * 2; }
    __device__ __forceinline__ void a_ready(const pg8::Unit&) const {}
    __device__ __forceinline__ void done(const pg8::Unit&) const {}
};
struct ProjSched {
    const char* U; const char* MEMN; const char* W; int G, c, wv;
    __device__ __forceinline__ bool next(int i, pg8::Unit& u) const { const int L = i * G + c; u.z = 0;
        if (L < 1728) { pg8::map_tile(L, 64, 27, u.pm, u.pn); return true; }
        if (L < 1732) { u.pm = 64; u.pn = 27 + (L - 1728); return true; } return false; }
    __device__ __forceinline__ const char* aptr(const pg8::Unit& u) const { return u.pm < 64 ? U + (size_t)u.pm * (256 * 1024 * 2) : MEMN; }
    __device__ __forceinline__ const char* bptr(const pg8::Unit& u) const { return W + (size_t)u.pn * (256 * 1024 * 2); }
    __device__ __forceinline__ void a_ready(const pg8::Unit&) const {}
    __device__ __forceinline__ void done(const pg8::Unit&) const {}
};
struct MergeSched {
    const char *A0, *B0; int G, c, wv; size_t segA, segB;
    __device__ __forceinline__ bool next(int i, pg8::Unit& u) const { const int T = c + G * i; if (T >= 256) return false; pg8::map_tile(T, 64, 4, u.pm, u.pn); u.z = 0; return true; }
    __device__ __forceinline__ const char* aptr(const pg8::Unit& u) const { return A0 + (size_t)u.pm * (256 * 512 * 2); }
    __device__ __forceinline__ const char* bptr(const pg8::Unit& u) const { return B0 + (size_t)u.pn * (256 * 512 * 2); }
    __device__ __forceinline__ void a_ready(const pg8::Unit&) const {}
    __device__ __forceinline__ void done(const pg8::Unit&) const {}
};
typedef pg8::f32x4 accv;
__device__ __forceinline__ void store_bf16_tile(const accv (&acc)[2][2][4][2], bf16* base, int ldc, int row0, int col0, float sc, bool sig) {
#pragma unroll
    for (int ai = 0; ai < 2; ++ai)
#pragma unroll
        for (int m = 0; m < 4; ++m) { bf16* rowp = base + (size_t)(row0 + ai * 128 + m * 16) * ldc + col0;
#pragma unroll
            for (int bj = 0; bj < 2; ++bj) { accv v0 = acc[ai][bj][m][0] * sc, v1 = acc[ai][bj][m][1] * sc;
                if (sig) { v0 = (accv){sigmoidf_(v0[0]), sigmoidf_(v0[1]), sigmoidf_(v0[2]), sigmoidf_(v0[3])}; v1 = (accv){sigmoidf_(v1[0]), sigmoidf_(v1[1]), sigmoidf_(v1[2]), sigmoidf_(v1[3])}; }
                v4u w; w.x = pg8::cvt_pk_bf16(v0[0], v0[1]); w.y = pg8::cvt_pk_bf16(v0[2], v0[3]); w.z = pg8::cvt_pk_bf16(v1[0], v1[1]); w.w = pg8::cvt_pk_bf16(v1[2], v1[3]);
                *(v4u*)(rowp + bj * 128) = w; } }
}
struct EpiProj {
    static constexpr bool PERM = true, AFTER_DRAIN = false;
    unsigned char* ws; const float* b_forget;
    __device__ __forceinline__ void operator()(const accv (&acc)[2][2][4][2], const pg8::Unit& u, int wr, int wc, int fr, int fq) const {
        const int pn = u.pn;
        if (pn != 26) {
            size_t off; int ldc, colt, prow = u.pm * 256; float sc = 1.f; bool sig = false;
            if (pn == 0) { off = WS_GQ; ldc = 256; colt = 0; sc = 0.125f; }
            else if (pn == 1) { off = WS_GK; ldc = 256; colt = 0; }
            else if (pn < 4) { off = WS_GV; ldc = 512; colt = (pn - 2) * 256; }
            else if (pn < 6) { off = WS_GG; ldc = 512; colt = (pn - 4) * 256; }
            else if (pn < 8) { off = WS_FQ; ldc = 512; colt = (pn - 6) * 256; sc = 0.125f * LOG2E_; }
            else if (pn < 10) { off = WS_FK; ldc = 512; colt = (pn - 8) * 256; }
            else if (pn < 12) { off = WS_FV; ldc = 512; colt = (pn - 10) * 256; }
            else if (pn < 14) { off = WS_MQ; ldc = 512; colt = (pn - 12) * 256; sc = 0.08838834764831845f * LOG2E_; }
            else if (pn < 26) { off = WS_GT; ldc = 3072; colt = (pn - 14) * 256; sig = true; }
            else if (pn < 29) { off = WS_MK; ldc = 512; colt = (pn - 27) * 256; prow = 0; }
            else { off = WS_MVT; ldc = 512; colt = (pn - 29) * 256; prow = 0; }
            store_bf16_tile(acc, (bf16*)(ws + off), ldc, prow + wr * 64 + fr, colt + wc * 32 + 8 * fq, sc, sig);
        } else {
            if (wc == 0 && fq < 3) {
                float* GA = (float*)(ws + WS_GA); float* LF = (float*)(ws + WS_LOGF);
                accv bf0 = (accv){0.f, 0.f, 0.f, 0.f}, bf1 = bf0;
                if (fq == 2) { bf0 = *(const accv*)(b_forget); bf1 = *(const accv*)(b_forget + 4); }
#pragma unroll
                for (int ai = 0; ai < 2; ++ai)
#pragma unroll
                    for (int m = 0; m < 4; ++m) { const size_t row = (size_t)(u.pm * 256 + wr * 64 + fr + ai * 128 + m * 16);
                        const accv v0 = acc[ai][0][m][0], v1 = acc[ai][0][m][1];
                        if (fq < 2) { *(accv*)(GA + row * 16 + 8 * fq) = v0; *(accv*)(GA + row * 16 + 8 * fq + 4) = v1; }
                        else { const accv a = v0 + bf0, b = v1 + bf1;
#pragma unroll
                            for (int j = 0; j < 4; ++j) { LF[(size_t)j * S_ + row] = logsigmoidf_(a[j]); LF[(size_t)(4 + j) * S_ + row] = logsigmoidf_(b[j]); } } }
            }
        }
    }
};
struct EpiMerge {
    static constexpr bool PERM = true, AFTER_DRAIN = false;
    bf16* MG; const bf16* GT;
    __device__ __forceinline__ void mid(accv (&acc)[2][2][4][2], const pg8::Unit& u, int s, int wr, int wc, int fr, int fq) const {
        const int row0 = u.pm * 256 + wr * 64 + fr, col0 = u.pn * 256 + wc * 32 + 8 * fq;
#pragma unroll
        for (int ai = 0; ai < 2; ++ai)
#pragma unroll
            for (int m = 0; m < 4; ++m) { const size_t row = (size_t)(row0 + ai * 128 + m * 16);
#pragma unroll
                for (int bj = 0; bj < 2; ++bj) { const int col = col0 + bj * 128;
                    const v4u a = *(const v4u*)(GT + row * 3072 + (s - 1) * 1024 + col), b = *(const v4u*)(GT + row * 3072 + s * 1024 + col);
                    const accv r0 = (accv){bflo(a.x) * __builtin_amdgcn_rcpf(fmaxf(bflo(b.x), 1e-30f)), bfhi(a.x) * __builtin_amdgcn_rcpf(fmaxf(bfhi(b.x), 1e-30f)), bflo(a.y) * __builtin_amdgcn_rcpf(fmaxf(bflo(b.y), 1e-30f)), bfhi(a.y) * __builtin_amdgcn_rcpf(fmaxf(bfhi(b.y), 1e-30f))};
                    const accv r1 = (accv){bflo(a.z) * __builtin_amdgcn_rcpf(fmaxf(bflo(b.z), 1e-30f)), bfhi(a.z) * __builtin_amdgcn_rcpf(fmaxf(bfhi(b.z), 1e-30f)), bflo(a.w) * __builtin_amdgcn_rcpf(fmaxf(bflo(b.w), 1e-30f)), bfhi(a.w) * __builtin_amdgcn_rcpf(fmaxf(bfhi(b.w), 1e-30f))};
                    acc[ai][bj][m][0] = acc[ai][bj][m][0] * r0; acc[ai][bj][m][1] = acc[ai][bj][m][1] * r1; } }
    }
    __device__ __forceinline__ void operator()(const accv (&acc)[2][2][4][2], const pg8::Unit& u, int wr, int wc, int fr, int fq) const {
        const int row0 = u.pm * 256 + wr * 64 + fr, col0 = u.pn * 256 + wc * 32 + 8 * fq;
#pragma unroll
        for (int ai = 0; ai < 2; ++ai)
#pragma unroll
            for (int m = 0; m < 4; ++m) { const size_t row = (size_t)(row0 + ai * 128 + m * 16);
#pragma unroll
                for (int bj = 0; bj < 2; ++bj) { const int col = col0 + bj * 128;
                    const v4u g = *(const v4u*)(GT + row * 3072 + 2 * 1024 + col);
                    accv v0 = acc[ai][bj][m][0], v1 = acc[ai][bj][m][1];
                    v0 = v0 * (accv){bflo(g.x), bfhi(g.x), bflo(g.y), bfhi(g.y)}; v1 = v1 * (accv){bflo(g.z), bfhi(g.z), bflo(g.w), bfhi(g.w)};
                    v4u w; w.x = pg8::cvt_pk_bf16(v0[0], v0[1]); w.y = pg8::cvt_pk_bf16(v0[2], v0[3]); w.z = pg8::cvt_pk_bf16(v1[0], v1[1]); w.w = pg8::cvt_pk_bf16(v1[2], v1[3]);
                    *(v4u*)(MG + row * 1024 + col) = w; } }
    }
};
template <bool WRITE_U2, bool BASE_BF16> struct EpiResid {
    static constexpr bool PERM = true, AFTER_DRAIN = false;
    const void* base; bf16* H0; bf16* H1; bf16* U2; const float* gain; float* SS;
    __device__ __forceinline__ void operator()(const accv (&acc)[2][2][4][2], const pg8::Unit& u, int wr, int wc, int fr, int fq) const {
        bf16* HB = u.pm < 32 ? H0 : H1;
        const int row0 = u.pm * 256 + wr * 64 + fr, col0 = u.pn * 256 + wc * 32 + 8 * fq;
#pragma unroll
        for (int ai = 0; ai < 2; ++ai)
#pragma unroll
            for (int m = 0; m < 4; ++m) { const size_t row = (size_t)(row0 + ai * 128 + m * 16); float ssq = 0.f;
#pragma unroll
                for (int bj = 0; bj < 2; ++bj) { const int col = col0 + bj * 128; const size_t o = row * 1024 + col;
                    accv b0, b1;
                    if (BASE_BF16) { const v4u bw = *(const v4u*)((const bf16*)base + o); b0 = (accv){bflo(bw.x), bfhi(bw.x), bflo(bw.y), bfhi(bw.y)}; b1 = (accv){bflo(bw.z), bfhi(bw.z), bflo(bw.w), bfhi(bw.w)}; }
                    else { b0 = *(const accv*)((const float*)base + o); b1 = *(const accv*)((const float*)base + o + 4); }
                    const accv h0 = b0 + acc[ai][bj][m][0], h1 = b1 + acc[ai][bj][m][1];
                    { v4u w; w.x = pg8::cvt_pk_bf16(h0[0], h0[1]); w.y = pg8::cvt_pk_bf16(h0[2], h0[3]); w.z = pg8::cvt_pk_bf16(h1[0], h1[1]); w.w = pg8::cvt_pk_bf16(h1[2], h1[3]); *(v4u*)(HB + o) = w; }
                    ssq += (h0[0] * h0[0] + h0[1] * h0[1]) + (h0[2] * h0[2] + h0[3] * h0[3]) + (h1[0] * h1[0] + h1[1] * h1[1]) + (h1[2] * h1[2] + h1[3] * h1[3]);
                    if (WRITE_U2) { const accv g0 = *(const accv*)(gain + col), g1 = *(const accv*)(gain + col + 4); const accv a = h0 * g0, b = h1 * g1;
                        v4u w; w.x = pg8::cvt_pk_bf16(a[0], a[1]); w.y = pg8::cvt_pk_bf16(a[2], a[3]); w.z = pg8::cvt_pk_bf16(b[0], b[1]); w.w = pg8::cvt_pk_bf16(b[2], b[3]);
                        *(v4u*)(U2 + o) = w; } }
                ssq += __shfl_xor(ssq, 16); ssq += __shfl_xor(ssq, 32);
                if (fq == 0) SS[row * 16 + u.pn * 4 + wc] = ssq; }
    }
};
struct EpiFinal {
    static constexpr bool PERM = true, AFTER_DRAIN = true;
    const bf16* H0; const bf16* H1; float* out; const float* gain; float* xbuf; unsigned* cnt;
    __device__ __forceinline__ void fused(accv (&acc)[2][2][4][2], const pg8::Unit& u, int wr, int wc, int fr, int fq, LAS unsigned char* lds, int wid, int lane) const {
        const bf16* HB = u.pm < 32 ? H0 : H1;
        LAS float* Pl = (LAS float*)lds; LAS float* Sl = (LAS float*)(lds + 4096);
        const int row0 = u.pm * 256 + wr * 64 + fr, col0 = u.pn * 256 + wc * 32 + 8 * fq;
#pragma unroll
        for (int ai = 0; ai < 2; ++ai)
#pragma unroll
            for (int m = 0; m < 4; ++m) { const size_t row = (size_t)(row0 + ai * 128 + m * 16); float ssq = 0.f;
#pragma unroll
                for (int bj = 0; bj < 2; ++bj) { const size_t o = row * 1024 + col0 + bj * 128; const v4u bw = *(const v4u*)(HB + o);
                    const accv h0 = acc[ai][bj][m][0] + (accv){bflo(bw.x), bfhi(bw.x), bflo(bw.y), bfhi(bw.y)}, h1 = acc[ai][bj][m][1] + (accv){bflo(bw.z), bfhi(bw.z), bflo(bw.w), bfhi(bw.w)};
                    acc[ai][bj][m][0] = h0; acc[ai][bj][m][1] = h1;
                    ssq += (h0[0] * h0[0] + h0[1] * h0[1]) + (h0[2] * h0[2] + h0[3] * h0[3]) + (h1[0] * h1[0] + h1[1] * h1[1]) + (h1[2] * h1[2] + h1[3] * h1[3]); }
                ssq += __shfl_xor(ssq, 16); ssq += __shfl_xor(ssq, 32);
                if (fq == 0) Pl[(ai * 128 + wr * 64 + m * 16 + fr) * 4 + wc] = ssq; }
        asm volatile("s_waitcnt lgkmcnt(0)" ::: "memory"); __builtin_amdgcn_s_barrier(); asm volatile("" ::: "memory");
        const int rowl = wid * 32 + (lane & 31);
        if (lane < 32) { const float s = (Pl[rowl * 4] + Pl[rowl * 4 + 1]) + (Pl[rowl * 4 + 2] + Pl[rowl * 4 + 3]);
            __hip_atomic_store(xbuf + ((size_t)(u.pm * 256 + rowl) * 4 + u.pn), s, __ATOMIC_RELAXED, __HIP_MEMORY_SCOPE_AGENT); }
        asm volatile("s_waitcnt vmcnt(0)" ::: "memory");
        if (lane == 0) __hip_atomic_fetch_add(cnt + 64 * u.pm, 1u, __ATOMIC_RELAXED, __HIP_MEMORY_SCOPE_AGENT);
        if (wid == 0) { unsigned sp = 0;
            while ((unsigned)__builtin_amdgcn_readfirstlane(__hip_atomic_load(cnt + 64 * u.pm, __ATOMIC_RELAXED, __HIP_MEMORY_SCOPE_AGENT)) < 32u) { __builtin_amdgcn_s_sleep(2); if (++sp > (1u << 22)) break; }
            __builtin_amdgcn_fence(__ATOMIC_ACQUIRE, "agent"); }
        asm volatile("s_waitcnt vmcnt(0) lgkmcnt(0)" ::: "memory"); __builtin_amdgcn_s_barrier(); asm volatile("" ::: "memory");
        if (lane < 32) { const float* sl = xbuf + (size_t)(u.pm * 256 + rowl) * 4;
            const float a = __hip_atomic_load(sl, __ATOMIC_RELAXED, __HIP_MEMORY_SCOPE_AGENT), b = __hip_atomic_load(sl + 1, __ATOMIC_RELAXED, __HIP_MEMORY_SCOPE_AGENT),
                        c = __hip_atomic_load(sl + 2, __ATOMIC_RELAXED, __HIP_MEMORY_SCOPE_AGENT), d = __hip_atomic_load(sl + 3, __ATOMIC_RELAXED, __HIP_MEMORY_SCOPE_AGENT);
            Sl[rowl] = rsqrtf(((a + b) + (c + d)) * (1.f / 1024.f) + EPS_); }
        asm volatile("s_waitcnt vmcnt(0) lgkmcnt(0)" ::: "memory"); __builtin_amdgcn_s_barrier(); asm volatile("" ::: "memory");
#pragma unroll
        for (int ai = 0; ai < 2; ++ai)
#pragma unroll
            for (int m = 0; m < 4; ++m) { const int rl = ai * 128 + wr * 64 + m * 16 + fr; const float r = Sl[rl]; const size_t row = (size_t)(u.pm * 256 + rl);
#pragma unroll
                for (int bj = 0; bj < 2; ++bj) { const int col = col0 + bj * 128; const accv g0 = *(const accv*)(gain + col), g1 = *(const accv*)(gain + col + 4);
                    *(accv*)(out + row * 1024 + col) = acc[ai][bj][m][0] * r * g0; *(accv*)(out + row * 1024 + col + 4) = acc[ai][bj][m][1] * r * g1; } }
    }
};
struct EpiFfn1 {
    static constexpr bool PERM = true, AFTER_DRAIN = false;
    bf16* HID; const float* SS;
    __device__ __forceinline__ void operator()(const accv (&acc)[2][2][4][2], const pg8::Unit& u, int wr, int wc, int fr, int fq) const {
        const int row0 = u.pm * 256 + wr * 64 + fr, col0 = u.pn * 256 + wc * 32 + 8 * fq;
#pragma unroll
        for (int ai = 0; ai < 2; ++ai)
#pragma unroll
            for (int m = 0; m < 4; ++m) { const size_t row = (size_t)(row0 + ai * 128 + m * 16);
                const accv s0 = *(const accv*)(SS + row * 16), s1 = *(const accv*)(SS + row * 16 + 4), s2 = *(const accv*)(SS + row * 16 + 8), s3 = *(const accv*)(SS + row * 16 + 12);
                const float tot = ((s0[0] + s0[1]) + (s0[2] + s0[3])) + ((s1[0] + s1[1]) + (s1[2] + s1[3])) + ((s2[0] + s2[1]) + (s2[2] + s2[3])) + ((s3[0] + s3[1]) + (s3[2] + s3[3]));
                const float r = rsqrtf(tot * (1.f / 1024.f) + EPS_);
#pragma unroll
                for (int bj = 0; bj < 2; ++bj) { accv v0 = acc[ai][bj][m][0] * r, v1 = acc[ai][bj][m][1] * r;
#pragma unroll
                    for (int j = 0; j < 4; ++j) { const float a = fmaxf(v0[j], 0.f), b = fmaxf(v1[j], 0.f); v0[j] = a * a; v1[j] = b * b; }
                    v4u w; w.x = pg8::cvt_pk_bf16(v0[0], v0[1]); w.y = pg8::cvt_pk_bf16(v0[2], v0[3]); w.z = pg8::cvt_pk_bf16(v1[0], v1[1]); w.w = pg8::cvt_pk_bf16(v1[2], v1[3]);
                    *(v4u*)(HID + row * 4096 + col0 + bj * 128) = w; } }
    }
};

constexpr int GP = 144;
__device__ __forceinline__ void gla_a_unit(const Ptrs& P, LAS unsigned char* lds, int n, int h, int wv) {
    const int tid = fresh_tid(wv), lane = tid & 63, g = wv, r32 = lane & 31, hh = lane >> 5;
    LAS unsigned char* QP = lds; LAS unsigned char* QN = lds + 9216; LAS unsigned char* KN = lds + 18432; LAS unsigned char* KP = lds + 27648;
    LAS unsigned char* KLT = lds + 36864; LAS unsigned char* AT = lds + 46080; LAS unsigned char* VT = lds + 55296; LAS float* TOT = (LAS float*)(lds + 73728);
    bf16* GQ = (bf16*)(P.ws + WS_GQ); const bf16* GK = (const bf16*)(P.ws + WS_GK); bf16* GV = (bf16*)(P.ws + WS_GV);
    const float* GA = (const float*)(P.ws + WS_GA); float* DEC = (float*)(P.ws + WS_DEC); bf16* STATE = (bf16*)((unsigned char*)P.out + OUT_STATE);
    const int c = h * 64 + lane, t0 = n * 64;
#ifdef PROBE_PHASE
#define GSTAMP(k) do { if (n == 64 && h == 0 && tid == 0) ((unsigned long long*)(P.ws + 253 * MiB))[(k)] = __builtin_amdgcn_s_memrealtime(); } while (0)
#else
#define GSTAMP(k) do {} while (0)
#endif
    GSTAMP(60);
    float wup[16];
#pragma unroll
    for (int j = 0; j < 16; ++j) wup[j] = P.w_alpha_up[j * 256 + c];
    const float ba = P.b_alpha[c];
    unsigned short qraw[8], kraw[8];
#pragma unroll
    for (int i = 0; i < 8; ++i) { const size_t gi = (size_t)(t0 + 8 * g + i) * 256 + c; qraw[i] = GQ[gi]; kraw[i] = GK[gi]; }
    float bl[8]; float run = 0.f;
#pragma unroll
    for (int i = 0; i < 8; ++i) { const f32x4* gar = (const f32x4*)(GA + (size_t)(t0 + 8 * g + i) * 16); float z = ba;
#pragma unroll
        for (int j4 = 0; j4 < 4; ++j4) { const f32x4 a = gar[j4]; z += a[0] * wup[4 * j4] + a[1] * wup[4 * j4 + 1] + a[2] * wup[4 * j4 + 2] + a[3] * wup[4 * j4 + 3]; }
        run += logsigmoid_fast(z) * (1.f / 16.f); bl[i] = run; }
    TOT[g * 64 + lane] = run;
    { const int s = tid >> 3, vc = tid & 7; const v4u a = *(const v4u*)(GV + (size_t)(t0 + s) * 512 + h * 128 + vc * 16), b = *(const v4u*)(GV + (size_t)(t0 + s) * 512 + h * 128 + vc * 16 + 8);
      LAS bf16* vt = (LAS bf16*)VT; const unsigned w[8] = {a.x, a.y, a.z, a.w, b.x, b.y, b.z, b.w};
#pragma unroll
      for (int j = 0; j < 8; ++j) { vt[(vc * 16 + 2 * j) * 72 + s] = (bf16)(w[j] & 0xffffu); vt[(vc * 16 + 2 * j + 1) * 72 + s] = (bf16)(w[j] >> 16); } }
    LBAR(); GSTAMP(61);
    float off = 0.f, blast = 0.f;
#pragma unroll
    for (int gg = 0; gg < 8; ++gg) { const float tv = TOT[gg * 64 + lane]; if (gg < g) off += tv; blast += tv; }
    unsigned kl[8];
#pragma unroll
    for (int i = 0; i < 8; ++i) { const int t = 8 * g + i; const float b = off + bl[i]; const size_t gi = (size_t)(t0 + t) * 256 + c;
        const float q = bf2f(qraw[i]), k = bf2f(kraw[i]); const float ep = __expf(b), en = __expf(-b), el = __expf(blast - b);
        const unsigned qp = f2bf(q * ep); GQ[gi] = (bf16)qp;
        ((LAS bf16*)QP)[t * 72 + lane] = (bf16)qp; ((LAS bf16*)QN)[t * 72 + lane] = (bf16)f2bf(q * en);
        ((LAS bf16*)KN)[t * 72 + lane] = (bf16)f2bf(k * en); ((LAS bf16*)KP)[t * 72 + lane] = (bf16)f2bf(k * ep); kl[i] = f2bf(k * el); }
    *(LAS v4u*)(KLT + lane * GP + 16 * g) = (v4u){kl[0] | (kl[1] << 16), kl[2] | (kl[3] << 16), kl[4] | (kl[5] << 16), kl[6] | (kl[7] << 16)};
    if (g == 0) DEC[(n * 4 + h) * 64 + lane] = __expf(blast);
    LBAR(); GSTAMP(62);
    const f32x16 zero = {};
    if (g < 4) {
        const int ti = g >> 1, si = g & 1; f32x16 ac = zero, an = zero;
        if (ti >= si) {
#pragma unroll
            for (int ks = 0; ks < 4; ++ks) ac = MFMA32(ldfrag(QP, 32 * ti + r32, GP, 32 * ks + 16 * hh), ldfrag(KN, 32 * si + r32, GP, 32 * ks + 16 * hh), ac); }
        if (ti <= si) {
#pragma unroll
            for (int ks = 0; ks < 4; ++ks) an = MFMA32(ldfrag(QN, 32 * ti + r32, GP, 32 * ks + 16 * hh), ldfrag(KP, 32 * si + r32, GP, 32 * ks + 16 * hh), an); }
#pragma unroll
        for (int i = 0; i < 16; ++i) { const int t = 32 * ti + crow_(i, hh), s = 32 * si + r32; ((LAS bf16*)AT)[t * 72 + s] = (bf16)f2bf(t >= s ? ac[i] : an[i]); }
    } else {
        const int vi = g - 4;
#pragma unroll
        for (int dj = 0; dj < 2; ++dj) { f32x16 st = zero;
#pragma unroll
            for (int ks = 0; ks < 4; ++ks) st = MFMA32(ldfrag(KLT, 32 * dj + r32, GP, 32 * ks + 16 * hh), ldfrag(VT, 32 * vi + r32, GP, 32 * ks + 16 * hh), st);
#pragma unroll
            for (int i4 = 0; i4 < 4; ++i4) *(v2u*)(STATE + (size_t)(n * 4 + h) * 8192 + (size_t)(((vi * 4 + 2 * dj + (i4 >> 1)) * 64 + r32 + 32 * (i4 & 1)) * 8 + 4 * hh)) = (v2u){pk2(st[4 * i4], st[4 * i4 + 1]), pk2(st[4 * i4 + 2], st[4 * i4 + 3])}; }
    }
    LBAR(); GSTAMP(63);
    { const int ti = g >> 2, vj = g & 3; f32x16 oi = zero;
#pragma unroll
      for (int ks = 0; ks < 4; ++ks) oi = MFMA32(ldfrag(AT, 32 * ti + r32, GP, 32 * ks + 16 * hh), ldfrag(VT, 32 * vj + r32, GP, 32 * ks + 16 * hh), oi);
#pragma unroll
      for (int i = 0; i < 16; ++i) GV[(size_t)(t0 + 32 * ti + crow_(i, hh)) * 512 + h * 128 + 32 * vj + r32] = (bf16)f2bf(oi[i]); }
    LBAR(); GSTAMP(64);
}
__device__ __forceinline__ void gla_scan_unit(const Ptrs& P, LAS unsigned char* lds, int u, int wv) {
    const int tid = fresh_tid(wv), lane = tid & 63, w = wv;
    const int h = u >> 6, e0 = (u & 63) * 128;
    const int dch = 16 * ((e0 >> 9) & 3) + 8 * ((e0 >> 8) & 1) + ((2 * lane) & 7);
    unsigned* STATE = (unsigned*)((unsigned char*)P.out + OUT_STATE); const float* DEC = (const float*)(P.ws + WS_DEC);
    LAS float* segS = (LAS float*)lds; LAS float* segP = (LAS float*)(lds + 8192);
    float kv[2][32], dc[2][32];
#pragma unroll
    for (int i = 0; i < 32; ++i) { const int n = 32 * w + i; const unsigned wd = STATE[((size_t)(n * 4 + h) * 8192 + e0) / 2 + lane]; kv[0][i] = bflo(wd); kv[1][i] = bfhi(wd);
        const float2 d2 = *(const float2*)(DEC + (n * 4 + h) * 64 + dch); dc[0][i] = d2.x; dc[1][i] = d2.y; }
    float s[2] = {0.f, 0.f}, pr[2] = {1.f, 1.f};
#pragma unroll
    for (int i = 0; i < 32; ++i) {
#pragma unroll
        for (int e = 0; e < 2; ++e) { const float pv = s[e]; s[e] = s[e] * dc[e][i] + kv[e][i]; kv[e][i] = pv; pr[e] *= dc[e][i]; } }
    segS[w * 64 + lane] = s[0]; segS[512 + w * 64 + lane] = s[1]; segP[w * 64 + lane] = pr[0]; segP[512 + w * 64 + lane] = pr[1];
    LBAR();
    float sin_[2] = {0.f, 0.f};
#pragma unroll
    for (int ww = 0; ww < 8; ++ww) { const float a0 = segS[ww * 64 + lane], a1 = segS[512 + ww * 64 + lane], b0 = segP[ww * 64 + lane], b1 = segP[512 + ww * 64 + lane]; if (ww < w) { sin_[0] = sin_[0] * b0 + a0; sin_[1] = sin_[1] * b1 + a1; } }
    float cp[2] = {1.f, 1.f};
#pragma unroll
    for (int i = 0; i < 32; ++i) { const int n = 32 * w + i;
        STATE[((size_t)(n * 4 + h) * 8192 + e0) / 2 + lane] = pk2(kv[0][i] + cp[0] * sin_[0], kv[1][i] + cp[1] * sin_[1]);
        cp[0] *= dc[0][i]; cp[1] *= dc[1][i]; }
    LBAR();
}
__device__ __forceinline__ void gla_b_task(const Ptrs& P, int task, int lane) {
    const int r32 = lane & 31, hh = lane >> 5;
    const int ti = task & 1, h = (task >> 1) & 3, n = task >> 3;
    const bf16* GQ = (const bf16*)(P.ws + WS_GQ); const bf16* GV = (const bf16*)(P.ws + WS_GV); bf16* GG = (bf16*)(P.ws + WS_GG);
    const bf16* SB = (const bf16*)((unsigned char*)P.out + OUT_STATE) + (size_t)(n * 4 + h) * 8192;
    const size_t t = (size_t)n * 64 + 32 * ti + r32;
    bf16x8 qf[4];
#pragma unroll
    for (int ks = 0; ks < 4; ++ks) qf[ks] = *(const bf16x8*)(GQ + t * 256 + h * 64 + 16 * ks + 8 * hh);
    f32x16 o[4];
#pragma unroll
    for (int vj = 0; vj < 4; ++vj) { o[vj] = (f32x16){};
#pragma unroll
        for (int ks = 0; ks < 4; ++ks) { const bf16x8 af = *(const bf16x8*)(SB + ((vj * 4 + ks) * 64 + lane) * 8);
            o[vj] = MFMA32(af, qf[ks], o[vj]); }
        asm volatile("" ::: "memory"); }
    float ov[64]; float ss = 0.f;
#pragma unroll
    for (int vj = 0; vj < 4; ++vj) {
#pragma unroll
        for (int g4 = 0; g4 < 4; ++g4) { const v2u w = *(const v2u*)(GV + t * 512 + h * 128 + 32 * vj + 8 * g4 + 4 * hh);
            const float a0 = o[vj][4 * g4] + bflo(w.x), a1 = o[vj][4 * g4 + 1] + bfhi(w.x), a2 = o[vj][4 * g4 + 2] + bflo(w.y), a3 = o[vj][4 * g4 + 3] + bfhi(w.y);
            ov[16 * vj + 4 * g4] = a0; ov[16 * vj + 4 * g4 + 1] = a1; ov[16 * vj + 4 * g4 + 2] = a2; ov[16 * vj + 4 * g4 + 3] = a3;
            ss += (a0 * a0 + a1 * a1) + (a2 * a2 + a3 * a3); } }
    ss += __shfl_xor(ss, 32);
    const float r = rsqrtf(ss * (1.f / 128.f) + EPS_);
#pragma unroll
    for (int vj = 0; vj < 4; ++vj) {
#pragma unroll
        for (int g4 = 0; g4 < 4; ++g4) { const int vc = h * 128 + 32 * vj + 8 * g4 + 4 * hh; const v2u gw = *(const v2u*)(GG + t * 512 + vc); const f32x4 gn = *(const f32x4*)(P.g_gla_head + vc);
            const float g0 = bflo(gw.x), g1 = bfhi(gw.x), g2 = bflo(gw.y), g3 = bfhi(gw.y);
            v2u ow; ow.x = pk2(ov[16 * vj + 4 * g4] * r * gn[0] * (g0 * sigmoidf_(g0)), ov[16 * vj + 4 * g4 + 1] * r * gn[1] * (g1 * sigmoidf_(g1)));
            ow.y = pk2(ov[16 * vj + 4 * g4 + 2] * r * gn[2] * (g2 * sigmoidf_(g2)), ov[16 * vj + 4 * g4 + 3] * r * gn[3] * (g3 * sigmoidf_(g3)));
            *(v2u*)(GG + t * 512 + vc) = ow; }
        asm volatile("" ::: "memory"); }
}
__device__ __forceinline__ void memattn_unit(const Ptrs& P, LAS unsigned char* lds, int hm, int qb, int wv) {
    const int tid = fresh_tid(wv), lane = tid & 63, w = wv, r32 = lane & 31, hh = lane >> 5;
    constexpr int KPB = 272, VPB = 528;
    LAS unsigned char* KM = lds; LAS unsigned char* VTM = lds + 69632; LAS float* LSUM = (LAS float*)(lds + 137216);
    const bf16* MK = (const bf16*)(P.ws + WS_MK); const bf16* MVT = (const bf16*)(P.ws + WS_MVT); bf16* MQ = (bf16*)(P.ws + WS_MQ);
#pragma unroll
    for (int j = 0; j < 8; ++j) { const int idx = tid + 512 * j; const int key = idx >> 4, ch = idx & 15; *(LAS v4u*)(KM + key * KPB + ch * 16) = *(const v4u*)(MK + (size_t)key * 512 + hm * 128 + ch * 8);
    }
    { const int dc = tid & 15, key0 = (tid >> 4) * 8; v4u in[8];
#pragma unroll
      for (int k = 0; k < 8; ++k) in[k] = *(const v4u*)(MVT + (size_t)(key0 + k) * 512 + hm * 128 + dc * 8);
#pragma unroll
      for (int jp = 0; jp < 4; ++jp) {
          unsigned e[8];
#pragma unroll
          for (int k = 0; k < 8; ++k) e[k] = jp == 0 ? in[k].x : (jp == 1 ? in[k].y : (jp == 2 ? in[k].z : in[k].w));
          const v4u lo = (v4u){(e[0] & 0xffffu) | (e[1] << 16), (e[2] & 0xffffu) | (e[3] << 16), (e[4] & 0xffffu) | (e[5] << 16), (e[6] & 0xffffu) | (e[7] << 16)};
          const v4u hi = (v4u){(e[0] >> 16) | (e[1] & 0xffff0000u), (e[2] >> 16) | (e[3] & 0xffff0000u), (e[4] >> 16) | (e[5] & 0xffff0000u), (e[6] >> 16) | (e[7] & 0xffff0000u)};
          *(LAS v4u*)(VTM + (8 * dc + 2 * jp) * VPB + key0 * 2) = lo; *(LAS v4u*)(VTM + (8 * dc + 2 * jp + 1) * VPB + key0 * 2) = hi; } }
    const size_t qrow = (size_t)qb * 256 + 32 * w + r32;
    bf16x8 qr[8];
#pragma unroll
    for (int ks = 0; ks < 8; ++ks) qr[ks] = *(const bf16x8*)(MQ + qrow * 512 + hm * 128 + 16 * ks + 8 * hh);
    LBAR();
    f32x16 p[8];
#pragma unroll
    for (int kb = 0; kb < 8; ++kb) { p[kb] = (f32x16){};
#pragma unroll
        for (int ks = 0; ks < 8; ++ks) p[kb] = MFMA32(ldfrag(KM, 32 * kb + r32, KPB, 32 * ks + 16 * hh), qr[ks], p[kb]); }
    float mx = -INFINITY;
#pragma unroll
    for (int kb = 0; kb < 8; ++kb)
#pragma unroll
        for (int i = 0; i < 16; ++i) mx = fmaxf(mx, p[kb][i]);
    mx = fmaxf(mx, __shfl_xor(mx, 32));
    float l = 0.f; v4u pk[8][2];
#pragma unroll
    for (int kb = 0; kb < 8; ++kb) {
#pragma unroll
        for (int i = 0; i < 16; ++i) { p[kb][i] = __builtin_amdgcn_exp2f(p[kb][i] - mx); l += p[kb][i]; }
#pragma unroll
        for (int s = 0; s < 2; ++s) pk[kb][s] = (v4u){pk2(p[kb][8 * s], p[kb][8 * s + 1]), pk2(p[kb][8 * s + 2], p[kb][8 * s + 3]), pk2(p[kb][8 * s + 4], p[kb][8 * s + 5]), pk2(p[kb][8 * s + 6], p[kb][8 * s + 7])}; }
    l += __shfl_xor(l, 32);
    if (hh == 0) LSUM[w * 32 + r32] = l;
    f32x16 o[4];
#pragma unroll
    for (int db = 0; db < 4; ++db) { o[db] = (f32x16){};
#pragma unroll
        for (int kb = 0; kb < 8; ++kb)
#pragma unroll
            for (int s = 0; s < 2; ++s) { const LAS unsigned char* vp = VTM + (32 * db + r32) * VPB + 64 * kb + 32 * s + 8 * hh;
                const s16x4 lo = *(const LAS s16x4*)vp, hi = *(const LAS s16x4*)(vp + 16);
                const bf16x8 bfr = (bf16x8){lo[0], lo[1], lo[2], lo[3], hi[0], hi[1], hi[2], hi[3]};
                o[db] = MFMA32(__builtin_bit_cast(bf16x8, pk[kb][s]), bfr, o[db]); } }
    LDS_WAIT(); asm volatile("" ::: "memory");
#pragma unroll
    for (int i = 0; i < 16; ++i) { const int ql = crow_(i, hh); const float rl = __builtin_amdgcn_rcpf(LSUM[w * 32 + ql]);
#pragma unroll
        for (int db = 0; db < 4; ++db) MQ[((size_t)qb * 256 + 32 * w + ql) * 512 + hm * 128 + 32 * db + r32] = (bf16)f2bf(o[db][i] * rl); }
    LBAR();
}
__device__ __forceinline__ float lse2f(float a, float b) { const float m = fmaxf(a, b), d = fminf(a, b) - m; return (m == -INFINITY) ? m : m + __log2f(1.f + __builtin_amdgcn_exp2f(d)); }
__device__ __forceinline__ void fcumsum_unit(const Ptrs& P, LAS unsigned char* lds, int hf, int wv) {
    const int tid = fresh_tid(wv), lane = tid & 63, w = wv;
    const float* LF = (const float*)(P.ws + WS_LOGF) + (size_t)hf * S_; float* F = (float*)(P.ws + WS_F) + (size_t)hf * S_;
    LAS float* X = (LAS float*)lds; LAS float* WT = (LAS float*)(lds + 69632);
#pragma unroll 8
    for (int j = 0; j < 32; ++j) { const int t = j * 512 + tid; X[t + (t >> 5)] = LF[t]; }
    LBAR();
    float loc[32]; float s = 0.f;
#pragma unroll
    for (int i = 0; i < 32; ++i) { s += X[tid * 33 + i]; loc[i] = s; }
    float incl = s;
#pragma unroll
    for (int o = 1; o < 64; o <<= 1) { const float y = __shfl_up(incl, o); if (lane >= o) incl += y; }
    if (lane == 63) WT[w] = incl;
    LBAR();
    float woff = 0.f;
#pragma unroll
    for (int ww = 0; ww < 8; ++ww) { const float a = WT[ww]; if (ww < w) woff += a; }
    const float off = woff + incl - s;
#pragma unroll
    for (int i = 0; i < 32; ++i) { loc[i] = off + loc[i]; X[tid * 33 + i] = loc[i]; }
    LBAR();
#pragma unroll 8
    for (int j = 0; j < 32; ++j) { const int t = j * 512 + tid; F[t] = X[t + (t >> 5)]; }
    LBAR();
    const float ref = loc[0]; float accl = 0.f;
#pragma unroll
    for (int i = 0; i < 32; ++i) accl += __builtin_amdgcn_exp2f((ref - loc[i]) * LOG2E_);
    float linc = __log2f(accl) - ref * LOG2E_;
#pragma unroll
    for (int o = 1; o < 64; o <<= 1) { const float y = __shfl_up(linc, o); if (lane >= o) linc = lse2f(linc, y); }
    if (lane == 63) WT[w] = linc;
    LBAR();
    float wpre = -INFINITY;
#pragma unroll
    for (int ww = 0; ww < 8; ++ww) { const float a = WT[ww]; if (ww < w) wpre = lse2f(wpre, a); }
    if ((tid & 3) == 3) ((float*)(P.ws + WS_LSEF))[hf * 128 + (tid >> 2)] = lse2f(wpre, linc);
    LBAR();
}

__device__ __forceinline__ void normmax_unit(const Ptrs& P, LAS unsigned char* lds, int j, int wv) {
    const int tid = fresh_tid(wv), r = tid >> 3, h = tid & 7;
    const bf16* FQ = (const bf16*)(P.ws + WS_FQ); const bf16* FK = (const bf16*)(P.ws + WS_FK); LAS float* RED = (LAS float*)lds;
    const v4u* qp = (const v4u*)(FQ + (size_t)(64 * j + r) * 512 + h * 64); const v4u* kp = (const v4u*)(FK + (size_t)(64 * j + r) * 512 + h * 64);
    float sq = 0.f, sk = 0.f, sd = 0.f;
#pragma unroll
    for (int c = 0; c < 8; ++c) { const v4u a = qp[c], b = kp[c];
        sq += bflo(a.x) * bflo(a.x) + bfhi(a.x) * bfhi(a.x) + bflo(a.y) * bflo(a.y) + bfhi(a.y) * bfhi(a.y) + bflo(a.z) * bflo(a.z) + bfhi(a.z) * bfhi(a.z) + bflo(a.w) * bflo(a.w) + bfhi(a.w) * bfhi(a.w);
        sk += bflo(b.x) * bflo(b.x) + bfhi(b.x) * bfhi(b.x) + bflo(b.y) * bflo(b.y) + bfhi(b.y) * bfhi(b.y) + bflo(b.z) * bflo(b.z) + bfhi(b.z) * bfhi(b.z) + bflo(b.w) * bflo(b.w) + bfhi(b.w) * bfhi(b.w);
        sd += bflo(a.x) * bflo(b.x) + bfhi(a.x) * bfhi(b.x) + bflo(a.y) * bflo(b.y) + bfhi(a.y) * bfhi(b.y) + bflo(a.z) * bflo(b.z) + bfhi(a.z) * bfhi(b.z) + bflo(a.w) * bflo(b.w) + bfhi(a.w) * bfhi(b.w); }
    RED[tid] = sq; RED[512 + tid] = sk; RED[1024 + tid] = -sd;
    LBAR();
    if (tid < 16) { const int hh = tid & 7, which = tid >> 3; float m = 0.f;
        for (int rr = 0; rr < 64; ++rr) m = fmaxf(m, RED[which * 512 + rr * 8 + hh]);
        atomicMax((unsigned*)P.ws + which * 8 + hh, __float_as_uint(m));
        if (which == 0) ((float*)(P.ws + WS_QB2))[j * 8 + hh] = m; }
    else if (tid < 24) { const int hh = tid & 7; float m = -INFINITY;
        for (int rr = 0; rr < 64; ++rr) m = fmaxf(m, RED[1024 + rr * 8 + hh]);
        ((float*)(P.ws + WS_NDOT))[j * 8 + hh] = m; }
    LBAR();
}
#define RLX_AGENT __ATOMIC_RELAXED, __HIP_MEMORY_SCOPE_AGENT
#define XB_TMO      128
#define XB_XCNT(j)  (256  + 64 * (j))
#define XB_XSUB(j)  (1280 + 64 * (j))
#define XB_XGEN(j)  (2304 + 64 * (j))
#define XB_TOP      3328
#define XB_TOPGEN   3392
#define XCD_BAR_WORDS 3456
#define XB_SPIN_CAP (1u << 18)

__device__ __forceinline__ unsigned xb_ld(unsigned* p)              { return __hip_atomic_load(p, __ATOMIC_RELAXED, __HIP_MEMORY_SCOPE_AGENT); }
__device__ __forceinline__ unsigned xb_add(unsigned* p, unsigned v) { return __hip_atomic_fetch_add(p, v, __ATOMIC_RELAXED, __HIP_MEMORY_SCOPE_AGENT); }
__device__ __forceinline__ unsigned xb_xcc_id() { return (unsigned)__builtin_amdgcn_s_getreg((3 << 11) | 20) & 0xFu; }
#define XB_SPIN(cond, bar) do { unsigned _sp = 0; while (cond) { __builtin_amdgcn_s_sleep(1); \
    if ((++_sp & 255u) == 0u) { if (xb_ld(&(bar)[XB_TMO])) break; if (_sp > XB_SPIN_CAP) { atomicAdd(&(bar)[XB_TMO], 1u); break; } } } } while (0)

struct XcdBarrier {
    unsigned* bar; unsigned x;
    volatile LAS unsigned* st;
};

__device__ __forceinline__ XcdBarrier xcd_barrier_post(unsigned* bar, volatile LAS unsigned* st, int wv) {
    XcdBarrier b; b.bar = bar; b.x = xb_xcc_id(); b.st = st;
    if (fresh_tid(wv) == 0) (void)xb_add(&bar[XB_XCNT(b.x)], 1u);
    return b;
}
__device__ __forceinline__ void xcd_barrier_complete(unsigned* bar, unsigned x, unsigned& nloc, unsigned& nx) {
    const unsigned G = gridDim.x * gridDim.y * gridDim.z;
    unsigned sum, cnt, mine, sp = 0u;
    for (;;) {
        sum = 0u; cnt = 0u; mine = 0u;
#pragma unroll
        for (unsigned j = 0; j < 16; ++j) { const unsigned c = xb_ld(&bar[XB_XCNT(j)]); sum += c; cnt += (c > 0u) ? 1u : 0u; mine = (j == x) ? c : mine; }
        if (sum == G) break;
        __builtin_amdgcn_s_sleep(1);
        if ((++sp & 255u) == 0u) { if (xb_ld(&bar[XB_TMO])) break; if (sp > XB_SPIN_CAP) { atomicAdd(&bar[XB_TMO], 1u); break; } }
    }
    nloc = mine > 0u ? mine : 1u; nx = cnt > 0u ? cnt : 1u;
}

__device__ __forceinline__ void xcd_barrier(const XcdBarrier& b, int wv) {
    asm volatile("s_waitcnt vmcnt(0)" ::: "memory");
    __syncthreads();
    if (fresh_tid(wv) == 0) {
        unsigned* bar = b.bar;
        __builtin_amdgcn_s_waitcnt(0);
        unsigned nloc = b.st[0], nx = b.st[1];
        if (nloc == 0u) { xcd_barrier_complete(bar, b.x, nloc, nx); b.st[0] = nloc; b.st[1] = nx; }
        const unsigned old = xb_add(&bar[XB_XSUB(b.x)], 1u);
        const unsigned gen = old / nloc;
        if (old + 1u == (gen + 1u) * nloc) {
            __builtin_amdgcn_fence(__ATOMIC_RELEASE, "agent");
            asm volatile("s_waitcnt vmcnt(0)" ::: "memory");
            const unsigned og = xb_add(&bar[XB_TOP], 1u);
            const unsigned tg = og / nx;
            if (og + 1u == (tg + 1u) * nx) xb_add(&bar[XB_TOPGEN], 1u);
            else XB_SPIN(xb_ld(&bar[XB_TOPGEN]) == tg, bar);
            __builtin_amdgcn_fence(__ATOMIC_ACQUIRE, "agent");
            xb_add(&bar[XB_XGEN(b.x)], 1u);
            asm volatile("s_waitcnt vmcnt(0)" ::: "memory");
        } else {
            XB_SPIN(xb_ld(&bar[XB_XGEN(b.x)]) == gen, bar);
            __builtin_amdgcn_fence(__ATOMIC_ACQUIRE, "agent");
            asm volatile("s_waitcnt vmcnt(0)" ::: "memory");
        }
    }
    __syncthreads();
}

constexpr int CW_BAR = 4096;
constexpr size_t CTL_ZERO_BYTES = 65536;
constexpr int MISC_OFF = 151552;
struct Args { const float* in[18]; float* out; unsigned char* ws; int ph_lo, ph_hi; };
constexpr int N_PHASES = 9;
__global__ void __launch_bounds__(NWAVES * 64, 2) hybrid_fwd(Args args) {
    extern __shared__ __attribute__((aligned(16))) unsigned char lds_raw[];
    cg::grid_group grid = cg::this_grid();
    LAS unsigned char* lds = (LAS unsigned char*)lds_raw;
    const int wv = __builtin_amdgcn_readfirstlane((int)(threadIdx.x >> 6));
    const int G = gridDim.x, bx = blockIdx.x; const int vcu = (G % 8 == 0) ? (bx % 8) * (G / 8) + bx / 8 : bx;
    Ptrs P;
    P.x = args.in[0]; P.mem = args.in[1]; P.g_mix = args.in[2]; P.w_in = args.in[3]; P.w_alpha_up = args.in[4]; P.b_alpha = args.in[5]; P.b_forget = args.in[6]; P.g_gla_head = args.in[7];
    P.g_mem = args.in[8]; P.w_mem_kv = args.in[9]; P.w_gla_o = args.in[10]; P.w_fox_o = args.in[11]; P.w_mem_o = args.in[12]; P.w_out = args.in[13]; P.g_ffn = args.in[14]; P.w_ff1 = args.in[15];
    P.w_ff2 = args.in[16]; P.g_final = args.in[17]; P.out = args.out; P.ws = args.ws;
    unsigned char* ws = args.ws;
    const int lo = args.ph_lo, hi = args.ph_hi;
    if (hi > 1000) grid.sync();
    volatile LAS unsigned* MISC = (volatile LAS unsigned*)(lds + MISC_OFF);
    { const int t_ = fresh_tid(wv); if (t_ < 2) MISC[t_] = 0u; }
    __syncthreads();
    const XcdBarrier bar = xcd_barrier_post((unsigned*)ws + CW_BAR, MISC, wv);
#ifndef PH_MASK
#define PH_MASK 0x3ff
#endif
#define IN(k) ((((PH_MASK) >> (k)) & 1) && lo <= (k) && (k) < hi)
#ifdef PROBE_PHASE
#define STAMP(k) do { if (bx == 0 && fresh_tid(wv) == 0) ((unsigned long long*)(ws + 253 * MiB))[(k)] = __builtin_amdgcn_s_memrealtime(); } while (0)
#else
#define STAMP(k) do {} while (0)
#endif
#define SEAM(k) do { if (lo <= (k) && (k) + 1 < hi) xcd_barrier(bar, wv); STAMP((k) + 1); } while (0)

    STAMP(0);
#define STAGGER() do { const int grp_ = (bx >> 3) & 3; for (int i_ = 0; i_ < grp_; ++i_) __builtin_amdgcn_s_sleep(127); } while (0)
    if (IN(0)) { p0_prologue(P, lds, vcu, G, wv); __syncthreads(); }
    SEAM(0);
    if (IN(1)) {
        ProjSched S{(const char*)P.out + OUT_U, (const char*)(ws + WS_MEMN), (const char*)(ws + WS_WIN), G, bx, wv};
        EpiProj E{ws, P.b_forget};
        STAGGER();
        pg8::gemm_phase<EpiProj, ProjSched, true, true>(lds, 1024, 1024, 1024, S, E);
    }
    SEAM(1);
    if (IN(2)) {
        if (bx < 8) fcumsum_unit(P, lds, bx, wv);
        else for (int u = bx - 8; u < 256; u += G - 8) normmax_unit(P, lds, u, wv);
    }
    SEAM(2);
    if (IN(3)) {
        const attn_body::AttnTensors AT{(const attn_body::bf16*)(ws + WS_FQ), (const attn_body::bf16*)(ws + WS_FK), (const attn_body::bf16*)(ws + WS_FV), (attn_body::bf16*)(ws + WS_FQ), (const float*)(ws + WS_F)};
        LAS float* THRU = (LAS float*)(lds + MISC_OFF + 128); volatile LAS unsigned* qslot = (volatile LAS unsigned*)(lds + MISC_OFF + 32);
        { const int i_ = fresh_tid(wv); const int h_ = i_ & 7, qb_ = i_ >> 3;
          const float* QB2 = (const float*)(ws + WS_QB2); const float* NDOT = (const float*)(ws + WS_NDOT); const float k2 = __uint_as_float(((const unsigned*)ws)[8 + h_]);
          float a2 = 0.f, b = -INFINITY;
#pragma unroll
          for (int bb = 0; bb < 4; ++bb) { a2 = fmaxf(a2, QB2[(4 * qb_ + bb) * 8 + h_]); b = fmaxf(b, NDOT[(4 * qb_ + bb) * 8 + h_]); }
          THRU[qb_ * 8 + h_] = -(24.1f + 1.01f * sqrtf(a2 * k2) + b); }
        __syncthreads();
        for (;;) {
            if (fresh_tid(wv) == 0) qslot[0] = __hip_atomic_fetch_add((unsigned*)ws + 64, 1u, __ATOMIC_RELAXED, __HIP_MEMORY_SCOPE_AGENT);
            asm volatile("s_waitcnt vmcnt(0) lgkmcnt(0)\n\ts_barrier" ::: "memory");
            const int idx = __builtin_amdgcn_readfirstlane((int)qslot[0]);
            if (idx >= 1792) break;
            if (idx < 512) { const int h = idx & 7, qb = 63 - (idx >> 3); attn_body::attn_unit<8>(0, h, qb, AT.Q, AT.K, AT.V, AT.O, AT.F + (size_t)h * S_, (const float*)(ws + WS_LSEF) + h * 128, THRU[qb * 8 + h], (char*)lds_raw, wv); }
            else if (idx < 768) memattn_unit(P, lds, (idx - 512) & 3, (idx - 512) >> 2, wv);
            else gla_a_unit(P, lds, (idx - 768) >> 2, (idx - 768) & 3, wv);
        }
    }
    SEAM(3);
    if (IN(3)) { for (int u = bx; u < 256; u += G) gla_scan_unit(P, lds, u, wv); }
    if (lo <= 3 && 4 < hi) xcd_barrier(bar, wv);
    STAMP(40);

    if (IN(4)) { for (int task = bx * NWAVES + wv; task < 2048; task += G * NWAVES) { const int lane_ = fresh_tid(wv) & 63; gla_b_task(P, task, lane_); } }
    SEAM(4);
    if (IN(5)) {
        static_assert(WS_FQ - WS_GG == 16 * MiB && WS_MQ - WS_FQ == 16 * MiB && WS_WFOXO - WS_WGLAO == MiB && WS_WMEMO - WS_WFOXO == MiB, "merge operand spacing");
        MergeSched S{(const char*)(ws + WS_GG), (const char*)(ws + WS_WGLAO), G, bx, wv, 16 * MiB - 1024, MiB - 1024};
        EpiMerge E{(bf16*)(ws + WS_MG), (const bf16*)(ws + WS_GT)};
        pg8::gemm_phase<EpiMerge, MergeSched, true, true, 8>(lds, 1536, 512, 512, S, E);
    }
    SEAM(5);
    if (IN(6)) {
        GemmSched S{(const char*)(ws + WS_MG), (const char*)(ws + WS_WOUT), 64, 4, 1024, 1024, G, bx, wv};
        EpiResid<true, false> E{P.x, (bf16*)(ws + WS_H0), (bf16*)(ws + WS_H1) - (size_t)8192 * 1024, (bf16*)(ws + WS_U2), P.g_ffn, (float*)(ws + WS_SS1)};
        pg8::gemm_phase<EpiResid<true, false>, GemmSched, true, true>(lds, 1024, 1024, 1024, S, E);
    }
    SEAM(6);
    if (IN(7)) {
        GemmSched S{(const char*)(ws + WS_U2), (const char*)(ws + WS_WFF1), 64, 16, 1024, 1024, G, bx, wv};
        EpiFfn1 E{(bf16*)(ws + WS_HID), (const float*)(ws + WS_SS1)};
        STAGGER();
        pg8::gemm_phase<EpiFfn1, GemmSched, true, true>(lds, 1024, 1024, 1024, S, E);
    }
    SEAM(7);
    if (IN(8)) {
        GemmSched S{(const char*)(ws + WS_HID), (const char*)(ws + WS_WFF2), 64, 4, 4096, 4096, G, bx, wv};
        EpiFinal E{(const bf16*)(ws + WS_H0), (const bf16*)(ws + WS_H1) - (size_t)8192 * 1024, P.out, P.g_final, (float*)(ws + WS_SS2), (unsigned*)ws + CW_PANEL};
        pg8::gemm_phase<EpiFinal, GemmSched, false, true>(lds, 4096, 4096, 4096, S, E);
    }
    STAMP(9);
#ifdef PROBE_PHASE
    __syncthreads(); xcd_barrier(bar, wv); STAMP(10);
    if (PROBE_PHASE == 200) { xcd_barrier(bar, wv); xcd_barrier(bar, wv); xcd_barrier(bar, wv); xcd_barrier(bar, wv); STAMP(11); }
    if (bx == 0) { __syncthreads(); const unsigned long long* ts = (const unsigned long long*)(ws + 253 * MiB);
        long K = (PROBE_PHASE < 0) ? 100000 : (PROBE_PHASE == 200) ? (long)(ts[11] - ts[10]) * 10 : (PROBE_PHASE == 777) ? (long)((ts[61] - ts[60]) / 5 + 540 * ((ts[62] - ts[61]) / 5)) : (PROBE_PHASE == 778) ? (long)((ts[63] - ts[62]) / 5 + 540 * ((ts[64] - ts[63]) / 5)) : (PROBE_PHASE >= 1000) ? (long)(ts[PROBE_PHASE % 1000] - ts[PROBE_PHASE / 1000]) : (PROBE_PHASE >= 100 ? (long)(ts[10] - ts[0]) / 10 : (long)(ts[PROBE_PHASE + 1] - ts[PROBE_PHASE]));
        if (K > 300000) K = 300000;
        for (long i = fresh_tid(wv); i < K; i += 512) P.out[i] += 0.1f; }
#endif
#undef IN
#undef SEAM
}

extern "C" void kernel_launch(void* const* d_in, const int* in_sizes, int n_in, void* d_out, int out_size, void* d_ws, size_t ws_size, hipStream_t stream) {
    static int grid = 0;
    if (grid == 0) {
        if (n_in != 18 || out_size != S_ * DM_ || ws_size < WS_END) { fprintf(stderr, "kernel_launch: unexpected shapes (n_in %d out %d ws %zu)\n", n_in, out_size, ws_size); grid = -1; return; }
        int dev = 0, cus = 0, per_cu = 0;
        (void)hipGetDevice(&dev); (void)hipDeviceGetAttribute(&cus, hipDeviceAttributeMultiprocessorCount, dev);
        (void)hipFuncSetAttribute((const void*)hybrid_fwd, hipFuncAttributeMaxDynamicSharedMemorySize, LDS_BYTES);
        (void)hipOccupancyMaxActiveBlocksPerMultiprocessor(&per_cu, (const void*)hybrid_fwd, NWAVES * 64, LDS_BYTES);
        (void)hipGetLastError();
        grid = 256;
        if (cus != 256 || per_cu < 1) fprintf(stderr, "kernel_launch: note: cus %d per_cu %d (built for 256 CUs, one workgroup each)\n", cus, per_cu);
    }
    if (grid < 0) return;
    (void)hipMemsetAsync(d_ws, 0, CTL_ZERO_BYTES, stream);
    Args a{};
    for (int i = 0; i < 18; ++i) a.in[i] = (const float*)d_in[i];
    a.out = (float*)d_out; a.ws = (unsigned char*)d_ws;
#ifndef MK_PER_PHASE
    a.ph_lo = 0; a.ph_hi = N_PHASES;
    { void* kargs[] = {&a}; hipError_t e = hipLaunchCooperativeKernel((const void*)hybrid_fwd, dim3(grid), dim3(NWAVES * 64), kargs, LDS_BYTES, stream);
      if (e != hipSuccess) fprintf(stderr, "cooperative launch failed: %s\n", hipGetErrorString(e)); }
#else
    for (int k = 0; k < N_PHASES; ++k) { a.ph_lo = k; a.ph_hi = k + 1; void* kargs[] = {&a};
        hipError_t e = hipLaunchCooperativeKernel((const void*)hybrid_fwd, dim3(grid), dim3(NWAVES * 64), kargs, LDS_BYTES, stream);
        if (e != hipSuccess) { fprintf(stderr, "cooperative launch %d failed: %s\n", k, hipGetErrorString(e)); break; } }
#endif
}
```

```cpp
#include <hip/hip_runtime.h>
#include <hip/hip_cooperative_groups.h>
#include <hip/hip_bf16.h>
#include <cstdio>
#include <cstdint>
#include <cmath>
namespace cg = cooperative_groups;
__device__ __forceinline__ int fresh_tid(int wv) { int lane_; asm volatile("v_mbcnt_lo_u32_b32 %0, -1, 0\n\tv_mbcnt_hi_u32_b32 %0, -1, %0" : "=v"(lane_)); return wv * 64 + lane_; }
namespace pg8 {
#define PG8_LAS __attribute__((address_space(3)))
typedef unsigned short bf16_t;
typedef short bf16x8 __attribute__((ext_vector_type(8)));
typedef float f32x4 __attribute__((ext_vector_type(4)));
typedef unsigned u32x4 __attribute__((ext_vector_type(4)));
constexpr int BM = 256, BK = 64, HALF = 128, HTB = HALF * BK * 2  , STAGE_BYTES = 8 * HTB, NXCD = 8, WGM = 8;

__host__ __device__ __forceinline__ int lds_byte(int r, int c) { const int st = (r >> 4) * 2 + (c >> 5), rr = r & 15, cc = c & 31, ob = rr * 64 + cc * 2; return st * 1024 + (ob ^ (((ob >> 9) & 1) << 5)); }
__host__ __device__ __forceinline__ void stage_rc(int b, int& R, int& C) { const int st = b / 1024, sb = b % 1024, swz = sb ^ (((sb >> 9) & 1) << 5); R = (st >> 1) * 16 + swz / 64; C = (st & 1) * 32 + (swz % 64) / 2; }
__host__ __device__ __forceinline__ int perm32(int rho) { const int n = rho >> 4, i = rho & 15; return 8 * (i >> 2) + 4 * n + (i & 3); }

struct Unit { int pm, pn, z; };
__device__ __forceinline__ unsigned cvt_pk_bf16(float lo, float hi) { unsigned r; asm volatile("v_cvt_pk_bf16_f32 %0, %1, %2" : "=v"(r) : "v"(lo), "v"(hi)); return r; }
__device__ __forceinline__ void map_tile(int L, int nM, int nN, int& pm, int& pn) {
    const int nwg = nM * nN; int wgid = L; { const int q = nwg / NXCD, r = nwg % NXCD, xcd = wgid % NXCD, off = wgid / NXCD; wgid = (xcd < r ? xcd * (q + 1) : r * (q + 1) + (xcd - r) * q) + off; }
    const int nig = WGM * nN, gid = wgid / nig, fm = gid * WGM, gsz = (nM - fm) < WGM ? (nM - fm) : WGM;
    pm = fm + ((wgid % nig) % gsz); pn = (wgid % nig) / gsz;
}
template <class Epi, class Sched, bool ALIGN_EPI = false, bool SP2 = false, int SEGT = 0>
__device__ __forceinline__ void gemm_phase(PG8_LAS unsigned char* lds, const int K, const int lda, const int ldb, const Sched& S, const Epi& E) {
    const int tid = fresh_tid(S.wv), wid = S.wv, lane = tid & 63, wr = wid >> 2, wc = wid & 3, fr = lane & 15, fq = lane >> 4;
    const int nt = K / BK;
    unsigned voffA[2], voffB[2];
#pragma unroll
    for (int i = 0; i < 2; ++i) { int R, C; stage_rc(tid * 16 + i * 8192, R, C); const int Rb = Epi::PERM ? ((R & ~31) + perm32(R & 31)) : R;
        voffA[i] = (unsigned)(R * lda + C) * 2u; voffB[i] = (unsigned)(Rb * ldb + C) * 2u; }
    const size_t kstep = (size_t)(BK * 2);
    const size_t hstepA = (size_t)HALF * lda * 2, hstepB = (size_t)HALF * ldb * 2;
    const unsigned ldsw = (unsigned)wid * 1024u;
    const int aoff = lds_byte(wr * 64 + fr, fq * 8), boff = lds_byte(wc * 32 + fr, fq * 8);
#define PG8_SA(b, h) (((b) * 2 + (h)) * HTB)
#define PG8_SB(b, h) ((4 + (b) * 2 + (h)) * HTB)
#define PG8_STAGE(bufoff, gbase, voff) do { _Pragma("unroll") for (int _i = 0; _i < 2; ++_i) \
        __builtin_amdgcn_global_load_lds((const unsigned*)((const char*)(gbase) + (voff)[_i]), (PG8_LAS unsigned*)(lds + (bufoff) + ldsw + _i * 8192), 16, 0, 0); } while (0)
#define PG8_LDA(dst, b, h) do { _Pragma("unroll") for (int m = 0; m < 4; ++m) _Pragma("unroll") for (int k = 0; k < 2; ++k) dst[m][k] = *(const PG8_LAS bf16x8*)(lds + PG8_SA(b, h) + aoff + m * 2048 + k * 1024); } while (0)
#define PG8_LDB(dst, b, h) do { _Pragma("unroll") for (int n = 0; n < 2; ++n) _Pragma("unroll") for (int k = 0; k < 2; ++k) dst[n][k] = *(const PG8_LAS bf16x8*)(lds + PG8_SB(b, h) + boff + n * 2048 + k * 1024); } while (0)
#define PG8_MMA(ai, bj, At, Bt) do { __builtin_amdgcn_s_setprio(1); _Pragma("unroll") for (int m = 0; m < 4; ++m) _Pragma("unroll") for (int n = 0; n < 2; ++n) _Pragma("unroll") for (int k = 0; k < 2; ++k) \
        acc[ai][bj][m][n] = __builtin_amdgcn_mfma_f32_16x16x32_bf16(Bt[n][k], At[m][k], acc[ai][bj][m][n], 0, 0, 0); __builtin_amdgcn_s_setprio(0); } while (0)
#define PG8_WAIT_V(n) asm volatile("s_waitcnt vmcnt(" #n ")" ::: "memory")
#define PG8_WAIT_L(n) asm volatile("s_waitcnt lgkmcnt(" #n ")" ::: "memory")
#define PG8_BAR __builtin_amdgcn_s_barrier()
#define PG8_SCHED __builtin_amdgcn_sched_barrier(0)
    Unit cur, nxt; int ui = 0;
    if (!S.next(0, cur)) return;
    f32x4 acc[2][2][4][2];
#pragma unroll
    for (int a = 0; a < 2; ++a)
#pragma unroll
        for (int b = 0; b < 2; ++b)
#pragma unroll
            for (int m = 0; m < 4; ++m)
#pragma unroll
                for (int n = 0; n < 2; ++n) acc[a][b][m][n] = (f32x4){0.f, 0.f, 0.f, 0.f};
    bf16x8 At[4][2], B0[2][2], B1[2][2];
    const char* cA = S.aptr(cur); const char* cB = S.bptr(cur);
    S.a_ready(cur);
    if constexpr (SP2) {
        PG8_STAGE(PG8_SB(0, 0), cB, voffB); PG8_STAGE(PG8_SB(0, 1), cB + hstepB, voffB); PG8_STAGE(PG8_SA(0, 0), cA, voffA); PG8_STAGE(PG8_SA(0, 1), cA + hstepA, voffA);
        if (wr == 1) PG8_BAR;
        PG8_WAIT_V(2); PG8_BAR;
        PG8_STAGE(PG8_SB(1, 0), cB + kstep, voffB); PG8_STAGE(PG8_SA(1, 0), cA + kstep, voffA); PG8_STAGE(PG8_SB(1, 1), cB + hstepB + kstep, voffB);
        PG8_WAIT_V(6); PG8_BAR;
    } else {
        PG8_STAGE(PG8_SB(0, 0), cB, voffB); PG8_STAGE(PG8_SA(0, 0), cA, voffA); PG8_STAGE(PG8_SB(0, 1), cB + hstepB, voffB); PG8_STAGE(PG8_SA(0, 1), cA + hstepA, voffA);
        if (wr == 1) PG8_BAR;
        PG8_WAIT_V(4); PG8_BAR;
        PG8_STAGE(PG8_SB(1, 0), cB + kstep, voffB); PG8_STAGE(PG8_SA(1, 0), cA + kstep, voffA); PG8_STAGE(PG8_SB(1, 1), cB + hstepB + kstep, voffB);
        PG8_WAIT_V(6); PG8_BAR;
    }
    for (;;) {
        const bool has_next = S.next(ui + 1, nxt);
        const char* nA = has_next ? S.aptr(nxt) : cA; const char* nB = has_next ? S.bptr(nxt) : cB;
        for (int t = 0; t < nt; t += 2) {
            const bool last = (t == nt - 2);
            size_t sa1 = 0, sa2 = 0, sb2 = 0;
            if constexpr (SEGT > 0) { if (t > 0 && (t % SEGT) == 0) E.mid(acc, cur, t / SEGT, wr, wc, fr, fq);
                sa1 = (size_t)(t / SEGT) * S.segA; sa2 = (size_t)((t + 2) / SEGT) * S.segA; sb2 = (size_t)((t + 2) / SEGT) * S.segB; }
            const char* a1 = cA + (size_t)(t + 1) * kstep + sa1;
            const char* a2 = last ? nA : cA + (size_t)(t + 2) * kstep + sa2; const char* b2 = last ? nB : cB + (size_t)(t + 2) * kstep + sb2;
            const char* a3 = a2 + kstep; const char* b3 = b2 + kstep;
            if (last && has_next) S.a_ready(nxt);
            if constexpr (SP2) {
            PG8_LDB(B0, 0, 0); PG8_LDB(B1, 0, 1); PG8_SCHED; PG8_LDA(At, 0, 0); PG8_STAGE(PG8_SA(1, 1), a1 + hstepA, voffA);
            PG8_WAIT_V(8); PG8_WAIT_L(0); PG8_BAR; PG8_MMA(0, 0, At, B0); PG8_MMA(0, 1, At, B1); PG8_BAR; PG8_SCHED;
            PG8_LDA(At, 0, 1); PG8_STAGE(PG8_SB(0, 0), b2, voffB); PG8_STAGE(PG8_SB(0, 1), b2 + hstepB, voffB); PG8_STAGE(PG8_SA(0, 0), a2, voffA);
            PG8_WAIT_V(8); PG8_WAIT_L(0); PG8_BAR; PG8_MMA(1, 0, At, B0); PG8_MMA(1, 1, At, B1); PG8_BAR; PG8_SCHED;
            PG8_LDB(B0, 1, 0); PG8_LDB(B1, 1, 1); PG8_SCHED; PG8_LDA(At, 1, 0); PG8_STAGE(PG8_SA(0, 1), a2 + hstepA, voffA);
            PG8_WAIT_V(8); PG8_WAIT_L(0); PG8_BAR; PG8_MMA(0, 0, At, B0); PG8_MMA(0, 1, At, B1); PG8_BAR; PG8_SCHED;
            PG8_LDA(At, 1, 1); PG8_STAGE(PG8_SB(1, 0), b3, voffB); PG8_STAGE(PG8_SB(1, 1), b3 + hstepB, voffB); PG8_STAGE(PG8_SA(1, 0), a3, voffA);
            PG8_WAIT_V(8); PG8_WAIT_L(0); PG8_BAR; PG8_MMA(1, 0, At, B0); PG8_MMA(1, 1, At, B1); PG8_BAR; PG8_SCHED;
            } else {
            PG8_LDB(B0, 0, 0); PG8_SCHED; PG8_LDA(At, 0, 0); PG8_STAGE(PG8_SA(1, 1), a1 + hstepA, voffA);
            PG8_WAIT_L(8); PG8_BAR; PG8_WAIT_L(0); PG8_MMA(0, 0, At, B0); PG8_BAR; PG8_SCHED;
            PG8_LDB(B1, 0, 1); PG8_STAGE(PG8_SB(0, 0), b2, voffB);
            PG8_BAR; PG8_WAIT_L(0); PG8_MMA(0, 1, At, B1); PG8_BAR;
            PG8_LDA(At, 0, 1); PG8_STAGE(PG8_SA(0, 0), a2, voffA);
            PG8_BAR; PG8_WAIT_L(0); PG8_MMA(1, 0, At, B0); PG8_BAR; PG8_SCHED;
            PG8_STAGE(PG8_SB(0, 1), b2 + hstepB, voffB);
            PG8_WAIT_V(6); PG8_BAR; PG8_MMA(1, 1, At, B1); PG8_BAR;
            PG8_LDB(B0, 1, 0); PG8_SCHED; PG8_LDA(At, 1, 0); PG8_STAGE(PG8_SA(0, 1), a2 + hstepA, voffA);
            PG8_WAIT_L(8); PG8_BAR; PG8_WAIT_L(0); PG8_MMA(0, 0, At, B0); PG8_BAR; PG8_SCHED;
            PG8_LDB(B1, 1, 1); PG8_STAGE(PG8_SB(1, 0), b3, voffB);
            PG8_BAR; PG8_WAIT_L(0); PG8_MMA(0, 1, At, B1); PG8_BAR;
            PG8_LDA(At, 1, 1); PG8_STAGE(PG8_SA(1, 0), a3, voffA);
            PG8_BAR; PG8_WAIT_L(0); PG8_MMA(1, 0, At, B0); PG8_BAR; PG8_SCHED;
            PG8_STAGE(PG8_SB(1, 1), b3 + hstepB, voffB);
            PG8_WAIT_V(6); PG8_BAR; PG8_MMA(1, 1, At, B1); PG8_BAR;
            }
        }
        if constexpr (ALIGN_EPI) { if (wr == 0) PG8_BAR; }
        if constexpr (!Epi::AFTER_DRAIN) { E(acc, cur, wr, wc, fr, fq); S.done(cur); }
        if (!has_next) break;
#pragma unroll
        for (int a = 0; a < 2; ++a)
#pragma unroll
            for (int b = 0; b < 2; ++b)
#pragma unroll
                for (int m = 0; m < 4; ++m)
#pragma unroll
                    for (int n = 0; n < 2; ++n) acc[a][b][m][n] = (f32x4){0.f, 0.f, 0.f, 0.f};
        cur = nxt; cA = nA; cB = nB; ++ui;
        if constexpr (ALIGN_EPI) { if (wr == 1) PG8_BAR; }
    }
    PG8_WAIT_V(0);
    if constexpr (!ALIGN_EPI) { if (wr == 0) PG8_BAR; }
    PG8_BAR;
    if constexpr (Epi::AFTER_DRAIN) { E.fused(acc, cur, wr, wc, fr, fq, lds, wid, lane); S.done(cur); }
#undef PG8_SA
#undef PG8_SB
#undef PG8_STAGE
#undef PG8_LDA
#undef PG8_LDB
#undef PG8_MMA
#undef PG8_WAIT_V
#undef PG8_WAIT_L
#undef PG8_BAR
#undef PG8_SCHED
}
}
#include <hip/hip_bf16.h>
namespace attn_body {
using bf16=__hip_bfloat16;
using bf16x8=__attribute__((ext_vector_type(8)))short;
using s16x4=__attribute__((ext_vector_type(4)))short;
using f32x16=__attribute__((ext_vector_type(16)))float;
using u32x4=__attribute__((ext_vector_type(4)))unsigned;
constexpr int BATCH=1,NHEAD=8,SEQ=16384,D=64,DM=NHEAD*D;
constexpr int NW=8,QBLK=32,QB=QBLK*NW,KVBLK=64,NQB=SEQ/QB;
constexpr int ATTN_PITCH=DM, ATTN_UNIT_ROWS=QB;
__device__ __forceinline__ int crow(int r,int hi){return (r&3)+8*(r>>2)+4*hi;}
#define SBAR() __builtin_amdgcn_sched_barrier(0)
__device__ __forceinline__ void cmask(f32x16&p0,f32x16&p1,int jb,int qrel,int hi){
  const float NEG=-INFINITY; int kb=64*jb+4*hi;
  #pragma unroll
  for(int r=0;r<16;++r){int kv=kb+(r&3)+8*(r>>2); if(kv>qrel)p0[r]=NEG; if(kv+32>qrel)p1[r]=NEG;}
}

constexpr int NSLOT=3, SLOTB=8192;
constexpr int LDS_K=0, LDS_V=NSLOT*SLOTB, LDS_WS=2*NSLOT*SLOTB, LDS_OST=LDS_WS+NW*64*4, LDS_BIAS=LDS_OST+NW*4096, LDS_BYTES=LDS_BIAS+SEQ*4+512;
constexpr float C2=0.125f*1.4426950408889634f;
__device__ __forceinline__ void glds16(const void*gsrc,unsigned lds_dst){unsigned keep;
  asm volatile("s_mov_b32 %0, m0\n\ts_mov_b32 m0, %2\n\ts_nop 0\n\tglobal_load_lds_dwordx4 %1, off\n\ts_mov_b32 m0, %0":"=&s"(keep):"v"(gsrc),"s"(lds_dst):"memory");}
__device__ __forceinline__ float max3f(float a,float b,float c){float r;asm("v_max3_f32 %0, %1, %2, %3":"=v"(r):"v"(a),"v"(b),"v"(c));return r;}
__device__ __forceinline__ float max2f(float a,float b){float r;asm("v_max_f32_e32 %0, %1, %2":"=v"(r):"v"(a),"v"(b));return r;}
__device__ __forceinline__ float fadd_s(float a,float b){float r;asm("v_add_f32_e32 %0, %1, %2":"=v"(r):"v"(a),"v"(b));return r;}
__device__ __forceinline__ float fsub_s(float a,float b){float r;asm("v_sub_f32_e32 %0, %1, %2":"=v"(r):"v"(a),"v"(b));return r;}
typedef float f32x2_t __attribute__((ext_vector_type(2))); typedef __bf16 bf16x2_t __attribute__((ext_vector_type(2)));
__device__ __forceinline__ unsigned cvtpk_s(float lo,float hi){f32x2_t v={lo,hi};bf16x2_t b=__builtin_convertvector(v,bf16x2_t);return __builtin_bit_cast(unsigned,b);}
#define WAIT_BAR(N) asm volatile("s_waitcnt vmcnt(" #N ") lgkmcnt(0)\n\ts_barrier":::"memory")

__device__ __forceinline__ void qkt(f32x16&p0,f32x16&p1,const char*Kslot,const bf16x8*qr,int r32,int hi){
  const char*kb=Kslot+hi*1024+r32*16;
  #pragma unroll
  for(int d0=0;d0<4;++d0){
    const bf16x8 b0=*reinterpret_cast<const bf16x8*>(kb+d0*2048);
    const bf16x8 b1=*reinterpret_cast<const bf16x8*>(kb+d0*2048+512);
    p0=__builtin_amdgcn_mfma_f32_32x32x16_bf16(b0,qr[d0],p0,0,0,0);p1=__builtin_amdgcn_mfma_f32_32x32x16_bf16(b1,qr[d0],p1,0,0,0);}
}
typedef __attribute__((address_space(3))) const char* lds_cptr;
typedef short v4i16_t __attribute__((ext_vector_type(4)));
__device__ __forceinline__ void kload8(bf16x8*kf,lds_cptr kp){
  kf[0]=*(const __attribute__((address_space(3))) bf16x8*)(kp);      kf[1]=*(const __attribute__((address_space(3))) bf16x8*)(kp+512);
  kf[2]=*(const __attribute__((address_space(3))) bf16x8*)(kp+2048); kf[3]=*(const __attribute__((address_space(3))) bf16x8*)(kp+2560);
  kf[4]=*(const __attribute__((address_space(3))) bf16x8*)(kp+4096); kf[5]=*(const __attribute__((address_space(3))) bf16x8*)(kp+4608);
  kf[6]=*(const __attribute__((address_space(3))) bf16x8*)(kp+6144); kf[7]=*(const __attribute__((address_space(3))) bf16x8*)(kp+6656);
}
__device__ __forceinline__ void kload2(bf16x8*kf,lds_cptr kp,int j){ kf[2*j]=*(const __attribute__((address_space(3))) bf16x8*)(kp+j*2048); kf[2*j+1]=*(const __attribute__((address_space(3))) bf16x8*)(kp+j*2048+512); }
__device__ __forceinline__ s16x4 vtr(lds_cptr p){ return __builtin_bit_cast(s16x4,__builtin_amdgcn_ds_read_tr16_b64_v4i16((__attribute__((address_space(3))) v4i16_t*)p)); }
__device__ __forceinline__ float rowmax(const f32x16&p0,const f32x16&p1){
  float a=max3f(p0[0],p0[1],p1[0]),b=max3f(p0[2],p0[3],p1[1]);a=max3f(a,p1[2],p1[3]);
  #pragma unroll
  for(int r=4;r<16;r+=4){a=max3f(a,p0[r],p0[r+1]);b=max3f(b,p0[r+2],p0[r+3]);a=max3f(a,p1[r],p1[r+1]);b=max3f(b,p1[r+2],p1[r+3]);}
  const float m=max2f(a,b);
  auto rr=__builtin_amdgcn_permlane32_swap(__float_as_uint(m),__float_as_uint(m),false,false);
  return max2f(__uint_as_float(rr[0]),__uint_as_float(rr[1]));
}
__device__ __forceinline__ void pv(f32x16*o,int vb,bf16x8 pa0,bf16x8 pa1,bf16x8 pa2,bf16x8 pa3){
  #pragma unroll
  for(int d0=0;d0<2;++d0){s16x4 lo[4],hi[4];
    #pragma unroll
    for(int ks=0;ks<4;++ks){
      asm volatile("ds_read_b64_tr_b16 %0,%1 offset:%c2":"=&v"(lo[ks]):"v"(vb),"i"(d0*4096+ks*1024):"memory");
      asm volatile("ds_read_b64_tr_b16 %0,%1 offset:%c2":"=&v"(hi[ks]):"v"(vb),"i"(d0*4096+ks*1024+512):"memory");}
    asm volatile("s_waitcnt lgkmcnt(0)":::"memory");SBAR();
    #define PK(k) (bf16x8){lo[k][0],lo[k][1],lo[k][2],lo[k][3],hi[k][0],hi[k][1],hi[k][2],hi[k][3]}
    o[d0]=__builtin_amdgcn_mfma_f32_32x32x16_bf16(pa0,PK(0),o[d0],0,0,0);
    o[d0]=__builtin_amdgcn_mfma_f32_32x32x16_bf16(pa1,PK(1),o[d0],0,0,0);
    o[d0]=__builtin_amdgcn_mfma_f32_32x32x16_bf16(pa2,PK(2),o[d0],0,0,0);
    o[d0]=__builtin_amdgcn_mfma_f32_32x32x16_bf16(pa3,PK(3),o[d0],0,0,0);
    #undef PK
  }
}

#ifndef ATTN_STORE16
#define ATTN_STORE16(p,v) (*(u32x4*)(p)=(v))
#endif
typedef float f32x4_t __attribute__((ext_vector_type(4)));
template<int THRL> __device__ __forceinline__ void attn_unit(int b,int h,int qb,const bf16*Q,const bf16*__restrict__ K,const bf16*__restrict__ V,bf16*O,const float*__restrict__ Fh,const float*__restrict__ Lh,float thrb,char*shm,int wv){
  const int tid=fresh_tid(wv),lane=tid&63,r32=lane&31,hi=lane>>5; const int wid=wv;
  const long rowbase=(long)b*SEQ; const int q0=qb*QB;
  const bf16*Qw=Q+(rowbase+q0+wid*QBLK)*DM+h*D;
  const lds_cptr shm3=(lds_cptr)shm;
  const float fref=Fh[q0];
  int T0; { __attribute__((address_space(3))) float* pb=(__attribute__((address_space(3))) float*)(shm3+LDS_WS);
    if(tid<2*qb) pb[tid]=Lh[tid]+fref*1.4426950408889634f;
    asm volatile("s_waitcnt lgkmcnt(0)\n\ts_barrier":::"memory");
    int lo_=0,hi_=2*qb; while(lo_<hi_){ const int mid=(lo_+hi_)>>1; if(!(pb[mid]<=thrb)) hi_=mid; else lo_=mid+1; } T0=__builtin_amdgcn_readfirstlane(2*lo_); }
  { __attribute__((address_space(3))) float* bl=(__attribute__((address_space(3))) float*)(shm3+LDS_BIAS);
    #pragma unroll 4
    for(int s=64*T0+tid;s<q0+QB;s+=NW*64) bl[s]=(fref-Fh[s])*1.4426950408889634f; }
  const bf16*Kh=K+(rowbase+(long)T0*KVBLK)*DM+h*D,*Vh=V+(rowbase+(long)T0*KVBLK)*DM+h*D;
  const unsigned lds0=(unsigned)(uintptr_t)shm;
  float*wsf=(float*)(shm+LDS_WS)+wid*64;
  const bf16*ksrc=Kh+(long)lane*DM+wid*8;
  const bf16*vsrc=Vh+(long)(16*(wid&3)+(lane>>2))*DM+(wid>>2)*32+(lane&3)*8;
  const unsigned kdst=lds0+LDS_K+wid*1024, vdst=lds0+LDS_V+wid*1024;
  #define DMA_K(t,slot) glds16(ksrc+(long)(t)*KVBLK*DM,(unsigned)__builtin_amdgcn_readfirstlane(kdst+(slot)))
  #define DMA_V(t,slot) glds16(vsrc+(long)(t)*KVBLK*DM,(unsigned)__builtin_amdgcn_readfirstlane(vdst+(slot)))
  const int vb0=(int)(lds0+LDS_V)+((lane>>4)&1)*32+(lane&3)*8+(4*hi+((lane&15)>>2))*64;
  const char*Kbase=shm+LDS_K; bf16x8 kf[8];
  const lds_cptr kp0=shm3+LDS_K+hi*1024+r32*16; const lds_cptr vp0=shm3+LDS_V+((lane>>4)&1)*32+(lane&3)*8+(4*hi+((lane&15)>>2))*64;
  const int NT=(q0+QB)/KVBLK-T0;
  #define BLOAD(X0,X1,tt) do{ const __attribute__((address_space(3))) f32x4_t* bp_=(const __attribute__((address_space(3))) f32x4_t*)(shm3+LDS_BIAS+(((tt)+T0)*64+4*hi)*4); \
    _Pragma("unroll") for(int g_=0;g_<4;++g_){ const f32x4_t a_=bp_[2*g_], b_=bp_[8+2*g_]; \
      X0[4*g_]=a_[0];X0[4*g_+1]=a_[1];X0[4*g_+2]=a_[2];X0[4*g_+3]=a_[3]; X1[4*g_]=b_[0];X1[4*g_+1]=b_[1];X1[4*g_+2]=b_[2];X1[4*g_+3]=b_[3]; } }while(0)
  DMA_K(0,0);DMA_V(0,0);DMA_K(1,SLOTB);
  bf16x8 qr[4];
  #pragma unroll
  for(int d0=0;d0<4;++d0)qr[d0]=*reinterpret_cast<const bf16x8*>(&Qw[(long)r32*DM+d0*16+hi*8]);
  float mhat=0.f,l_reg=0.f;f32x16 o[2];o[0]=f32x16{};o[1]=f32x16{};
  const int qrel=wid*QBLK+r32;
  #define CMASK(P0,P1,t) do{int jb_=(t)-(NT-4); if(jb_>=0)cmask(P0,P1,jb_,qrel,hi);}while(0)
  bool resc=false;
    \
  #define START(P0,P1) do{ const float rm=rowmax(P0,P1); resc=false; \
    { const float dl=__builtin_fmaxf(rm,((const __attribute__((address_space(3))) float*)(shm3+LDS_BIAS))[q0+qrel]+10.f); mhat=fadd_s(mhat,dl); \
      _Pragma("unroll") for(int r=0;r<16;++r){P0[r]=fsub_s(P0[r],dl);P1[r]=fsub_s(P1[r],dl);} \
 } \
    _Pragma("unroll") for(int r=0;r<16;++r)P0[r]=__builtin_amdgcn_exp2f(P0[r]); }while(0)
  #define RESC() do{ if(resc){ asm volatile("s_waitcnt lgkmcnt(0)":::"memory"); \
      _Pragma("unroll") for(int d_=0;d_<2;++d_) _Pragma("unroll") for(int r=0;r<16;++r)o[d_][r]*=wsf[crow(r,hi)]; } }while(0)
  f32x16 pA0,pA1,pB0,pB1;
  int sl_prev=0,sl_cur=0,sl_next=SLOTB;
  #define ROT() do{sl_prev=sl_cur;sl_cur=sl_next;sl_next=(sl_next==(NSLOT-1)*SLOTB)?0:sl_next+SLOTB;}while(0)
  DMA_K(2,2*SLOTB);
  WAIT_BAR(3);
  BLOAD(pA0,pA1,0); BLOAD(pB0,pB1,1);
  qkt(pA0,pA1,Kbase,qr,r32,hi);asm volatile("s_nop 15\n\ts_nop 7":"+v"(pA0),"+v"(pA1));CMASK(pA0,pA1,0);
  START(pA0,pA1);
  _Pragma("unroll") for(int r=0;r<16;++r)pA1[r]=__builtin_amdgcn_exp2f(pA1[r]);
  WAIT_BAR(0);
  DMA_K(3,0);DMA_V(1,SLOTB);
  ROT();
  kload8(kf,kp0+sl_cur);
  WAIT_BAR(2);
  s16x4 vlo[8],vhi[8]; u32x4 pw0,pw1,pw2,pw3;
  #define PKW(P,B) cvtpk_s(P[B],P[B+1])
  #define PAF(k) __builtin_bit_cast(bf16x8,pw##k)
  #define VFR(i) (bf16x8){vlo[i][0],vlo[i][1],vlo[i][2],vlo[i][3],vhi[i][0],vhi[i][1],vhi[i][2],vhi[i][3]}
  #define PIN(x) asm volatile("":"+v"(x))
  #define MX3(a,b,c) __builtin_fmaxf(__builtin_fmaxf((a),(b)),(c))
  #define GAPA(MF,A0,A1,A2,A3,W0,W1,PW) do{ MF; sacc+=A0; sacc+=A1; sacc+=A2; sacc+=A3; PIN(sacc); W0; W1; PIN(PW); SBAR(); }while(0)
  #define EX(v) __builtin_amdgcn_exp2f(v)
  #define GAPB(MF,X,B) do{ MF; X[B]=EX(X[B]); X[B+1]=EX(X[B+1]); X[B+2]=EX(X[B+2]); X[B+3]=EX(X[B+3]); PIN(X); SBAR(); }while(0)
  #define VRD(i) do{ vlo[i]=vtr(vp_+(((i)>>2)*4096+((i)&3)*1024)); vhi[i]=vtr(vp_+(((i)>>2)*4096+((i)&3)*1024+512)); }while(0)
  #define KRD(G,j) do{ if(G){ kload2(kf,kp0+sl_next,j); SBAR(); } }while(0)
  #define STEP(C0,C1,P0,P1,t,GK,GV,GL) do{ SBAR(); \
    _Pragma("unroll") for(int r=0;r<16;++r){C0[r]-=mhat;C1[r]-=mhat;} \
    const lds_cptr vp_=vp0+sl_prev; \
    VRD(0); SBAR(); float sacc=(P0[0]+P0[1]); \
    GAPA(C0=__builtin_amdgcn_mfma_f32_32x32x16_bf16(kf[0],qr[0],C0,0,0,0), P0[2],P0[3],P0[4],P0[5],     pw0[0]=PKW(P0,0), pw0[1]=PKW(P0,2), pw0); \
    VRD(4); SBAR(); GAPA(C1=__builtin_amdgcn_mfma_f32_32x32x16_bf16(kf[1],qr[0],C1,0,0,0), P0[6],P0[7],P0[8],P0[9],     pw0[2]=PKW(P0,4), pw0[3]=PKW(P0,6), pw0); \
    VRD(1); SBAR(); GAPA(C0=__builtin_amdgcn_mfma_f32_32x32x16_bf16(kf[2],qr[1],C0,0,0,0),   P0[10],P0[11],P0[12],P0[13], pw1[0]=PKW(P0,8), pw1[1]=PKW(P0,10), pw1); \
    VRD(5); SBAR(); GAPA(C1=__builtin_amdgcn_mfma_f32_32x32x16_bf16(kf[3],qr[1],C1,0,0,0),   P0[14],P0[15],P1[0],P1[1],   pw1[2]=PKW(P0,12),pw1[3]=PKW(P0,14), pw1); \
    VRD(2); SBAR(); GAPA(C0=__builtin_amdgcn_mfma_f32_32x32x16_bf16(kf[4],qr[2],C0,0,0,0),   P1[2],P1[3],P1[4],P1[5],     pw2[0]=PKW(P1,0), pw2[1]=PKW(P1,2), pw2); \
    VRD(6); SBAR(); GAPA(C1=__builtin_amdgcn_mfma_f32_32x32x16_bf16(kf[5],qr[2],C1,0,0,0),   P1[6],P1[7],P1[8],P1[9],     pw2[2]=PKW(P1,4), pw2[3]=PKW(P1,6), pw2); \
    VRD(3); SBAR(); GAPA(C0=__builtin_amdgcn_mfma_f32_32x32x16_bf16(kf[6],qr[3],C0,0,0,0),   P1[10],P1[11],P1[12],P1[13], pw3[0]=PKW(P1,8), pw3[1]=PKW(P1,10), pw3); \
    VRD(7); SBAR(); GAPA(C1=__builtin_amdgcn_mfma_f32_32x32x16_bf16(kf[7],qr[3],C1,0,0,0),   P1[14],P1[15],0.f,0.f,       pw3[2]=PKW(P1,12),pw3[3]=PKW(P1,14), pw3); \
    l_reg+=sacc; \
    if(GK){DMA_K((t)+3,sl_cur);} if(GV){DMA_V((t)+1,sl_next);} \
    CMASK(C0,C1,t); \
    { float a=MX3(C0[0],C0[1],C1[0]),b=MX3(C0[2],C0[3],C1[1]); a=MX3(a,C1[2],C1[3]); \
      _Pragma("unroll") for(int r=4;r<16;r+=4){a=MX3(a,C0[r],C0[r+1]);b=MX3(b,C0[r+2],C0[r+3]);a=MX3(a,C1[r],C1[r+1]);b=MX3(b,C1[r+2],C1[r+3]);} \
      float rm=__builtin_fmaxf(a,b); { auto rr=__builtin_amdgcn_permlane32_swap(__float_as_uint(rm),__float_as_uint(rm),false,false); rm=__builtin_fmaxf(__uint_as_float(rr[0]),__uint_as_float(rr[1])); } \
      resc=false; \
      if(__builtin_expect(__any(rm>(float)THRL),0)){ const float dl=__builtin_fmaxf(rm,0.f); mhat+=dl; \
        _Pragma("unroll") for(int r=0;r<16;++r){C0[r]-=dl;C1[r]-=dl;} \
        const float f=__builtin_amdgcn_exp2f(-dl); l_reg*=f; if(hi==0)wsf[r32]=f; resc=true; } } \
    SBAR(); \
    GAPB(o[0]=__builtin_amdgcn_mfma_f32_32x32x16_bf16(PAF(0),VFR(0),o[0],0,0,0), C0,0); \
    GAPB(o[1]=__builtin_amdgcn_mfma_f32_32x32x16_bf16(PAF(0),VFR(4),o[1],0,0,0), C0,4); \
    KRD(GL,0); GAPB(o[0]=__builtin_amdgcn_mfma_f32_32x32x16_bf16(PAF(1),VFR(1),o[0],0,0,0), C0,8); \
    KRD(GL,1); GAPB(o[1]=__builtin_amdgcn_mfma_f32_32x32x16_bf16(PAF(1),VFR(5),o[1],0,0,0), C0,12); \
    KRD(GL,2); GAPB(o[0]=__builtin_amdgcn_mfma_f32_32x32x16_bf16(PAF(2),VFR(2),o[0],0,0,0), C1,0); \
    KRD(GL,3); GAPB(o[1]=__builtin_amdgcn_mfma_f32_32x32x16_bf16(PAF(2),VFR(6),o[1],0,0,0), C1,4); \
    GAPB(o[0]=__builtin_amdgcn_mfma_f32_32x32x16_bf16(PAF(3),VFR(3),o[0],0,0,0), C1,8); \
    GAPB(o[1]=__builtin_amdgcn_mfma_f32_32x32x16_bf16(PAF(3),VFR(7),o[1],0,0,0), C1,12); \
    if(GL){BLOAD(P0,P1,(t)+1);} SBAR(); \
    }while(0)
  int t=1;
  #undef CMASK
  #define CMASK(P0,P1,t) do{}while(0)
  for(;t+5<NT;t+=2){
    STEP(pB0,pB1,pA0,pA1,t,true,true,true);     WAIT_BAR(2); RESC(); ROT();
    STEP(pA0,pA1,pB0,pB1,t+1,true,true,true);   WAIT_BAR(2); RESC(); ROT();
  }
  #undef CMASK
  #define CMASK(P0,P1,t) do{int jb_=(t)-(NT-4); if(jb_>=0)cmask(P0,P1,jb_,qrel,hi);}while(0)
  #define ENDW(tt) do{ if((tt)+3<NT){WAIT_BAR(2);} else if((tt)+2<NT){WAIT_BAR(1);} else {WAIT_BAR(0);} }while(0)
  for(;t+1<NT;t+=2){
    STEP(pB0,pB1,pA0,pA1,t,(t+3<NT),(t+1<NT),(t+1<NT));       ENDW(t);   RESC(); ROT();
    STEP(pA0,pA1,pB0,pB1,t+1,(t+4<NT),(t+2<NT),(t+2<NT));     ENDW(t+1); RESC(); ROT();
  }
  STEP(pB0,pB1,pA0,pA1,NT-1,false,false,false); RESC();
  { float sacc=pB0[0]+pB0[1]; _Pragma("unroll") for(int r=2;r<16;++r)sacc+=pB0[r]; _Pragma("unroll") for(int r=0;r<16;++r)sacc+=pB1[r]; l_reg+=sacc;
    pw0=(u32x4){PKW(pB0,0),PKW(pB0,2),PKW(pB0,4),PKW(pB0,6)};pw1=(u32x4){PKW(pB0,8),PKW(pB0,10),PKW(pB0,12),PKW(pB0,14)};pw2=(u32x4){PKW(pB1,0),PKW(pB1,2),PKW(pB1,4),PKW(pB1,6)};pw3=(u32x4){PKW(pB1,8),PKW(pB1,10),PKW(pB1,12),PKW(pB1,14)};
    SBAR(); pv(o,vb0+sl_cur,PAF(0),PAF(1),PAF(2),PAF(3)); }
  #undef PKW
  #undef PAF
  #undef VFR
  #undef PIN
  #undef MX3
  #undef GAPA
  #undef GAPB
  #undef EX
  #undef VRD
  #undef KRD
  #undef STEP
  #undef ENDW
  {auto rr=__builtin_amdgcn_permlane32_swap(__float_as_uint(l_reg),__float_as_uint(l_reg),false,false);l_reg=__uint_as_float(rr[0])+__uint_as_float(rr[1]);}
  if(hi==0)wsf[32+r32]=l_reg;asm volatile("s_waitcnt lgkmcnt(0)":::"memory");
  float rli[16];
  #pragma unroll
  for(int r=0;r<16;++r)rli[r]=__builtin_amdgcn_rcpf(wsf[32+crow(r,hi)]);
  bf16*Ow=O+(rowbase+q0+wid*QBLK)*DM+h*D;
  { bf16*stg=(bf16*)(shm+LDS_OST)+wid*2048;
    #pragma unroll
    for(int r=0;r<16;++r){const int orow=crow(r,hi);
      #pragma unroll
      for(int d0=0;d0<2;++d0)stg[orow*64+d0*32+r32]=__float2bfloat16(o[d0][r]*rli[r]);}
    asm volatile("s_waitcnt lgkmcnt(0)":::"memory");
    #pragma unroll
    for(int i=0;i<4;++i){const int row=i*8+(lane>>3),ch=lane&7; const u32x4 v=*(const u32x4*)(stg+row*64+ch*8); ATTN_STORE16(Ow+(long)row*DM+ch*8,v);} }
  asm volatile("s_waitcnt lgkmcnt(0)\n\ts_barrier":::"memory");
  #undef DMA_K
  #undef BLOAD
  #undef DMA_V
  #undef CMASK
  #undef START
  #undef RESC
  #undef ROT
}
constexpr int ATTN_LDS_BYTES=LDS_BYTES;
struct AttnTensors { const bf16* Q; const bf16* K; const bf16* V; bf16* O; const float* F; };
struct AttnUnit { int bh; int qb; };
template<int THRL=8> __device__ __forceinline__ void attn_phase(char*lds,const AttnTensors&T,unsigned*qctr,const __attribute__((address_space(3))) float*thr8,volatile __attribute__((address_space(3))) unsigned*qslot,int wv){
  for(;;){
    if(fresh_tid(wv)==0){ qslot[0]=__hip_atomic_fetch_add(qctr,1u,__ATOMIC_RELAXED,__HIP_MEMORY_SCOPE_AGENT); }
    asm volatile("s_waitcnt vmcnt(0) lgkmcnt(0)\n\ts_barrier":::"memory");
    const int idx=__builtin_amdgcn_readfirstlane((int)qslot[0]);
    if(idx>=NHEAD*NQB)break;
    const int h=idx%NHEAD, qb=NQB-1-idx/NHEAD;
    attn_unit<THRL>(0,h,qb,T.Q,T.K,T.V,T.O,T.F+(size_t)h*SEQ,thr8[h],lds,wv);
  }
}
#undef SBAR
#undef WAIT_BAR
}
#define GAS __attribute__((address_space(1)))
#define LAS __attribute__((address_space(3)))
typedef unsigned short bf16;
typedef unsigned v4u __attribute__((ext_vector_type(4)));
typedef unsigned v2u __attribute__((ext_vector_type(2)));
typedef float f32x4 __attribute__((ext_vector_type(4)));
typedef float f32x16 __attribute__((ext_vector_type(16)));
typedef short bf16x8 __attribute__((ext_vector_type(8)));
typedef short s16x4 __attribute__((ext_vector_type(4)));

constexpr int NWAVES = 8;
constexpr int S_ = 16384, DM_ = 1024, DIN_ = 6680, FF_ = 4096, NMEM_ = 256;
constexpr float EPS_ = 1e-6f;
constexpr float LOG2E_ = 1.4426950408889634f;
constexpr size_t MiB = 1u << 20;
constexpr size_t WS_WIN = 1 * MiB;
constexpr size_t WS_WGLAO = 17 * MiB, WS_WFOXO = 18 * MiB, WS_WMEMO = 19 * MiB;
constexpr size_t WS_WOUT = 20 * MiB;
constexpr size_t WS_WFF1 = 22 * MiB;
constexpr size_t WS_WFF2 = 30 * MiB;
constexpr size_t WS_GA = 38 * MiB;
constexpr size_t WS_LOGF = 39 * MiB;
constexpr size_t WS_F = 39 * MiB + 512 * 1024;
constexpr size_t WS_MK = 40 * MiB;
constexpr size_t WS_MVT = 40 * MiB + 256 * 1024;
constexpr size_t WS_DEC = 40 * MiB + 512 * 1024;
constexpr size_t WS_MEMN = 40 * MiB + 768 * 1024;
constexpr size_t WS_GQ = 42 * MiB, WS_GK = 50 * MiB, WS_GV = 58 * MiB;
constexpr size_t WS_MG = 42 * MiB;
constexpr size_t WS_GG = 74 * MiB, WS_FQ = 90 * MiB;
constexpr size_t WS_U2 = 74 * MiB;
constexpr size_t WS_MQ = 106 * MiB, WS_FK = 122 * MiB, WS_FV = 138 * MiB;
constexpr size_t WS_GT = 154 * MiB;
constexpr size_t WS_HID = 122 * MiB;
constexpr size_t WS_SS1 = 250 * MiB, WS_SS2 = 251 * MiB;
constexpr size_t WS_END = 253 * MiB;
constexpr size_t WS_LSEF = 252 * MiB;
constexpr size_t WS_QB2 = 251 * MiB + 512 * 1024, WS_NDOT = 251 * MiB + 544 * 1024;
constexpr size_t WS_H0 = 106 * MiB, WS_H1 = 1 * MiB;
constexpr int CW_PANEL = 8192;
constexpr size_t OUT_U = 0, OUT_STATE = 32 * MiB;

constexpr int LDS_BYTES = 155648;

#define LDS_WAIT() asm volatile("s_waitcnt lgkmcnt(0)" ::: "memory")
__device__ __forceinline__ unsigned f2bf(float f) { unsigned u = __builtin_bit_cast(unsigned, f); return (u + 0x7fffu + ((u >> 16) & 1u)) >> 16; }
__device__ __forceinline__ unsigned pk2(float lo, float hi) { return f2bf(lo) | (f2bf(hi) << 16); }
__device__ __forceinline__ float bf2f(unsigned b) { return __builtin_bit_cast(float, (b & 0xffffu) << 16); }
__device__ __forceinline__ float bflo(unsigned w) { return __builtin_bit_cast(float, w << 16); }
__device__ __forceinline__ float bfhi(unsigned w) { return __builtin_bit_cast(float, w & 0xffff0000u); }
__device__ __forceinline__ float sigmoidf_(float x) { return __builtin_amdgcn_rcpf(1.f + __expf(-x)); }
__device__ __forceinline__ float logsigmoidf_(float z) { return -(fmaxf(-z, 0.f) + log1pf(__expf(-fabsf(z)))); }
__device__ __forceinline__ float logsigmoid_fast(float z) { return -(fmaxf(-z, 0.f) + __logf(1.f + __expf(-fabsf(z)))); }
__device__ __forceinline__ int crow_(int r, int hi) { return (r & 3) + 8 * (r >> 2) + 4 * hi; }
__device__ __forceinline__ float wave_sum(float v) {
#pragma unroll
    for (int o = 1; o < 64; o <<= 1) v += __shfl_xor(v, o);
    return v;
}
#define LBAR() asm volatile("s_waitcnt lgkmcnt(0)\n\ts_barrier" ::: "memory")
#define MFMA32(a, b, c) __builtin_amdgcn_mfma_f32_32x32x16_bf16((a), (b), (c), 0, 0, 0)
__device__ __forceinline__ bf16x8 ldfrag(const LAS unsigned char* base, int row, int pitchB, int kbyte) { return *(const LAS bf16x8*)(base + row * pitchB + kbyte); }

struct Ptrs {
    const float *x, *mem, *g_mix, *w_in, *w_alpha_up, *b_alpha, *b_forget, *g_gla_head, *g_mem, *w_mem_kv, *w_gla_o, *w_fox_o, *w_mem_o, *w_out, *g_ffn, *w_ff1, *w_ff2, *g_final;
    float* out; unsigned char* ws;
};

__device__ __forceinline__ void p0_transpose_item(const float* W, int ldw, int srccol0, int k0, bf16* WT, int ldt, int dstrow0, LAS float* scr, int lane) {
#pragma unroll 8
    for (int i = 0; i < 32; ++i) { const int kk = 2 * i + (lane >> 5); scr[kk * 33 + (lane & 31)] = W[(size_t)(k0 + kk) * ldw + srccol0 + (lane & 31)]; }
    LDS_WAIT(); asm volatile("" ::: "memory");
    const int c = lane & 7;
#pragma unroll
    for (int j = 0; j < 4; ++j) { const int n = (lane >> 3) + 8 * j; const LAS float* s = scr + (8 * c) * 33 + n;
        v4u o; o.x = pk2(s[0 * 33], s[1 * 33]); o.y = pk2(s[2 * 33], s[3 * 33]); o.z = pk2(s[4 * 33], s[5 * 33]); o.w = pk2(s[6 * 33], s[7 * 33]);
        *(v4u*)(WT + (size_t)(dstrow0 + n) * ldt + k0 + 8 * c) = o; }
    LDS_WAIT(); asm volatile("" ::: "memory");
}
__device__ __forceinline__ void rms_row_to_bf16(const float* xrow, const float* gain, bf16* orow, int lane) {
    const f32x4* xr = (const f32x4*)xrow + lane; const f32x4* gr = (const f32x4*)gain + lane;
    f32x4 v[4]; float s = 0.f;
#pragma unroll
    for (int j = 0; j < 4; ++j) { v[j] = xr[64 * j]; s += (v[j].x * v[j].x + v[j].y * v[j].y) + (v[j].z * v[j].z + v[j].w * v[j].w); }
    const float r = rsqrtf(wave_sum(s) * (1.f / 1024.f) + EPS_);
    unsigned long long* o8 = (unsigned long long*)orow + lane;
#pragma unroll
    for (int j = 0; j < 4; ++j) { const f32x4 g = gr[64 * j]; o8[64 * j] = (unsigned long long)pk2(v[j].x * r * g.x, v[j].y * r * g.y) | ((unsigned long long)pk2(v[j].z * r * g.z, v[j].w * r * g.w) << 32); }
}
__device__ __forceinline__ void p0_prologue(const Ptrs& P, LAS unsigned char* lds, int vcu, int G, int wv) {
    const int tid = fresh_tid(wv), lane = tid & 63, wave = wv;
    LAS float* scr = (LAS float*)(lds + wave * 16384);
    const int gw = vcu * NWAVES + wave, NGW = G * NWAVES;
    bf16* WIN = (bf16*)(P.ws + WS_WIN);
    constexpr int I_IN = 16 * 208, I_KV = 16 * 32, I_GO = 8 * 32, I_WO = 16 * 32, I_F1 = 16 * 128, I_F2 = 64 * 32;
    constexpr int NITEMS = I_IN + I_KV + 3 * I_GO + I_WO + I_F1 + I_F2;
    for (int it = gw; it < NITEMS; it += NGW) {
        int r = it;
        if (r < I_IN) { const int kb = r / 208, nb = r % 208, d0 = 32 * nb; const int src = d0 < 1536 ? d0 : (d0 < 3072 ? d0 + 16 : d0 + 24);
            p0_transpose_item(P.w_in, DIN_, src, 64 * kb, WIN, 1024, d0, scr, lane); continue; } r -= I_IN;
        if (r < I_KV) { const int kb = r / 32, nb = r % 32; p0_transpose_item(P.w_mem_kv, 1024, 32 * nb, 64 * kb, WIN, 1024, 6912 + 32 * nb, scr, lane); continue; } r -= I_KV;
        if (r < I_GO) { const int kb = r / 32, nb = r % 32; p0_transpose_item(P.w_gla_o, 1024, 32 * nb, 64 * kb, (bf16*)(P.ws + WS_WGLAO), 512, 32 * nb, scr, lane); continue; } r -= I_GO;
        if (r < I_GO) { const int kb = r / 32, nb = r % 32; p0_transpose_item(P.w_fox_o, 1024, 32 * nb, 64 * kb, (bf16*)(P.ws + WS_WFOXO), 512, 32 * nb, scr, lane); continue; } r -= I_GO;
        if (r < I_GO) { const int kb = r / 32, nb = r % 32; p0_transpose_item(P.w_mem_o, 1024, 32 * nb, 64 * kb, (bf16*)(P.ws + WS_WMEMO), 512, 32 * nb, scr, lane); continue; } r -= I_GO;
        if (r < I_WO) { const int kb = r / 32, nb = r % 32; p0_transpose_item(P.w_out, 1024, 32 * nb, 64 * kb, (bf16*)(P.ws + WS_WOUT), 1024, 32 * nb, scr, lane); continue; } r -= I_WO;
        if (r < I_F1) { const int kb = r / 128, nb = r % 128; p0_transpose_item(P.w_ff1, FF_, 32 * nb, 64 * kb, (bf16*)(P.ws + WS_WFF1), 1024, 32 * nb, scr, lane); continue; } r -= I_F1;
        { const int kb = r / 32, nb = r % 32; p0_transpose_item(P.w_ff2, 1024, 32 * nb, 64 * kb, (bf16*)(P.ws + WS_WFF2), FF_, 32 * nb, scr, lane); }
    }
    for (int idx = vcu * 512 + tid; idx < 256 * 128; idx += G * 512) {
        const int row = idx >> 7, kc = idx & 127; const int src = row < 16 ? 1536 + row : (row < 24 ? 3088 + (row - 16) : -1);
        v4u o = (v4u){0u, 0u, 0u, 0u};
        if (src >= 0) { const float* wp = P.w_in + (size_t)(8 * kc) * DIN_ + src;
            o.x = pk2(wp[0], wp[DIN_]); o.y = pk2(wp[2 * DIN_], wp[3 * DIN_]); o.z = pk2(wp[4 * DIN_], wp[5 * DIN_]); o.w = pk2(wp[6 * DIN_], wp[7 * DIN_]); }
        *(v4u*)(WIN + (size_t)(6656 + row) * 1024 + 8 * kc) = o;
    }
    bf16* U = (bf16*)((unsigned char*)P.out + OUT_U); bf16* MEMN = (bf16*)(P.ws + WS_MEMN);
    for (int m = gw; m < S_ + NMEM_; m += NGW) {
        if (m < S_) rms_row_to_bf16(P.x + (size_t)m * DM_, P.g_mix, U + (size_t)m * DM_, lane);
        else rms_row_to_bf16(P.mem + (size_t)(m - S_) * DM_, P.g_mem, MEMN + (size_t)(m - S_) * DM_, lane);
    }
}

struct GemmSched {
    const char* A; const char* B; int nM, nN, lda, ldb, G, c, wv;
    __device__ __forceinline__ bool next(int i, pg8::Unit& u) const { const long L = (long)i * G + c; if (L >= nM * nN) return false; pg8::map_tile((int)L, nM, nN, u.pm, u.pn); u.z = 0; return true; }
    __device__ __forceinline__ const char* aptr(const pg8::Unit& u) const { return A + (size_t)u.pm * 256 * lda * 2; }
    __device__ __forceinline__ const char* bptr(const pg8::Unit& u) const { return B + (size_t)u.pn * 256 * ldb * 2; }
    __device__ __forceinline__ void a_ready(const pg8::Unit&) const {}
    __device__ __forceinline__ void done(const pg8::Unit&) const {}
};
struct ProjSched {
    const char* U; const char* MEMN; const char* W; int G, c, wv;
    __device__ __forceinline__ bool next(int i, pg8::Unit& u) const { const int L = i * G + c; u.z = 0;
        if (L < 1728) { pg8::map_tile(L, 64, 27, u.pm, u.pn); return true; }
        if (L < 1732) { u.pm = 64; u.pn = 27 + (L - 1728); return true; } return false; }
    __device__ __forceinline__ const char* aptr(const pg8::Unit& u) const { return u.pm < 64 ? U + (size_t)u.pm * (256 * 1024 * 2) : MEMN; }
    __device__ __forceinline__ const char* bptr(const pg8::Unit& u) const { return W + (size_t)u.pn * (256 * 1024 * 2); }
    __device__ __forceinline__ void a_ready(const pg8::Unit&) const {}
    __device__ __forceinline__ void done(const pg8::Unit&) const {}
};
struct MergeSched {
    const char *A0, *B0; int G, c, wv; size_t segA, segB;
    __device__ __forceinline__ bool next(int i, pg8::Unit& u) const { const int T = c + G * i; if (T >= 256) return false; pg8::map_tile(T, 64, 4, u.pm, u.pn); u.z = 0; return true; }
    __device__ __forceinline__ const char* aptr(const pg8::Unit& u) const { return A0 + (size_t)u.pm * (256 * 512 * 2); }
    __device__ __forceinline__ const char* bptr(const pg8::Unit& u) const { return B0 + (size_t)u.pn * (256 * 512 * 2); }
    __device__ __forceinline__ void a_ready(const pg8::Unit&) const {}
    __device__ __forceinline__ void done(const pg8::Unit&) const {}
};
typedef pg8::f32x4 accv;
__device__ __forceinline__ void store_bf16_tile(const accv (&acc)[2][2][4][2], bf16* base, int ldc, int row0, int col0, float sc, bool sig) {
#pragma unroll
    for (int ai = 0; ai < 2; ++ai)
#pragma unroll
        for (int m = 0; m < 4; ++m) { bf16* rowp = base + (size_t)(row0 + ai * 128 + m * 16) * ldc + col0;
#pragma unroll
            for (int bj = 0; bj < 2; ++bj) { accv v0 = acc[ai][bj][m][0] * sc, v1 = acc[ai][bj][m][1] * sc;
                if (sig) { v0 = (accv){sigmoidf_(v0[0]), sigmoidf_(v0[1]), sigmoidf_(v0[2]), sigmoidf_(v0[3])}; v1 = (accv){sigmoidf_(v1[0]), sigmoidf_(v1[1]), sigmoidf_(v1[2]), sigmoidf_(v1[3])}; }
                v4u w; w.x = pg8::cvt_pk_bf16(v0[0], v0[1]); w.y = pg8::cvt_pk_bf16(v0[2], v0[3]); w.z = pg8::cvt_pk_bf16(v1[0], v1[1]); w.w = pg8::cvt_pk_bf16(v1[2], v1[3]);
                *(v4u*)(rowp + bj * 128) = w; } }
}
struct EpiProj {
    static constexpr bool PERM = true, AFTER_DRAIN = false;
    unsigned char* ws; const float* b_forget;
    __device__ __forceinline__ void operator()(const accv (&acc)[2][2][4][2], const pg8::Unit& u, int wr, int wc, int fr, int fq) const {
        const int pn = u.pn;
        if (pn != 26) {
            size_t off; int ldc, colt, prow = u.pm * 256; float sc = 1.f; bool sig = false;
            if (pn == 0) { off = WS_GQ; ldc = 256; colt = 0; sc = 0.125f; }
            else if (pn == 1) { off = WS_GK; ldc = 256; colt = 0; }
            else if (pn < 4) { off = WS_GV; ldc = 512; colt = (pn - 2) * 256; }
            else if (pn < 6) { off = WS_GG; ldc = 512; colt = (pn - 4) * 256; }
            else if (pn < 8) { off = WS_FQ; ldc = 512; colt = (pn - 6) * 256; sc = 0.125f * LOG2E_; }
            else if (pn < 10) { off = WS_FK; ldc = 512; colt = (pn - 8) * 256; }
            else if (pn < 12) { off = WS_FV; ldc = 512; colt = (pn - 10) * 256; }
            else if (pn < 14) { off = WS_MQ; ldc = 512; colt = (pn - 12) * 256; sc = 0.08838834764831845f * LOG2E_; }
            else if (pn < 26) { off = WS_GT; ldc = 3072; colt = (pn - 14) * 256; sig = true; }
            else if (pn < 29) { off = WS_MK; ldc = 512; colt = (pn - 27) * 256; prow = 0; }
            else { off = WS_MVT; ldc = 512; colt = (pn - 29) * 256; prow = 0; }
            store_bf16_tile(acc, (bf16*)(ws + off), ldc, prow + wr * 64 + fr, colt + wc * 32 + 8 * fq, sc, sig);
        } else {
            if (wc == 0 && fq < 3) {
                float* GA = (float*)(ws + WS_GA); float* LF = (float*)(ws + WS_LOGF);
                accv bf0 = (accv){0.f, 0.f, 0.f, 0.f}, bf1 = bf0;
                if (fq == 2) { bf0 = *(const accv*)(b_forget); bf1 = *(const accv*)(b_forget + 4); }
#pragma unroll
                for (int ai = 0; ai < 2; ++ai)
#pragma unroll
                    for (int m = 0; m < 4; ++m) { const size_t row = (size_t)(u.pm * 256 + wr * 64 + fr + ai * 128 + m * 16);
                        const accv v0 = acc[ai][0][m][0], v1 = acc[ai][0][m][1];
                        if (fq < 2) { *(accv*)(GA + row * 16 + 8 * fq) = v0; *(accv*)(GA + row * 16 + 8 * fq + 4) = v1; }
                        else { const accv a = v0 + bf0, b = v1 + bf1;
#pragma unroll
                            for (int j = 0; j < 4; ++j) { LF[(size_t)j * S_ + row] = logsigmoidf_(a[j]); LF[(size_t)(4 + j) * S_ + row] = logsigmoidf_(b[j]); } } }
            }
        }
    }
};
struct EpiMerge {
    static constexpr bool PERM = true, AFTER_DRAIN = false;
    bf16* MG; const bf16* GT;
    __device__ __forceinline__ void mid(accv (&acc)[2][2][4][2], const pg8::Unit& u, int s, int wr, int wc, int fr, int fq) const {
        const int row0 = u.pm * 256 + wr * 64 + fr, col0 = u.pn * 256 + wc * 32 + 8 * fq;
#pragma unroll
        for (int ai = 0; ai < 2; ++ai)
#pragma unroll
            for (int m = 0; m < 4; ++m) { const size_t row = (size_t)(row0 + ai * 128 + m * 16);
#pragma unroll
                for (int bj = 0; bj < 2; ++bj) { const int col = col0 + bj * 128;
                    const v4u a = *(const v4u*)(GT + row * 3072 + (s - 1) * 1024 + col), b = *(const v4u*)(GT + row * 3072 + s * 1024 + col);
                    const accv r0 = (accv){bflo(a.x) * __builtin_amdgcn_rcpf(fmaxf(bflo(b.x), 1e-30f)), bfhi(a.x) * __builtin_amdgcn_rcpf(fmaxf(bfhi(b.x), 1e-30f)), bflo(a.y) * __builtin_amdgcn_rcpf(fmaxf(bflo(b.y), 1e-30f)), bfhi(a.y) * __builtin_amdgcn_rcpf(fmaxf(bfhi(b.y), 1e-30f))};
                    const accv r1 = (accv){bflo(a.z) * __builtin_amdgcn_rcpf(fmaxf(bflo(b.z), 1e-30f)), bfhi(a.z) * __builtin_amdgcn_rcpf(fmaxf(bfhi(b.z), 1e-30f)), bflo(a.w) * __builtin_amdgcn_rcpf(fmaxf(bflo(b.w), 1e-30f)), bfhi(a.w) * __builtin_amdgcn_rcpf(fmaxf(bfhi(b.w), 1e-30f))};
                    acc[ai][bj][m][0] = acc[ai][bj][m][0] * r0; acc[ai][bj][m][1] = acc[ai][bj][m][1] * r1; } }
    }
    __device__ __forceinline__ void operator()(const accv (&acc)[2][2][4][2], const pg8::Unit& u, int wr, int wc, int fr, int fq) const {
        const int row0 = u.pm * 256 + wr * 64 + fr, col0 = u.pn * 256 + wc * 32 + 8 * fq;
#pragma unroll
        for (int ai = 0; ai < 2; ++ai)
#pragma unroll
            for (int m = 0; m < 4; ++m) { const size_t row = (size_t)(row0 + ai * 128 + m * 16);
#pragma unroll
                for (int bj = 0; bj < 2; ++bj) { const int col = col0 + bj * 128;
                    const v4u g = *(const v4u*)(GT + row * 3072 + 2 * 1024 + col);
                    accv v0 = acc[ai][bj][m][0], v1 = acc[ai][bj][m][1];
                    v0 = v0 * (accv){bflo(g.x), bfhi(g.x), bflo(g.y), bfhi(g.y)}; v1 = v1 * (accv){bflo(g.z), bfhi(g.z), bflo(g.w), bfhi(g.w)};
                    v4u w; w.x = pg8::cvt_pk_bf16(v0[0], v0[1]); w.y = pg8::cvt_pk_bf16(v0[2], v0[3]); w.z = pg8::cvt_pk_bf16(v1[0], v1[1]); w.w = pg8::cvt_pk_bf16(v1[2], v1[3]);
                    *(v4u*)(MG + row * 1024 + col) = w; } }
    }
};
template <bool WRITE_U2, bool BASE_BF16> struct EpiResid {
    static constexpr bool PERM = true, AFTER_DRAIN = false;
    const void* base; bf16* H0; bf16* H1; bf16* U2; const float* gain; float* SS;
    __device__ __forceinline__ void operator()(const accv (&acc)[2][2][4][2], const pg8::Unit& u, int wr, int wc, int fr, int fq) const {
        bf16* HB = u.pm < 32 ? H0 : H1;
        const int row0 = u.pm * 256 + wr * 64 + fr, col0 = u.pn * 256 + wc * 32 + 8 * fq;
#pragma unroll
        for (int ai = 0; ai < 2; ++ai)
#pragma unroll
            for (int m = 0; m < 4; ++m) { const size_t row = (size_t)(row0 + ai * 128 + m * 16); float ssq = 0.f;
#pragma unroll
                for (int bj = 0; bj < 2; ++bj) { const int col = col0 + bj * 128; const size_t o = row * 1024 + col;
                    accv b0, b1;
                    if (BASE_BF16) { const v4u bw = *(const v4u*)((const bf16*)base + o); b0 = (accv){bflo(bw.x), bfhi(bw.x), bflo(bw.y), bfhi(bw.y)}; b1 = (accv){bflo(bw.z), bfhi(bw.z), bflo(bw.w), bfhi(bw.w)}; }
                    else { b0 = *(const accv*)((const float*)base + o); b1 = *(const accv*)((const float*)base + o + 4); }
                    const accv h0 = b0 + acc[ai][bj][m][0], h1 = b1 + acc[ai][bj][m][1];
                    { v4u w; w.x = pg8::cvt_pk_bf16(h0[0], h0[1]); w.y = pg8::cvt_pk_bf16(h0[2], h0[3]); w.z = pg8::cvt_pk_bf16(h1[0], h1[1]); w.w = pg8::cvt_pk_bf16(h1[2], h1[3]); *(v4u*)(HB + o) = w; }
                    ssq += (h0[0] * h0[0] + h0[1] * h0[1]) + (h0[2] * h0[2] + h0[3] * h0[3]) + (h1[0] * h1[0] + h1[1] * h1[1]) + (h1[2] * h1[2] + h1[3] * h1[3]);
                    if (WRITE_U2) { const accv g0 = *(const accv*)(gain + col), g1 = *(const accv*)(gain + col + 4); const accv a = h0 * g0, b = h1 * g1;
                        v4u w; w.x = pg8::cvt_pk_bf16(a[0], a[1]); w.y = pg8::cvt_pk_bf16(a[2], a[3]); w.z = pg8::cvt_pk_bf16(b[0], b[1]); w.w = pg8::cvt_pk_bf16(b[2], b[3]);
                        *(v4u*)(U2 + o) = w; } }
                ssq += __shfl_xor(ssq, 16); ssq += __shfl_xor(ssq, 32);
                if (fq == 0) SS[row * 16 + u.pn * 4 + wc] = ssq; }
    }
};
struct EpiFinal {
    static constexpr bool PERM = true, AFTER_DRAIN = true;
    const bf16* H0; const bf16* H1; float* out; const float* gain; float* xbuf; unsigned* cnt;
    __device__ __forceinline__ void fused(accv (&acc)[2][2][4][2], const pg8::Unit& u, int wr, int wc, int fr, int fq, LAS unsigned char* lds, int wid, int lane) const {
        const bf16* HB = u.pm < 32 ? H0 : H1;
        LAS float* Pl = (LAS float*)lds; LAS float* Sl = (LAS float*)(lds + 4096);
        const int row0 = u.pm * 256 + wr * 64 + fr, col0 = u.pn * 256 + wc * 32 + 8 * fq;
#pragma unroll
        for (int ai = 0; ai < 2; ++ai)
#pragma unroll
            for (int m = 0; m < 4; ++m) { const size_t row = (size_t)(row0 + ai * 128 + m * 16); float ssq = 0.f;
#pragma unroll
                for (int bj = 0; bj < 2; ++bj) { const size_t o = row * 1024 + col0 + bj * 128; const v4u bw = *(const v4u*)(HB + o);
                    const accv h0 = acc[ai][bj][m][0] + (accv){bflo(bw.x), bfhi(bw.x), bflo(bw.y), bfhi(bw.y)}, h1 = acc[ai][bj][m][1] + (accv){bflo(bw.z), bfhi(bw.z), bflo(bw.w), bfhi(bw.w)};
                    acc[ai][bj][m][0] = h0; acc[ai][bj][m][1] = h1;
                    ssq += (h0[0] * h0[0] + h0[1] * h0[1]) + (h0[2] * h0[2] + h0[3] * h0[3]) + (h1[0] * h1[0] + h1[1] * h1[1]) + (h1[2] * h1[2] + h1[3] * h1[3]); }
                ssq += __shfl_xor(ssq, 16); ssq += __shfl_xor(ssq, 32);
                if (fq == 0) Pl[(ai * 128 + wr * 64 + m * 16 + fr) * 4 + wc] = ssq; }
        asm volatile("s_waitcnt lgkmcnt(0)" ::: "memory"); __builtin_amdgcn_s_barrier(); asm volatile("" ::: "memory");
        const int rowl = wid * 32 + (lane & 31);
        if (lane < 32) { const float s = (Pl[rowl * 4] + Pl[rowl * 4 + 1]) + (Pl[rowl * 4 + 2] + Pl[rowl * 4 + 3]);
            __hip_atomic_store(xbuf + ((size_t)(u.pm * 256 + rowl) * 4 + u.pn), s, __ATOMIC_RELAXED, __HIP_MEMORY_SCOPE_AGENT); }
        asm volatile("s_waitcnt vmcnt(0)" ::: "memory");
        if (lane == 0) __hip_atomic_fetch_add(cnt + 64 * u.pm, 1u, __ATOMIC_RELAXED, __HIP_MEMORY_SCOPE_AGENT);
        if (wid == 0) { unsigned sp = 0;
            while ((unsigned)__builtin_amdgcn_readfirstlane(__hip_atomic_load(cnt + 64 * u.pm, __ATOMIC_RELAXED, __HIP_MEMORY_SCOPE_AGENT)) < 32u) { __builtin_amdgcn_s_sleep(2); if (++sp > (1u << 22)) break; }
            __builtin_amdgcn_fence(__ATOMIC_ACQUIRE, "agent"); }
        asm volatile("s_waitcnt vmcnt(0) lgkmcnt(0)" ::: "memory"); __builtin_amdgcn_s_barrier(); asm volatile("" ::: "memory");
        if (lane < 32) { const float* sl = xbuf + (size_t)(u.pm * 256 + rowl) * 4;
            const float a = __hip_atomic_load(sl, __ATOMIC_RELAXED, __HIP_MEMORY_SCOPE_AGENT), b = __hip_atomic_load(sl + 1, __ATOMIC_RELAXED, __HIP_MEMORY_SCOPE_AGENT),
                        c = __hip_atomic_load(sl + 2, __ATOMIC_RELAXED, __HIP_MEMORY_SCOPE_AGENT), d = __hip_atomic_load(sl + 3, __ATOMIC_RELAXED, __HIP_MEMORY_SCOPE_AGENT);
            Sl[rowl] = rsqrtf(((a + b) + (c + d)) * (1.f / 1024.f) + EPS_); }
        asm volatile("s_waitcnt vmcnt(0) lgkmcnt(0)" ::: "memory"); __builtin_amdgcn_s_barrier(); asm volatile("" ::: "memory");
#pragma unroll
        for (int ai = 0; ai < 2; ++ai)
#pragma unroll
            for (int m = 0; m < 4; ++m) { const int rl = ai * 128 + wr * 64 + m * 16 + fr; const float r = Sl[rl]; const size_t row = (size_t)(u.pm * 256 + rl);
#pragma unroll
                for (int bj = 0; bj < 2; ++bj) { const int col = col0 + bj * 128; const accv g0 = *(const accv*)(gain + col), g1 = *(const accv*)(gain + col + 4);
                    *(accv*)(out + row * 1024 + col) = acc[ai][bj][m][0] * r * g0; *(accv*)(out + row * 1024 + col + 4) = acc[ai][bj][m][1] * r * g1; } }
    }
};
struct EpiFfn1 {
    static constexpr bool PERM = true, AFTER_DRAIN = false;
    bf16* HID; const float* SS;
    __device__ __forceinline__ void operator()(const accv (&acc)[2][2][4][2], const pg8::Unit& u, int wr, int wc, int fr, int fq) const {
        const int row0 = u.pm * 256 + wr * 64 + fr, col0 = u.pn * 256 + wc * 32 + 8 * fq;
#pragma unroll
        for (int ai = 0; ai < 2; ++ai)
#pragma unroll
            for (int m = 0; m < 4; ++m) { const size_t row = (size_t)(row0 + ai * 128 + m * 16);
                const accv s0 = *(const accv*)(SS + row * 16), s1 = *(const accv*)(SS + row * 16 + 4), s2 = *(const accv*)(SS + row * 16 + 8), s3 = *(const accv*)(SS + row * 16 + 12);
                const float tot = ((s0[0] + s0[1]) + (s0[2] + s0[3])) + ((s1[0] + s1[1]) + (s1[2] + s1[3])) + ((s2[0] + s2[1]) + (s2[2] + s2[3])) + ((s3[0] + s3[1]) + (s3[2] + s3[3]));
                const float r = rsqrtf(tot * (1.f / 1024.f) + EPS_);
#pragma unroll
                for (int bj = 0; bj < 2; ++bj) { accv v0 = acc[ai][bj][m][0] * r, v1 = acc[ai][bj][m][1] * r;
#pragma unroll
                    for (int j = 0; j < 4; ++j) { const float a = fmaxf(v0[j], 0.f), b = fmaxf(v1[j], 0.f); v0[j] = a * a; v1[j] = b * b; }
                    v4u w; w.x = pg8::cvt_pk_bf16(v0[0], v0[1]); w.y = pg8::cvt_pk_bf16(v0[2], v0[3]); w.z = pg8::cvt_pk_bf16(v1[0], v1[1]); w.w = pg8::cvt_pk_bf16(v1[2], v1[3]);
                    *(v4u*)(HID + row * 4096 + col0 + bj * 128) = w; } }
    }
};

constexpr int GP = 144;
__device__ __forceinline__ void gla_a_unit(const Ptrs& P, LAS unsigned char* lds, int n, int h, int wv) {
    const int tid = fresh_tid(wv), lane = tid & 63, g = wv, r32 = lane & 31, hh = lane >> 5;
    LAS unsigned char* QP = lds; LAS unsigned char* QN = lds + 9216; LAS unsigned char* KN = lds + 18432; LAS unsigned char* KP = lds + 27648;
    LAS unsigned char* KLT = lds + 36864; LAS unsigned char* AT = lds + 46080; LAS unsigned char* VT = lds + 55296; LAS float* TOT = (LAS float*)(lds + 73728);
    bf16* GQ = (bf16*)(P.ws + WS_GQ); const bf16* GK = (const bf16*)(P.ws + WS_GK); bf16* GV = (bf16*)(P.ws + WS_GV);
    const float* GA = (const float*)(P.ws + WS_GA); float* DEC = (float*)(P.ws + WS_DEC); bf16* STATE = (bf16*)((unsigned char*)P.out + OUT_STATE);
    const int c = h * 64 + lane, t0 = n * 64;
#ifdef PROBE_PHASE
#define GSTAMP(k) do { if (n == 64 && h == 0 && tid == 0) ((unsigned long long*)(P.ws + 253 * MiB))[(k)] = __builtin_amdgcn_s_memrealtime(); } while (0)
#else
#define GSTAMP(k) do {} while (0)
#endif
    GSTAMP(60);
    float wup[16];
#pragma unroll
    for (int j = 0; j < 16; ++j) wup[j] = P.w_alpha_up[j * 256 + c];
    const float ba = P.b_alpha[c];
    unsigned short qraw[8], kraw[8];
#pragma unroll
    for (int i = 0; i < 8; ++i) { const size_t gi = (size_t)(t0 + 8 * g + i) * 256 + c; qraw[i] = GQ[gi]; kraw[i] = GK[gi]; }
    float bl[8]; float run = 0.f;
#pragma unroll
    for (int i = 0; i < 8; ++i) { const f32x4* gar = (const f32x4*)(GA + (size_t)(t0 + 8 * g + i) * 16); float z = ba;
#pragma unroll
        for (int j4 = 0; j4 < 4; ++j4) { const f32x4 a = gar[j4]; z += a[0] * wup[4 * j4] + a[1] * wup[4 * j4 + 1] + a[2] * wup[4 * j4 + 2] + a[3] * wup[4 * j4 + 3]; }
        run += logsigmoid_fast(z) * (1.f / 16.f); bl[i] = run; }
    TOT[g * 64 + lane] = run;
    { const int s = tid >> 3, vc = tid & 7; const v4u a = *(const v4u*)(GV + (size_t)(t0 + s) * 512 + h * 128 + vc * 16), b = *(const v4u*)(GV + (size_t)(t0 + s) * 512 + h * 128 + vc * 16 + 8);
      LAS bf16* vt = (LAS bf16*)VT; const unsigned w[8] = {a.x, a.y, a.z, a.w, b.x, b.y, b.z, b.w};
#pragma unroll
      for (int j = 0; j < 8; ++j) { vt[(vc * 16 + 2 * j) * 72 + s] = (bf16)(w[j] & 0xffffu); vt[(vc * 16 + 2 * j + 1) * 72 + s] = (bf16)(w[j] >> 16); } }
    LBAR(); GSTAMP(61);
    float off = 0.f, blast = 0.f;
#pragma unroll
    for (int gg = 0; gg < 8; ++gg) { const float tv = TOT[gg * 64 + lane]; if (gg < g) off += tv; blast += tv; }
    unsigned kl[8];
#pragma unroll
    for (int i = 0; i < 8; ++i) { const int t = 8 * g + i; const float b = off + bl[i]; const size_t gi = (size_t)(t0 + t) * 256 + c;
        const float q = bf2f(qraw[i]), k = bf2f(kraw[i]); const float ep = __expf(b), en = __expf(-b), el = __expf(blast - b);
        const unsigned qp = f2bf(q * ep); GQ[gi] = (bf16)qp;
        ((LAS bf16*)QP)[t * 72 + lane] = (bf16)qp; ((LAS bf16*)QN)[t * 72 + lane] = (bf16)f2bf(q * en);
        ((LAS bf16*)KN)[t * 72 + lane] = (bf16)f2bf(k * en); ((LAS bf16*)KP)[t * 72 + lane] = (bf16)f2bf(k * ep); kl[i] = f2bf(k * el); }
    *(LAS v4u*)(KLT + lane * GP + 16 * g) = (v4u){kl[0] | (kl[1] << 16), kl[2] | (kl[3] << 16), kl[4] | (kl[5] << 16), kl[6] | (kl[7] << 16)};
    if (g == 0) DEC[(n * 4 + h) * 64 + lane] = __expf(blast);
    LBAR(); GSTAMP(62);
    const f32x16 zero = {};
    if (g < 4) {
        const int ti = g >> 1, si = g & 1; f32x16 ac = zero, an = zero;
        if (ti >= si) {
#pragma unroll
            for (int ks = 0; ks < 4; ++ks) ac = MFMA32(ldfrag(QP, 32 * ti + r32, GP, 32 * ks + 16 * hh), ldfrag(KN, 32 * si + r32, GP, 32 * ks + 16 * hh), ac); }
        if (ti <= si) {
#pragma unroll
            for (int ks = 0; ks < 4; ++ks) an = MFMA32(ldfrag(QN, 32 * ti + r32, GP, 32 * ks + 16 * hh), ldfrag(KP, 32 * si + r32, GP, 32 * ks + 16 * hh), an); }
#pragma unroll
        for (int i = 0; i < 16; ++i) { const int t = 32 * ti + crow_(i, hh), s = 32 * si + r32; ((LAS bf16*)AT)[t * 72 + s] = (bf16)f2bf(t >= s ? ac[i] : an[i]); }
    } else {
        const int vi = g - 4;
#pragma unroll
        for (int dj = 0; dj < 2; ++dj) { f32x16 st = zero;
#pragma unroll
            for (int ks = 0; ks < 4; ++ks) st = MFMA32(ldfrag(KLT, 32 * dj + r32, GP, 32 * ks + 16 * hh), ldfrag(VT, 32 * vi + r32, GP, 32 * ks + 16 * hh), st);
#pragma unroll
            for (int i4 = 0; i4 < 4; ++i4) *(v2u*)(STATE + (size_t)(n * 4 + h) * 8192 + (size_t)(((vi * 4 + 2 * dj + (i4 >> 1)) * 64 + r32 + 32 * (i4 & 1)) * 8 + 4 * hh)) = (v2u){pk2(st[4 * i4], st[4 * i4 + 1]), pk2(st[4 * i4 + 2], st[4 * i4 + 3])}; }
    }
    LBAR(); GSTAMP(63);
    { const int ti = g >> 2, vj = g & 3; f32x16 oi = zero;
#pragma unroll
      for (int ks = 0; ks < 4; ++ks) oi = MFMA32(ldfrag(AT, 32 * ti + r32, GP, 32 * ks + 16 * hh), ldfrag(VT, 32 * vj + r32, GP, 32 * ks + 16 * hh), oi);
#pragma unroll
      for (int i = 0; i < 16; ++i) GV[(size_t)(t0 + 32 * ti + crow_(i, hh)) * 512 + h * 128 + 32 * vj + r32] = (bf16)f2bf(oi[i]); }
    LBAR(); GSTAMP(64);
}
__device__ __forceinline__ void gla_scan_unit(const Ptrs& P, LAS unsigned char* lds, int u, int wv) {
    const int tid = fresh_tid(wv), lane = tid & 63, w = wv;
    const int h = u >> 6, e0 = (u & 63) * 128;
    const int dch = 16 * ((e0 >> 9) & 3) + 8 * ((e0 >> 8) & 1) + ((2 * lane) & 7);
    unsigned* STATE = (unsigned*)((unsigned char*)P.out + OUT_STATE); const float* DEC = (const float*)(P.ws + WS_DEC);
    LAS float* segS = (LAS float*)lds; LAS float* segP = (LAS float*)(lds + 8192);
    float kv[2][32], dc[2][32];
#pragma unroll
    for (int i = 0; i < 32; ++i) { const int n = 32 * w + i; const unsigned wd = STATE[((size_t)(n * 4 + h) * 8192 + e0) / 2 + lane]; kv[0][i] = bflo(wd); kv[1][i] = bfhi(wd);
        const float2 d2 = *(const float2*)(DEC + (n * 4 + h) * 64 + dch); dc[0][i] = d2.x; dc[1][i] = d2.y; }
    float s[2] = {0.f, 0.f}, pr[2] = {1.f, 1.f};
#pragma unroll
    for (int i = 0; i < 32; ++i) {
#pragma unroll
        for (int e = 0; e < 2; ++e) { const float pv = s[e]; s[e] = s[e] * dc[e][i] + kv[e][i]; kv[e][i] = pv; pr[e] *= dc[e][i]; } }
    segS[w * 64 + lane] = s[0]; segS[512 + w * 64 + lane] = s[1]; segP[w * 64 + lane] = pr[0]; segP[512 + w * 64 + lane] = pr[1];
    LBAR();
    float sin_[2] = {0.f, 0.f};
#pragma unroll
    for (int ww = 0; ww < 8; ++ww) { const float a0 = segS[ww * 64 + lane], a1 = segS[512 + ww * 64 + lane], b0 = segP[ww * 64 + lane], b1 = segP[512 + ww * 64 + lane]; if (ww < w) { sin_[0] = sin_[0] * b0 + a0; sin_[1] = sin_[1] * b1 + a1; } }
    float cp[2] = {1.f, 1.f};
#pragma unroll
    for (int i = 0; i < 32; ++i) { const int n = 32 * w + i;
        STATE[((size_t)(n * 4 + h) * 8192 + e0) / 2 + lane] = pk2(kv[0][i] + cp[0] * sin_[0], kv[1][i] + cp[1] * sin_[1]);
        cp[0] *= dc[0][i]; cp[1] *= dc[1][i]; }
    LBAR();
}
__device__ __forceinline__ void gla_b_task(const Ptrs& P, int task, int lane) {
    const int r32 = lane & 31, hh = lane >> 5;
    const int ti = task & 1, h = (task >> 1) & 3, n = task >> 3;
    const bf16* GQ = (const bf16*)(P.ws + WS_GQ); const bf16* GV = (const bf16*)(P.ws + WS_GV); bf16* GG = (bf16*)(P.ws + WS_GG);
    const bf16* SB = (const bf16*)((unsigned char*)P.out + OUT_STATE) + (size_t)(n * 4 + h) * 8192;
    const size_t t = (size_t)n * 64 + 32 * ti + r32;
    bf16x8 qf[4];
#pragma unroll
    for (int ks = 0; ks < 4; ++ks) qf[ks] = *(const bf16x8*)(GQ + t * 256 + h * 64 + 16 * ks + 8 * hh);
    f32x16 o[4];
#pragma unroll
    for (int vj = 0; vj < 4; ++vj) { o[vj] = (f32x16){};
#pragma unroll
        for (int ks = 0; ks < 4; ++ks) { const bf16x8 af = *(const bf16x8*)(SB + ((vj * 4 + ks) * 64 + lane) * 8);
            o[vj] = MFMA32(af, qf[ks], o[vj]); }
        asm volatile("" ::: "memory"); }
    float ov[64]; float ss = 0.f;
#pragma unroll
    for (int vj = 0; vj < 4; ++vj) {
#pragma unroll
        for (int g4 = 0; g4 < 4; ++g4) { const v2u w = *(const v2u*)(GV + t * 512 + h * 128 + 32 * vj + 8 * g4 + 4 * hh);
            const float a0 = o[vj][4 * g4] + bflo(w.x), a1 = o[vj][4 * g4 + 1] + bfhi(w.x), a2 = o[vj][4 * g4 + 2] + bflo(w.y), a3 = o[vj][4 * g4 + 3] + bfhi(w.y);
            ov[16 * vj + 4 * g4] = a0; ov[16 * vj + 4 * g4 + 1] = a1; ov[16 * vj + 4 * g4 + 2] = a2; ov[16 * vj + 4 * g4 + 3] = a3;
            ss += (a0 * a0 + a1 * a1) + (a2 * a2 + a3 * a3); } }
    ss += __shfl_xor(ss, 32);
    const float r = rsqrtf(ss * (1.f / 128.f) + EPS_);
#pragma unroll
    for (int vj = 0; vj < 4; ++vj) {
#pragma unroll
        for (int g4 = 0; g4 < 4; ++g4) { const int vc = h * 128 + 32 * vj + 8 * g4 + 4 * hh; const v2u gw = *(const v2u*)(GG + t * 512 + vc); const f32x4 gn = *(const f32x4*)(P.g_gla_head + vc);
            const float g0 = bflo(gw.x), g1 = bfhi(gw.x), g2 = bflo(gw.y), g3 = bfhi(gw.y);
            v2u ow; ow.x = pk2(ov[16 * vj + 4 * g4] * r * gn[0] * (g0 * sigmoidf_(g0)), ov[16 * vj + 4 * g4 + 1] * r * gn[1] * (g1 * sigmoidf_(g1)));
            ow.y = pk2(ov[16 * vj + 4 * g4 + 2] * r * gn[2] * (g2 * sigmoidf_(g2)), ov[16 * vj + 4 * g4 + 3] * r * gn[3] * (g3 * sigmoidf_(g3)));
            *(v2u*)(GG + t * 512 + vc) = ow; }
        asm volatile("" ::: "memory"); }
}
__device__ __forceinline__ void memattn_unit(const Ptrs& P, LAS unsigned char* lds, int hm, int qb, int wv) {
    const int tid = fresh_tid(wv), lane = tid & 63, w = wv, r32 = lane & 31, hh = lane >> 5;
    constexpr int KPB = 272, VPB = 528;
    LAS unsigned char* KM = lds; LAS unsigned char* VTM = lds + 69632; LAS float* LSUM = (LAS float*)(lds + 137216);
    const bf16* MK = (const bf16*)(P.ws + WS_MK); const bf16* MVT = (const bf16*)(P.ws + WS_MVT); bf16* MQ = (bf16*)(P.ws + WS_MQ);
#pragma unroll
    for (int j = 0; j < 8; ++j) { const int idx = tid + 512 * j; const int key = idx >> 4, ch = idx & 15; *(LAS v4u*)(KM + key * KPB + ch * 16) = *(const v4u*)(MK + (size_t)key * 512 + hm * 128 + ch * 8);
    }
    { const int dc = tid & 15, key0 = (tid >> 4) * 8; v4u in[8];
#pragma unroll
      for (int k = 0; k < 8; ++k) in[k] = *(const v4u*)(MVT + (size_t)(key0 + k) * 512 + hm * 128 + dc * 8);
#pragma unroll
      for (int jp = 0; jp < 4; ++jp) {
          unsigned e[8];
#pragma unroll
          for (int k = 0; k < 8; ++k) e[k] = jp == 0 ? in[k].x : (jp == 1 ? in[k].y : (jp == 2 ? in[k].z : in[k].w));
          const v4u lo = (v4u){(e[0] & 0xffffu) | (e[1] << 16), (e[2] & 0xffffu) | (e[3] << 16), (e[4] & 0xffffu) | (e[5] << 16), (e[6] & 0xffffu) | (e[7] << 16)};
          const v4u hi = (v4u){(e[0] >> 16) | (e[1] & 0xffff0000u), (e[2] >> 16) | (e[3] & 0xffff0000u), (e[4] >> 16) | (e[5] & 0xffff0000u), (e[6] >> 16) | (e[7] & 0xffff0000u)};
          *(LAS v4u*)(VTM + (8 * dc + 2 * jp) * VPB + key0 * 2) = lo; *(LAS v4u*)(VTM + (8 * dc + 2 * jp + 1) * VPB + key0 * 2) = hi; } }
    LBAR();
    for (int qq = 0; qq < 2; ++qq) { const int qbb = 2 * qb + qq;
    const size_t qrow = (size_t)qbb * 256 + 32 * w + r32;
    bf16x8 qr[8];
#pragma unroll
    for (int ks = 0; ks < 8; ++ks) qr[ks] = *(const bf16x8*)(MQ + qrow * 512 + hm * 128 + 16 * ks + 8 * hh);
    f32x16 p[8];
#pragma unroll
    for (int kb = 0; kb < 8; ++kb) { p[kb] = (f32x16){};
#pragma unroll
        for (int ks = 0; ks < 8; ++ks) p[kb] = MFMA32(ldfrag(KM, 32 * kb + r32, KPB, 32 * ks + 16 * hh), qr[ks], p[kb]); }
    float mx = -INFINITY;
#pragma unroll
    for (int kb = 0; kb < 8; ++kb)
#pragma unroll
        for (int i = 0; i < 16; ++i) mx = fmaxf(mx, p[kb][i]);
    mx = fmaxf(mx, __shfl_xor(mx, 32));
    float l = 0.f; v4u pk[8][2];
#pragma unroll
    for (int kb = 0; kb < 8; ++kb) {
#pragma unroll
        for (int i = 0; i < 16; ++i) { p[kb][i] = __builtin_amdgcn_exp2f(p[kb][i] - mx); l += p[kb][i]; }
#pragma unroll
        for (int s = 0; s < 2; ++s) pk[kb][s] = (v4u){pk2(p[kb][8 * s], p[kb][8 * s + 1]), pk2(p[kb][8 * s + 2], p[kb][8 * s + 3]), pk2(p[kb][8 * s + 4], p[kb][8 * s + 5]), pk2(p[kb][8 * s + 6], p[kb][8 * s + 7])}; }
    l += __shfl_xor(l, 32);
    if (hh == 0) LSUM[w * 32 + r32] = l;
    f32x16 o[4];
#pragma unroll
    for (int db = 0; db < 4; ++db) { o[db] = (f32x16){};
#pragma unroll
        for (int kb = 0; kb < 8; ++kb)
#pragma unroll
            for (int s = 0; s < 2; ++s) { const LAS unsigned char* vp = VTM + (32 * db + r32) * VPB + 64 * kb + 32 * s + 8 * hh;
                const s16x4 lo = *(const LAS s16x4*)vp, hi = *(const LAS s16x4*)(vp + 16);
                const bf16x8 bfr = (bf16x8){lo[0], lo[1], lo[2], lo[3], hi[0], hi[1], hi[2], hi[3]};
                o[db] = MFMA32(__builtin_bit_cast(bf16x8, pk[kb][s]), bfr, o[db]); } }
    LDS_WAIT(); asm volatile("" ::: "memory");
#pragma unroll
    for (int i = 0; i < 16; ++i) { const int ql = crow_(i, hh); const float rl = __builtin_amdgcn_rcpf(LSUM[w * 32 + ql]);
#pragma unroll
        for (int db = 0; db < 4; ++db) MQ[((size_t)qbb * 256 + 32 * w + ql) * 512 + hm * 128 + 32 * db + r32] = (bf16)f2bf(o[db][i] * rl); }
    LDS_WAIT(); asm volatile("" ::: "memory"); }
    LBAR();
}
__device__ __forceinline__ float lse2f(float a, float b) { const float m = fmaxf(a, b), d = fminf(a, b) - m; return (m == -INFINITY) ? m : m + __log2f(1.f + __builtin_amdgcn_exp2f(d)); }
__device__ __forceinline__ void fcumsum_unit(const Ptrs& P, LAS unsigned char* lds, int hf, int wv) {
    const int tid = fresh_tid(wv), lane = tid & 63, w = wv;
    const float* LF = (const float*)(P.ws + WS_LOGF) + (size_t)hf * S_; float* F = (float*)(P.ws + WS_F) + (size_t)hf * S_;
    LAS float* X = (LAS float*)lds; LAS float* WT = (LAS float*)(lds + 69632);
#pragma unroll 8
    for (int j = 0; j < 32; ++j) { const int t = j * 512 + tid; X[t + (t >> 5)] = LF[t]; }
    LBAR();
    float loc[32]; float s = 0.f;
#pragma unroll
    for (int i = 0; i < 32; ++i) { s += X[tid * 33 + i]; loc[i] = s; }
    float incl = s;
#pragma unroll
    for (int o = 1; o < 64; o <<= 1) { const float y = __shfl_up(incl, o); if (lane >= o) incl += y; }
    if (lane == 63) WT[w] = incl;
    LBAR();
    float woff = 0.f;
#pragma unroll
    for (int ww = 0; ww < 8; ++ww) { const float a = WT[ww]; if (ww < w) woff += a; }
    const float off = woff + incl - s;
#pragma unroll
    for (int i = 0; i < 32; ++i) { loc[i] = off + loc[i]; X[tid * 33 + i] = loc[i]; }
    LBAR();
#pragma unroll 8
    for (int j = 0; j < 32; ++j) { const int t = j * 512 + tid; F[t] = X[t + (t >> 5)]; }
    LBAR();
    const float ref = loc[0]; float accl = 0.f;
#pragma unroll
    for (int i = 0; i < 32; ++i) accl += __builtin_amdgcn_exp2f((ref - loc[i]) * LOG2E_);
    float linc = __log2f(accl) - ref * LOG2E_;
#pragma unroll
    for (int o = 1; o < 64; o <<= 1) { const float y = __shfl_up(linc, o); if (lane >= o) linc = lse2f(linc, y); }
    if (lane == 63) WT[w] = linc;
    LBAR();
    float wpre = -INFINITY;
#pragma unroll
    for (int ww = 0; ww < 8; ++ww) { const float a = WT[ww]; if (ww < w) wpre = lse2f(wpre, a); }
    if ((tid & 3) == 3) ((float*)(P.ws + WS_LSEF))[hf * 128 + (tid >> 2)] = lse2f(wpre, linc);
    LBAR();
}

__device__ __forceinline__ void normmax_unit(const Ptrs& P, LAS unsigned char* lds, int j, int wv) {
    const int tid = fresh_tid(wv), r = tid >> 3, h = tid & 7;
    const bf16* FQ = (const bf16*)(P.ws + WS_FQ); const bf16* FK = (const bf16*)(P.ws + WS_FK); LAS float* RED = (LAS float*)lds;
    const v4u* qp = (const v4u*)(FQ + (size_t)(64 * j + r) * 512 + h * 64); const v4u* kp = (const v4u*)(FK + (size_t)(64 * j + r) * 512 + h * 64);
    float sq = 0.f, sk = 0.f, sd = 0.f;
#pragma unroll
    for (int c = 0; c < 8; ++c) { const v4u a = qp[c], b = kp[c];
        sq += bflo(a.x) * bflo(a.x) + bfhi(a.x) * bfhi(a.x) + bflo(a.y) * bflo(a.y) + bfhi(a.y) * bfhi(a.y) + bflo(a.z) * bflo(a.z) + bfhi(a.z) * bfhi(a.z) + bflo(a.w) * bflo(a.w) + bfhi(a.w) * bfhi(a.w);
        sk += bflo(b.x) * bflo(b.x) + bfhi(b.x) * bfhi(b.x) + bflo(b.y) * bflo(b.y) + bfhi(b.y) * bfhi(b.y) + bflo(b.z) * bflo(b.z) + bfhi(b.z) * bfhi(b.z) + bflo(b.w) * bflo(b.w) + bfhi(b.w) * bfhi(b.w);
        sd += bflo(a.x) * bflo(b.x) + bfhi(a.x) * bfhi(b.x) + bflo(a.y) * bflo(b.y) + bfhi(a.y) * bfhi(b.y) + bflo(a.z) * bflo(b.z) + bfhi(a.z) * bfhi(b.z) + bflo(a.w) * bflo(b.w) + bfhi(a.w) * bfhi(b.w); }
    RED[tid] = sq; RED[512 + tid] = sk; RED[1024 + tid] = -sd;
    LBAR();
    if (tid < 16) { const int hh = tid & 7, which = tid >> 3; float m = 0.f;
        for (int rr = 0; rr < 64; ++rr) m = fmaxf(m, RED[which * 512 + rr * 8 + hh]);
        atomicMax((unsigned*)P.ws + which * 8 + hh, __float_as_uint(m));
        if (which == 0) ((float*)(P.ws + WS_QB2))[j * 8 + hh] = m; }
    else if (tid < 24) { const int hh = tid & 7; float m = -INFINITY;
        for (int rr = 0; rr < 64; ++rr) m = fmaxf(m, RED[1024 + rr * 8 + hh]);
        ((float*)(P.ws + WS_NDOT))[j * 8 + hh] = m; }
    LBAR();
}
#define RLX_AGENT __ATOMIC_RELAXED, __HIP_MEMORY_SCOPE_AGENT
#define XB_TMO      128
#define XB_XCNT(j)  (256  + 64 * (j))
#define XB_XSUB(j)  (1280 + 64 * (j))
#define XB_XGEN(j)  (2304 + 64 * (j))
#define XB_TOP      3328
#define XB_TOPGEN   3392
#define XCD_BAR_WORDS 3456
#define XB_SPIN_CAP (1u << 18)

__device__ __forceinline__ unsigned xb_ld(unsigned* p)              { return __hip_atomic_load(p, __ATOMIC_RELAXED, __HIP_MEMORY_SCOPE_AGENT); }
__device__ __forceinline__ unsigned xb_add(unsigned* p, unsigned v) { return __hip_atomic_fetch_add(p, v, __ATOMIC_RELAXED, __HIP_MEMORY_SCOPE_AGENT); }
__device__ __forceinline__ unsigned xb_xcc_id() { return (unsigned)__builtin_amdgcn_s_getreg((3 << 11) | 20) & 0xFu; }
#define XB_SPIN(cond, bar) do { unsigned _sp = 0; while (cond) { __builtin_amdgcn_s_sleep(1); \
    if ((++_sp & 255u) == 0u) { if (xb_ld(&(bar)[XB_TMO])) break; if (_sp > XB_SPIN_CAP) { atomicAdd(&(bar)[XB_TMO], 1u); break; } } } } while (0)

struct XcdBarrier {
    unsigned* bar; unsigned x;
    volatile LAS unsigned* st;
};

__device__ __forceinline__ XcdBarrier xcd_barrier_post(unsigned* bar, volatile LAS unsigned* st, int wv) {
    XcdBarrier b; b.bar = bar; b.x = xb_xcc_id(); b.st = st;
    if (fresh_tid(wv) == 0) (void)xb_add(&bar[XB_XCNT(b.x)], 1u);
    return b;
}
__device__ __forceinline__ void xcd_barrier_complete(unsigned* bar, unsigned x, unsigned& nloc, unsigned& nx) {
    const unsigned G = gridDim.x * gridDim.y * gridDim.z;
    unsigned sum, cnt, mine, sp = 0u;
    for (;;) {
        sum = 0u; cnt = 0u; mine = 0u;
#pragma unroll
        for (unsigned j = 0; j < 16; ++j) { const unsigned c = xb_ld(&bar[XB_XCNT(j)]); sum += c; cnt += (c > 0u) ? 1u : 0u; mine = (j == x) ? c : mine; }
        if (sum == G) break;
        __builtin_amdgcn_s_sleep(1);
        if ((++sp & 255u) == 0u) { if (xb_ld(&bar[XB_TMO])) break; if (sp > XB_SPIN_CAP) { atomicAdd(&bar[XB_TMO], 1u); break; } }
    }
    nloc = mine > 0u ? mine : 1u; nx = cnt > 0u ? cnt : 1u;
}

__device__ __forceinline__ void xcd_barrier(const XcdBarrier& b, int wv) {
    asm volatile("s_waitcnt vmcnt(0)" ::: "memory");
    __syncthreads();
    if (fresh_tid(wv) == 0) {
        unsigned* bar = b.bar;
        __builtin_amdgcn_s_waitcnt(0);
        unsigned nloc = b.st[0], nx = b.st[1];
        if (nloc == 0u) { xcd_barrier_complete(bar, b.x, nloc, nx); b.st[0] = nloc; b.st[1] = nx; }
        const unsigned old = xb_add(&bar[XB_XSUB(b.x)], 1u);
        const unsigned gen = old / nloc;
        if (old + 1u == (gen + 1u) * nloc) {
            __builtin_amdgcn_fence(__ATOMIC_RELEASE, "agent");
            asm volatile("s_waitcnt vmcnt(0)" ::: "memory");
            const unsigned og = xb_add(&bar[XB_TOP], 1u);
            const unsigned tg = og / nx;
            if (og + 1u == (tg + 1u) * nx) xb_add(&bar[XB_TOPGEN], 1u);
            else XB_SPIN(xb_ld(&bar[XB_TOPGEN]) == tg, bar);
            __builtin_amdgcn_fence(__ATOMIC_ACQUIRE, "agent");
            xb_add(&bar[XB_XGEN(b.x)], 1u);
            asm volatile("s_waitcnt vmcnt(0)" ::: "memory");
        } else {
            XB_SPIN(xb_ld(&bar[XB_XGEN(b.x)]) == gen, bar);
            __builtin_amdgcn_fence(__ATOMIC_ACQUIRE, "agent");
            asm volatile("s_waitcnt vmcnt(0)" ::: "memory");
        }
    }
    __syncthreads();
}

constexpr int CW_BAR = 4096;
constexpr size_t CTL_ZERO_BYTES = 65536;
constexpr int MISC_OFF = 151552;
struct Args { const float* in[18]; float* out; unsigned char* ws; int ph_lo, ph_hi; };
constexpr int N_PHASES = 9;
__global__ void __launch_bounds__(NWAVES * 64, 2) hybrid_fwd(Args args) {
    extern __shared__ __attribute__((aligned(16))) unsigned char lds_raw[];
    cg::grid_group grid = cg::this_grid();
    LAS unsigned char* lds = (LAS unsigned char*)lds_raw;
    const int wv = __builtin_amdgcn_readfirstlane((int)(threadIdx.x >> 6));
    const int G = gridDim.x, bx = blockIdx.x; const int vcu = (G % 8 == 0) ? (bx % 8) * (G / 8) + bx / 8 : bx;
    Ptrs P;
    P.x = args.in[0]; P.mem = args.in[1]; P.g_mix = args.in[2]; P.w_in = args.in[3]; P.w_alpha_up = args.in[4]; P.b_alpha = args.in[5]; P.b_forget = args.in[6]; P.g_gla_head = args.in[7];
    P.g_mem = args.in[8]; P.w_mem_kv = args.in[9]; P.w_gla_o = args.in[10]; P.w_fox_o = args.in[11]; P.w_mem_o = args.in[12]; P.w_out = args.in[13]; P.g_ffn = args.in[14]; P.w_ff1 = args.in[15];
    P.w_ff2 = args.in[16]; P.g_final = args.in[17]; P.out = args.out; P.ws = args.ws;
    unsigned char* ws = args.ws;
    const int lo = args.ph_lo, hi = args.ph_hi;
    if (hi > 1000) grid.sync();
    volatile LAS unsigned* MISC = (volatile LAS unsigned*)(lds + MISC_OFF);
    { const int t_ = fresh_tid(wv); if (t_ < 2) MISC[t_] = 0u; }
    __syncthreads();
    const XcdBarrier bar = xcd_barrier_post((unsigned*)ws + CW_BAR, MISC, wv);
#ifndef PH_MASK
#define PH_MASK 0x3ff
#endif
#define IN(k) ((((PH_MASK) >> (k)) & 1) && lo <= (k) && (k) < hi)
#ifdef PROBE_PHASE
#define STAMP(k) do { if (bx == 0 && fresh_tid(wv) == 0) ((unsigned long long*)(ws + 253 * MiB))[(k)] = __builtin_amdgcn_s_memrealtime(); } while (0)
#else
#define STAMP(k) do {} while (0)
#endif
#define SEAM(k) do { if (lo <= (k) && (k) + 1 < hi) xcd_barrier(bar, wv); STAMP((k) + 1); } while (0)

    STAMP(0);
#define STAGGER() do { const int grp_ = (bx >> 3) & 3; for (int i_ = 0; i_ < grp_; ++i_) __builtin_amdgcn_s_sleep(127); } while (0)
    if (IN(0)) { p0_prologue(P, lds, vcu, G, wv); __syncthreads(); }
    SEAM(0);
    if (IN(1)) {
        ProjSched S{(const char*)P.out + OUT_U, (const char*)(ws + WS_MEMN), (const char*)(ws + WS_WIN), G, bx, wv};
        EpiProj E{ws, P.b_forget};
        STAGGER();
        pg8::gemm_phase<EpiProj, ProjSched, true, true>(lds, 1024, 1024, 1024, S, E);
    }
    SEAM(1);
    if (IN(2)) {
        if (bx < 8) fcumsum_unit(P, lds, bx, wv);
        else for (int u = bx - 8; u < 256; u += G - 8) normmax_unit(P, lds, u, wv);
    }
    SEAM(2);
    if (IN(3)) {
        const attn_body::AttnTensors AT{(const attn_body::bf16*)(ws + WS_FQ), (const attn_body::bf16*)(ws + WS_FK), (const attn_body::bf16*)(ws + WS_FV), (attn_body::bf16*)(ws + WS_FQ), (const float*)(ws + WS_F)};
        LAS float* THRU = (LAS float*)(lds + MISC_OFF + 128); volatile LAS unsigned* qslot = (volatile LAS unsigned*)(lds + MISC_OFF + 32);
        { const int i_ = fresh_tid(wv); const int h_ = i_ & 7, qb_ = i_ >> 3;
          const float* QB2 = (const float*)(ws + WS_QB2); const float* NDOT = (const float*)(ws + WS_NDOT); const float k2 = __uint_as_float(((const unsigned*)ws)[8 + h_]);
          float a2 = 0.f, b = -INFINITY;
#pragma unroll
          for (int bb = 0; bb < 4; ++bb) { a2 = fmaxf(a2, QB2[(4 * qb_ + bb) * 8 + h_]); b = fmaxf(b, NDOT[(4 * qb_ + bb) * 8 + h_]); }
          THRU[qb_ * 8 + h_] = -(24.1f + 1.01f * sqrtf(a2 * k2) + b); }
        __syncthreads();
        for (;;) {
            if (fresh_tid(wv) == 0) qslot[0] = __hip_atomic_fetch_add((unsigned*)ws + 64, 1u, __ATOMIC_RELAXED, __HIP_MEMORY_SCOPE_AGENT);
            asm volatile("s_waitcnt vmcnt(0) lgkmcnt(0)\n\ts_barrier" ::: "memory");
            const int idx = __builtin_amdgcn_readfirstlane((int)qslot[0]);
            if (idx >= 1664) break;
            if (idx < 512) { const int h = idx & 7, qb = 63 - (idx >> 3); attn_body::attn_unit<8>(0, h, qb, AT.Q, AT.K, AT.V, AT.O, AT.F + (size_t)h * S_, (const float*)(ws + WS_LSEF) + h * 128, THRU[qb * 8 + h], (char*)lds_raw, wv); }
            else if (idx < 640) memattn_unit(P, lds, (idx - 512) & 3, (idx - 512) >> 2, wv);
            else gla_a_unit(P, lds, (idx - 640) >> 2, (idx - 640) & 3, wv);
        }
    }
    SEAM(3);
    if (IN(3)) { for (int u = bx; u < 256; u += G) gla_scan_unit(P, lds, u, wv); }
    if (lo <= 3 && 4 < hi) xcd_barrier(bar, wv);
    STAMP(40);

    if (IN(4)) { for (int task = bx * NWAVES + wv; task < 2048; task += G * NWAVES) { const int lane_ = fresh_tid(wv) & 63; gla_b_task(P, task, lane_); } }
    SEAM(4);
    if (IN(5)) {
        static_assert(WS_FQ - WS_GG == 16 * MiB && WS_MQ - WS_FQ == 16 * MiB && WS_WFOXO - WS_WGLAO == MiB && WS_WMEMO - WS_WFOXO == MiB, "merge operand spacing");
        MergeSched S{(const char*)(ws + WS_GG), (const char*)(ws + WS_WGLAO), G, bx, wv, 16 * MiB - 1024, MiB - 1024};
        EpiMerge E{(bf16*)(ws + WS_MG), (const bf16*)(ws + WS_GT)};
        pg8::gemm_phase<EpiMerge, MergeSched, true, true, 8>(lds, 1536, 512, 512, S, E);
    }
    SEAM(5);
    if (IN(6)) {
        GemmSched S{(const char*)(ws + WS_MG), (const char*)(ws + WS_WOUT), 64, 4, 1024, 1024, G, bx, wv};
        EpiResid<true, false> E{P.x, (bf16*)(ws + WS_H0), (bf16*)(ws + WS_H1) - (size_t)8192 * 1024, (bf16*)(ws + WS_U2), P.g_ffn, (float*)(ws + WS_SS1)};
        pg8::gemm_phase<EpiResid<true, false>, GemmSched, true, true>(lds, 1024, 1024, 1024, S, E);
    }
    SEAM(6);
    if (IN(7)) {
        GemmSched S{(const char*)(ws + WS_U2), (const char*)(ws + WS_WFF1), 64, 16, 1024, 1024, G, bx, wv};
        EpiFfn1 E{(bf16*)(ws + WS_HID), (const float*)(ws + WS_SS1)};
        STAGGER();
        pg8::gemm_phase<EpiFfn1, GemmSched, true, true>(lds, 1024, 1024, 1024, S, E);
    }
    SEAM(7);
    if (IN(8)) {
        GemmSched S{(const char*)(ws + WS_HID), (const char*)(ws + WS_WFF2), 64, 4, 4096, 4096, G, bx, wv};
        EpiFinal E{(const bf16*)(ws + WS_H0), (const bf16*)(ws + WS_H1) - (size_t)8192 * 1024, P.out, P.g_final, (float*)(ws + WS_SS2), (unsigned*)ws + CW_PANEL};
        pg8::gemm_phase<EpiFinal, GemmSched, false, true>(lds, 4096, 4096, 4096, S, E);
    }
    STAMP(9);
#ifdef PROBE_PHASE
    __syncthreads(); xcd_barrier(bar, wv); STAMP(10);
    if (PROBE_PHASE == 200) { xcd_barrier(bar, wv); xcd_barrier(bar, wv); xcd_barrier(bar, wv); xcd_barrier(bar, wv); STAMP(11); }
    if (bx == 0) { __syncthreads(); const unsigned long long* ts = (const unsigned long long*)(ws + 253 * MiB);
        long K = (PROBE_PHASE < 0) ? 100000 : (PROBE_PHASE == 200) ? (long)(ts[11] - ts[10]) * 10 : (PROBE_PHASE == 777) ? (long)((ts[61] - ts[60]) / 5 + 540 * ((ts[62] - ts[61]) / 5)) : (PROBE_PHASE == 778) ? (long)((ts[63] - ts[62]) / 5 + 540 * ((ts[64] - ts[63]) / 5)) : (PROBE_PHASE >= 1000) ? (long)(ts[PROBE_PHASE % 1000] - ts[PROBE_PHASE / 1000]) : (PROBE_PHASE >= 100 ? (long)(ts[10] - ts[0]) / 10 : (long)(ts[PROBE_PHASE + 1] - ts[PROBE_PHASE]));
        if (K > 300000) K = 300000;
        for (long i = fresh_tid(wv); i < K; i += 512) P.out[i] += 0.1f; }
#endif
#undef IN
#undef SEAM
}

extern "C" void kernel_launch(void* const* d_in, const int* in_sizes, int n_in, void* d_out, int out_size, void* d_ws, size_t ws_size, hipStream_t stream) {
    static int grid = 0;
    if (grid == 0) {
        if (n_in != 18 || out_size != S_ * DM_ || ws_size < WS_END) { fprintf(stderr, "kernel_launch: unexpected shapes (n_in %d out %d ws %zu)\n", n_in, out_size, ws_size); grid = -1; return; }
        int dev = 0, cus = 0, per_cu = 0;
        (void)hipGetDevice(&dev); (void)hipDeviceGetAttribute(&cus, hipDeviceAttributeMultiprocessorCount, dev);
        (void)hipFuncSetAttribute((const void*)hybrid_fwd, hipFuncAttributeMaxDynamicSharedMemorySize, LDS_BYTES);
        (void)hipOccupancyMaxActiveBlocksPerMultiprocessor(&per_cu, (const void*)hybrid_fwd, NWAVES * 64, LDS_BYTES);
        (void)hipGetLastError();
        grid = 256;
        if (cus != 256 || per_cu < 1) fprintf(stderr, "kernel_launch: note: cus %d per_cu %d (built for 256 CUs, one workgroup each)\n", cus, per_cu);
    }
    if (grid < 0) return;
    (void)hipMemsetAsync(d_ws, 0, CTL_ZERO_BYTES, stream);
    Args a{};
    for (int i = 0; i < 18; ++i) a.in[i] = (const float*)d_in[i];
    a.out = (float*)d_out; a.ws = (unsigned char*)d_ws;
#ifndef MK_PER_PHASE
    a.ph_lo = 0; a.ph_hi = N_PHASES;
    { void* kargs[] = {&a}; hipError_t e = hipLaunchCooperativeKernel((const void*)hybrid_fwd, dim3(grid), dim3(NWAVES * 64), kargs, LDS_BYTES, stream);
      if (e != hipSuccess) fprintf(stderr, "cooperative launch failed: %s\n", hipGetErrorString(e)); }
#else
    for (int k = 0; k < N_PHASES; ++k) { a.ph_lo = k; a.ph_hi = k + 1; void* kargs[] = {&a};
        hipError_t e = hipLaunchCooperativeKernel((const void*)hybrid_fwd, dim3(grid), dim3(NWAVES * 64), kargs, LDS_BYTES, stream);
        if (e != hipSuccess) { fprintf(stderr, "cooperative launch %d failed: %s\n", k, hipGetErrorString(e)); break; } }
#endif
}
```

```cpp
#include <hip/hip_runtime.h>
#include <hip/hip_cooperative_groups.h>
#include <hip/hip_bf16.h>
#include <cstdio>
#include <cstdint>
#include <cmath>
namespace cg = cooperative_groups;
__device__ __forceinline__ int fresh_tid(int wv) { int lane_; asm volatile("v_mbcnt_lo_u32_b32 %0, -1, 0\n\tv_mbcnt_hi_u32_b32 %0, -1, %0" : "=v"(lane_)); return wv * 64 + lane_; }
namespace pg8 {
#define PG8_LAS __attribute__((address_space(3)))
typedef unsigned short bf16_t;
typedef short bf16x8 __attribute__((ext_vector_type(8)));
typedef float f32x4 __attribute__((ext_vector_type(4)));
typedef unsigned u32x4 __attribute__((ext_vector_type(4)));
constexpr int BM = 256, BK = 64, HALF = 128, HTB = HALF * BK * 2  , STAGE_BYTES = 8 * HTB, NXCD = 8, WGM = 8;

__host__ __device__ __forceinline__ int lds_byte(int r, int c) { const int st = (r >> 4) * 2 + (c >> 5), rr = r & 15, cc = c & 31, ob = rr * 64 + cc * 2; return st * 1024 + (ob ^ (((ob >> 9) & 1) << 5)); }
__host__ __device__ __forceinline__ void stage_rc(int b, int& R, int& C) { const int st = b / 1024, sb = b % 1024, swz = sb ^ (((sb >> 9) & 1) << 5); R = (st >> 1) * 16 + swz / 64; C = (st & 1) * 32 + (swz % 64) / 2; }
__host__ __device__ __forceinline__ int perm32(int rho) { const int n = rho >> 4, i = rho & 15; return 8 * (i >> 2) + 4 * n + (i & 3); }

struct Unit { int pm, pn, z; };
__device__ __forceinline__ unsigned cvt_pk_bf16(float lo, float hi) { unsigned r; asm volatile("v_cvt_pk_bf16_f32 %0, %1, %2" : "=v"(r) : "v"(lo), "v"(hi)); return r; }
__device__ __forceinline__ void map_tile(int L, int nM, int nN, int& pm, int& pn) {
    const int nwg = nM * nN; int wgid = L; { const int q = nwg / NXCD, r = nwg % NXCD, xcd = wgid % NXCD, off = wgid / NXCD; wgid = (xcd < r ? xcd * (q + 1) : r * (q + 1) + (xcd - r) * q) + off; }
    const int nig = WGM * nN, gid = wgid / nig, fm = gid * WGM, gsz = (nM - fm) < WGM ? (nM - fm) : WGM;
    pm = fm + ((wgid % nig) % gsz); pn = (wgid % nig) / gsz;
}
template <class Epi, class Sched, bool ALIGN_EPI = false, bool SP2 = false, int SEGT = 0>
__device__ __forceinline__ void gemm_phase(PG8_LAS unsigned char* lds, const int K, const int lda, const int ldb, const Sched& S, const Epi& E) {
    const int tid = fresh_tid(S.wv), wid = S.wv, lane = tid & 63, wr = wid >> 2, wc = wid & 3, fr = lane & 15, fq = lane >> 4;
    const int nt = K / BK;
    unsigned voffA[2], voffB[2];
#pragma unroll
    for (int i = 0; i < 2; ++i) { int R, C; stage_rc(tid * 16 + i * 8192, R, C); const int Rb = Epi::PERM ? ((R & ~31) + perm32(R & 31)) : R;
        voffA[i] = (unsigned)(R * lda + C) * 2u; voffB[i] = (unsigned)(Rb * ldb + C) * 2u; }
    const size_t kstep = (size_t)(BK * 2);
    const size_t hstepA = (size_t)HALF * lda * 2, hstepB = (size_t)HALF * ldb * 2;
    const unsigned ldsw = (unsigned)wid * 1024u;
    const int aoff = lds_byte(wr * 64 + fr, fq * 8), boff = lds_byte(wc * 32 + fr, fq * 8);
#define PG8_SA(b, h) (((b) * 2 + (h)) * HTB)
#define PG8_SB(b, h) ((4 + (b) * 2 + (h)) * HTB)
#define PG8_STAGE(bufoff, gbase, voff) do { _Pragma("unroll") for (int _i = 0; _i < 2; ++_i) \
        __builtin_amdgcn_global_load_lds((const unsigned*)((const char*)(gbase) + (voff)[_i]), (PG8_LAS unsigned*)(lds + (bufoff) + ldsw + _i * 8192), 16, 0, 0); } while (0)
#define PG8_LDA(dst, b, h) do { _Pragma("unroll") for (int m = 0; m < 4; ++m) _Pragma("unroll") for (int k = 0; k < 2; ++k) dst[m][k] = *(const PG8_LAS bf16x8*)(lds + PG8_SA(b, h) + aoff + m * 2048 + k * 1024); } while (0)
#define PG8_LDB(dst, b, h) do { _Pragma("unroll") for (int n = 0; n < 2; ++n) _Pragma("unroll") for (int k = 0; k < 2; ++k) dst[n][k] = *(const PG8_LAS bf16x8*)(lds + PG8_SB(b, h) + boff + n * 2048 + k * 1024); } while (0)
#define PG8_MMA(ai, bj, At, Bt) do { __builtin_amdgcn_s_setprio(1); _Pragma("unroll") for (int m = 0; m < 4; ++m) _Pragma("unroll") for (int n = 0; n < 2; ++n) _Pragma("unroll") for (int k = 0; k < 2; ++k) \
        acc[ai][bj][m][n] = __builtin_amdgcn_mfma_f32_16x16x32_bf16(Bt[n][k], At[m][k], acc[ai][bj][m][n], 0, 0, 0); __builtin_amdgcn_s_setprio(0); } while (0)
#define PG8_WAIT_V(n) asm volatile("s_waitcnt vmcnt(" #n ")" ::: "memory")
#define PG8_WAIT_L(n) asm volatile("s_waitcnt lgkmcnt(" #n ")" ::: "memory")
#define PG8_BAR __builtin_amdgcn_s_barrier()
#define PG8_SCHED __builtin_amdgcn_sched_barrier(0)
    Unit cur, nxt; int ui = 0;
    if (!S.next(0, cur)) return;
    f32x4 acc[2][2][4][2];
#pragma unroll
    for (int a = 0; a < 2; ++a)
#pragma unroll
        for (int b = 0; b < 2; ++b)
#pragma unroll
            for (int m = 0; m < 4; ++m)
#pragma unroll
                for (int n = 0; n < 2; ++n) acc[a][b][m][n] = (f32x4){0.f, 0.f, 0.f, 0.f};
    bf16x8 At[4][2], B0[2][2], B1[2][2];
    const char* cA = S.aptr(cur); const char* cB = S.bptr(cur);
    S.a_ready(cur);
    if constexpr (SP2) {
        PG8_STAGE(PG8_SB(0, 0), cB, voffB); PG8_STAGE(PG8_SB(0, 1), cB + hstepB, voffB); PG8_STAGE(PG8_SA(0, 0), cA, voffA); PG8_STAGE(PG8_SA(0, 1), cA + hstepA, voffA);
        if (wr == 1) PG8_BAR;
        PG8_WAIT_V(2); PG8_BAR;
        PG8_STAGE(PG8_SB(1, 0), cB + kstep, voffB); PG8_STAGE(PG8_SA(1, 0), cA + kstep, voffA); PG8_STAGE(PG8_SB(1, 1), cB + hstepB + kstep, voffB);
        PG8_WAIT_V(6); PG8_BAR;
    } else {
        PG8_STAGE(PG8_SB(0, 0), cB, voffB); PG8_STAGE(PG8_SA(0, 0), cA, voffA); PG8_STAGE(PG8_SB(0, 1), cB + hstepB, voffB); PG8_STAGE(PG8_SA(0, 1), cA + hstepA, voffA);
        if (wr == 1) PG8_BAR;
        PG8_WAIT_V(4); PG8_BAR;
        PG8_STAGE(PG8_SB(1, 0), cB + kstep, voffB); PG8_STAGE(PG8_SA(1, 0), cA + kstep, voffA); PG8_STAGE(PG8_SB(1, 1), cB + hstepB + kstep, voffB);
        PG8_WAIT_V(6); PG8_BAR;
    }
    for (;;) {
        const bool has_next = S.next(ui + 1, nxt);
        const char* nA = has_next ? S.aptr(nxt) : cA; const char* nB = has_next ? S.bptr(nxt) : cB;
        for (int t = 0; t < nt; t += 2) {
            const bool last = (t == nt - 2);
            size_t sa1 = 0, sa2 = 0, sb2 = 0;
            if constexpr (SEGT > 0) { if (t > 0 && (t % SEGT) == 0) E.mid(acc, cur, t / SEGT, wr, wc, fr, fq);
                sa1 = (size_t)(t / SEGT) * S.segA; sa2 = (size_t)((t + 2) / SEGT) * S.segA; sb2 = (size_t)((t + 2) / SEGT) * S.segB; }
            const char* a1 = cA + (size_t)(t + 1) * kstep + sa1;
            const char* a2 = last ? nA : cA + (size_t)(t + 2) * kstep + sa2; const char* b2 = last ? nB : cB + (size_t)(t + 2) * kstep + sb2;
            const char* a3 = a2 + kstep; const char* b3 = b2 + kstep;
            if (last && has_next) S.a_ready(nxt);
            if constexpr (SP2) {
            PG8_LDB(B0, 0, 0); PG8_LDB(B1, 0, 1); PG8_SCHED; PG8_LDA(At, 0, 0); PG8_STAGE(PG8_SA(1, 1), a1 + hstepA, voffA);
            PG8_WAIT_V(8); PG8_WAIT_L(0); PG8_BAR; PG8_MMA(0, 0, At, B0); PG8_MMA(0, 1, At, B1); PG8_BAR; PG8_SCHED;
            PG8_LDA(At, 0, 1); PG8_STAGE(PG8_SB(0, 0), b2, voffB); PG8_STAGE(PG8_SB(0, 1), b2 + hstepB, voffB); PG8_STAGE(PG8_SA(0, 0), a2, voffA);
            PG8_WAIT_V(8); PG8_WAIT_L(0); PG8_BAR; PG8_MMA(1, 0, At, B0); PG8_MMA(1, 1, At, B1); PG8_BAR; PG8_SCHED;
            PG8_LDB(B0, 1, 0); PG8_LDB(B1, 1, 1); PG8_SCHED; PG8_LDA(At, 1, 0); PG8_STAGE(PG8_SA(0, 1), a2 + hstepA, voffA);
            PG8_WAIT_V(8); PG8_WAIT_L(0); PG8_BAR; PG8_MMA(0, 0, At, B0); PG8_MMA(0, 1, At, B1); PG8_BAR; PG8_SCHED;
            PG8_LDA(At, 1, 1); PG8_STAGE(PG8_SB(1, 0), b3, voffB); PG8_STAGE(PG8_SB(1, 1), b3 + hstepB, voffB); PG8_STAGE(PG8_SA(1, 0), a3, voffA);
            PG8_WAIT_V(8); PG8_WAIT_L(0); PG8_BAR; PG8_MMA(1, 0, At, B0); PG8_MMA(1, 1, At, B1); PG8_BAR; PG8_SCHED;
            } else {
            PG8_LDB(B0, 0, 0); PG8_SCHED; PG8_LDA(At, 0, 0); PG8_STAGE(PG8_SA(1, 1), a1 + hstepA, voffA);
            PG8_WAIT_L(8); PG8_BAR; PG8_WAIT_L(0); PG8_MMA(0, 0, At, B0); PG8_BAR; PG8_SCHED;
            PG8_LDB(B1, 0, 1); PG8_STAGE(PG8_SB(0, 0), b2, voffB);
            PG8_BAR; PG8_WAIT_L(0); PG8_MMA(0, 1, At, B1); PG8_BAR;
            PG8_LDA(At, 0, 1); PG8_STAGE(PG8_SA(0, 0), a2, voffA);
            PG8_BAR; PG8_WAIT_L(0); PG8_MMA(1, 0, At, B0); PG8_BAR; PG8_SCHED;
            PG8_STAGE(PG8_SB(0, 1), b2 + hstepB, voffB);
            PG8_WAIT_V(6); PG8_BAR; PG8_MMA(1, 1, At, B1); PG8_BAR;
            PG8_LDB(B0, 1, 0); PG8_SCHED; PG8_LDA(At, 1, 0); PG8_STAGE(PG8_SA(0, 1), a2 + hstepA, voffA);
            PG8_WAIT_L(8); PG8_BAR; PG8_WAIT_L(0); PG8_MMA(0, 0, At, B0); PG8_BAR; PG8_SCHED;
            PG8_LDB(B1, 1, 1); PG8_STAGE(PG8_SB(1, 0), b3, voffB);
            PG8_BAR; PG8_WAIT_L(0); PG8_MMA(0, 1, At, B1); PG8_BAR;
            PG8_LDA(At, 1, 1); PG8_STAGE(PG8_SA(1, 0), a3, voffA);
            PG8_BAR; PG8_WAIT_L(0); PG8_MMA(1, 0, At, B0); PG8_BAR; PG8_SCHED;
            PG8_STAGE(PG8_SB(1, 1), b3 + hstepB, voffB);
            PG8_WAIT_V(6); PG8_BAR; PG8_MMA(1, 1, At, B1); PG8_BAR;
            }
        }
        if constexpr (ALIGN_EPI) { if (wr == 0) PG8_BAR; }
        if constexpr (!Epi::AFTER_DRAIN) { E(acc, cur, wr, wc, fr, fq); S.done(cur); }
        if (!has_next) break;
#pragma unroll
        for (int a = 0; a < 2; ++a)
#pragma unroll
            for (int b = 0; b < 2; ++b)
#pragma unroll
                for (int m = 0; m < 4; ++m)
#pragma unroll
                    for (int n = 0; n < 2; ++n) acc[a][b][m][n] = (f32x4){0.f, 0.f, 0.f, 0.f};
        cur = nxt; cA = nA; cB = nB; ++ui;
        if constexpr (ALIGN_EPI) { if (wr == 1) PG8_BAR; }
    }
    PG8_WAIT_V(0);
    if constexpr (!ALIGN_EPI) { if (wr == 0) PG8_BAR; }
    PG8_BAR;
    if constexpr (Epi::AFTER_DRAIN) { E.fused(acc, cur, wr, wc, fr, fq, lds, wid, lane); S.done(cur); }
#undef PG8_SA
#undef PG8_SB
#undef PG8_STAGE
#undef PG8_LDA
#undef PG8_LDB
#undef PG8_MMA
#undef PG8_WAIT_V
#undef PG8_WAIT_L
#undef PG8_BAR
#undef PG8_SCHED
}
}
#include <hip/hip_bf16.h>
namespace attn_body {
using bf16=__hip_bfloat16;
using bf16x8=__attribute__((ext_vector_type(8)))short;
using s16x4=__attribute__((ext_vector_type(4)))short;
using f32x16=__attribute__((ext_vector_type(16)))float;
using u32x4=__attribute__((ext_vector_type(4)))unsigned;
constexpr int BATCH=1,NHEAD=8,SEQ=16384,D=64,DM=NHEAD*D;
constexpr int NW=8,QBLK=32,QB=QBLK*NW,KVBLK=64,NQB=SEQ/QB;
constexpr int ATTN_PITCH=DM, ATTN_UNIT_ROWS=QB;
__device__ __forceinline__ int crow(int r,int hi){return (r&3)+8*(r>>2)+4*hi;}
#define SBAR() __builtin_amdgcn_sched_barrier(0)
__device__ __forceinline__ void cmask(f32x16&p0,f32x16&p1,int jb,int qrel,int hi){
  const float NEG=-INFINITY; int kb=64*jb+4*hi;
  #pragma unroll
  for(int r=0;r<16;++r){int kv=kb+(r&3)+8*(r>>2); if(kv>qrel)p0[r]=NEG; if(kv+32>qrel)p1[r]=NEG;}
}

constexpr int NSLOT=3, SLOTB=8192;
constexpr int LDS_K=0, LDS_V=NSLOT*SLOTB, LDS_WS=2*NSLOT*SLOTB, LDS_OST=LDS_WS+NW*64*4, LDS_BIAS=LDS_OST+NW*4096, LDS_BYTES=LDS_BIAS+SEQ*4+512;
constexpr float C2=0.125f*1.4426950408889634f;
__device__ __forceinline__ void glds16(const void*gsrc,unsigned lds_dst){unsigned keep;
  asm volatile("s_mov_b32 %0, m0\n\ts_mov_b32 m0, %2\n\ts_nop 0\n\tglobal_load_lds_dwordx4 %1, off\n\ts_mov_b32 m0, %0":"=&s"(keep):"v"(gsrc),"s"(lds_dst):"memory");}
__device__ __forceinline__ float max3f(float a,float b,float c){float r;asm("v_max3_f32 %0, %1, %2, %3":"=v"(r):"v"(a),"v"(b),"v"(c));return r;}
__device__ __forceinline__ float max2f(float a,float b){float r;asm("v_max_f32_e32 %0, %1, %2":"=v"(r):"v"(a),"v"(b));return r;}
__device__ __forceinline__ float fadd_s(float a,float b){float r;asm("v_add_f32_e32 %0, %1, %2":"=v"(r):"v"(a),"v"(b));return r;}
__device__ __forceinline__ float fsub_s(float a,float b){float r;asm("v_sub_f32_e32 %0, %1, %2":"=v"(r):"v"(a),"v"(b));return r;}
typedef float f32x2_t __attribute__((ext_vector_type(2))); typedef __bf16 bf16x2_t __attribute__((ext_vector_type(2)));
__device__ __forceinline__ unsigned cvtpk_s(float lo,float hi){f32x2_t v={lo,hi};bf16x2_t b=__builtin_convertvector(v,bf16x2_t);return __builtin_bit_cast(unsigned,b);}
#define WAIT_BAR(N) asm volatile("s_waitcnt vmcnt(" #N ") lgkmcnt(0)\n\ts_barrier":::"memory")

__device__ __forceinline__ void qkt(f32x16&p0,f32x16&p1,const char*Kslot,const bf16x8*qr,int r32,int hi){
  const char*kb=Kslot+hi*1024+r32*16;
  #pragma unroll
  for(int d0=0;d0<4;++d0){
    const bf16x8 b0=*reinterpret_cast<const bf16x8*>(kb+d0*2048);
    const bf16x8 b1=*reinterpret_cast<const bf16x8*>(kb+d0*2048+512);
    p0=__builtin_amdgcn_mfma_f32_32x32x16_bf16(b0,qr[d0],p0,0,0,0);p1=__builtin_amdgcn_mfma_f32_32x32x16_bf16(b1,qr[d0],p1,0,0,0);}
}
typedef __attribute__((address_space(3))) const char* lds_cptr;
typedef short v4i16_t __attribute__((ext_vector_type(4)));
__device__ __forceinline__ void kload8(bf16x8*kf,lds_cptr kp){
  kf[0]=*(const __attribute__((address_space(3))) bf16x8*)(kp);      kf[1]=*(const __attribute__((address_space(3))) bf16x8*)(kp+512);
  kf[2]=*(const __attribute__((address_space(3))) bf16x8*)(kp+2048); kf[3]=*(const __attribute__((address_space(3))) bf16x8*)(kp+2560);
  kf[4]=*(const __attribute__((address_space(3))) bf16x8*)(kp+4096); kf[5]=*(const __attribute__((address_space(3))) bf16x8*)(kp+4608);
  kf[6]=*(const __attribute__((address_space(3))) bf16x8*)(kp+6144); kf[7]=*(const __attribute__((address_space(3))) bf16x8*)(kp+6656);
}
__device__ __forceinline__ void kload2(bf16x8*kf,lds_cptr kp,int j){ kf[2*j]=*(const __attribute__((address_space(3))) bf16x8*)(kp+j*2048); kf[2*j+1]=*(const __attribute__((address_space(3))) bf16x8*)(kp+j*2048+512); }
__device__ __forceinline__ s16x4 vtr(lds_cptr p){ return __builtin_bit_cast(s16x4,__builtin_amdgcn_ds_read_tr16_b64_v4i16((__attribute__((address_space(3))) v4i16_t*)p)); }
__device__ __forceinline__ float rowmax(const f32x16&p0,const f32x16&p1){
  float a=max3f(p0[0],p0[1],p1[0]),b=max3f(p0[2],p0[3],p1[1]);a=max3f(a,p1[2],p1[3]);
  #pragma unroll
  for(int r=4;r<16;r+=4){a=max3f(a,p0[r],p0[r+1]);b=max3f(b,p0[r+2],p0[r+3]);a=max3f(a,p1[r],p1[r+1]);b=max3f(b,p1[r+2],p1[r+3]);}
  const float m=max2f(a,b);
  auto rr=__builtin_amdgcn_permlane32_swap(__float_as_uint(m),__float_as_uint(m),false,false);
  return max2f(__uint_as_float(rr[0]),__uint_as_float(rr[1]));
}
__device__ __forceinline__ void pv(f32x16*o,int vb,bf16x8 pa0,bf16x8 pa1,bf16x8 pa2,bf16x8 pa3){
  #pragma unroll
  for(int d0=0;d0<2;++d0){s16x4 lo[4],hi[4];
    #pragma unroll
    for(int ks=0;ks<4;++ks){
      asm volatile("ds_read_b64_tr_b16 %0,%1 offset:%c2":"=&v"(lo[ks]):"v"(vb),"i"(d0*4096+ks*1024):"memory");
      asm volatile("ds_read_b64_tr_b16 %0,%1 offset:%c2":"=&v"(hi[ks]):"v"(vb),"i"(d0*4096+ks*1024+512):"memory");}
    asm volatile("s_waitcnt lgkmcnt(0)":::"memory");SBAR();
    #define PK(k) (bf16x8){lo[k][0],lo[k][1],lo[k][2],lo[k][3],hi[k][0],hi[k][1],hi[k][2],hi[k][3]}
    o[d0]=__builtin_amdgcn_mfma_f32_32x32x16_bf16(pa0,PK(0),o[d0],0,0,0);
    o[d0]=__builtin_amdgcn_mfma_f32_32x32x16_bf16(pa1,PK(1),o[d0],0,0,0);
    o[d0]=__builtin_amdgcn_mfma_f32_32x32x16_bf16(pa2,PK(2),o[d0],0,0,0);
    o[d0]=__builtin_amdgcn_mfma_f32_32x32x16_bf16(pa3,PK(3),o[d0],0,0,0);
    #undef PK
  }
}

#ifndef ATTN_STORE16
#define ATTN_STORE16(p,v) (*(u32x4*)(p)=(v))
#endif
typedef float f32x4_t __attribute__((ext_vector_type(4)));
template<int THRL> __device__ __forceinline__ void attn_unit(int b,int h,int qb,const bf16*Q,const bf16*__restrict__ K,const bf16*__restrict__ V,bf16*O,const float*__restrict__ Fh,const float*__restrict__ Lh,float thrb,char*shm,int wv){
  const int tid=fresh_tid(wv),lane=tid&63,r32=lane&31,hi=lane>>5; const int wid=wv;
  const long rowbase=(long)b*SEQ; const int q0=qb*QB;
  const bf16*Qw=Q+(rowbase+q0+wid*QBLK)*DM+h*D;
  const lds_cptr shm3=(lds_cptr)shm;
  const float fref=Fh[q0];
  int T0; { __attribute__((address_space(3))) float* pb=(__attribute__((address_space(3))) float*)(shm3+LDS_WS);
    if(tid<2*qb) pb[tid]=Lh[tid]+fref*1.4426950408889634f;
    asm volatile("s_waitcnt lgkmcnt(0)\n\ts_barrier":::"memory");
    int lo_=0,hi_=2*qb; while(lo_<hi_){ const int mid=(lo_+hi_)>>1; if(!(pb[mid]<=thrb)) hi_=mid; else lo_=mid+1; } T0=__builtin_amdgcn_readfirstlane(2*lo_); }
  { __attribute__((address_space(3))) float* bl=(__attribute__((address_space(3))) float*)(shm3+LDS_BIAS);
    #pragma unroll 4
    for(int s=64*T0+tid;s<q0+QB;s+=NW*64) bl[s]=(fref-Fh[s])*1.4426950408889634f; }
  const bf16*Kh=K+(rowbase+(long)T0*KVBLK)*DM+h*D,*Vh=V+(rowbase+(long)T0*KVBLK)*DM+h*D;
  const unsigned lds0=(unsigned)(uintptr_t)shm;
  float*wsf=(float*)(shm+LDS_WS)+wid*64;
  const bf16*ksrc=Kh+(long)lane*DM+wid*8;
  const bf16*vsrc=Vh+(long)(16*(wid&3)+(lane>>2))*DM+(wid>>2)*32+(lane&3)*8;
  const unsigned kdst=lds0+LDS_K+wid*1024, vdst=lds0+LDS_V+wid*1024;
  #define DMA_K(t,slot) glds16(ksrc+(long)(t)*KVBLK*DM,(unsigned)__builtin_amdgcn_readfirstlane(kdst+(slot)))
  #define DMA_V(t,slot) glds16(vsrc+(long)(t)*KVBLK*DM,(unsigned)__builtin_amdgcn_readfirstlane(vdst+(slot)))
  const int vb0=(int)(lds0+LDS_V)+((lane>>4)&1)*32+(lane&3)*8+(4*hi+((lane&15)>>2))*64;
  const char*Kbase=shm+LDS_K; bf16x8 kf[8];
  const lds_cptr kp0=shm3+LDS_K+hi*1024+r32*16; const lds_cptr vp0=shm3+LDS_V+((lane>>4)&1)*32+(lane&3)*8+(4*hi+((lane&15)>>2))*64;
  const int NT=(q0+QB)/KVBLK-T0;
  #define BLOAD(X0,X1,tt) do{ const __attribute__((address_space(3))) f32x4_t* bp_=(const __attribute__((address_space(3))) f32x4_t*)(shm3+LDS_BIAS+(((tt)+T0)*64+4*hi)*4); \
    _Pragma("unroll") for(int g_=0;g_<4;++g_){ const f32x4_t a_=bp_[2*g_], b_=bp_[8+2*g_]; \
      X0[4*g_]=a_[0];X0[4*g_+1]=a_[1];X0[4*g_+2]=a_[2];X0[4*g_+3]=a_[3]; X1[4*g_]=b_[0];X1[4*g_+1]=b_[1];X1[4*g_+2]=b_[2];X1[4*g_+3]=b_[3]; } }while(0)
  DMA_K(0,0);DMA_V(0,0);DMA_K(1,SLOTB);
  bf16x8 qr[4];
  #pragma unroll
  for(int d0=0;d0<4;++d0)qr[d0]=*reinterpret_cast<const bf16x8*>(&Qw[(long)r32*DM+d0*16+hi*8]);
  float mhat=0.f,l_reg=0.f;f32x16 o[2];o[0]=f32x16{};o[1]=f32x16{};
  const int qrel=wid*QBLK+r32;
  #define CMASK(P0,P1,t) do{int jb_=(t)-(NT-4); if(jb_>=0)cmask(P0,P1,jb_,qrel,hi);}while(0)
  bool resc=false;
    \
  #define START(P0,P1) do{ const float rm=rowmax(P0,P1); resc=false; \
    { const float dl=__builtin_fmaxf(rm,((const __attribute__((address_space(3))) float*)(shm3+LDS_BIAS))[q0+qrel]+10.f); mhat=fadd_s(mhat,dl); \
      _Pragma("unroll") for(int r=0;r<16;++r){P0[r]=fsub_s(P0[r],dl);P1[r]=fsub_s(P1[r],dl);} \
 } \
    _Pragma("unroll") for(int r=0;r<16;++r)P0[r]=__builtin_amdgcn_exp2f(P0[r]); }while(0)
  #define RESC() do{ if(resc){ asm volatile("s_waitcnt lgkmcnt(0)":::"memory"); \
      _Pragma("unroll") for(int d_=0;d_<2;++d_) _Pragma("unroll") for(int r=0;r<16;++r)o[d_][r]*=wsf[crow(r,hi)]; } }while(0)
  f32x16 pA0,pA1,pB0,pB1;
  int sl_prev=0,sl_cur=0,sl_next=SLOTB;
  #define ROT() do{sl_prev=sl_cur;sl_cur=sl_next;sl_next=(sl_next==(NSLOT-1)*SLOTB)?0:sl_next+SLOTB;}while(0)
  DMA_K(2,2*SLOTB);
  WAIT_BAR(3);
  BLOAD(pA0,pA1,0); BLOAD(pB0,pB1,1);
  qkt(pA0,pA1,Kbase,qr,r32,hi);asm volatile("s_nop 15\n\ts_nop 7":"+v"(pA0),"+v"(pA1));CMASK(pA0,pA1,0);
  START(pA0,pA1);
  _Pragma("unroll") for(int r=0;r<16;++r)pA1[r]=__builtin_amdgcn_exp2f(pA1[r]);
  WAIT_BAR(0);
  DMA_K(3,0);DMA_V(1,SLOTB);
  ROT();
  kload8(kf,kp0+sl_cur);
  WAIT_BAR(2);
  s16x4 vlo[8],vhi[8]; u32x4 pw0,pw1,pw2,pw3;
  #define PKW(P,B) cvtpk_s(P[B],P[B+1])
  #define PAF(k) __builtin_bit_cast(bf16x8,pw##k)
  #define VFR(i) (bf16x8){vlo[i][0],vlo[i][1],vlo[i][2],vlo[i][3],vhi[i][0],vhi[i][1],vhi[i][2],vhi[i][3]}
  #define PIN(x) asm volatile("":"+v"(x))
  #define MX3(a,b,c) __builtin_fmaxf(__builtin_fmaxf((a),(b)),(c))
  #define GAPA(MF,A0,A1,A2,A3,W0,W1,PW) do{ MF; sacc+=A0; sacc+=A1; sacc+=A2; sacc+=A3; PIN(sacc); W0; W1; PIN(PW); SBAR(); }while(0)
  #define EX(v) __builtin_amdgcn_exp2f(v)
  #define GAPB(MF,X,B) do{ MF; X[B]=EX(X[B]); X[B+1]=EX(X[B+1]); X[B+2]=EX(X[B+2]); X[B+3]=EX(X[B+3]); PIN(X); SBAR(); }while(0)
  #define VRD(i) do{ vlo[i]=vtr(vp_+(((i)>>2)*4096+((i)&3)*1024)); vhi[i]=vtr(vp_+(((i)>>2)*4096+((i)&3)*1024+512)); }while(0)
  #define KRD(G,j) do{ if(G){ kload2(kf,kp0+sl_next,j); SBAR(); } }while(0)
  #define STEP(C0,C1,P0,P1,t,GK,GV,GL) do{ SBAR(); \
    _Pragma("unroll") for(int r=0;r<16;++r){C0[r]-=mhat;C1[r]-=mhat;} \
    const lds_cptr vp_=vp0+sl_prev; \
    VRD(0); SBAR(); float sacc=(P0[0]+P0[1]); \
    GAPA(C0=__builtin_amdgcn_mfma_f32_32x32x16_bf16(kf[0],qr[0],C0,0,0,0), P0[2],P0[3],P0[4],P0[5],     pw0[0]=PKW(P0,0), pw0[1]=PKW(P0,2), pw0); \
    VRD(4); SBAR(); GAPA(C1=__builtin_amdgcn_mfma_f32_32x32x16_bf16(kf[1],qr[0],C1,0,0,0), P0[6],P0[7],P0[8],P0[9],     pw0[2]=PKW(P0,4), pw0[3]=PKW(P0,6), pw0); \
    VRD(1); SBAR(); GAPA(C0=__builtin_amdgcn_mfma_f32_32x32x16_bf16(kf[2],qr[1],C0,0,0,0),   P0[10],P0[11],P0[12],P0[13], pw1[0]=PKW(P0,8), pw1[1]=PKW(P0,10), pw1); \
    VRD(5); SBAR(); GAPA(C1=__builtin_amdgcn_mfma_f32_32x32x16_bf16(kf[3],qr[1],C1,0,0,0),   P0[14],P0[15],P1[0],P1[1],   pw1[2]=PKW(P0,12),pw1[3]=PKW(P0,14), pw1); \
    VRD(2); SBAR(); GAPA(C0=__builtin_amdgcn_mfma_f32_32x32x16_bf16(kf[4],qr[2],C0,0,0,0),   P1[2],P1[3],P1[4],P1[5],     pw2[0]=PKW(P1,0), pw2[1]=PKW(P1,2), pw2); \
    VRD(6); SBAR(); GAPA(C1=__builtin_amdgcn_mfma_f32_32x32x16_bf16(kf[5],qr[2],C1,0,0,0),   P1[6],P1[7],P1[8],P1[9],     pw2[2]=PKW(P1,4), pw2[3]=PKW(P1,6), pw2); \
    VRD(3); SBAR(); GAPA(C0=__builtin_amdgcn_mfma_f32_32x32x16_bf16(kf[6],qr[3],C0,0,0,0),   P1[10],P1[11],P1[12],P1[13], pw3[0]=PKW(P1,8), pw3[1]=PKW(P1,10), pw3); \
    VRD(7); SBAR(); GAPA(C1=__builtin_amdgcn_mfma_f32_32x32x16_bf16(kf[7],qr[3],C1,0,0,0),   P1[14],P1[15],0.f,0.f,       pw3[2]=PKW(P1,12),pw3[3]=PKW(P1,14), pw3); \
    l_reg+=sacc; \
    if(GK){DMA_K((t)+3,sl_cur);} if(GV){DMA_V((t)+1,sl_next);} \
    CMASK(C0,C1,t); \
    { float a=MX3(C0[0],C0[1],C1[0]),b=MX3(C0[2],C0[3],C1[1]); a=MX3(a,C1[2],C1[3]); \
      _Pragma("unroll") for(int r=4;r<16;r+=4){a=MX3(a,C0[r],C0[r+1]);b=MX3(b,C0[r+2],C0[r+3]);a=MX3(a,C1[r],C1[r+1]);b=MX3(b,C1[r+2],C1[r+3]);} \
      float rm=__builtin_fmaxf(a,b); { auto rr=__builtin_amdgcn_permlane32_swap(__float_as_uint(rm),__float_as_uint(rm),false,false); rm=__builtin_fmaxf(__uint_as_float(rr[0]),__uint_as_float(rr[1])); } \
      resc=false; \
      if(__builtin_expect(__any(rm>(float)THRL),0)){ const float dl=__builtin_fmaxf(rm,0.f); mhat+=dl; \
        _Pragma("unroll") for(int r=0;r<16;++r){C0[r]-=dl;C1[r]-=dl;} \
        const float f=__builtin_amdgcn_exp2f(-dl); l_reg*=f; if(hi==0)wsf[r32]=f; resc=true; } } \
    SBAR(); \
    GAPB(o[0]=__builtin_amdgcn_mfma_f32_32x32x16_bf16(PAF(0),VFR(0),o[0],0,0,0), C0,0); \
    GAPB(o[1]=__builtin_amdgcn_mfma_f32_32x32x16_bf16(PAF(0),VFR(4),o[1],0,0,0), C0,4); \
    KRD(GL,0); GAPB(o[0]=__builtin_amdgcn_mfma_f32_32x32x16_bf16(PAF(1),VFR(1),o[0],0,0,0), C0,8); \
    KRD(GL,1); GAPB(o[1]=__builtin_amdgcn_mfma_f32_32x32x16_bf16(PAF(1),VFR(5),o[1],0,0,0), C0,12); \
    KRD(GL,2); GAPB(o[0]=__builtin_amdgcn_mfma_f32_32x32x16_bf16(PAF(2),VFR(2),o[0],0,0,0), C1,0); \
    KRD(GL,3); GAPB(o[1]=__builtin_amdgcn_mfma_f32_32x32x16_bf16(PAF(2),VFR(6),o[1],0,0,0), C1,4); \
    GAPB(o[0]=__builtin_amdgcn_mfma_f32_32x32x16_bf16(PAF(3),VFR(3),o[0],0,0,0), C1,8); \
    GAPB(o[1]=__builtin_amdgcn_mfma_f32_32x32x16_bf16(PAF(3),VFR(7),o[1],0,0,0), C1,12); \
    if(GL){BLOAD(P0,P1,(t)+1);} SBAR(); \
    }while(0)
  int t=1;
  #undef CMASK
  #define CMASK(P0,P1,t) do{}while(0)
  for(;t+5<NT;t+=2){
    STEP(pB0,pB1,pA0,pA1,t,true,true,true);     WAIT_BAR(2); RESC(); ROT();
    STEP(pA0,pA1,pB0,pB1,t+1,true,true,true);   WAIT_BAR(2); RESC(); ROT();
  }
  #undef CMASK
  #define CMASK(P0,P1,t) do{int jb_=(t)-(NT-4); if(jb_>=0)cmask(P0,P1,jb_,qrel,hi);}while(0)
  #define ENDW(tt) do{ if((tt)+3<NT){WAIT_BAR(2);} else if((tt)+2<NT){WAIT_BAR(1);} else {WAIT_BAR(0);} }while(0)
  for(;t+1<NT;t+=2){
    STEP(pB0,pB1,pA0,pA1,t,(t+3<NT),(t+1<NT),(t+1<NT));       ENDW(t);   RESC(); ROT();
    STEP(pA0,pA1,pB0,pB1,t+1,(t+4<NT),(t+2<NT),(t+2<NT));     ENDW(t+1); RESC(); ROT();
  }
  STEP(pB0,pB1,pA0,pA1,NT-1,false,false,false); RESC();
  { float sacc=pB0[0]+pB0[1]; _Pragma("unroll") for(int r=2;r<16;++r)sacc+=pB0[r]; _Pragma("unroll") for(int r=0;r<16;++r)sacc+=pB1[r]; l_reg+=sacc;
    pw0=(u32x4){PKW(pB0,0),PKW(pB0,2),PKW(pB0,4),PKW(pB0,6)};pw1=(u32x4){PKW(pB0,8),PKW(pB0,10),PKW(pB0,12),PKW(pB0,14)};pw2=(u32x4){PKW(pB1,0),PKW(pB1,2),PKW(pB1,4),PKW(pB1,6)};pw3=(u32x4){PKW(pB1,8),PKW(pB1,10),PKW(pB1,12),PKW(pB1,14)};
    SBAR(); pv(o,vb0+sl_cur,PAF(0),PAF(1),PAF(2),PAF(3)); }
  #undef PKW
  #undef PAF
  #undef VFR
  #undef PIN
  #undef MX3
  #undef GAPA
  #undef GAPB
  #undef EX
  #undef VRD
  #undef KRD
  #undef STEP
  #undef ENDW
  {auto rr=__builtin_amdgcn_permlane32_swap(__float_as_uint(l_reg),__float_as_uint(l_reg),false,false);l_reg=__uint_as_float(rr[0])+__uint_as_float(rr[1]);}
  if(hi==0)wsf[32+r32]=l_reg;asm volatile("s_waitcnt lgkmcnt(0)":::"memory");
  float rli[16];
  #pragma unroll
  for(int r=0;r<16;++r)rli[r]=__builtin_amdgcn_rcpf(wsf[32+crow(r,hi)]);
  bf16*Ow=O+(rowbase+q0+wid*QBLK)*DM+h*D;
  { bf16*stg=(bf16*)(shm+LDS_OST)+wid*2048;
    #pragma unroll
    for(int r=0;r<16;++r){const int orow=crow(r,hi);
      #pragma unroll
      for(int d0=0;d0<2;++d0)stg[orow*64+d0*32+r32]=__float2bfloat16(o[d0][r]*rli[r]);}
    asm volatile("s_waitcnt lgkmcnt(0)":::"memory");
    #pragma unroll
    for(int i=0;i<4;++i){const int row=i*8+(lane>>3),ch=lane&7; const u32x4 v=*(const u32x4*)(stg+row*64+ch*8); ATTN_STORE16(Ow+(long)row*DM+ch*8,v);} }
  asm volatile("s_waitcnt lgkmcnt(0)\n\ts_barrier":::"memory");
  #undef DMA_K
  #undef BLOAD
  #undef DMA_V
  #undef CMASK
  #undef START
  #undef RESC
  #undef ROT
}
constexpr int ATTN_LDS_BYTES=LDS_BYTES;
struct AttnTensors { const bf16* Q; const bf16* K; const bf16* V; bf16* O; const float* F; };
struct AttnUnit { int bh; int qb; };
template<int THRL=8> __device__ __forceinline__ void attn_phase(char*lds,const AttnTensors&T,unsigned*qctr,const __attribute__((address_space(3))) float*thr8,volatile __attribute__((address_space(3))) unsigned*qslot,int wv){
  for(;;){
    if(fresh_tid(wv)==0){ qslot[0]=__hip_atomic_fetch_add(qctr,1u,__ATOMIC_RELAXED,__HIP_MEMORY_SCOPE_AGENT); }
    asm volatile("s_waitcnt vmcnt(0) lgkmcnt(0)\n\ts_barrier":::"memory");
    const int idx=__builtin_amdgcn_readfirstlane((int)qslot[0]);
    if(idx>=NHEAD*NQB)break;
    const int h=idx%NHEAD, qb=NQB-1-idx/NHEAD;
    attn_unit<THRL>(0,h,qb,T.Q,T.K,T.V,T.O,T.F+(size_t)h*SEQ,thr8[h],lds,wv);
  }
}
#undef SBAR
#undef WAIT_BAR
}
#define GAS __attribute__((address_space(1)))
#define LAS __attribute__((address_space(3)))
typedef unsigned short bf16;
typedef unsigned v4u __attribute__((ext_vector_type(4)));
typedef unsigned v2u __attribute__((ext_vector_type(2)));
typedef float f32x4 __attribute__((ext_vector_type(4)));
typedef float f32x16 __attribute__((ext_vector_type(16)));
typedef short bf16x8 __attribute__((ext_vector_type(8)));
typedef short s16x4 __attribute__((ext_vector_type(4)));

constexpr int NWAVES = 8;
constexpr int S_ = 16384, DM_ = 1024, DIN_ = 6680, FF_ = 4096, NMEM_ = 256;
constexpr float EPS_ = 1e-6f;
constexpr float LOG2E_ = 1.4426950408889634f;
constexpr size_t MiB = 1u << 20;
constexpr size_t WS_WIN = 1 * MiB;
constexpr size_t WS_WGLAO = 17 * MiB, WS_WFOXO = 18 * MiB, WS_WMEMO = 19 * MiB;
constexpr size_t WS_WOUT = 20 * MiB;
constexpr size_t WS_WFF1 = 22 * MiB;
constexpr size_t WS_WFF2 = 30 * MiB;
constexpr size_t WS_GA = 38 * MiB;
constexpr size_t WS_LOGF = 39 * MiB;
constexpr size_t WS_F = 39 * MiB + 512 * 1024;
constexpr size_t WS_MK = 40 * MiB;
constexpr size_t WS_MVT = 40 * MiB + 256 * 1024;
constexpr size_t WS_DEC = 40 * MiB + 512 * 1024;
constexpr size_t WS_MEMN = 40 * MiB + 768 * 1024;
constexpr size_t WS_GQ = 42 * MiB, WS_GK = 50 * MiB, WS_GV = 58 * MiB;
constexpr size_t WS_MG = 42 * MiB;
constexpr size_t WS_GG = 74 * MiB, WS_FQ = 90 * MiB;
constexpr size_t WS_U2 = 74 * MiB;
constexpr size_t WS_MQ = 106 * MiB, WS_FK = 122 * MiB, WS_FV = 138 * MiB;
constexpr size_t WS_GT = 154 * MiB;
constexpr size_t WS_HID = 122 * MiB;
constexpr size_t WS_SS1 = 250 * MiB, WS_SS2 = 251 * MiB;
constexpr size_t WS_END = 253 * MiB;
constexpr size_t WS_LSEF = 252 * MiB;
constexpr size_t WS_QB2 = 251 * MiB + 512 * 1024, WS_NDOT = 251 * MiB + 544 * 1024;
constexpr size_t WS_H0 = 106 * MiB, WS_H1 = 1 * MiB;
constexpr int CW_PANEL = 8192;
constexpr size_t OUT_U = 0, OUT_STATE = 32 * MiB;

constexpr int LDS_BYTES = 155648;

#define LDS_WAIT() asm volatile("s_waitcnt lgkmcnt(0)" ::: "memory")
__device__ __forceinline__ unsigned f2bf(float f) { unsigned u = __builtin_bit_cast(unsigned, f); return (u + 0x7fffu + ((u >> 16) & 1u)) >> 16; }
__device__ __forceinline__ unsigned pk2(float lo, float hi) { return f2bf(lo) | (f2bf(hi) << 16); }
__device__ __forceinline__ float bf2f(unsigned b) { return __builtin_bit_cast(float, (b & 0xffffu) << 16); }
__device__ __forceinline__ float bflo(unsigned w) { return __builtin_bit_cast(float, w << 16); }
__device__ __forceinline__ float bfhi(unsigned w) { return __builtin_bit_cast(float, w & 0xffff0000u); }
__device__ __forceinline__ float sigmoidf_(float x) { return __builtin_amdgcn_rcpf(1.f + __expf(-x)); }
__device__ __forceinline__ float logsigmoidf_(float z) { return -(fmaxf(-z, 0.f) + log1pf(__expf(-fabsf(z)))); }
__device__ __forceinline__ float logsigmoid_fast(float z) { return -(fmaxf(-z, 0.f) + __logf(1.f + __expf(-fabsf(z)))); }
__device__ __forceinline__ int crow_(int r, int hi) { return (r & 3) + 8 * (r >> 2) + 4 * hi; }
__device__ __forceinline__ float wave_sum(float v) {
#pragma unroll
    for (int o = 1; o < 64; o <<= 1) v += __shfl_xor(v, o);
    return v;
}
#define LBAR() asm volatile("s_waitcnt lgkmcnt(0)\n\ts_barrier" ::: "memory")
#define MFMA32(a, b, c) __builtin_amdgcn_mfma_f32_32x32x16_bf16((a), (b), (c), 0, 0, 0)
__device__ __forceinline__ bf16x8 ldfrag(const LAS unsigned char* base, int row, int pitchB, int kbyte) { return *(const LAS bf16x8*)(base + row * pitchB + kbyte); }

struct Ptrs {
    const float *x, *mem, *g_mix, *w_in, *w_alpha_up, *b_alpha, *b_forget, *g_gla_head, *g_mem, *w_mem_kv, *w_gla_o, *w_fox_o, *w_mem_o, *w_out, *g_ffn, *w_ff1, *w_ff2, *g_final;
    float* out; unsigned char* ws;
};

__device__ __forceinline__ void p0_transpose_item(const float* W, int ldw, int srccol0, int k0, bf16* WT, int ldt, int dstrow0, LAS float* scr, int lane) {
#pragma unroll 8
    for (int i = 0; i < 32; ++i) { const int kk = 2 * i + (lane >> 5); scr[kk * 33 + (lane & 31)] = W[(size_t)(k0 + kk) * ldw + srccol0 + (lane & 31)]; }
    LDS_WAIT(); asm volatile("" ::: "memory");
    const int c = lane & 7;
#pragma unroll
    for (int j = 0; j < 4; ++j) { const int n = (lane >> 3) + 8 * j; const LAS float* s = scr + (8 * c) * 33 + n;
        v4u o; o.x = pk2(s[0 * 33], s[1 * 33]); o.y = pk2(s[2 * 33], s[3 * 33]); o.z = pk2(s[4 * 33], s[5 * 33]); o.w = pk2(s[6 * 33], s[7 * 33]);
        *(v4u*)(WT + (size_t)(dstrow0 + n) * ldt + k0 + 8 * c) = o; }
    LDS_WAIT(); asm volatile("" ::: "memory");
}
__device__ __forceinline__ void rms_row_to_bf16(const float* xrow, const float* gain, bf16* orow, int lane) {
    const f32x4* xr = (const f32x4*)xrow + lane; const f32x4* gr = (const f32x4*)gain + lane;
    f32x4 v[4]; float s = 0.f;
#pragma unroll
    for (int j = 0; j < 4; ++j) { v[j] = xr[64 * j]; s += (v[j].x * v[j].x + v[j].y * v[j].y) + (v[j].z * v[j].z + v[j].w * v[j].w); }
    const float r = rsqrtf(wave_sum(s) * (1.f / 1024.f) + EPS_);
    unsigned long long* o8 = (unsigned long long*)orow + lane;
#pragma unroll
    for (int j = 0; j < 4; ++j) { const f32x4 g = gr[64 * j]; o8[64 * j] = (unsigned long long)pk2(v[j].x * r * g.x, v[j].y * r * g.y) | ((unsigned long long)pk2(v[j].z * r * g.z, v[j].w * r * g.w) << 32); }
}
__device__ __forceinline__ void p0_prologue(const Ptrs& P, LAS unsigned char* lds, int vcu, int G, int wv) {
    const int tid = fresh_tid(wv), lane = tid & 63, wave = wv;
    LAS float* scr = (LAS float*)(lds + wave * 16384);
    const int gw = vcu * NWAVES + wave, NGW = G * NWAVES;
    bf16* WIN = (bf16*)(P.ws + WS_WIN);
    constexpr int I_IN = 16 * 208, I_KV = 16 * 32, I_GO = 8 * 32, I_WO = 16 * 32, I_F1 = 16 * 128, I_F2 = 64 * 32;
    constexpr int NITEMS = I_IN + I_KV + 3 * I_GO + I_WO + I_F1 + I_F2;
    for (int it = gw; it < NITEMS; it += NGW) {
        int r = it;
        if (r < I_IN) { const int kb = r / 208, nb = r % 208, d0 = 32 * nb; const int src = d0 < 1536 ? d0 : (d0 < 3072 ? d0 + 16 : d0 + 24);
            p0_transpose_item(P.w_in, DIN_, src, 64 * kb, WIN, 1024, d0, scr, lane); continue; } r -= I_IN;
        if (r < I_KV) { const int kb = r / 32, nb = r % 32; p0_transpose_item(P.w_mem_kv, 1024, 32 * nb, 64 * kb, WIN, 1024, 6912 + 32 * nb, scr, lane); continue; } r -= I_KV;
        if (r < I_GO) { const int kb = r / 32, nb = r % 32; p0_transpose_item(P.w_gla_o, 1024, 32 * nb, 64 * kb, (bf16*)(P.ws + WS_WGLAO), 512, 32 * nb, scr, lane); continue; } r -= I_GO;
        if (r < I_GO) { const int kb = r / 32, nb = r % 32; p0_transpose_item(P.w_fox_o, 1024, 32 * nb, 64 * kb, (bf16*)(P.ws + WS_WFOXO), 512, 32 * nb, scr, lane); continue; } r -= I_GO;
        if (r < I_GO) { const int kb = r / 32, nb = r % 32; p0_transpose_item(P.w_mem_o, 1024, 32 * nb, 64 * kb, (bf16*)(P.ws + WS_WMEMO), 512, 32 * nb, scr, lane); continue; } r -= I_GO;
        if (r < I_WO) { const int kb = r / 32, nb = r % 32; p0_transpose_item(P.w_out, 1024, 32 * nb, 64 * kb, (bf16*)(P.ws + WS_WOUT), 1024, 32 * nb, scr, lane); continue; } r -= I_WO;
        if (r < I_F1) { const int kb = r / 128, nb = r % 128; p0_transpose_item(P.w_ff1, FF_, 32 * nb, 64 * kb, (bf16*)(P.ws + WS_WFF1), 1024, 32 * nb, scr, lane); continue; } r -= I_F1;
        { const int kb = r / 32, nb = r % 32; p0_transpose_item(P.w_ff2, 1024, 32 * nb, 64 * kb, (bf16*)(P.ws + WS_WFF2), FF_, 32 * nb, scr, lane); }
    }
    for (int idx = vcu * 512 + tid; idx < 256 * 128; idx += G * 512) {
        const int row = idx >> 7, kc = idx & 127; const int src = row < 16 ? 1536 + row : (row < 24 ? 3088 + (row - 16) : -1);
        v4u o = (v4u){0u, 0u, 0u, 0u};
        if (src >= 0) { const float* wp = P.w_in + (size_t)(8 * kc) * DIN_ + src;
            o.x = pk2(wp[0], wp[DIN_]); o.y = pk2(wp[2 * DIN_], wp[3 * DIN_]); o.z = pk2(wp[4 * DIN_], wp[5 * DIN_]); o.w = pk2(wp[6 * DIN_], wp[7 * DIN_]); }
        *(v4u*)(WIN + (size_t)(6656 + row) * 1024 + 8 * kc) = o;
    }
    bf16* U = (bf16*)((unsigned char*)P.out + OUT_U); bf16* MEMN = (bf16*)(P.ws + WS_MEMN);
    for (int m = gw; m < S_ + NMEM_; m += NGW) {
        if (m < S_) rms_row_to_bf16(P.x + (size_t)m * DM_, P.g_mix, U + (size_t)m * DM_, lane);
        else rms_row_to_bf16(P.mem + (size_t)(m - S_) * DM_, P.g_mem, MEMN + (size_t)(m - S_) * DM_, lane);
    }
}

struct GemmSched {
    const char* A; const char* B; int nM, nN, lda, ldb, G, c, wv;
    __device__ __forceinline__ bool next(int i, pg8::Unit& u) const { const long L = (long)i * G + c; if (L >= nM * nN) return false; pg8::map_tile((int)L, nM, nN, u.pm, u.pn); u.z = 0; return true; }
    __device__ __forceinline__ const char* aptr(const pg8::Unit& u) const { return A + (size_t)u.pm * 256 * lda * 2; }
    __device__ __forceinline__ const char* bptr(const pg8::Unit& u) const { return B + (size_t)u.pn * 256 * ldb * 2; }
    __device__ __forceinline__ void a_ready(const pg8::Unit&) const {}
    __device__ __forceinline__ void done(const pg8::Unit&) const {}
};
struct ProjSched {
    const char* U; const char* MEMN; const char* W; int G, c, wv;
    __device__ __forceinline__ bool next(int i, pg8::Unit& u) const { const int L = i * G + c; u.z = 0;
        if (L < 1728) { pg8::map_tile(L, 64, 27, u.pm, u.pn); return true; }
        if (L < 1732) { u.pm = 64; u.pn = 27 + (L - 1728); return true; } return false; }
    __device__ __forceinline__ const char* aptr(const pg8::Unit& u) const { return u.pm < 64 ? U + (size_t)u.pm * (256 * 1024 * 2) : MEMN; }
    __device__ __forceinline__ const char* bptr(const pg8::Unit& u) const { return W + (size_t)u.pn * (256 * 1024 * 2); }
    __device__ __forceinline__ void a_ready(const pg8::Unit&) const {}
    __device__ __forceinline__ void done(const pg8::Unit&) const {}
};
struct MergeSched {
    const char *A0, *B0; int G, c, wv; size_t segA, segB;
    __device__ __forceinline__ bool next(int i, pg8::Unit& u) const { const int T = c + G * i; if (T >= 256) return false; pg8::map_tile(T, 64, 4, u.pm, u.pn); u.z = 0; return true; }
    __device__ __forceinline__ const char* aptr(const pg8::Unit& u) const { return A0 + (size_t)u.pm * (256 * 512 * 2); }
    __device__ __forceinline__ const char* bptr(const pg8::Unit& u) const { return B0 + (size_t)u.pn * (256 * 512 * 2); }
    __device__ __forceinline__ void a_ready(const pg8::Unit&) const {}
    __device__ __forceinline__ void done(const pg8::Unit&) const {}
};
typedef pg8::f32x4 accv;
__device__ __forceinline__ void store_bf16_tile(const accv (&acc)[2][2][4][2], bf16* base, int ldc, int row0, int col0, float sc, bool sig) {
#pragma unroll
    for (int ai = 0; ai < 2; ++ai)
#pragma unroll
        for (int m = 0; m < 4; ++m) { bf16* rowp = base + (size_t)(row0 + ai * 128 + m * 16) * ldc + col0;
#pragma unroll
            for (int bj = 0; bj < 2; ++bj) { accv v0 = acc[ai][bj][m][0] * sc, v1 = acc[ai][bj][m][1] * sc;
                if (sig) { v0 = (accv){sigmoidf_(v0[0]), sigmoidf_(v0[1]), sigmoidf_(v0[2]), sigmoidf_(v0[3])}; v1 = (accv){sigmoidf_(v1[0]), sigmoidf_(v1[1]), sigmoidf_(v1[2]), sigmoidf_(v1[3])}; }
                v4u w; w.x = pg8::cvt_pk_bf16(v0[0], v0[1]); w.y = pg8::cvt_pk_bf16(v0[2], v0[3]); w.z = pg8::cvt_pk_bf16(v1[0], v1[1]); w.w = pg8::cvt_pk_bf16(v1[2], v1[3]);
                *(v4u*)(rowp + bj * 128) = w; } }
}
struct EpiProj {
    static constexpr bool PERM = true, AFTER_DRAIN = false;
    unsigned char* ws; const float* b_forget;
    __device__ __forceinline__ void operator()(const accv (&acc)[2][2][4][2], const pg8::Unit& u, int wr, int wc, int fr, int fq) const {
        const int pn = u.pn;
        if (pn != 26) {
            size_t off; int ldc, colt, prow = u.pm * 256; float sc = 1.f; bool sig = false;
            if (pn == 0) { off = WS_GQ; ldc = 256; colt = 0; sc = 0.125f; }
            else if (pn == 1) { off = WS_GK; ldc = 256; colt = 0; }
            else if (pn < 4) { off = WS_GV; ldc = 512; colt = (pn - 2) * 256; }
            else if (pn < 6) { off = WS_GG; ldc = 512; colt = (pn - 4) * 256; }
            else if (pn < 8) { off = WS_FQ; ldc = 512; colt = (pn - 6) * 256; sc = 0.125f * LOG2E_; }
            else if (pn < 10) { off = WS_FK; ldc = 512; colt = (pn - 8) * 256; }
            else if (pn < 12) { off = WS_FV; ldc = 512; colt = (pn - 10) * 256; }
            else if (pn < 14) { off = WS_MQ; ldc = 512; colt = (pn - 12) * 256; sc = 0.08838834764831845f * LOG2E_; }
            else if (pn < 26) { off = WS_GT; ldc = 3072; colt = (pn - 14) * 256; sig = true; }
            else if (pn < 29) { off = WS_MK; ldc = 512; colt = (pn - 27) * 256; prow = 0; }
            else { off = WS_MVT; ldc = 512; colt = (pn - 29) * 256; prow = 0; }
            store_bf16_tile(acc, (bf16*)(ws + off), ldc, prow + wr * 64 + fr, colt + wc * 32 + 8 * fq, sc, sig);
        } else {
            if (wc == 0 && fq < 3) {
                float* GA = (float*)(ws + WS_GA); float* LF = (float*)(ws + WS_LOGF);
                accv bf0 = (accv){0.f, 0.f, 0.f, 0.f}, bf1 = bf0;
                if (fq == 2) { bf0 = *(const accv*)(b_forget); bf1 = *(const accv*)(b_forget + 4); }
#pragma unroll
                for (int ai = 0; ai < 2; ++ai)
#pragma unroll
                    for (int m = 0; m < 4; ++m) { const size_t row = (size_t)(u.pm * 256 + wr * 64 + fr + ai * 128 + m * 16);
                        const accv v0 = acc[ai][0][m][0], v1 = acc[ai][0][m][1];
                        if (fq < 2) { *(accv*)(GA + row * 16 + 8 * fq) = v0; *(accv*)(GA + row * 16 + 8 * fq + 4) = v1; }
                        else { const accv a = v0 + bf0, b = v1 + bf1;
#pragma unroll
                            for (int j = 0; j < 4; ++j) { LF[(size_t)j * S_ + row] = logsigmoidf_(a[j]); LF[(size_t)(4 + j) * S_ + row] = logsigmoidf_(b[j]); } } }
            }
        }
    }
};
struct EpiMerge {
    static constexpr bool PERM = true, AFTER_DRAIN = false;
    bf16* MG; const bf16* GT;
    __device__ __forceinline__ void mid(accv (&acc)[2][2][4][2], const pg8::Unit& u, int s, int wr, int wc, int fr, int fq) const {
        const int row0 = u.pm * 256 + wr * 64 + fr, col0 = u.pn * 256 + wc * 32 + 8 * fq;
#pragma unroll
        for (int ai = 0; ai < 2; ++ai)
#pragma unroll
            for (int m = 0; m < 4; ++m) { const size_t row = (size_t)(row0 + ai * 128 + m * 16);
#pragma unroll
                for (int bj = 0; bj < 2; ++bj) { const int col = col0 + bj * 128;
                    const v4u a = *(const v4u*)(GT + row * 3072 + (s - 1) * 1024 + col), b = *(const v4u*)(GT + row * 3072 + s * 1024 + col);
                    const accv r0 = (accv){bflo(a.x) * __builtin_amdgcn_rcpf(fmaxf(bflo(b.x), 1e-30f)), bfhi(a.x) * __builtin_amdgcn_rcpf(fmaxf(bfhi(b.x), 1e-30f)), bflo(a.y) * __builtin_amdgcn_rcpf(fmaxf(bflo(b.y), 1e-30f)), bfhi(a.y) * __builtin_amdgcn_rcpf(fmaxf(bfhi(b.y), 1e-30f))};
                    const accv r1 = (accv){bflo(a.z) * __builtin_amdgcn_rcpf(fmaxf(bflo(b.z), 1e-30f)), bfhi(a.z) * __builtin_amdgcn_rcpf(fmaxf(bfhi(b.z), 1e-30f)), bflo(a.w) * __builtin_amdgcn_rcpf(fmaxf(bflo(b.w), 1e-30f)), bfhi(a.w) * __builtin_amdgcn_rcpf(fmaxf(bfhi(b.w), 1e-30f))};
                    acc[ai][bj][m][0] = acc[ai][bj][m][0] * r0; acc[ai][bj][m][1] = acc[ai][bj][m][1] * r1; } }
    }
    __device__ __forceinline__ void operator()(const accv (&acc)[2][2][4][2], const pg8::Unit& u, int wr, int wc, int fr, int fq) const {
        const int row0 = u.pm * 256 + wr * 64 + fr, col0 = u.pn * 256 + wc * 32 + 8 * fq;
#pragma unroll
        for (int ai = 0; ai < 2; ++ai)
#pragma unroll
            for (int m = 0; m < 4; ++m) { const size_t row = (size_t)(row0 + ai * 128 + m * 16);
#pragma unroll
                for (int bj = 0; bj < 2; ++bj) { const int col = col0 + bj * 128;
                    const v4u g = *(const v4u*)(GT + row * 3072 + 2 * 1024 + col);
                    accv v0 = acc[ai][bj][m][0], v1 = acc[ai][bj][m][1];
                    v0 = v0 * (accv){bflo(g.x), bfhi(g.x), bflo(g.y), bfhi(g.y)}; v1 = v1 * (accv){bflo(g.z), bfhi(g.z), bflo(g.w), bfhi(g.w)};
                    v4u w; w.x = pg8::cvt_pk_bf16(v0[0], v0[1]); w.y = pg8::cvt_pk_bf16(v0[2], v0[3]); w.z = pg8::cvt_pk_bf16(v1[0], v1[1]); w.w = pg8::cvt_pk_bf16(v1[2], v1[3]);
                    *(v4u*)(MG + row * 1024 + col) = w; } }
    }
};
template <bool WRITE_U2, bool BASE_BF16> struct EpiResid {
    static constexpr bool PERM = true, AFTER_DRAIN = false;
    const void* base; bf16* H0; bf16* H1; bf16* U2; const float* gain; float* SS;
    __device__ __forceinline__ void operator()(const accv (&acc)[2][2][4][2], const pg8::Unit& u, int wr, int wc, int fr, int fq) const {
        bf16* HB = u.pm < 32 ? H0 : H1;
        const int row0 = u.pm * 256 + wr * 64 + fr, col0 = u.pn * 256 + wc * 32 + 8 * fq;
#pragma unroll
        for (int ai = 0; ai < 2; ++ai)
#pragma unroll
            for (int m = 0; m < 4; ++m) { const size_t row = (size_t)(row0 + ai * 128 + m * 16); float ssq = 0.f;
#pragma unroll
                for (int bj = 0; bj < 2; ++bj) { const int col = col0 + bj * 128; const size_t o = row * 1024 + col;
                    accv b0, b1;
                    if (BASE_BF16) { const v4u bw = *(const v4u*)((const bf16*)base + o); b0 = (accv){bflo(bw.x), bfhi(bw.x), bflo(bw.y), bfhi(bw.y)}; b1 = (accv){bflo(bw.z), bfhi(bw.z), bflo(bw.w), bfhi(bw.w)}; }
                    else { b0 = *(const accv*)((const float*)base + o); b1 = *(const accv*)((const float*)base + o + 4); }
                    const accv h0 = b0 + acc[ai][bj][m][0], h1 = b1 + acc[ai][bj][m][1];
                    { v4u w; w.x = pg8::cvt_pk_bf16(h0[0], h0[1]); w.y = pg8::cvt_pk_bf16(h0[2], h0[3]); w.z = pg8::cvt_pk_bf16(h1[0], h1[1]); w.w = pg8::cvt_pk_bf16(h1[2], h1[3]); *(v4u*)(HB + o) = w; }
                    ssq += (h0[0] * h0[0] + h0[1] * h0[1]) + (h0[2] * h0[2] + h0[3] * h0[3]) + (h1[0] * h1[0] + h1[1] * h1[1]) + (h1[2] * h1[2] + h1[3] * h1[3]);
                    if (WRITE_U2) { const accv g0 = *(const accv*)(gain + col), g1 = *(const accv*)(gain + col + 4); const accv a = h0 * g0, b = h1 * g1;
                        v4u w; w.x = pg8::cvt_pk_bf16(a[0], a[1]); w.y = pg8::cvt_pk_bf16(a[2], a[3]); w.z = pg8::cvt_pk_bf16(b[0], b[1]); w.w = pg8::cvt_pk_bf16(b[2], b[3]);
                        *(v4u*)(U2 + o) = w; } }
                ssq += __shfl_xor(ssq, 16); ssq += __shfl_xor(ssq, 32);
                if (fq == 0) SS[row * 16 + u.pn * 4 + wc] = ssq; }
    }
};
struct EpiFinal {
    static constexpr bool PERM = true, AFTER_DRAIN = true;
    const bf16* H0; const bf16* H1; float* out; const float* gain; float* xbuf; unsigned* cnt;
    __device__ __forceinline__ void fused(accv (&acc)[2][2][4][2], const pg8::Unit& u, int wr, int wc, int fr, int fq, LAS unsigned char* lds, int wid, int lane) const {
        const bf16* HB = u.pm < 32 ? H0 : H1;
        LAS float* Pl = (LAS float*)lds; LAS float* Sl = (LAS float*)(lds + 4096);
        const int row0 = u.pm * 256 + wr * 64 + fr, col0 = u.pn * 256 + wc * 32 + 8 * fq;
#pragma unroll
        for (int ai = 0; ai < 2; ++ai)
#pragma unroll
            for (int m = 0; m < 4; ++m) { const size_t row = (size_t)(row0 + ai * 128 + m * 16); float ssq = 0.f;
#pragma unroll
                for (int bj = 0; bj < 2; ++bj) { const size_t o = row * 1024 + col0 + bj * 128; const v4u bw = *(const v4u*)(HB + o);
                    const accv h0 = acc[ai][bj][m][0] + (accv){bflo(bw.x), bfhi(bw.x), bflo(bw.y), bfhi(bw.y)}, h1 = acc[ai][bj][m][1] + (accv){bflo(bw.z), bfhi(bw.z), bflo(bw.w), bfhi(bw.w)};
                    acc[ai][bj][m][0] = h0; acc[ai][bj][m][1] = h1;
                    ssq += (h0[0] * h0[0] + h0[1] * h0[1]) + (h0[2] * h0[2] + h0[3] * h0[3]) + (h1[0] * h1[0] + h1[1] * h1[1]) + (h1[2] * h1[2] + h1[3] * h1[3]); }
                ssq += __shfl_xor(ssq, 16); ssq += __shfl_xor(ssq, 32);
                if (fq == 0) Pl[(ai * 128 + wr * 64 + m * 16 + fr) * 4 + wc] = ssq; }
        asm volatile("s_waitcnt lgkmcnt(0)" ::: "memory"); __builtin_amdgcn_s_barrier(); asm volatile("" ::: "memory");
        const int rowl = wid * 32 + (lane & 31);
        if (lane < 32) { const float s = (Pl[rowl * 4] + Pl[rowl * 4 + 1]) + (Pl[rowl * 4 + 2] + Pl[rowl * 4 + 3]);
            __hip_atomic_store(xbuf + ((size_t)(u.pm * 256 + rowl) * 4 + u.pn), s, __ATOMIC_RELAXED, __HIP_MEMORY_SCOPE_AGENT); }
        asm volatile("s_waitcnt vmcnt(0)" ::: "memory");
        if (lane == 0) __hip_atomic_fetch_add(cnt + 64 * u.pm, 1u, __ATOMIC_RELAXED, __HIP_MEMORY_SCOPE_AGENT);
        if (wid == 0) { unsigned sp = 0;
            while ((unsigned)__builtin_amdgcn_readfirstlane(__hip_atomic_load(cnt + 64 * u.pm, __ATOMIC_RELAXED, __HIP_MEMORY_SCOPE_AGENT)) < 32u) { __builtin_amdgcn_s_sleep(2); if (++sp > (1u << 22)) break; }
            __builtin_amdgcn_fence(__ATOMIC_ACQUIRE, "agent"); }
        asm volatile("s_waitcnt vmcnt(0) lgkmcnt(0)" ::: "memory"); __builtin_amdgcn_s_barrier(); asm volatile("" ::: "memory");
        if (lane < 32) { const float* sl = xbuf + (size_t)(u.pm * 256 + rowl) * 4;
            const float a = __hip_atomic_load(sl, __ATOMIC_RELAXED, __HIP_MEMORY_SCOPE_AGENT), b = __hip_atomic_load(sl + 1, __ATOMIC_RELAXED, __HIP_MEMORY_SCOPE_AGENT),
                        c = __hip_atomic_load(sl + 2, __ATOMIC_RELAXED, __HIP_MEMORY_SCOPE_AGENT), d = __hip_atomic_load(sl + 3, __ATOMIC_RELAXED, __HIP_MEMORY_SCOPE_AGENT);
            Sl[rowl] = rsqrtf(((a + b) + (c + d)) * (1.f / 1024.f) + EPS_); }
        asm volatile("s_waitcnt vmcnt(0) lgkmcnt(0)" ::: "memory"); __builtin_amdgcn_s_barrier(); asm volatile("" ::: "memory");
#pragma unroll
        for (int ai = 0; ai < 2; ++ai)
#pragma unroll
            for (int m = 0; m < 4; ++m) { const int rl = ai * 128 + wr * 64 + m * 16 + fr; const float r = Sl[rl]; const size_t row = (size_t)(u.pm * 256 + rl);
#pragma unroll
                for (int bj = 0; bj < 2; ++bj) { const int col = col0 + bj * 128; const accv g0 = *(const accv*)(gain + col), g1 = *(const accv*)(gain + col + 4);
                    *(accv*)(out + row * 1024 + col) = acc[ai][bj][m][0] * r * g0; *(accv*)(out + row * 1024 + col + 4) = acc[ai][bj][m][1] * r * g1; } }
    }
};
struct EpiFfn1 {
    static constexpr bool PERM = true, AFTER_DRAIN = false;
    bf16* HID; const float* SS;
    __device__ __forceinline__ void operator()(const accv (&acc)[2][2][4][2], const pg8::Unit& u, int wr, int wc, int fr, int fq) const {
        const int row0 = u.pm * 256 + wr * 64 + fr, col0 = u.pn * 256 + wc * 32 + 8 * fq;
#pragma unroll
        for (int ai = 0; ai < 2; ++ai)
#pragma unroll
            for (int m = 0; m < 4; ++m) { const size_t row = (size_t)(row0 + ai * 128 + m * 16);
                const accv s0 = *(const accv*)(SS + row * 16), s1 = *(const accv*)(SS + row * 16 + 4), s2 = *(const accv*)(SS + row * 16 + 8), s3 = *(const accv*)(SS + row * 16 + 12);
                const float tot = ((s0[0] + s0[1]) + (s0[2] + s0[3])) + ((s1[0] + s1[1]) + (s1[2] + s1[3])) + ((s2[0] + s2[1]) + (s2[2] + s2[3])) + ((s3[0] + s3[1]) + (s3[2] + s3[3]));
                const float r = rsqrtf(tot * (1.f / 1024.f) + EPS_);
#pragma unroll
                for (int bj = 0; bj < 2; ++bj) { accv v0 = acc[ai][bj][m][0] * r, v1 = acc[ai][bj][m][1] * r;
#pragma unroll
                    for (int j = 0; j < 4; ++j) { const float a = fmaxf(v0[j], 0.f), b = fmaxf(v1[j], 0.f); v0[j] = a * a; v1[j] = b * b; }
                    v4u w; w.x = pg8::cvt_pk_bf16(v0[0], v0[1]); w.y = pg8::cvt_pk_bf16(v0[2], v0[3]); w.z = pg8::cvt_pk_bf16(v1[0], v1[1]); w.w = pg8::cvt_pk_bf16(v1[2], v1[3]);
                    *(v4u*)(HID + row * 4096 + col0 + bj * 128) = w; } }
    }
};

constexpr int GP = 144;
__device__ __forceinline__ void gla_a_unit(const Ptrs& P, LAS unsigned char* lds, int n, int h, int wv) {
    const int tid = fresh_tid(wv), lane = tid & 63, g = wv, r32 = lane & 31, hh = lane >> 5;
    LAS unsigned char* QP = lds; LAS unsigned char* QN = lds + 9216; LAS unsigned char* KN = lds + 18432; LAS unsigned char* KP = lds + 27648;
    LAS unsigned char* KLT = lds + 36864; LAS unsigned char* AT = lds + 46080; LAS unsigned char* VT = lds + 55296; LAS float* TOT = (LAS float*)(lds + 73728);
    bf16* GQ = (bf16*)(P.ws + WS_GQ); const bf16* GK = (const bf16*)(P.ws + WS_GK); bf16* GV = (bf16*)(P.ws + WS_GV);
    const float* GA = (const float*)(P.ws + WS_GA); float* DEC = (float*)(P.ws + WS_DEC); bf16* STATE = (bf16*)((unsigned char*)P.out + OUT_STATE);
    const int c = h * 64 + lane, t0 = n * 64;
#ifdef PROBE_PHASE
#define GSTAMP(k) do { if (n == 64 && h == 0 && tid == 0) ((unsigned long long*)(P.ws + 253 * MiB))[(k)] = __builtin_amdgcn_s_memrealtime(); } while (0)
#else
#define GSTAMP(k) do {} while (0)
#endif
    GSTAMP(60);
    float wup[16];
#pragma unroll
    for (int j = 0; j < 16; ++j) wup[j] = P.w_alpha_up[j * 256 + c];
    const float ba = P.b_alpha[c];
    unsigned short qraw[8], kraw[8];
#pragma unroll
    for (int i = 0; i < 8; ++i) { const size_t gi = (size_t)(t0 + 8 * g + i) * 256 + c; qraw[i] = GQ[gi]; kraw[i] = GK[gi]; }
    float bl[8]; float run = 0.f;
#pragma unroll
    for (int i = 0; i < 8; ++i) { const f32x4* gar = (const f32x4*)(GA + (size_t)(t0 + 8 * g + i) * 16); float z = ba;
#pragma unroll
        for (int j4 = 0; j4 < 4; ++j4) { const f32x4 a = gar[j4]; z += a[0] * wup[4 * j4] + a[1] * wup[4 * j4 + 1] + a[2] * wup[4 * j4 + 2] + a[3] * wup[4 * j4 + 3]; }
        run += logsigmoid_fast(z) * (1.f / 16.f); bl[i] = run; }
    TOT[g * 64 + lane] = run;
    { const int s = tid >> 3, vc = tid & 7; const v4u a = *(const v4u*)(GV + (size_t)(t0 + s) * 512 + h * 128 + vc * 16), b = *(const v4u*)(GV + (size_t)(t0 + s) * 512 + h * 128 + vc * 16 + 8);
      LAS bf16* vt = (LAS bf16*)VT; const unsigned w[8] = {a.x, a.y, a.z, a.w, b.x, b.y, b.z, b.w};
#pragma unroll
      for (int j = 0; j < 8; ++j) { vt[(vc * 16 + 2 * j) * 72 + s] = (bf16)(w[j] & 0xffffu); vt[(vc * 16 + 2 * j + 1) * 72 + s] = (bf16)(w[j] >> 16); } }
    LBAR(); GSTAMP(61);
    float off = 0.f, blast = 0.f;
#pragma unroll
    for (int gg = 0; gg < 8; ++gg) { const float tv = TOT[gg * 64 + lane]; if (gg < g) off += tv; blast += tv; }
    unsigned kl[8];
#pragma unroll
    for (int i = 0; i < 8; ++i) { const int t = 8 * g + i; const float b = off + bl[i]; const size_t gi = (size_t)(t0 + t) * 256 + c;
        const float q = bf2f(qraw[i]), k = bf2f(kraw[i]); const float ep = __expf(b), en = __expf(-b), el = __expf(blast - b);
        const unsigned qp = f2bf(q * ep); GQ[gi] = (bf16)qp;
        ((LAS bf16*)QP)[t * 72 + lane] = (bf16)qp; ((LAS bf16*)QN)[t * 72 + lane] = (bf16)f2bf(q * en);
        ((LAS bf16*)KN)[t * 72 + lane] = (bf16)f2bf(k * en); ((LAS bf16*)KP)[t * 72 + lane] = (bf16)f2bf(k * ep); kl[i] = f2bf(k * el); }
    *(LAS v4u*)(KLT + lane * GP + 16 * g) = (v4u){kl[0] | (kl[1] << 16), kl[2] | (kl[3] << 16), kl[4] | (kl[5] << 16), kl[6] | (kl[7] << 16)};
    if (g == 0) DEC[(n * 4 + h) * 64 + lane] = __expf(blast);
    LBAR(); GSTAMP(62);
    const f32x16 zero = {};
    if (g < 4) {
        const int ti = g >> 1, si = g & 1; f32x16 ac = zero, an = zero;
        if (ti >= si) {
#pragma unroll
            for (int ks = 0; ks < 4; ++ks) ac = MFMA32(ldfrag(QP, 32 * ti + r32, GP, 32 * ks + 16 * hh), ldfrag(KN, 32 * si + r32, GP, 32 * ks + 16 * hh), ac); }
        if (ti <= si) {
#pragma unroll
            for (int ks = 0; ks < 4; ++ks) an = MFMA32(ldfrag(QN, 32 * ti + r32, GP, 32 * ks + 16 * hh), ldfrag(KP, 32 * si + r32, GP, 32 * ks + 16 * hh), an); }
#pragma unroll
        for (int i = 0; i < 16; ++i) { const int t = 32 * ti + crow_(i, hh), s = 32 * si + r32; ((LAS bf16*)AT)[t * 72 + s] = (bf16)f2bf(t >= s ? ac[i] : an[i]); }
    } else {
        const int vi = g - 4;
#pragma unroll
        for (int dj = 0; dj < 2; ++dj) { f32x16 st = zero;
#pragma unroll
            for (int ks = 0; ks < 4; ++ks) st = MFMA32(ldfrag(KLT, 32 * dj + r32, GP, 32 * ks + 16 * hh), ldfrag(VT, 32 * vi + r32, GP, 32 * ks + 16 * hh), st);
#pragma unroll
            for (int i4 = 0; i4 < 4; ++i4) *(v2u*)(STATE + (size_t)(n * 4 + h) * 8192 + (size_t)(((vi * 4 + 2 * dj + (i4 >> 1)) * 64 + r32 + 32 * (i4 & 1)) * 8 + 4 * hh)) = (v2u){pk2(st[4 * i4], st[4 * i4 + 1]), pk2(st[4 * i4 + 2], st[4 * i4 + 3])}; }
    }
    LBAR(); GSTAMP(63);
    { const int ti = g >> 2, vj = g & 3; f32x16 oi = zero;
#pragma unroll
      for (int ks = 0; ks < 4; ++ks) oi = MFMA32(ldfrag(AT, 32 * ti + r32, GP, 32 * ks + 16 * hh), ldfrag(VT, 32 * vj + r32, GP, 32 * ks + 16 * hh), oi);
#pragma unroll
      for (int i = 0; i < 16; ++i) GV[(size_t)(t0 + 32 * ti + crow_(i, hh)) * 512 + h * 128 + 32 * vj + r32] = (bf16)f2bf(oi[i]); }
    LBAR(); GSTAMP(64);
}
__device__ __forceinline__ void gla_scan_unit(const Ptrs& P, LAS unsigned char* lds, int u, int wv) {
    const int tid = fresh_tid(wv), lane = tid & 63, w = wv;
    const int h = u >> 6, e0 = (u & 63) * 128;
    const int dch = 16 * ((e0 >> 9) & 3) + 8 * ((e0 >> 8) & 1) + ((2 * lane) & 7);
    unsigned* STATE = (unsigned*)((unsigned char*)P.out + OUT_STATE); const float* DEC = (const float*)(P.ws + WS_DEC);
    LAS float* segS = (LAS float*)lds; LAS float* segP = (LAS float*)(lds + 8192);
    float kv[2][32], dc[2][32];
#pragma unroll
    for (int i = 0; i < 32; ++i) { const int n = 32 * w + i; const unsigned wd = STATE[((size_t)(n * 4 + h) * 8192 + e0) / 2 + lane]; kv[0][i] = bflo(wd); kv[1][i] = bfhi(wd);
        const float2 d2 = *(const float2*)(DEC + (n * 4 + h) * 64 + dch); dc[0][i] = d2.x; dc[1][i] = d2.y; }
    float s[2] = {0.f, 0.f}, pr[2] = {1.f, 1.f};
#pragma unroll
    for (int i = 0; i < 32; ++i) {
#pragma unroll
        for (int e = 0; e < 2; ++e) { const float pv = s[e]; s[e] = s[e] * dc[e][i] + kv[e][i]; kv[e][i] = pv; pr[e] *= dc[e][i]; } }
    segS[w * 64 + lane] = s[0]; segS[512 + w * 64 + lane] = s[1]; segP[w * 64 + lane] = pr[0]; segP[512 + w * 64 + lane] = pr[1];
    LBAR();
    float sin_[2] = {0.f, 0.f};
#pragma unroll
    for (int ww = 0; ww < 8; ++ww) { const float a0 = segS[ww * 64 + lane], a1 = segS[512 + ww * 64 + lane], b0 = segP[ww * 64 + lane], b1 = segP[512 + ww * 64 + lane]; if (ww < w) { sin_[0] = sin_[0] * b0 + a0; sin_[1] = sin_[1] * b1 + a1; } }
    float cp[2] = {1.f, 1.f};
#pragma unroll
    for (int i = 0; i < 32; ++i) { const int n = 32 * w + i;
        STATE[((size_t)(n * 4 + h) * 8192 + e0) / 2 + lane] = pk2(kv[0][i] + cp[0] * sin_[0], kv[1][i] + cp[1] * sin_[1]);
        cp[0] *= dc[0][i]; cp[1] *= dc[1][i]; }
    LBAR();
}
__device__ __forceinline__ void gla_b_task(const Ptrs& P, int task, int lane) {
    const int r32 = lane & 31, hh = lane >> 5;
    const int ti = task & 1, h = (task >> 1) & 3, n = task >> 3;
    const bf16* GQ = (const bf16*)(P.ws + WS_GQ); const bf16* GV = (const bf16*)(P.ws + WS_GV); bf16* GG = (bf16*)(P.ws + WS_GG);
    const bf16* SB = (const bf16*)((unsigned char*)P.out + OUT_STATE) + (size_t)(n * 4 + h) * 8192;
    const size_t t = (size_t)n * 64 + 32 * ti + r32;
    bf16x8 qf[4];
#pragma unroll
    for (int ks = 0; ks < 4; ++ks) qf[ks] = *(const bf16x8*)(GQ + t * 256 + h * 64 + 16 * ks + 8 * hh);
    f32x16 o[4];
#pragma unroll
    for (int vj = 0; vj < 4; ++vj) { o[vj] = (f32x16){};
#pragma unroll
        for (int ks = 0; ks < 4; ++ks) { const bf16x8 af = *(const bf16x8*)(SB + ((vj * 4 + ks) * 64 + lane) * 8);
            o[vj] = MFMA32(af, qf[ks], o[vj]); }
        asm volatile("" ::: "memory"); }
    float ov[64]; float ss = 0.f;
#pragma unroll
    for (int vj = 0; vj < 4; ++vj) {
#pragma unroll
        for (int g4 = 0; g4 < 4; ++g4) { const v2u w = *(const v2u*)(GV + t * 512 + h * 128 + 32 * vj + 8 * g4 + 4 * hh);
            const float a0 = o[vj][4 * g4] + bflo(w.x), a1 = o[vj][4 * g4 + 1] + bfhi(w.x), a2 = o[vj][4 * g4 + 2] + bflo(w.y), a3 = o[vj][4 * g4 + 3] + bfhi(w.y);
            ov[16 * vj + 4 * g4] = a0; ov[16 * vj + 4 * g4 + 1] = a1; ov[16 * vj + 4 * g4 + 2] = a2; ov[16 * vj + 4 * g4 + 3] = a3;
            ss += (a0 * a0 + a1 * a1) + (a2 * a2 + a3 * a3); } }
    ss += __shfl_xor(ss, 32);
    const float r = rsqrtf(ss * (1.f / 128.f) + EPS_);
#pragma unroll
    for (int vj = 0; vj < 4; ++vj) {
#pragma unroll
        for (int g4 = 0; g4 < 4; ++g4) { const int vc = h * 128 + 32 * vj + 8 * g4 + 4 * hh; const v2u gw = *(const v2u*)(GG + t * 512 + vc); const f32x4 gn = *(const f32x4*)(P.g_gla_head + vc);
            const float g0 = bflo(gw.x), g1 = bfhi(gw.x), g2 = bflo(gw.y), g3 = bfhi(gw.y);
            v2u ow; ow.x = pk2(ov[16 * vj + 4 * g4] * r * gn[0] * (g0 * sigmoidf_(g0)), ov[16 * vj + 4 * g4 + 1] * r * gn[1] * (g1 * sigmoidf_(g1)));
            ow.y = pk2(ov[16 * vj + 4 * g4 + 2] * r * gn[2] * (g2 * sigmoidf_(g2)), ov[16 * vj + 4 * g4 + 3] * r * gn[3] * (g3 * sigmoidf_(g3)));
            *(v2u*)(GG + t * 512 + vc) = ow; }
        asm volatile("" ::: "memory"); }
}
__device__ __forceinline__ void memattn_unit(const Ptrs& P, LAS unsigned char* lds, int hm, int qb, int wv) {
    const int tid = fresh_tid(wv), lane = tid & 63, w = wv, r32 = lane & 31, hh = lane >> 5;
    constexpr int KPB = 272, VPB = 536;
    LAS unsigned char* KM = lds; LAS unsigned char* VTM = lds + 69632; LAS float* LSUM = (LAS float*)(lds + 139264);
    const bf16* MK = (const bf16*)(P.ws + WS_MK); const bf16* MVT = (const bf16*)(P.ws + WS_MVT); bf16* MQ = (bf16*)(P.ws + WS_MQ);
#pragma unroll
    for (int j = 0; j < 8; ++j) { const int idx = tid + 512 * j; const int key = idx >> 4, ch = idx & 15; *(LAS v4u*)(KM + key * KPB + ch * 16) = *(const v4u*)(MK + (size_t)key * 512 + hm * 128 + ch * 8);
    }
    { const int dc = tid & 15, key0 = (tid >> 4) * 8; v4u in[8];
#pragma unroll
      for (int k = 0; k < 8; ++k) in[k] = *(const v4u*)(MVT + (size_t)(key0 + k) * 512 + hm * 128 + dc * 8);
#pragma unroll
      for (int jp = 0; jp < 4; ++jp) {
          unsigned e[8];
#pragma unroll
          for (int k = 0; k < 8; ++k) e[k] = jp == 0 ? in[k].x : (jp == 1 ? in[k].y : (jp == 2 ? in[k].z : in[k].w));
          const v4u lo = (v4u){(e[0] & 0xffffu) | (e[1] << 16), (e[2] & 0xffffu) | (e[3] << 16), (e[4] & 0xffffu) | (e[5] << 16), (e[6] & 0xffffu) | (e[7] << 16)};
          const v4u hi = (v4u){(e[0] >> 16) | (e[1] & 0xffff0000u), (e[2] >> 16) | (e[3] & 0xffff0000u), (e[4] >> 16) | (e[5] & 0xffff0000u), (e[6] >> 16) | (e[7] & 0xffff0000u)};
          *(LAS v4u*)(VTM + (8 * dc + 2 * jp) * VPB + key0 * 2) = lo; *(LAS v4u*)(VTM + (8 * dc + 2 * jp + 1) * VPB + key0 * 2) = hi; } }
    LBAR();
    for (int qq = 0; qq < 2; ++qq) { const int qbb = 2 * qb + qq;
    const size_t qrow = (size_t)qbb * 256 + 32 * w + r32;
    bf16x8 qr[8];
#pragma unroll
    for (int ks = 0; ks < 8; ++ks) qr[ks] = *(const bf16x8*)(MQ + qrow * 512 + hm * 128 + 16 * ks + 8 * hh);
    f32x16 p[8];
#pragma unroll
    for (int kb = 0; kb < 8; ++kb) { p[kb] = (f32x16){};
#pragma unroll
        for (int ks = 0; ks < 8; ++ks) p[kb] = MFMA32(ldfrag(KM, 32 * kb + r32, KPB, 32 * ks + 16 * hh), qr[ks], p[kb]); }
    float mx = -INFINITY;
#pragma unroll
    for (int kb = 0; kb < 8; ++kb)
#pragma unroll
        for (int i = 0; i < 16; ++i) mx = fmaxf(mx, p[kb][i]);
    mx = fmaxf(mx, __shfl_xor(mx, 32));
    float l = 0.f; v4u pk[8][2];
#pragma unroll
    for (int kb = 0; kb < 8; ++kb) {
#pragma unroll
        for (int i = 0; i < 16; ++i) { p[kb][i] = __builtin_amdgcn_exp2f(p[kb][i] - mx); l += p[kb][i]; }
#pragma unroll
        for (int s = 0; s < 2; ++s) pk[kb][s] = (v4u){pk2(p[kb][8 * s], p[kb][8 * s + 1]), pk2(p[kb][8 * s + 2], p[kb][8 * s + 3]), pk2(p[kb][8 * s + 4], p[kb][8 * s + 5]), pk2(p[kb][8 * s + 6], p[kb][8 * s + 7])}; }
    l += __shfl_xor(l, 32);
    if (hh == 0) LSUM[w * 32 + r32] = l;
    f32x16 o[4];
#pragma unroll
    for (int db = 0; db < 4; ++db) { o[db] = (f32x16){};
#pragma unroll
        for (int kb = 0; kb < 8; ++kb)
#pragma unroll
            for (int s = 0; s < 2; ++s) { const LAS unsigned char* vp = VTM + (32 * db + r32) * VPB + 64 * kb + 32 * s + 8 * hh;
                const s16x4 lo = *(const LAS s16x4*)vp, hi = *(const LAS s16x4*)(vp + 16);
                const bf16x8 bfr = (bf16x8){lo[0], lo[1], lo[2], lo[3], hi[0], hi[1], hi[2], hi[3]};
                o[db] = MFMA32(__builtin_bit_cast(bf16x8, pk[kb][s]), bfr, o[db]); } }
    LDS_WAIT(); asm volatile("" ::: "memory");
#pragma unroll
    for (int i = 0; i < 16; ++i) { const int ql = crow_(i, hh); const float rl = __builtin_amdgcn_rcpf(LSUM[w * 32 + ql]);
#pragma unroll
        for (int db = 0; db < 4; ++db) MQ[((size_t)qbb * 256 + 32 * w + ql) * 512 + hm * 128 + 32 * db + r32] = (bf16)f2bf(o[db][i] * rl); }
    LDS_WAIT(); asm volatile("" ::: "memory"); }
    LBAR();
}
__device__ __forceinline__ float lse2f(float a, float b) { const float m = fmaxf(a, b), d = fminf(a, b) - m; return (m == -INFINITY) ? m : m + __log2f(1.f + __builtin_amdgcn_exp2f(d)); }
__device__ __forceinline__ void fcumsum_unit(const Ptrs& P, LAS unsigned char* lds, int hf, int wv) {
    const int tid = fresh_tid(wv), lane = tid & 63, w = wv;
    const float* LF = (const float*)(P.ws + WS_LOGF) + (size_t)hf * S_; float* F = (float*)(P.ws + WS_F) + (size_t)hf * S_;
    LAS float* X = (LAS float*)lds; LAS float* WT = (LAS float*)(lds + 69632);
#pragma unroll 8
    for (int j = 0; j < 32; ++j) { const int t = j * 512 + tid; X[t + (t >> 5)] = LF[t]; }
    LBAR();
    float loc[32]; float s = 0.f;
#pragma unroll
    for (int i = 0; i < 32; ++i) { s += X[tid * 33 + i]; loc[i] = s; }
    float incl = s;
#pragma unroll
    for (int o = 1; o < 64; o <<= 1) { const float y = __shfl_up(incl, o); if (lane >= o) incl += y; }
    if (lane == 63) WT[w] = incl;
    LBAR();
    float woff = 0.f;
#pragma unroll
    for (int ww = 0; ww < 8; ++ww) { const float a = WT[ww]; if (ww < w) woff += a; }
    const float off = woff + incl - s;
#pragma unroll
    for (int i = 0; i < 32; ++i) { loc[i] = off + loc[i]; X[tid * 33 + i] = loc[i]; }
    LBAR();
#pragma unroll 8
    for (int j = 0; j < 32; ++j) { const int t = j * 512 + tid; F[t] = X[t + (t >> 5)]; }
    LBAR();
    const float ref = loc[0]; float accl = 0.f;
#pragma unroll
    for (int i = 0; i < 32; ++i) accl += __builtin_amdgcn_exp2f((ref - loc[i]) * LOG2E_);
    float linc = __log2f(accl) - ref * LOG2E_;
#pragma unroll
    for (int o = 1; o < 64; o <<= 1) { const float y = __shfl_up(linc, o); if (lane >= o) linc = lse2f(linc, y); }
    if (lane == 63) WT[w] = linc;
    LBAR();
    float wpre = -INFINITY;
#pragma unroll
    for (int ww = 0; ww < 8; ++ww) { const float a = WT[ww]; if (ww < w) wpre = lse2f(wpre, a); }
    if ((tid & 3) == 3) ((float*)(P.ws + WS_LSEF))[hf * 128 + (tid >> 2)] = lse2f(wpre, linc);
    LBAR();
}

__device__ __forceinline__ void normmax_unit(const Ptrs& P, LAS unsigned char* lds, int j, int wv) {
    const int tid = fresh_tid(wv), r = tid >> 3, h = tid & 7;
    const bf16* FQ = (const bf16*)(P.ws + WS_FQ); const bf16* FK = (const bf16*)(P.ws + WS_FK); LAS float* RED = (LAS float*)lds;
    const v4u* qp = (const v4u*)(FQ + (size_t)(64 * j + r) * 512 + h * 64); const v4u* kp = (const v4u*)(FK + (size_t)(64 * j + r) * 512 + h * 64);
    float sq = 0.f, sk = 0.f, sd = 0.f;
#pragma unroll
    for (int c = 0; c < 8; ++c) { const v4u a = qp[c], b = kp[c];
        sq += bflo(a.x) * bflo(a.x) + bfhi(a.x) * bfhi(a.x) + bflo(a.y) * bflo(a.y) + bfhi(a.y) * bfhi(a.y) + bflo(a.z) * bflo(a.z) + bfhi(a.z) * bfhi(a.z) + bflo(a.w) * bflo(a.w) + bfhi(a.w) * bfhi(a.w);
        sk += bflo(b.x) * bflo(b.x) + bfhi(b.x) * bfhi(b.x) + bflo(b.y) * bflo(b.y) + bfhi(b.y) * bfhi(b.y) + bflo(b.z) * bflo(b.z) + bfhi(b.z) * bfhi(b.z) + bflo(b.w) * bflo(b.w) + bfhi(b.w) * bfhi(b.w);
        sd += bflo(a.x) * bflo(b.x) + bfhi(a.x) * bfhi(b.x) + bflo(a.y) * bflo(b.y) + bfhi(a.y) * bfhi(b.y) + bflo(a.z) * bflo(b.z) + bfhi(a.z) * bfhi(b.z) + bflo(a.w) * bflo(b.w) + bfhi(a.w) * bfhi(b.w); }
    RED[tid] = sq; RED[512 + tid] = sk; RED[1024 + tid] = -sd;
    LBAR();
    if (tid < 16) { const int hh = tid & 7, which = tid >> 3; float m = 0.f;
        for (int rr = 0; rr < 64; ++rr) m = fmaxf(m, RED[which * 512 + rr * 8 + hh]);
        atomicMax((unsigned*)P.ws + which * 8 + hh, __float_as_uint(m));
        if (which == 0) ((float*)(P.ws + WS_QB2))[j * 8 + hh] = m; }
    else if (tid < 24) { const int hh = tid & 7; float m = -INFINITY;
        for (int rr = 0; rr < 64; ++rr) m = fmaxf(m, RED[1024 + rr * 8 + hh]);
        ((float*)(P.ws + WS_NDOT))[j * 8 + hh] = m; }
    LBAR();
}
#define RLX_AGENT __ATOMIC_RELAXED, __HIP_MEMORY_SCOPE_AGENT
#define XB_TMO      128
#define XB_XCNT(j)  (256  + 64 * (j))
#define XB_XSUB(j)  (1280 + 64 * (j))
#define XB_XGEN(j)  (2304 + 64 * (j))
#define XB_TOP      3328
#define XB_TOPGEN   3392
#define XCD_BAR_WORDS 3456
#define XB_SPIN_CAP (1u << 18)

__device__ __forceinline__ unsigned xb_ld(unsigned* p)              { return __hip_atomic_load(p, __ATOMIC_RELAXED, __HIP_MEMORY_SCOPE_AGENT); }
__device__ __forceinline__ unsigned xb_add(unsigned* p, unsigned v) { return __hip_atomic_fetch_add(p, v, __ATOMIC_RELAXED, __HIP_MEMORY_SCOPE_AGENT); }
__device__ __forceinline__ unsigned xb_xcc_id() { return (unsigned)__builtin_amdgcn_s_getreg((3 << 11) | 20) & 0xFu; }
#define XB_SPIN(cond, bar) do { unsigned _sp = 0; while (cond) { __builtin_amdgcn_s_sleep(1); \
    if ((++_sp & 255u) == 0u) { if (xb_ld(&(bar)[XB_TMO])) break; if (_sp > XB_SPIN_CAP) { atomicAdd(&(bar)[XB_TMO], 1u); break; } } } } while (0)

struct XcdBarrier {
    unsigned* bar; unsigned x;
    volatile LAS unsigned* st;
};

__device__ __forceinline__ XcdBarrier xcd_barrier_post(unsigned* bar, volatile LAS unsigned* st, int wv) {
    XcdBarrier b; b.bar = bar; b.x = xb_xcc_id(); b.st = st;
    if (fresh_tid(wv) == 0) (void)xb_add(&bar[XB_XCNT(b.x)], 1u);
    return b;
}
__device__ __forceinline__ void xcd_barrier_complete(unsigned* bar, unsigned x, unsigned& nloc, unsigned& nx) {
    const unsigned G = gridDim.x * gridDim.y * gridDim.z;
    unsigned sum, cnt, mine, sp = 0u;
    for (;;) {
        sum = 0u; cnt = 0u; mine = 0u;
#pragma unroll
        for (unsigned j = 0; j < 16; ++j) { const unsigned c = xb_ld(&bar[XB_XCNT(j)]); sum += c; cnt += (c > 0u) ? 1u : 0u; mine = (j == x) ? c : mine; }
        if (sum == G) break;
        __builtin_amdgcn_s_sleep(1);
        if ((++sp & 255u) == 0u) { if (xb_ld(&bar[XB_TMO])) break; if (sp > XB_SPIN_CAP) { atomicAdd(&bar[XB_TMO], 1u); break; } }
    }
    nloc = mine > 0u ? mine : 1u; nx = cnt > 0u ? cnt : 1u;
}

__device__ __forceinline__ void xcd_barrier(const XcdBarrier& b, int wv) {
    asm volatile("s_waitcnt vmcnt(0)" ::: "memory");
    __syncthreads();
    if (fresh_tid(wv) == 0) {
        unsigned* bar = b.bar;
        __builtin_amdgcn_s_waitcnt(0);
        unsigned nloc = b.st[0], nx = b.st[1];
        if (nloc == 0u) { xcd_barrier_complete(bar, b.x, nloc, nx); b.st[0] = nloc; b.st[1] = nx; }
        const unsigned old = xb_add(&bar[XB_XSUB(b.x)], 1u);
        const unsigned gen = old / nloc;
        if (old + 1u == (gen + 1u) * nloc) {
            __builtin_amdgcn_fence(__ATOMIC_RELEASE, "agent");
            asm volatile("s_waitcnt vmcnt(0)" ::: "memory");
            const unsigned og = xb_add(&bar[XB_TOP], 1u);
            const unsigned tg = og / nx;
            if (og + 1u == (tg + 1u) * nx) xb_add(&bar[XB_TOPGEN], 1u);
            else XB_SPIN(xb_ld(&bar[XB_TOPGEN]) == tg, bar);
            __builtin_amdgcn_fence(__ATOMIC_ACQUIRE, "agent");
            xb_add(&bar[XB_XGEN(b.x)], 1u);
            asm volatile("s_waitcnt vmcnt(0)" ::: "memory");
        } else {
            XB_SPIN(xb_ld(&bar[XB_XGEN(b.x)]) == gen, bar);
            __builtin_amdgcn_fence(__ATOMIC_ACQUIRE, "agent");
            asm volatile("s_waitcnt vmcnt(0)" ::: "memory");
        }
    }
    __syncthreads();
}

constexpr int CW_BAR = 4096;
constexpr size_t CTL_ZERO_BYTES = 65536;
constexpr int MISC_OFF = 151552;
struct Args { const float* in[18]; float* out; unsigned char* ws; int ph_lo, ph_hi; };
constexpr int N_PHASES = 9;
__global__ void __launch_bounds__(NWAVES * 64, 2) hybrid_fwd(Args args) {
    extern __shared__ __attribute__((aligned(16))) unsigned char lds_raw[];
    cg::grid_group grid = cg::this_grid();
    LAS unsigned char* lds = (LAS unsigned char*)lds_raw;
    const int wv = __builtin_amdgcn_readfirstlane((int)(threadIdx.x >> 6));
    const int G = gridDim.x, bx = blockIdx.x; const int vcu = (G % 8 == 0) ? (bx % 8) * (G / 8) + bx / 8 : bx;
    Ptrs P;
    P.x = args.in[0]; P.mem = args.in[1]; P.g_mix = args.in[2]; P.w_in = args.in[3]; P.w_alpha_up = args.in[4]; P.b_alpha = args.in[5]; P.b_forget = args.in[6]; P.g_gla_head = args.in[7];
    P.g_mem = args.in[8]; P.w_mem_kv = args.in[9]; P.w_gla_o = args.in[10]; P.w_fox_o = args.in[11]; P.w_mem_o = args.in[12]; P.w_out = args.in[13]; P.g_ffn = args.in[14]; P.w_ff1 = args.in[15];
    P.w_ff2 = args.in[16]; P.g_final = args.in[17]; P.out = args.out; P.ws = args.ws;
    unsigned char* ws = args.ws;
    const int lo = args.ph_lo, hi = args.ph_hi;
    if (hi > 1000) grid.sync();
    volatile LAS unsigned* MISC = (volatile LAS unsigned*)(lds + MISC_OFF);
    { const int t_ = fresh_tid(wv); if (t_ < 2) MISC[t_] = 0u; }
    __syncthreads();
    const XcdBarrier bar = xcd_barrier_post((unsigned*)ws + CW_BAR, MISC, wv);
#ifndef PH_MASK
#define PH_MASK 0x3ff
#endif
#define IN(k) ((((PH_MASK) >> (k)) & 1) && lo <= (k) && (k) < hi)
#ifdef PROBE_PHASE
#define STAMP(k) do { if (bx == 0 && fresh_tid(wv) == 0) ((unsigned long long*)(ws + 253 * MiB))[(k)] = __builtin_amdgcn_s_memrealtime(); } while (0)
#else
#define STAMP(k) do {} while (0)
#endif
#define SEAM(k) do { if (lo <= (k) && (k) + 1 < hi) xcd_barrier(bar, wv); STAMP((k) + 1); } while (0)

    STAMP(0);
#define STAGGER() do { const int grp_ = (bx >> 3) & 3; for (int i_ = 0; i_ < grp_; ++i_) __builtin_amdgcn_s_sleep(127); } while (0)
    if (IN(0)) { p0_prologue(P, lds, vcu, G, wv); __syncthreads(); }
    SEAM(0);
    if (IN(1)) {
        ProjSched S{(const char*)P.out + OUT_U, (const char*)(ws + WS_MEMN), (const char*)(ws + WS_WIN), G, bx, wv};
        EpiProj E{ws, P.b_forget};
        STAGGER();
        pg8::gemm_phase<EpiProj, ProjSched, true, true>(lds, 1024, 1024, 1024, S, E);
    }
    SEAM(1);
    if (IN(2)) {
        if (bx < 8) fcumsum_unit(P, lds, bx, wv);
        else for (int u = bx - 8; u < 256; u += G - 8) normmax_unit(P, lds, u, wv);
    }
    SEAM(2);
    if (IN(3)) {
        const attn_body::AttnTensors AT{(const attn_body::bf16*)(ws + WS_FQ), (const attn_body::bf16*)(ws + WS_FK), (const attn_body::bf16*)(ws + WS_FV), (attn_body::bf16*)(ws + WS_FQ), (const float*)(ws + WS_F)};
        LAS float* THRU = (LAS float*)(lds + MISC_OFF + 128); volatile LAS unsigned* qslot = (volatile LAS unsigned*)(lds + MISC_OFF + 32);
        { const int i_ = fresh_tid(wv); const int h_ = i_ & 7, qb_ = i_ >> 3;
          const float* QB2 = (const float*)(ws + WS_QB2); const float* NDOT = (const float*)(ws + WS_NDOT); const float k2 = __uint_as_float(((const unsigned*)ws)[8 + h_]);
          float a2 = 0.f, b = -INFINITY;
#pragma unroll
          for (int bb = 0; bb < 4; ++bb) { a2 = fmaxf(a2, QB2[(4 * qb_ + bb) * 8 + h_]); b = fmaxf(b, NDOT[(4 * qb_ + bb) * 8 + h_]); }
          THRU[qb_ * 8 + h_] = -(24.1f + 1.01f * sqrtf(a2 * k2) + b); }
        __syncthreads();
        for (;;) {
            if (fresh_tid(wv) == 0) qslot[0] = __hip_atomic_fetch_add((unsigned*)ws + 64, 1u, __ATOMIC_RELAXED, __HIP_MEMORY_SCOPE_AGENT);
            asm volatile("s_waitcnt vmcnt(0) lgkmcnt(0)\n\ts_barrier" ::: "memory");
            const int idx = __builtin_amdgcn_readfirstlane((int)qslot[0]);
            if (idx >= 1664) break;
            if (idx < 512) { const int h = idx & 7, qb = 63 - (idx >> 3); attn_body::attn_unit<8>(0, h, qb, AT.Q, AT.K, AT.V, AT.O, AT.F + (size_t)h * S_, (const float*)(ws + WS_LSEF) + h * 128, THRU[qb * 8 + h], (char*)lds_raw, wv); }
            else if (idx < 640) memattn_unit(P, lds, (idx - 512) & 3, (idx - 512) >> 2, wv);
            else gla_a_unit(P, lds, (idx - 640) >> 2, (idx - 640) & 3, wv);
        }
    }
    SEAM(3);
    if (IN(3)) { for (int u = bx; u < 256; u += G) gla_scan_unit(P, lds, u, wv); }
    if (lo <= 3 && 4 < hi) xcd_barrier(bar, wv);
    STAMP(40);

    if (IN(4)) { for (int task = bx * NWAVES + wv; task < 2048; task += G * NWAVES) { const int lane_ = fresh_tid(wv) & 63; gla_b_task(P, task, lane_); } }
    SEAM(4);
    if (IN(5)) {
        static_assert(WS_FQ - WS_GG == 16 * MiB && WS_MQ - WS_FQ == 16 * MiB && WS_WFOXO - WS_WGLAO == MiB && WS_WMEMO - WS_WFOXO == MiB, "merge operand spacing");
        MergeSched S{(const char*)(ws + WS_GG), (const char*)(ws + WS_WGLAO), G, bx, wv, 16 * MiB - 1024, MiB - 1024};
        EpiMerge E{(bf16*)(ws + WS_MG), (const bf16*)(ws + WS_GT)};
        pg8::gemm_phase<EpiMerge, MergeSched, true, true, 8>(lds, 1536, 512, 512, S, E);
    }
    SEAM(5);
    if (IN(6)) {
        GemmSched S{(const char*)(ws + WS_MG), (const char*)(ws + WS_WOUT), 64, 4, 1024, 1024, G, bx, wv};
        EpiResid<true, false> E{P.x, (bf16*)(ws + WS_H0), (bf16*)(ws + WS_H1) - (size_t)8192 * 1024, (bf16*)(ws + WS_U2), P.g_ffn, (float*)(ws + WS_SS1)};
        pg8::gemm_phase<EpiResid<true, false>, GemmSched, true, true>(lds, 1024, 1024, 1024, S, E);
    }
    SEAM(6);
    if (IN(7)) {
        GemmSched S{(const char*)(ws + WS_U2), (const char*)(ws + WS_WFF1), 64, 16, 1024, 1024, G, bx, wv};
        EpiFfn1 E{(bf16*)(ws + WS_HID), (const float*)(ws + WS_SS1)};
        STAGGER();
        pg8::gemm_phase<EpiFfn1, GemmSched, true, true>(lds, 1024, 1024, 1024, S, E);
    }
    SEAM(7);
    if (IN(8)) {
        GemmSched S{(const char*)(ws + WS_HID), (const char*)(ws + WS_WFF2), 64, 4, 4096, 4096, G, bx, wv};
        EpiFinal E{(const bf16*)(ws + WS_H0), (const bf16*)(ws + WS_H1) - (size_t)8192 * 1024, P.out, P.g_final, (float*)(ws + WS_SS2), (unsigned*)ws + CW_PANEL};
        pg8::gemm_phase<EpiFinal, GemmSched, false, true>(lds, 4096, 4096, 4096, S, E);
    }
    STAMP(9);
#ifdef PROBE_PHASE
    __syncthreads(); xcd_barrier(bar, wv); STAMP(10);
    if (PROBE_PHASE == 200) { xcd_barrier(bar, wv); xcd_barrier(bar, wv); xcd_barrier(bar, wv); xcd_barrier(bar, wv); STAMP(11); }
    if (bx == 0) { __syncthreads(); const unsigned long long* ts = (const unsigned long long*)(ws + 253 * MiB);
        long K = (PROBE_PHASE < 0) ? 100000 : (PROBE_PHASE == 200) ? (long)(ts[11] - ts[10]) * 10 : (PROBE_PHASE == 777) ? (long)((ts[61] - ts[60]) / 5 + 540 * ((ts[62] - ts[61]) / 5)) : (PROBE_PHASE == 778) ? (long)((ts[63] - ts[62]) / 5 + 540 * ((ts[64] - ts[63]) / 5)) : (PROBE_PHASE >= 1000) ? (long)(ts[PROBE_PHASE % 1000] - ts[PROBE_PHASE / 1000]) : (PROBE_PHASE >= 100 ? (long)(ts[10] - ts[0]) / 10 : (long)(ts[PROBE_PHASE + 1] - ts[PROBE_PHASE]));
        if (K > 300000) K = 300000;
        for (long i = fresh_tid(wv); i < K; i += 512) P.out[i] += 0.1f; }
#endif
#undef IN
#undef SEAM
}

extern "C" void kernel_launch(void* const* d_in, const int* in_sizes, int n_in, void* d_out, int out_size, void* d_ws, size_t ws_size, hipStream_t stream) {
    static int grid = 0;
    if (grid == 0) {
        if (n_in != 18 || out_size != S_ * DM_ || ws_size < WS_END) { fprintf(stderr, "kernel_launch: unexpected shapes (n_in %d out %d ws %zu)\n", n_in, out_size, ws_size); grid = -1; return; }
        int dev = 0, cus = 0, per_cu = 0;
        (void)hipGetDevice(&dev); (void)hipDeviceGetAttribute(&cus, hipDeviceAttributeMultiprocessorCount, dev);
        (void)hipFuncSetAttribute((const void*)hybrid_fwd, hipFuncAttributeMaxDynamicSharedMemorySize, LDS_BYTES);
        (void)hipOccupancyMaxActiveBlocksPerMultiprocessor(&per_cu, (const void*)hybrid_fwd, NWAVES * 64, LDS_BYTES);
        (void)hipGetLastError();
        grid = 256;
        if (cus != 256 || per_cu < 1) fprintf(stderr, "kernel_launch: note: cus %d per_cu %d (built for 256 CUs, one workgroup each)\n", cus, per_cu);
    }
    if (grid < 0) return;
    (void)hipMemsetAsync(d_ws, 0, CTL_ZERO_BYTES, stream);
    Args a{};
    for (int i = 0; i < 18; ++i) a.in[i] = (const float*)d_in[i];
    a.out = (float*)d_out; a.ws = (unsigned char*)d_ws;
#ifndef MK_PER_PHASE
    a.ph_lo = 0; a.ph_hi = N_PHASES;
    { void* kargs[] = {&a}; hipError_t e = hipLaunchCooperativeKernel((const void*)hybrid_fwd, dim3(grid), dim3(NWAVES * 64), kargs, LDS_BYTES, stream);
      if (e != hipSuccess) fprintf(stderr, "cooperative launch failed: %s\n", hipGetErrorString(e)); }
#else
    for (int k = 0; k < N_PHASES; ++k) { a.ph_lo = k; a.ph_hi = k + 1; void* kargs[] = {&a};
        hipError_t e = hipLaunchCooperativeKernel((const void*)hybrid_fwd, dim3(grid), dim3(NWAVES * 64), kargs, LDS_BYTES, stream);
        if (e != hipSuccess) { fprintf(stderr, "cooperative launch %d failed: %s\n", k, hipGetErrorString(e)); break; } }
#endif
}
```

```cpp
#include <hip/hip_runtime.h>
#include <hip/hip_cooperative_groups.h>
#include <hip/hip_bf16.h>
#include <cstdio>
#include <cstdint>
#include <cmath>
namespace cg = cooperative_groups;
__device__ __forceinline__ int fresh_tid(int wv) { int lane_; asm volatile("v_mbcnt_lo_u32_b32 %0, -1, 0\n\tv_mbcnt_hi_u32_b32 %0, -1, %0" : "=v"(lane_)); return wv * 64 + lane_; }
namespace pg8 {
#define PG8_LAS __attribute__((address_space(3)))
typedef unsigned short bf16_t;
typedef short bf16x8 __attribute__((ext_vector_type(8)));
typedef float f32x4 __attribute__((ext_vector_type(4)));
typedef unsigned u32x4 __attribute__((ext_vector_type(4)));
constexpr int BM = 256, BK = 64, HALF = 128, HTB = HALF * BK * 2  , STAGE_BYTES = 8 * HTB, NXCD = 8, WGM = 8;

__host__ __device__ __forceinline__ int lds_byte(int r, int c) { const int st = (r >> 4) * 2 + (c >> 5), rr = r & 15, cc = c & 31, ob = rr * 64 + cc * 2; return st * 1024 + (ob ^ (((ob >> 9) & 1) << 5)); }
__host__ __device__ __forceinline__ void stage_rc(int b, int& R, int& C) { const int st = b / 1024, sb = b % 1024, swz = sb ^ (((sb >> 9) & 1) << 5); R = (st >> 1) * 16 + swz / 64; C = (st & 1) * 32 + (swz % 64) / 2; }
__host__ __device__ __forceinline__ int perm32(int rho) { const int n = rho >> 4, i = rho & 15; return 8 * (i >> 2) + 4 * n + (i & 3); }

struct Unit { int pm, pn, z; };
__device__ __forceinline__ unsigned cvt_pk_bf16(float lo, float hi) { unsigned r; asm volatile("v_cvt_pk_bf16_f32 %0, %1, %2" : "=v"(r) : "v"(lo), "v"(hi)); return r; }
__device__ __forceinline__ void map_tile(int L, int nM, int nN, int& pm, int& pn) {
    const int nwg = nM * nN; int wgid = L; { const int q = nwg / NXCD, r = nwg % NXCD, xcd = wgid % NXCD, off = wgid / NXCD; wgid = (xcd < r ? xcd * (q + 1) : r * (q + 1) + (xcd - r) * q) + off; }
    const int nig = WGM * nN, gid = wgid / nig, fm = gid * WGM, gsz = (nM - fm) < WGM ? (nM - fm) : WGM;
    pm = fm + ((wgid % nig) % gsz); pn = (wgid % nig) / gsz;
}
template <class Epi, class Sched, bool ALIGN_EPI = false, bool SP2 = false, int SEGT = 0>
__device__ __forceinline__ void gemm_phase(PG8_LAS unsigned char* lds, const int K, const int lda, const int ldb, const Sched& S, const Epi& E) {
    const int tid = fresh_tid(S.wv), wid = S.wv, lane = tid & 63, wr = wid >> 2, wc = wid & 3, fr = lane & 15, fq = lane >> 4;
    const int nt = K / BK;
    unsigned voffA[2], voffB[2];
#pragma unroll
    for (int i = 0; i < 2; ++i) { int R, C; stage_rc(tid * 16 + i * 8192, R, C); const int Rb = Epi::PERM ? ((R & ~31) + perm32(R & 31)) : R;
        voffA[i] = (unsigned)(R * lda + C) * 2u; voffB[i] = (unsigned)(Rb * ldb + C) * 2u; }
    const size_t kstep = (size_t)(BK * 2);
    const size_t hstepA = (size_t)HALF * lda * 2, hstepB = (size_t)HALF * ldb * 2;
    const unsigned ldsw = (unsigned)wid * 1024u;
    const int aoff = lds_byte(wr * 64 + fr, fq * 8), boff = lds_byte(wc * 32 + fr, fq * 8);
#define PG8_SA(b, h) (((b) * 2 + (h)) * HTB)
#define PG8_SB(b, h) ((4 + (b) * 2 + (h)) * HTB)
#define PG8_STAGE(bufoff, gbase, voff) do { _Pragma("unroll") for (int _i = 0; _i < 2; ++_i) \
        __builtin_amdgcn_global_load_lds((const unsigned*)((const char*)(gbase) + (voff)[_i]), (PG8_LAS unsigned*)(lds + (bufoff) + ldsw + _i * 8192), 16, 0, 0); } while (0)
#define PG8_LDA(dst, b, h) do { _Pragma("unroll") for (int m = 0; m < 4; ++m) _Pragma("unroll") for (int k = 0; k < 2; ++k) dst[m][k] = *(const PG8_LAS bf16x8*)(lds + PG8_SA(b, h) + aoff + m * 2048 + k * 1024); } while (0)
#define PG8_LDB(dst, b, h) do { _Pragma("unroll") for (int n = 0; n < 2; ++n) _Pragma("unroll") for (int k = 0; k < 2; ++k) dst[n][k] = *(const PG8_LAS bf16x8*)(lds + PG8_SB(b, h) + boff + n * 2048 + k * 1024); } while (0)
#define PG8_MMA(ai, bj, At, Bt) do { __builtin_amdgcn_s_setprio(1); _Pragma("unroll") for (int m = 0; m < 4; ++m) _Pragma("unroll") for (int n = 0; n < 2; ++n) _Pragma("unroll") for (int k = 0; k < 2; ++k) \
        acc[ai][bj][m][n] = __builtin_amdgcn_mfma_f32_16x16x32_bf16(Bt[n][k], At[m][k], acc[ai][bj][m][n], 0, 0, 0); __builtin_amdgcn_s_setprio(0); } while (0)
#define PG8_WAIT_V(n) asm volatile("s_waitcnt vmcnt(" #n ")" ::: "memory")
#define PG8_WAIT_L(n) asm volatile("s_waitcnt lgkmcnt(" #n ")" ::: "memory")
#define PG8_BAR __builtin_amdgcn_s_barrier()
#define PG8_SCHED __builtin_amdgcn_sched_barrier(0)
    Unit cur, nxt; int ui = 0;
    if (!S.next(0, cur)) return;
    f32x4 acc[2][2][4][2];
#pragma unroll
    for (int a = 0; a < 2; ++a)
#pragma unroll
        for (int b = 0; b < 2; ++b)
#pragma unroll
            for (int m = 0; m < 4; ++m)
#pragma unroll
                for (int n = 0; n < 2; ++n) acc[a][b][m][n] = (f32x4){0.f, 0.f, 0.f, 0.f};
    bf16x8 At[4][2], B0[2][2], B1[2][2];
    const char* cA = S.aptr(cur); const char* cB = S.bptr(cur);
    S.a_ready(cur);
    if constexpr (SP2) {
        PG8_STAGE(PG8_SB(0, 0), cB, voffB); PG8_STAGE(PG8_SB(0, 1), cB + hstepB, voffB); PG8_STAGE(PG8_SA(0, 0), cA, voffA); PG8_STAGE(PG8_SA(0, 1), cA + hstepA, voffA);
        if (wr == 1) PG8_BAR;
        PG8_WAIT_V(2); PG8_BAR;
        PG8_STAGE(PG8_SB(1, 0), cB + kstep, voffB); PG8_STAGE(PG8_SA(1, 0), cA + kstep, voffA); PG8_STAGE(PG8_SB(1, 1), cB + hstepB + kstep, voffB);
        PG8_WAIT_V(6); PG8_BAR;
    } else {
        PG8_STAGE(PG8_SB(0, 0), cB, voffB); PG8_STAGE(PG8_SA(0, 0), cA, voffA); PG8_STAGE(PG8_SB(0, 1), cB + hstepB, voffB); PG8_STAGE(PG8_SA(0, 1), cA + hstepA, voffA);
        if (wr == 1) PG8_BAR;
        PG8_WAIT_V(4); PG8_BAR;
        PG8_STAGE(PG8_SB(1, 0), cB + kstep, voffB); PG8_STAGE(PG8_SA(1, 0), cA + kstep, voffA); PG8_STAGE(PG8_SB(1, 1), cB + hstepB + kstep, voffB);
        PG8_WAIT_V(6); PG8_BAR;
    }
    for (;;) {
        const bool has_next = S.next(ui + 1, nxt);
        const char* nA = has_next ? S.aptr(nxt) : cA; const char* nB = has_next ? S.bptr(nxt) : cB;
        for (int t = 0; t < nt; t += 2) {
            const bool last = (t == nt - 2);
            size_t sa1 = 0, sa2 = 0, sb2 = 0;
            if constexpr (SEGT > 0) { if (t > 0 && (t % SEGT) == 0) E.mid(acc, cur, t / SEGT, wr, wc, fr, fq);
                sa1 = (size_t)(t / SEGT) * S.segA; sa2 = (size_t)((t + 2) / SEGT) * S.segA; sb2 = (size_t)((t + 2) / SEGT) * S.segB; }
            const char* a1 = cA + (size_t)(t + 1) * kstep + sa1;
            const char* a2 = last ? nA : cA + (size_t)(t + 2) * kstep + sa2; const char* b2 = last ? nB : cB + (size_t)(t + 2) * kstep + sb2;
            const char* a3 = a2 + kstep; const char* b3 = b2 + kstep;
            if (last && has_next) S.a_ready(nxt);
            if constexpr (SP2) {
            PG8_LDB(B0, 0, 0); PG8_LDB(B1, 0, 1); PG8_SCHED; PG8_LDA(At, 0, 0); PG8_STAGE(PG8_SA(1, 1), a1 + hstepA, voffA);
            PG8_WAIT_V(8); PG8_WAIT_L(0); PG8_BAR; PG8_MMA(0, 0, At, B0); PG8_MMA(0, 1, At, B1); PG8_BAR; PG8_SCHED;
            PG8_LDA(At, 0, 1); PG8_STAGE(PG8_SB(0, 0), b2, voffB); PG8_STAGE(PG8_SB(0, 1), b2 + hstepB, voffB); PG8_STAGE(PG8_SA(0, 0), a2, voffA);
            PG8_WAIT_V(8); PG8_WAIT_L(0); PG8_BAR; PG8_MMA(1, 0, At, B0); PG8_MMA(1, 1, At, B1); PG8_BAR; PG8_SCHED;
            PG8_LDB(B0, 1, 0); PG8_LDB(B1, 1, 1); PG8_SCHED; PG8_LDA(At, 1, 0); PG8_STAGE(PG8_SA(0, 1), a2 + hstepA, voffA);
            PG8_WAIT_V(8); PG8_WAIT_L(0); PG8_BAR; PG8_MMA(0, 0, At, B0); PG8_MMA(0, 1, At, B1); PG8_BAR; PG8_SCHED;
            PG8_LDA(At, 1, 1); PG8_STAGE(PG8_SB(1, 0), b3, voffB); PG8_STAGE(PG8_SB(1, 1), b3 + hstepB, voffB); PG8_STAGE(PG8_SA(1, 0), a3, voffA);
            PG8_WAIT_V(8); PG8_WAIT_L(0); PG8_BAR; PG8_MMA(1, 0, At, B0); PG8_MMA(1, 1, At, B1); PG8_BAR; PG8_SCHED;
            } else {
            PG8_LDB(B0, 0, 0); PG8_SCHED; PG8_LDA(At, 0, 0); PG8_STAGE(PG8_SA(1, 1), a1 + hstepA, voffA);
            PG8_WAIT_L(8); PG8_BAR; PG8_WAIT_L(0); PG8_MMA(0, 0, At, B0); PG8_BAR; PG8_SCHED;
            PG8_LDB(B1, 0, 1); PG8_STAGE(PG8_SB(0, 0), b2, voffB);
            PG8_BAR; PG8_WAIT_L(0); PG8_MMA(0, 1, At, B1); PG8_BAR;
            PG8_LDA(At, 0, 1); PG8_STAGE(PG8_SA(0, 0), a2, voffA);
            PG8_BAR; PG8_WAIT_L(0); PG8_MMA(1, 0, At, B0); PG8_BAR; PG8_SCHED;
            PG8_STAGE(PG8_SB(0, 1), b2 + hstepB, voffB);
            PG8_WAIT_V(6); PG8_BAR; PG8_MMA(1, 1, At, B1); PG8_BAR;
            PG8_LDB(B0, 1, 0); PG8_SCHED; PG8_LDA(At, 1, 0); PG8_STAGE(PG8_SA(0, 1), a2 + hstepA, voffA);
            PG8_WAIT_L(8); PG8_BAR; PG8_WAIT_L(0); PG8_MMA(0, 0, At, B0); PG8_BAR; PG8_SCHED;
            PG8_LDB(B1, 1, 1); PG8_STAGE(PG8_SB(1, 0), b3, voffB);
            PG8_BAR; PG8_WAIT_L(0); PG8_MMA(0, 1, At, B1); PG8_BAR;
            PG8_LDA(At, 1, 1); PG8_STAGE(PG8_SA(1, 0), a3, voffA);
            PG8_BAR; PG8_WAIT_L(0); PG8_MMA(1, 0, At, B0); PG8_BAR; PG8_SCHED;
            PG8_STAGE(PG8_SB(1, 1), b3 + hstepB, voffB);
            PG8_WAIT_V(6); PG8_BAR; PG8_MMA(1, 1, At, B1); PG8_BAR;
            }
        }
        if constexpr (ALIGN_EPI) { if (wr == 0) PG8_BAR; }
        if constexpr (!Epi::AFTER_DRAIN) { E(acc, cur, wr, wc, fr, fq); S.done(cur); }
        if (!has_next) break;
#pragma unroll
        for (int a = 0; a < 2; ++a)
#pragma unroll
            for (int b = 0; b < 2; ++b)
#pragma unroll
                for (int m = 0; m < 4; ++m)
#pragma unroll
                    for (int n = 0; n < 2; ++n) acc[a][b][m][n] = (f32x4){0.f, 0.f, 0.f, 0.f};
        cur = nxt; cA = nA; cB = nB; ++ui;
        if constexpr (ALIGN_EPI) { if (wr == 1) PG8_BAR; }
    }
    PG8_WAIT_V(0);
    if constexpr (!ALIGN_EPI) { if (wr == 0) PG8_BAR; }
    PG8_BAR;
    if constexpr (Epi::AFTER_DRAIN) { E.fused(acc, cur, wr, wc, fr, fq, lds, wid, lane); S.done(cur); }
#undef PG8_SA
#undef PG8_SB
#undef PG8_STAGE
#undef PG8_LDA
#undef PG8_LDB
#undef PG8_MMA
#undef PG8_WAIT_V
#undef PG8_WAIT_L
#undef PG8_BAR
#undef PG8_SCHED
}
}
#include <hip/hip_bf16.h>
namespace attn_body {
using bf16=__hip_bfloat16;
using bf16x8=__attribute__((ext_vector_type(8)))short;
using s16x4=__attribute__((ext_vector_type(4)))short;
using f32x16=__attribute__((ext_vector_type(16)))float;
using u32x4=__attribute__((ext_vector_type(4)))unsigned;
constexpr int BATCH=1,NHEAD=8,SEQ=16384,D=64,DM=NHEAD*D;
constexpr int NW=8,QBLK=32,QB=QBLK*NW,KVBLK=64,NQB=SEQ/QB;
constexpr int ATTN_PITCH=DM, ATTN_UNIT_ROWS=QB;
__device__ __forceinline__ int crow(int r,int hi){return (r&3)+8*(r>>2)+4*hi;}
#define SBAR() __builtin_amdgcn_sched_barrier(0)
__device__ __forceinline__ void cmask(f32x16&p0,f32x16&p1,int jb,int qrel,int hi){
  const float NEG=-INFINITY; int kb=64*jb+4*hi;
  #pragma unroll
  for(int r=0;r<16;++r){int kv=kb+(r&3)+8*(r>>2); if(kv>qrel)p0[r]=NEG; if(kv+32>qrel)p1[r]=NEG;}
}

constexpr int NSLOT=3, SLOTB=8192;
constexpr int LDS_K=0, LDS_V=NSLOT*SLOTB, LDS_WS=2*NSLOT*SLOTB, LDS_OST=LDS_WS+NW*64*4, LDS_BIAS=LDS_OST+NW*4096, LDS_BYTES=LDS_BIAS+SEQ*4+512;
constexpr float C2=0.125f*1.4426950408889634f;
__device__ __forceinline__ void glds16(const void*gsrc,unsigned lds_dst){unsigned keep;
  asm volatile("s_mov_b32 %0, m0\n\ts_mov_b32 m0, %2\n\ts_nop 0\n\tglobal_load_lds_dwordx4 %1, off\n\ts_mov_b32 m0, %0":"=&s"(keep):"v"(gsrc),"s"(lds_dst):"memory");}
__device__ __forceinline__ float max3f(float a,float b,float c){float r;asm("v_max3_f32 %0, %1, %2, %3":"=v"(r):"v"(a),"v"(b),"v"(c));return r;}
__device__ __forceinline__ float max2f(float a,float b){float r;asm("v_max_f32_e32 %0, %1, %2":"=v"(r):"v"(a),"v"(b));return r;}
__device__ __forceinline__ float fadd_s(float a,float b){float r;asm("v_add_f32_e32 %0, %1, %2":"=v"(r):"v"(a),"v"(b));return r;}
__device__ __forceinline__ float fsub_s(float a,float b){float r;asm("v_sub_f32_e32 %0, %1, %2":"=v"(r):"v"(a),"v"(b));return r;}
typedef float f32x2_t __attribute__((ext_vector_type(2))); typedef __bf16 bf16x2_t __attribute__((ext_vector_type(2)));
__device__ __forceinline__ unsigned cvtpk_s(float lo,float hi){f32x2_t v={lo,hi};bf16x2_t b=__builtin_convertvector(v,bf16x2_t);return __builtin_bit_cast(unsigned,b);}
#define WAIT_BAR(N) asm volatile("s_waitcnt vmcnt(" #N ") lgkmcnt(0)\n\ts_barrier":::"memory")

__device__ __forceinline__ void qkt(f32x16&p0,f32x16&p1,const char*Kslot,const bf16x8*qr,int r32,int hi){
  const char*kb=Kslot+hi*1024+r32*16;
  #pragma unroll
  for(int d0=0;d0<4;++d0){
    const bf16x8 b0=*reinterpret_cast<const bf16x8*>(kb+d0*2048);
    const bf16x8 b1=*reinterpret_cast<const bf16x8*>(kb+d0*2048+512);
    p0=__builtin_amdgcn_mfma_f32_32x32x16_bf16(b0,qr[d0],p0,0,0,0);p1=__builtin_amdgcn_mfma_f32_32x32x16_bf16(b1,qr[d0],p1,0,0,0);}
}
typedef __attribute__((address_space(3))) const char* lds_cptr;
typedef short v4i16_t __attribute__((ext_vector_type(4)));
__device__ __forceinline__ void kload8(bf16x8*kf,lds_cptr kp){
  kf[0]=*(const __attribute__((address_space(3))) bf16x8*)(kp);      kf[1]=*(const __attribute__((address_space(3))) bf16x8*)(kp+512);
  kf[2]=*(const __attribute__((address_space(3))) bf16x8*)(kp+2048); kf[3]=*(const __attribute__((address_space(3))) bf16x8*)(kp+2560);
  kf[4]=*(const __attribute__((address_space(3))) bf16x8*)(kp+4096); kf[5]=*(const __attribute__((address_space(3))) bf16x8*)(kp+4608);
  kf[6]=*(const __attribute__((address_space(3))) bf16x8*)(kp+6144); kf[7]=*(const __attribute__((address_space(3))) bf16x8*)(kp+6656);
}
__device__ __forceinline__ void kload2(bf16x8*kf,lds_cptr kp,int j){ kf[2*j]=*(const __attribute__((address_space(3))) bf16x8*)(kp+j*2048); kf[2*j+1]=*(const __attribute__((address_space(3))) bf16x8*)(kp+j*2048+512); }
__device__ __forceinline__ s16x4 vtr(lds_cptr p){ return __builtin_bit_cast(s16x4,__builtin_amdgcn_ds_read_tr16_b64_v4i16((__attribute__((address_space(3))) v4i16_t*)p)); }
__device__ __forceinline__ float rowmax(const f32x16&p0,const f32x16&p1){
  float a=max3f(p0[0],p0[1],p1[0]),b=max3f(p0[2],p0[3],p1[1]);a=max3f(a,p1[2],p1[3]);
  #pragma unroll
  for(int r=4;r<16;r+=4){a=max3f(a,p0[r],p0[r+1]);b=max3f(b,p0[r+2],p0[r+3]);a=max3f(a,p1[r],p1[r+1]);b=max3f(b,p1[r+2],p1[r+3]);}
  const float m=max2f(a,b);
  auto rr=__builtin_amdgcn_permlane32_swap(__float_as_uint(m),__float_as_uint(m),false,false);
  return max2f(__uint_as_float(rr[0]),__uint_as_float(rr[1]));
}
__device__ __forceinline__ void pv(f32x16*o,int vb,bf16x8 pa0,bf16x8 pa1,bf16x8 pa2,bf16x8 pa3){
  #pragma unroll
  for(int d0=0;d0<2;++d0){s16x4 lo[4],hi[4];
    #pragma unroll
    for(int ks=0;ks<4;++ks){
      asm volatile("ds_read_b64_tr_b16 %0,%1 offset:%c2":"=&v"(lo[ks]):"v"(vb),"i"(d0*4096+ks*1024):"memory");
      asm volatile("ds_read_b64_tr_b16 %0,%1 offset:%c2":"=&v"(hi[ks]):"v"(vb),"i"(d0*4096+ks*1024+512):"memory");}
    asm volatile("s_waitcnt lgkmcnt(0)":::"memory");SBAR();
    #define PK(k) (bf16x8){lo[k][0],lo[k][1],lo[k][2],lo[k][3],hi[k][0],hi[k][1],hi[k][2],hi[k][3]}
    o[d0]=__builtin_amdgcn_mfma_f32_32x32x16_bf16(pa0,PK(0),o[d0],0,0,0);
    o[d0]=__builtin_amdgcn_mfma_f32_32x32x16_bf16(pa1,PK(1),o[d0],0,0,0);
    o[d0]=__builtin_amdgcn_mfma_f32_32x32x16_bf16(pa2,PK(2),o[d0],0,0,0);
    o[d0]=__builtin_amdgcn_mfma_f32_32x32x16_bf16(pa3,PK(3),o[d0],0,0,0);
    #undef PK
  }
}

#ifndef ATTN_STORE16
#define ATTN_STORE16(p,v) (*(u32x4*)(p)=(v))
#endif
typedef float f32x4_t __attribute__((ext_vector_type(4)));
template<int THRL> __device__ __forceinline__ void attn_unit(int b,int h,int qb,const bf16*Q,const bf16*__restrict__ K,const bf16*__restrict__ V,bf16*O,const float*__restrict__ Fh,const float*__restrict__ Lh,float thrb,char*shm,int wv){
  const int tid=fresh_tid(wv),lane=tid&63,r32=lane&31,hi=lane>>5; const int wid=wv;
  const long rowbase=(long)b*SEQ; const int q0=qb*QB;
  const bf16*Qw=Q+(rowbase+q0+wid*QBLK)*DM+h*D;
  const lds_cptr shm3=(lds_cptr)shm;
  const float fref=Fh[q0];
  int T0; { __attribute__((address_space(3))) float* pb=(__attribute__((address_space(3))) float*)(shm3+LDS_WS);
    if(tid<2*qb) pb[tid]=Lh[tid]+fref*1.4426950408889634f;
    asm volatile("s_waitcnt lgkmcnt(0)\n\ts_barrier":::"memory");
    int lo_=0,hi_=2*qb; while(lo_<hi_){ const int mid=(lo_+hi_)>>1; if(!(pb[mid]<=thrb)) hi_=mid; else lo_=mid+1; } T0=__builtin_amdgcn_readfirstlane(2*lo_); }
  { __attribute__((address_space(3))) float* bl=(__attribute__((address_space(3))) float*)(shm3+LDS_BIAS);
    #pragma unroll 4
    for(int s=64*T0+tid;s<q0+QB;s+=NW*64) bl[s]=(fref-Fh[s])*1.4426950408889634f; }
  const bf16*Kh=K+(rowbase+(long)T0*KVBLK)*DM+h*D,*Vh=V+(rowbase+(long)T0*KVBLK)*DM+h*D;
  const unsigned lds0=(unsigned)(uintptr_t)shm;
  float*wsf=(float*)(shm+LDS_WS)+wid*64;
  const bf16*ksrc=Kh+(long)lane*DM+wid*8;
  const bf16*vsrc=Vh+(long)(16*(wid&3)+(lane>>2))*DM+(wid>>2)*32+(lane&3)*8;
  const unsigned kdst=lds0+LDS_K+wid*1024, vdst=lds0+LDS_V+wid*1024;
  #define DMA_K(t,slot) glds16(ksrc+(long)(t)*KVBLK*DM,(unsigned)__builtin_amdgcn_readfirstlane(kdst+(slot)))
  #define DMA_V(t,slot) glds16(vsrc+(long)(t)*KVBLK*DM,(unsigned)__builtin_amdgcn_readfirstlane(vdst+(slot)))
  const int vb0=(int)(lds0+LDS_V)+((lane>>4)&1)*32+(lane&3)*8+(4*hi+((lane&15)>>2))*64;
  const char*Kbase=shm+LDS_K; bf16x8 kf[8];
  const lds_cptr kp0=shm3+LDS_K+hi*1024+r32*16; const lds_cptr vp0=shm3+LDS_V+((lane>>4)&1)*32+(lane&3)*8+(4*hi+((lane&15)>>2))*64;
  const int NT=(q0+QB)/KVBLK-T0;
  #define BLOAD(X0,X1,tt) do{ const __attribute__((address_space(3))) f32x4_t* bp_=(const __attribute__((address_space(3))) f32x4_t*)(shm3+LDS_BIAS+(((tt)+T0)*64+4*hi)*4); \
    _Pragma("unroll") for(int g_=0;g_<4;++g_){ const f32x4_t a_=bp_[2*g_], b_=bp_[8+2*g_]; \
      X0[4*g_]=a_[0];X0[4*g_+1]=a_[1];X0[4*g_+2]=a_[2];X0[4*g_+3]=a_[3]; X1[4*g_]=b_[0];X1[4*g_+1]=b_[1];X1[4*g_+2]=b_[2];X1[4*g_+3]=b_[3]; } }while(0)
  DMA_K(0,0);DMA_V(0,0);DMA_K(1,SLOTB);
  bf16x8 qr[4];
  #pragma unroll
  for(int d0=0;d0<4;++d0)qr[d0]=*reinterpret_cast<const bf16x8*>(&Qw[(long)r32*DM+d0*16+hi*8]);
  float mhat=0.f,l_reg=0.f;f32x16 o[2];o[0]=f32x16{};o[1]=f32x16{};
  const int qrel=wid*QBLK+r32;
  #define CMASK(P0,P1,t) do{int jb_=(t)-(NT-4); if(jb_>=0)cmask(P0,P1,jb_,qrel,hi);}while(0)
  bool resc=false;
    \
  #define START(P0,P1) do{ const float rm=rowmax(P0,P1); resc=false; \
    { const float dl=__builtin_fmaxf(rm,((const __attribute__((address_space(3))) float*)(shm3+LDS_BIAS))[q0+qrel]+10.f); mhat=fadd_s(mhat,dl); \
      _Pragma("unroll") for(int r=0;r<16;++r){P0[r]=fsub_s(P0[r],dl);P1[r]=fsub_s(P1[r],dl);} \
 } \
    _Pragma("unroll") for(int r=0;r<16;++r)P0[r]=__builtin_amdgcn_exp2f(P0[r]); }while(0)
  #define RESC() do{ if(resc){ asm volatile("s_waitcnt lgkmcnt(0)":::"memory"); \
      _Pragma("unroll") for(int d_=0;d_<2;++d_) _Pragma("unroll") for(int r=0;r<16;++r)o[d_][r]*=wsf[crow(r,hi)]; } }while(0)
  f32x16 pA0,pA1,pB0,pB1;
  int sl_prev=0,sl_cur=0,sl_next=SLOTB;
  #define ROT() do{sl_prev=sl_cur;sl_cur=sl_next;sl_next=(sl_next==(NSLOT-1)*SLOTB)?0:sl_next+SLOTB;}while(0)
  DMA_K(2,2*SLOTB);
  WAIT_BAR(3);
  BLOAD(pA0,pA1,0); BLOAD(pB0,pB1,1);
  qkt(pA0,pA1,Kbase,qr,r32,hi);asm volatile("s_nop 15\n\ts_nop 7":"+v"(pA0),"+v"(pA1));CMASK(pA0,pA1,0);
  START(pA0,pA1);
  _Pragma("unroll") for(int r=0;r<16;++r)pA1[r]=__builtin_amdgcn_exp2f(pA1[r]);
  WAIT_BAR(0);
  DMA_K(3,0);DMA_V(1,SLOTB);
  ROT();
  kload8(kf,kp0+sl_cur);
  WAIT_BAR(2);
  s16x4 vlo[8],vhi[8]; u32x4 pw0,pw1,pw2,pw3;
  #define PKW(P,B) cvtpk_s(P[B],P[B+1])
  #define PAF(k) __builtin_bit_cast(bf16x8,pw##k)
  #define VFR(i) (bf16x8){vlo[i][0],vlo[i][1],vlo[i][2],vlo[i][3],vhi[i][0],vhi[i][1],vhi[i][2],vhi[i][3]}
  #define PIN(x) asm volatile("":"+v"(x))
  #define MX3(a,b,c) __builtin_fmaxf(__builtin_fmaxf((a),(b)),(c))
  #define GAPA(MF,A0,A1,A2,A3,W0,W1,PW) do{ MF; sacc+=A0; sacc+=A1; sacc+=A2; sacc+=A3; PIN(sacc); W0; W1; PIN(PW); SBAR(); }while(0)
  #define EX(v) __builtin_amdgcn_exp2f(v)
  #define GAPB(MF,X,B) do{ MF; X[B]=EX(X[B]); X[B+1]=EX(X[B+1]); X[B+2]=EX(X[B+2]); X[B+3]=EX(X[B+3]); PIN(X); SBAR(); }while(0)
  #define VRD(i) do{ vlo[i]=vtr(vp_+(((i)>>2)*4096+((i)&3)*1024)); vhi[i]=vtr(vp_+(((i)>>2)*4096+((i)&3)*1024+512)); }while(0)
  #define KRD(G,j) do{ if(G){ kload2(kf,kp0+sl_next,j); SBAR(); } }while(0)
  #define STEP(C0,C1,P0,P1,t,GK,GV,GL) do{ SBAR(); \
    _Pragma("unroll") for(int r=0;r<16;++r){C0[r]-=mhat;C1[r]-=mhat;} \
    const lds_cptr vp_=vp0+sl_prev; \
    VRD(0); SBAR(); float sacc=(P0[0]+P0[1]); \
    GAPA(C0=__builtin_amdgcn_mfma_f32_32x32x16_bf16(kf[0],qr[0],C0,0,0,0), P0[2],P0[3],P0[4],P0[5],     pw0[0]=PKW(P0,0), pw0[1]=PKW(P0,2), pw0); \
    VRD(4); SBAR(); GAPA(C1=__builtin_amdgcn_mfma_f32_32x32x16_bf16(kf[1],qr[0],C1,0,0,0), P0[6],P0[7],P0[8],P0[9],     pw0[2]=PKW(P0,4), pw0[3]=PKW(P0,6), pw0); \
    VRD(1); SBAR(); GAPA(C0=__builtin_amdgcn_mfma_f32_32x32x16_bf16(kf[2],qr[1],C0,0,0,0),   P0[10],P0[11],P0[12],P0[13], pw1[0]=PKW(P0,8), pw1[1]=PKW(P0,10), pw1); \
    VRD(5); SBAR(); GAPA(C1=__builtin_amdgcn_mfma_f32_32x32x16_bf16(kf[3],qr[1],C1,0,0,0),   P0[14],P0[15],P1[0],P1[1],   pw1[2]=PKW(P0,12),pw1[3]=PKW(P0,14), pw1); \
    VRD(2); SBAR(); GAPA(C0=__builtin_amdgcn_mfma_f32_32x32x16_bf16(kf[4],qr[2],C0,0,0,0),   P1[2],P1[3],P1[4],P1[5],     pw2[0]=PKW(P1,0), pw2[1]=PKW(P1,2), pw2); \
    VRD(6); SBAR(); GAPA(C1=__builtin_amdgcn_mfma_f32_32x32x16_bf16(kf[5],qr[2],C1,0,0,0),   P1[6],P1[7],P1[8],P1[9],     pw2[2]=PKW(P1,4), pw2[3]=PKW(P1,6), pw2); \
    VRD(3); SBAR(); GAPA(C0=__builtin_amdgcn_mfma_f32_32x32x16_bf16(kf[6],qr[3],C0,0,0,0),   P1[10],P1[11],P1[12],P1[13], pw3[0]=PKW(P1,8), pw3[1]=PKW(P1,10), pw3); \
    VRD(7); SBAR(); GAPA(C1=__builtin_amdgcn_mfma_f32_32x32x16_bf16(kf[7],qr[3],C1,0,0,0),   P1[14],P1[15],0.f,0.f,       pw3[2]=PKW(P1,12),pw3[3]=PKW(P1,14), pw3); \
    l_reg+=sacc; \
    if(GK){DMA_K((t)+3,sl_cur);} if(GV){DMA_V((t)+1,sl_next);} \
    CMASK(C0,C1,t); \
    { float a=MX3(C0[0],C0[1],C1[0]),b=MX3(C0[2],C0[3],C1[1]); a=MX3(a,C1[2],C1[3]); \
      _Pragma("unroll") for(int r=4;r<16;r+=4){a=MX3(a,C0[r],C0[r+1]);b=MX3(b,C0[r+2],C0[r+3]);a=MX3(a,C1[r],C1[r+1]);b=MX3(b,C1[r+2],C1[r+3]);} \
      float rm=__builtin_fmaxf(a,b); { auto rr=__builtin_amdgcn_permlane32_swap(__float_as_uint(rm),__float_as_uint(rm),false,false); rm=__builtin_fmaxf(__uint_as_float(rr[0]),__uint_as_float(rr[1])); } \
      resc=false; \
      if(__builtin_expect(__any(rm>(float)THRL),0)){ const float dl=__builtin_fmaxf(rm,0.f); mhat+=dl; \
        _Pragma("unroll") for(int r=0;r<16;++r){C0[r]-=dl;C1[r]-=dl;} \
        const float f=__builtin_amdgcn_exp2f(-dl); l_reg*=f; if(hi==0)wsf[r32]=f; resc=true; } } \
    SBAR(); \
    GAPB(o[0]=__builtin_amdgcn_mfma_f32_32x32x16_bf16(PAF(0),VFR(0),o[0],0,0,0), C0,0); \
    GAPB(o[1]=__builtin_amdgcn_mfma_f32_32x32x16_bf16(PAF(0),VFR(4),o[1],0,0,0), C0,4); \
    KRD(GL,0); GAPB(o[0]=__builtin_amdgcn_mfma_f32_32x32x16_bf16(PAF(1),VFR(1),o[0],0,0,0), C0,8); \
    KRD(GL,1); GAPB(o[1]=__builtin_amdgcn_mfma_f32_32x32x16_bf16(PAF(1),VFR(5),o[1],0,0,0), C0,12); \
    KRD(GL,2); GAPB(o[0]=__builtin_amdgcn_mfma_f32_32x32x16_bf16(PAF(2),VFR(2),o[0],0,0,0), C1,0); \
    KRD(GL,3); GAPB(o[1]=__builtin_amdgcn_mfma_f32_32x32x16_bf16(PAF(2),VFR(6),o[1],0,0,0), C1,4); \
    GAPB(o[0]=__builtin_amdgcn_mfma_f32_32x32x16_bf16(PAF(3),VFR(3),o[0],0,0,0), C1,8); \
    GAPB(o[1]=__builtin_amdgcn_mfma_f32_32x32x16_bf16(PAF(3),VFR(7),o[1],0,0,0), C1,12); \
    if(GL){BLOAD(P0,P1,(t)+1);} SBAR(); \
    }while(0)
  int t=1;
  #undef CMASK
  #define CMASK(P0,P1,t) do{}while(0)
  for(;t+5<NT;t+=2){
    STEP(pB0,pB1,pA0,pA1,t,true,true,true);     WAIT_BAR(2); RESC(); ROT();
    STEP(pA0,pA1,pB0,pB1,t+1,true,true,true);   WAIT_BAR(2); RESC(); ROT();
  }
  #undef CMASK
  #define CMASK(P0,P1,t) do{int jb_=(t)-(NT-4); if(jb_>=0)cmask(P0,P1,jb_,qrel,hi);}while(0)
  #define ENDW(tt) do{ if((tt)+3<NT){WAIT_BAR(2);} else if((tt)+2<NT){WAIT_BAR(1);} else {WAIT_BAR(0);} }while(0)
  for(;t+1<NT;t+=2){
    STEP(pB0,pB1,pA0,pA1,t,(t+3<NT),(t+1<NT),(t+1<NT));       ENDW(t);   RESC(); ROT();
    STEP(pA0,pA1,pB0,pB1,t+1,(t+4<NT),(t+2<NT),(t+2<NT));     ENDW(t+1); RESC(); ROT();
  }
  STEP(pB0,pB1,pA0,pA1,NT-1,false,false,false); RESC();
  { float sacc=pB0[0]+pB0[1]; _Pragma("unroll") for(int r=2;r<16;++r)sacc+=pB0[r]; _Pragma("unroll") for(int r=0;r<16;++r)sacc+=pB1[r]; l_reg+=sacc;
    pw0=(u32x4){PKW(pB0,0),PKW(pB0,2),PKW(pB0,4),PKW(pB0,6)};pw1=(u32x4){PKW(pB0,8),PKW(pB0,10),PKW(pB0,12),PKW(pB0,14)};pw2=(u32x4){PKW(pB1,0),PKW(pB1,2),PKW(pB1,4),PKW(pB1,6)};pw3=(u32x4){PKW(pB1,8),PKW(pB1,10),PKW(pB1,12),PKW(pB1,14)};
    SBAR(); pv(o,vb0+sl_cur,PAF(0),PAF(1),PAF(2),PAF(3)); }
  #undef PKW
  #undef PAF
  #undef VFR
  #undef PIN
  #undef MX3
  #undef GAPA
  #undef GAPB
  #undef EX
  #undef VRD
  #undef KRD
  #undef STEP
  #undef ENDW
  {auto rr=__builtin_amdgcn_permlane32_swap(__float_as_uint(l_reg),__float_as_uint(l_reg),false,false);l_reg=__uint_as_float(rr[0])+__uint_as_float(rr[1]);}
  if(hi==0)wsf[32+r32]=l_reg;asm volatile("s_waitcnt lgkmcnt(0)":::"memory");
  float rli[16];
  #pragma unroll
  for(int r=0;r<16;++r)rli[r]=__builtin_amdgcn_rcpf(wsf[32+crow(r,hi)]);
  bf16*Ow=O+(rowbase+q0+wid*QBLK)*DM+h*D;
  { bf16*stg=(bf16*)(shm+LDS_OST)+wid*2048;
    #pragma unroll
    for(int r=0;r<16;++r){const int orow=crow(r,hi);
      #pragma unroll
      for(int d0=0;d0<2;++d0)stg[orow*64+d0*32+r32]=__float2bfloat16(o[d0][r]*rli[r]);}
    asm volatile("s_waitcnt lgkmcnt(0)":::"memory");
    #pragma unroll
    for(int i=0;i<4;++i){const int row=i*8+(lane>>3),ch=lane&7; const u32x4 v=*(const u32x4*)(stg+row*64+ch*8); ATTN_STORE16(Ow+(long)row*DM+ch*8,v);} }
  asm volatile("s_waitcnt lgkmcnt(0)\n\ts_barrier":::"memory");
  #undef DMA_K
  #undef BLOAD
  #undef DMA_V
  #undef CMASK
  #undef START
  #undef RESC
  #undef ROT
}
constexpr int ATTN_LDS_BYTES=LDS_BYTES;
struct AttnTensors { const bf16* Q; const bf16* K; const bf16* V; bf16* O; const float* F; };
struct AttnUnit { int bh; int qb; };
template<int THRL=8> __device__ __forceinline__ void attn_phase(char*lds,const AttnTensors&T,unsigned*qctr,const __attribute__((address_space(3))) float*thr8,volatile __attribute__((address_space(3))) unsigned*qslot,int wv){
  for(;;){
    if(fresh_tid(wv)==0){ qslot[0]=__hip_atomic_fetch_add(qctr,1u,__ATOMIC_RELAXED,__HIP_MEMORY_SCOPE_AGENT); }
    asm volatile("s_waitcnt vmcnt(0) lgkmcnt(0)\n\ts_barrier":::"memory");
    const int idx=__builtin_amdgcn_readfirstlane((int)qslot[0]);
    if(idx>=NHEAD*NQB)break;
    const int h=idx%NHEAD, qb=NQB-1-idx/NHEAD;
    attn_unit<THRL>(0,h,qb,T.Q,T.K,T.V,T.O,T.F+(size_t)h*SEQ,thr8[h],lds,wv);
  }
}
#undef SBAR
#undef WAIT_BAR
}
#define GAS __attribute__((address_space(1)))
#define LAS __attribute__((address_space(3)))
typedef unsigned short bf16;
typedef unsigned v4u __attribute__((ext_vector_type(4)));
typedef unsigned v2u __attribute__((ext_vector_type(2)));
typedef float f32x4 __attribute__((ext_vector_type(4)));
typedef float f32x16 __attribute__((ext_vector_type(16)));
typedef short bf16x8 __attribute__((ext_vector_type(8)));
typedef short s16x4 __attribute__((ext_vector_type(4)));

constexpr int NWAVES = 8;
constexpr int S_ = 16384, DM_ = 1024, DIN_ = 6680, FF_ = 4096, NMEM_ = 256;
constexpr float EPS_ = 1e-6f;
constexpr float LOG2E_ = 1.4426950408889634f;
constexpr size_t MiB = 1u << 20;
constexpr size_t WS_WIN = 1 * MiB;
constexpr size_t WS_WGLAO = 17 * MiB, WS_WFOXO = 18 * MiB, WS_WMEMO = 19 * MiB;
constexpr size_t WS_WOUT = 20 * MiB;
constexpr size_t WS_WFF1 = 22 * MiB;
constexpr size_t WS_WFF2 = 30 * MiB;
constexpr size_t WS_GA = 38 * MiB;
constexpr size_t WS_LOGF = 39 * MiB;
constexpr size_t WS_F = 39 * MiB + 512 * 1024;
constexpr size_t WS_MK = 40 * MiB;
constexpr size_t WS_MVT = 40 * MiB + 256 * 1024;
constexpr size_t WS_DEC = 40 * MiB + 512 * 1024;
constexpr size_t WS_MEMN = 40 * MiB + 768 * 1024;
constexpr size_t WS_GQ = 42 * MiB, WS_GK = 50 * MiB, WS_GV = 58 * MiB;
constexpr size_t WS_MG = 42 * MiB;
constexpr size_t WS_GG = 74 * MiB, WS_FQ = 90 * MiB;
constexpr size_t WS_U2 = 74 * MiB;
constexpr size_t WS_MQ = 106 * MiB, WS_FK = 122 * MiB, WS_FV = 138 * MiB;
constexpr size_t WS_GT = 154 * MiB;
constexpr size_t WS_HID = 122 * MiB;
constexpr size_t WS_SS1 = 250 * MiB, WS_SS2 = 251 * MiB;
constexpr size_t WS_END = 253 * MiB;
constexpr size_t WS_LSEF = 252 * MiB;
constexpr size_t WS_QB2 = 251 * MiB + 512 * 1024, WS_NDOT = 251 * MiB + 544 * 1024;
constexpr size_t WS_H0 = 106 * MiB, WS_H1 = 1 * MiB;
constexpr int CW_PANEL = 8192;
constexpr size_t OUT_U = 0, OUT_STATE = 32 * MiB;

constexpr int LDS_BYTES = 155648;

#define LDS_WAIT() asm volatile("s_waitcnt lgkmcnt(0)" ::: "memory")
__device__ __forceinline__ unsigned f2bf(float f) { unsigned u = __builtin_bit_cast(unsigned, f); return (u + 0x7fffu + ((u >> 16) & 1u)) >> 16; }
__device__ __forceinline__ unsigned pk2(float lo, float hi) { return f2bf(lo) | (f2bf(hi) << 16); }
__device__ __forceinline__ float bf2f(unsigned b) { return __builtin_bit_cast(float, (b & 0xffffu) << 16); }
__device__ __forceinline__ float bflo(unsigned w) { return __builtin_bit_cast(float, w << 16); }
__device__ __forceinline__ float bfhi(unsigned w) { return __builtin_bit_cast(float, w & 0xffff0000u); }
__device__ __forceinline__ float sigmoidf_(float x) { return __builtin_amdgcn_rcpf(1.f + __expf(-x)); }
__device__ __forceinline__ float logsigmoidf_(float z) { return -(fmaxf(-z, 0.f) + log1pf(__expf(-fabsf(z)))); }
__device__ __forceinline__ float logsigmoid_fast(float z) { return -(fmaxf(-z, 0.f) + __logf(1.f + __expf(-fabsf(z)))); }
__device__ __forceinline__ int crow_(int r, int hi) { return (r & 3) + 8 * (r >> 2) + 4 * hi; }
__device__ __forceinline__ float wave_sum(float v) {
#pragma unroll
    for (int o = 1; o < 64; o <<= 1) v += __shfl_xor(v, o);
    return v;
}
#define LBAR() asm volatile("s_waitcnt lgkmcnt(0)\n\ts_barrier" ::: "memory")
#define MFMA32(a, b, c) __builtin_amdgcn_mfma_f32_32x32x16_bf16((a), (b), (c), 0, 0, 0)
__device__ __forceinline__ bf16x8 ldfrag(const LAS unsigned char* base, int row, int pitchB, int kbyte) { return *(const LAS bf16x8*)(base + row * pitchB + kbyte); }

struct Ptrs {
    const float *x, *mem, *g_mix, *w_in, *w_alpha_up, *b_alpha, *b_forget, *g_gla_head, *g_mem, *w_mem_kv, *w_gla_o, *w_fox_o, *w_mem_o, *w_out, *g_ffn, *w_ff1, *w_ff2, *g_final;
    float* out; unsigned char* ws;
};

__device__ __forceinline__ void p0_transpose_item(const float* W, int ldw, int srccol0, int k0, bf16* WT, int ldt, int dstrow0, LAS float* scr, int lane) {
#pragma unroll 8
    for (int i = 0; i < 32; ++i) { const int kk = 2 * i + (lane >> 5); scr[kk * 33 + (lane & 31)] = W[(size_t)(k0 + kk) * ldw + srccol0 + (lane & 31)]; }
    LDS_WAIT(); asm volatile("" ::: "memory");
    const int c = lane & 7;
#pragma unroll
    for (int j = 0; j < 4; ++j) { const int n = (lane >> 3) + 8 * j; const LAS float* s = scr + (8 * c) * 33 + n;
        v4u o; o.x = pk2(s[0 * 33], s[1 * 33]); o.y = pk2(s[2 * 33], s[3 * 33]); o.z = pk2(s[4 * 33], s[5 * 33]); o.w = pk2(s[6 * 33], s[7 * 33]);
        *(v4u*)(WT + (size_t)(dstrow0 + n) * ldt + k0 + 8 * c) = o; }
    LDS_WAIT(); asm volatile("" ::: "memory");
}
__device__ __forceinline__ void rms_row_to_bf16(const float* xrow, const float* gain, bf16* orow, int lane) {
    const f32x4* xr = (const f32x4*)xrow + lane; const f32x4* gr = (const f32x4*)gain + lane;
    f32x4 v[4]; float s = 0.f;
#pragma unroll
    for (int j = 0; j < 4; ++j) { v[j] = xr[64 * j]; s += (v[j].x * v[j].x + v[j].y * v[j].y) + (v[j].z * v[j].z + v[j].w * v[j].w); }
    const float r = rsqrtf(wave_sum(s) * (1.f / 1024.f) + EPS_);
    unsigned long long* o8 = (unsigned long long*)orow + lane;
#pragma unroll
    for (int j = 0; j < 4; ++j) { const f32x4 g = gr[64 * j]; o8[64 * j] = (unsigned long long)pk2(v[j].x * r * g.x, v[j].y * r * g.y) | ((unsigned long long)pk2(v[j].z * r * g.z, v[j].w * r * g.w) << 32); }
}
__device__ __forceinline__ void p0_prologue(const Ptrs& P, LAS unsigned char* lds, int vcu, int G, int wv) {
    const int tid = fresh_tid(wv), lane = tid & 63, wave = wv;
    LAS float* scr = (LAS float*)(lds + wave * 16384);
    const int gw = vcu * NWAVES + wave, NGW = G * NWAVES;
    bf16* WIN = (bf16*)(P.ws + WS_WIN);
    constexpr int I_IN = 16 * 208, I_KV = 16 * 32, I_GO = 8 * 32, I_WO = 16 * 32, I_F1 = 16 * 128, I_F2 = 64 * 32;
    constexpr int NITEMS = I_IN + I_KV + 3 * I_GO + I_WO + I_F1 + I_F2;
    for (int it = gw; it < NITEMS; it += NGW) {
        int r = it;
        if (r < I_IN) { const int kb = r / 208, nb = r % 208, d0 = 32 * nb; const int src = d0 < 1536 ? d0 : (d0 < 3072 ? d0 + 16 : d0 + 24);
            p0_transpose_item(P.w_in, DIN_, src, 64 * kb, WIN, 1024, d0, scr, lane); continue; } r -= I_IN;
        if (r < I_KV) { const int kb = r / 32, nb = r % 32; p0_transpose_item(P.w_mem_kv, 1024, 32 * nb, 64 * kb, WIN, 1024, 6912 + 32 * nb, scr, lane); continue; } r -= I_KV;
        if (r < I_GO) { const int kb = r / 32, nb = r % 32; p0_transpose_item(P.w_gla_o, 1024, 32 * nb, 64 * kb, (bf16*)(P.ws + WS_WGLAO), 512, 32 * nb, scr, lane); continue; } r -= I_GO;
        if (r < I_GO) { const int kb = r / 32, nb = r % 32; p0_transpose_item(P.w_fox_o, 1024, 32 * nb, 64 * kb, (bf16*)(P.ws + WS_WFOXO), 512, 32 * nb, scr, lane); continue; } r -= I_GO;
        if (r < I_GO) { const int kb = r / 32, nb = r % 32; p0_transpose_item(P.w_mem_o, 1024, 32 * nb, 64 * kb, (bf16*)(P.ws + WS_WMEMO), 512, 32 * nb, scr, lane); continue; } r -= I_GO;
        if (r < I_WO) { const int kb = r / 32, nb = r % 32; p0_transpose_item(P.w_out, 1024, 32 * nb, 64 * kb, (bf16*)(P.ws + WS_WOUT), 1024, 32 * nb, scr, lane); continue; } r -= I_WO;
        if (r < I_F1) { const int kb = r / 128, nb = r % 128; p0_transpose_item(P.w_ff1, FF_, 32 * nb, 64 * kb, (bf16*)(P.ws + WS_WFF1), 1024, 32 * nb, scr, lane); continue; } r -= I_F1;
        { const int kb = r / 32, nb = r % 32; p0_transpose_item(P.w_ff2, 1024, 32 * nb, 64 * kb, (bf16*)(P.ws + WS_WFF2), FF_, 32 * nb, scr, lane); }
    }
    for (int idx = vcu * 512 + tid; idx < 256 * 128; idx += G * 512) {
        const int row = idx >> 7, kc = idx & 127; const int src = row < 16 ? 1536 + row : (row < 24 ? 3088 + (row - 16) : -1);
        v4u o = (v4u){0u, 0u, 0u, 0u};
        if (src >= 0) { const float* wp = P.w_in + (size_t)(8 * kc) * DIN_ + src;
            o.x = pk2(wp[0], wp[DIN_]); o.y = pk2(wp[2 * DIN_], wp[3 * DIN_]); o.z = pk2(wp[4 * DIN_], wp[5 * DIN_]); o.w = pk2(wp[6 * DIN_], wp[7 * DIN_]); }
        *(v4u*)(WIN + (size_t)(6656 + row) * 1024 + 8 * kc) = o;
    }
    bf16* U = (bf16*)((unsigned char*)P.out + OUT_U); bf16* MEMN = (bf16*)(P.ws + WS_MEMN);
    for (int m = gw; m < S_ + NMEM_; m += NGW) {
        if (m < S_) rms_row_to_bf16(P.x + (size_t)m * DM_, P.g_mix, U + (size_t)m * DM_, lane);
        else rms_row_to_bf16(P.mem + (size_t)(m - S_) * DM_, P.g_mem, MEMN + (size_t)(m - S_) * DM_, lane);
    }
}

struct GemmSched {
    const char* A; const char* B; int nM, nN, lda, ldb, G, c, wv;
    __device__ __forceinline__ bool next(int i, pg8::Unit& u) const { const long L = (long)i * G + c; if (L >= nM * nN) return false; pg8::map_tile((int)L, nM, nN, u.pm, u.pn); u.z = 0; return true; }
    __device__ __forceinline__ const char* aptr(const pg8::Unit& u) const { return A + (size_t)u.pm * 256 * lda * 2; }
    __device__ __forceinline__ const char* bptr(const pg8::Unit& u) const { return B + (size_t)u.pn * 256 * ldb * 2; }
    __device__ __forceinline__ void a_ready(const pg8::Unit&) const {}
    __device__ __forceinline__ void done(const pg8::Unit&) const {}
};
struct ProjSched {
    const char* U; const char* MEMN; const char* W; int G, c, wv;
    __device__ __forceinline__ bool next(int i, pg8::Unit& u) const { const int L = i * G + c; u.z = 0;
        if (L < 1728) { pg8::map_tile(L, 64, 27, u.pm, u.pn); return true; }
        if (L < 1732) { u.pm = 64; u.pn = 27 + (L - 1728); return true; } return false; }
    __device__ __forceinline__ const char* aptr(const pg8::Unit& u) const { return u.pm < 64 ? U + (size_t)u.pm * (256 * 1024 * 2) : MEMN; }
    __device__ __forceinline__ const char* bptr(const pg8::Unit& u) const { return W + (size_t)u.pn * (256 * 1024 * 2); }
    __device__ __forceinline__ void a_ready(const pg8::Unit&) const {}
    __device__ __forceinline__ void done(const pg8::Unit&) const {}
};
struct MergeSched {
    const char *A0, *B0; int G, c, wv; size_t segA, segB;
    __device__ __forceinline__ bool next(int i, pg8::Unit& u) const { const int T = c + G * i; if (T >= 256) return false; pg8::map_tile(T, 64, 4, u.pm, u.pn); u.z = 0; return true; }
    __device__ __forceinline__ const char* aptr(const pg8::Unit& u) const { return A0 + (size_t)u.pm * (256 * 512 * 2); }
    __device__ __forceinline__ const char* bptr(const pg8::Unit& u) const { return B0 + (size_t)u.pn * (256 * 512 * 2); }
    __device__ __forceinline__ void a_ready(const pg8::Unit&) const {}
    __device__ __forceinline__ void done(const pg8::Unit&) const {}
};
typedef pg8::f32x4 accv;
__device__ __forceinline__ void store_bf16_tile(const accv (&acc)[2][2][4][2], bf16* base, int ldc, int row0, int col0, float sc, bool sig) {
#pragma unroll
    for (int ai = 0; ai < 2; ++ai)
#pragma unroll
        for (int m = 0; m < 4; ++m) { bf16* rowp = base + (size_t)(row0 + ai * 128 + m * 16) * ldc + col0;
#pragma unroll
            for (int bj = 0; bj < 2; ++bj) { accv v0 = acc[ai][bj][m][0] * sc, v1 = acc[ai][bj][m][1] * sc;
                if (sig) { v0 = (accv){sigmoidf_(v0[0]), sigmoidf_(v0[1]), sigmoidf_(v0[2]), sigmoidf_(v0[3])}; v1 = (accv){sigmoidf_(v1[0]), sigmoidf_(v1[1]), sigmoidf_(v1[2]), sigmoidf_(v1[3])}; }
                v4u w; w.x = pg8::cvt_pk_bf16(v0[0], v0[1]); w.y = pg8::cvt_pk_bf16(v0[2], v0[3]); w.z = pg8::cvt_pk_bf16(v1[0], v1[1]); w.w = pg8::cvt_pk_bf16(v1[2], v1[3]);
                *(v4u*)(rowp + bj * 128) = w; } }
}
struct EpiProj {
    static constexpr bool PERM = true, AFTER_DRAIN = false;
    unsigned char* ws; const float* b_forget;
    __device__ __forceinline__ void operator()(const accv (&acc)[2][2][4][2], const pg8::Unit& u, int wr, int wc, int fr, int fq) const {
        const int pn = u.pn;
        if (pn != 26) {
            size_t off; int ldc, colt, prow = u.pm * 256; float sc = 1.f; bool sig = false;
            if (pn == 0) { off = WS_GQ; ldc = 256; colt = 0; sc = 0.125f; }
            else if (pn == 1) { off = WS_GK; ldc = 256; colt = 0; }
            else if (pn < 4) { off = WS_GV; ldc = 512; colt = (pn - 2) * 256; }
            else if (pn < 6) { off = WS_GG; ldc = 512; colt = (pn - 4) * 256; }
            else if (pn < 8) { off = WS_FQ; ldc = 512; colt = (pn - 6) * 256; sc = 0.125f * LOG2E_; }
            else if (pn < 10) { off = WS_FK; ldc = 512; colt = (pn - 8) * 256; }
            else if (pn < 12) { off = WS_FV; ldc = 512; colt = (pn - 10) * 256; }
            else if (pn < 14) { off = WS_MQ; ldc = 512; colt = (pn - 12) * 256; sc = 0.08838834764831845f * LOG2E_; }
            else if (pn < 26) { off = WS_GT; ldc = 3072; colt = (pn - 14) * 256; sig = true; }
            else if (pn < 29) { off = WS_MK; ldc = 512; colt = (pn - 27) * 256; prow = 0; }
            else { off = WS_MVT; ldc = 512; colt = (pn - 29) * 256; prow = 0; }
            store_bf16_tile(acc, (bf16*)(ws + off), ldc, prow + wr * 64 + fr, colt + wc * 32 + 8 * fq, sc, sig);
        } else {
            if (wc == 0 && fq < 3) {
                float* GA = (float*)(ws + WS_GA); float* LF = (float*)(ws + WS_LOGF);
                accv bf0 = (accv){0.f, 0.f, 0.f, 0.f}, bf1 = bf0;
                if (fq == 2) { bf0 = *(const accv*)(b_forget); bf1 = *(const accv*)(b_forget + 4); }
#pragma unroll
                for (int ai = 0; ai < 2; ++ai)
#pragma unroll
                    for (int m = 0; m < 4; ++m) { const size_t row = (size_t)(u.pm * 256 + wr * 64 + fr + ai * 128 + m * 16);
                        const accv v0 = acc[ai][0][m][0], v1 = acc[ai][0][m][1];
                        if (fq < 2) { *(accv*)(GA + row * 16 + 8 * fq) = v0; *(accv*)(GA + row * 16 + 8 * fq + 4) = v1; }
                        else { const accv a = v0 + bf0, b = v1 + bf1;
#pragma unroll
                            for (int j = 0; j < 4; ++j) { LF[(size_t)j * S_ + row] = logsigmoidf_(a[j]); LF[(size_t)(4 + j) * S_ + row] = logsigmoidf_(b[j]); } } }
            }
        }
    }
};
struct EpiMerge {
    static constexpr bool PERM = true, AFTER_DRAIN = false;
    bf16* MG; const bf16* GT;
    __device__ __forceinline__ void mid(accv (&acc)[2][2][4][2], const pg8::Unit& u, int s, int wr, int wc, int fr, int fq) const {
        const int row0 = u.pm * 256 + wr * 64 + fr, col0 = u.pn * 256 + wc * 32 + 8 * fq;
#pragma unroll
        for (int ai = 0; ai < 2; ++ai)
#pragma unroll
            for (int m = 0; m < 4; ++m) { const size_t row = (size_t)(row0 + ai * 128 + m * 16);
#pragma unroll
                for (int bj = 0; bj < 2; ++bj) { const int col = col0 + bj * 128;
                    const v4u a = *(const v4u*)(GT + row * 3072 + (s - 1) * 1024 + col), b = *(const v4u*)(GT + row * 3072 + s * 1024 + col);
                    const accv r0 = (accv){bflo(a.x) * __builtin_amdgcn_rcpf(fmaxf(bflo(b.x), 1e-30f)), bfhi(a.x) * __builtin_amdgcn_rcpf(fmaxf(bfhi(b.x), 1e-30f)), bflo(a.y) * __builtin_amdgcn_rcpf(fmaxf(bflo(b.y), 1e-30f)), bfhi(a.y) * __builtin_amdgcn_rcpf(fmaxf(bfhi(b.y), 1e-30f))};
                    const accv r1 = (accv){bflo(a.z) * __builtin_amdgcn_rcpf(fmaxf(bflo(b.z), 1e-30f)), bfhi(a.z) * __builtin_amdgcn_rcpf(fmaxf(bfhi(b.z), 1e-30f)), bflo(a.w) * __builtin_amdgcn_rcpf(fmaxf(bflo(b.w), 1e-30f)), bfhi(a.w) * __builtin_amdgcn_rcpf(fmaxf(bfhi(b.w), 1e-30f))};
                    acc[ai][bj][m][0] = acc[ai][bj][m][0] * r0; acc[ai][bj][m][1] = acc[ai][bj][m][1] * r1; } }
    }
    __device__ __forceinline__ void operator()(const accv (&acc)[2][2][4][2], const pg8::Unit& u, int wr, int wc, int fr, int fq) const {
        const int row0 = u.pm * 256 + wr * 64 + fr, col0 = u.pn * 256 + wc * 32 + 8 * fq;
#pragma unroll
        for (int ai = 0; ai < 2; ++ai)
#pragma unroll
            for (int m = 0; m < 4; ++m) { const size_t row = (size_t)(row0 + ai * 128 + m * 16);
#pragma unroll
                for (int bj = 0; bj < 2; ++bj) { const int col = col0 + bj * 128;
                    const v4u g = *(const v4u*)(GT + row * 3072 + 2 * 1024 + col);
                    accv v0 = acc[ai][bj][m][0], v1 = acc[ai][bj][m][1];
                    v0 = v0 * (accv){bflo(g.x), bfhi(g.x), bflo(g.y), bfhi(g.y)}; v1 = v1 * (accv){bflo(g.z), bfhi(g.z), bflo(g.w), bfhi(g.w)};
                    v4u w; w.x = pg8::cvt_pk_bf16(v0[0], v0[1]); w.y = pg8::cvt_pk_bf16(v0[2], v0[3]); w.z = pg8::cvt_pk_bf16(v1[0], v1[1]); w.w = pg8::cvt_pk_bf16(v1[2], v1[3]);
                    *(v4u*)(MG + row * 1024 + col) = w; } }
    }
};
template <bool WRITE_U2, bool BASE_BF16> struct EpiResid {
    static constexpr bool PERM = true, AFTER_DRAIN = false;
    const void* base; bf16* H0; bf16* H1; bf16* U2; const float* gain; float* SS;
    __device__ __forceinline__ void operator()(const accv (&acc)[2][2][4][2], const pg8::Unit& u, int wr, int wc, int fr, int fq) const {
        bf16* HB = u.pm < 32 ? H0 : H1;
        const int row0 = u.pm * 256 + wr * 64 + fr, col0 = u.pn * 256 + wc * 32 + 8 * fq;
#pragma unroll
        for (int ai = 0; ai < 2; ++ai)
#pragma unroll
            for (int m = 0; m < 4; ++m) { const size_t row = (size_t)(row0 + ai * 128 + m * 16); float ssq = 0.f;
#pragma unroll
                for (int bj = 0; bj < 2; ++bj) { const int col = col0 + bj * 128; const size_t o = row * 1024 + col;
                    accv b0, b1;
                    if (BASE_BF16) { const v4u bw = *(const v4u*)((const bf16*)base + o); b0 = (accv){bflo(bw.x), bfhi(bw.x), bflo(bw.y), bfhi(bw.y)}; b1 = (accv){bflo(bw.z), bfhi(bw.z), bflo(bw.w), bfhi(bw.w)}; }
                    else { b0 = *(const accv*)((const float*)base + o); b1 = *(const accv*)((const float*)base + o + 4); }
                    const accv h0 = b0 + acc[ai][bj][m][0], h1 = b1 + acc[ai][bj][m][1];
                    { v4u w; w.x = pg8::cvt_pk_bf16(h0[0], h0[1]); w.y = pg8::cvt_pk_bf16(h0[2], h0[3]); w.z = pg8::cvt_pk_bf16(h1[0], h1[1]); w.w = pg8::cvt_pk_bf16(h1[2], h1[3]); *(v4u*)(HB + o) = w; }
                    ssq += (h0[0] * h0[0] + h0[1] * h0[1]) + (h0[2] * h0[2] + h0[3] * h0[3]) + (h1[0] * h1[0] + h1[1] * h1[1]) + (h1[2] * h1[2] + h1[3] * h1[3]);
                    if (WRITE_U2) { const accv g0 = *(const accv*)(gain + col), g1 = *(const accv*)(gain + col + 4); const accv a = h0 * g0, b = h1 * g1;
                        v4u w; w.x = pg8::cvt_pk_bf16(a[0], a[1]); w.y = pg8::cvt_pk_bf16(a[2], a[3]); w.z = pg8::cvt_pk_bf16(b[0], b[1]); w.w = pg8::cvt_pk_bf16(b[2], b[3]);
                        *(v4u*)(U2 + o) = w; } }
                ssq += __shfl_xor(ssq, 16); ssq += __shfl_xor(ssq, 32);
                if (fq == 0) SS[row * 16 + u.pn * 4 + wc] = ssq; }
    }
};
struct EpiFinal {
    static constexpr bool PERM = true, AFTER_DRAIN = true;
    const bf16* H0; const bf16* H1; float* out; const float* gain; float* xbuf; unsigned* cnt;
    __device__ __forceinline__ void fused(accv (&acc)[2][2][4][2], const pg8::Unit& u, int wr, int wc, int fr, int fq, LAS unsigned char* lds, int wid, int lane) const {
        const bf16* HB = u.pm < 32 ? H0 : H1;
        LAS float* Pl = (LAS float*)lds; LAS float* Sl = (LAS float*)(lds + 4096);
        const int row0 = u.pm * 256 + wr * 64 + fr, col0 = u.pn * 256 + wc * 32 + 8 * fq;
#pragma unroll
        for (int ai = 0; ai < 2; ++ai)
#pragma unroll
            for (int m = 0; m < 4; ++m) { const size_t row = (size_t)(row0 + ai * 128 + m * 16); float ssq = 0.f;
#pragma unroll
                for (int bj = 0; bj < 2; ++bj) { const size_t o = row * 1024 + col0 + bj * 128; const v4u bw = *(const v4u*)(HB + o);
                    const accv h0 = acc[ai][bj][m][0] + (accv){bflo(bw.x), bfhi(bw.x), bflo(bw.y), bfhi(bw.y)}, h1 = acc[ai][bj][m][1] + (accv){bflo(bw.z), bfhi(bw.z), bflo(bw.w), bfhi(bw.w)};
                    acc[ai][bj][m][0] = h0; acc[ai][bj][m][1] = h1;
                    ssq += (h0[0] * h0[0] + h0[1] * h0[1]) + (h0[2] * h0[2] + h0[3] * h0[3]) + (h1[0] * h1[0] + h1[1] * h1[1]) + (h1[2] * h1[2] + h1[3] * h1[3]); }
                ssq += __shfl_xor(ssq, 16); ssq += __shfl_xor(ssq, 32);
                if (fq == 0) Pl[(ai * 128 + wr * 64 + m * 16 + fr) * 4 + wc] = ssq; }
        asm volatile("s_waitcnt lgkmcnt(0)" ::: "memory"); __builtin_amdgcn_s_barrier(); asm volatile("" ::: "memory");
        const int rowl = wid * 32 + (lane & 31);
        if (lane < 32) { const float s = (Pl[rowl * 4] + Pl[rowl * 4 + 1]) + (Pl[rowl * 4 + 2] + Pl[rowl * 4 + 3]);
            __hip_atomic_store(xbuf + ((size_t)(u.pm * 256 + rowl) * 4 + u.pn), s, __ATOMIC_RELAXED, __HIP_MEMORY_SCOPE_AGENT); }
        asm volatile("s_waitcnt vmcnt(0)" ::: "memory");
        if (lane == 0) __hip_atomic_fetch_add(cnt + 64 * u.pm, 1u, __ATOMIC_RELAXED, __HIP_MEMORY_SCOPE_AGENT);
        if (wid == 0) { unsigned sp = 0;
            while ((unsigned)__builtin_amdgcn_readfirstlane(__hip_atomic_load(cnt + 64 * u.pm, __ATOMIC_RELAXED, __HIP_MEMORY_SCOPE_AGENT)) < 32u) { __builtin_amdgcn_s_sleep(2); if (++sp > (1u << 22)) break; }
            __builtin_amdgcn_fence(__ATOMIC_ACQUIRE, "agent"); }
        asm volatile("s_waitcnt vmcnt(0) lgkmcnt(0)" ::: "memory"); __builtin_amdgcn_s_barrier(); asm volatile("" ::: "memory");
        if (lane < 32) { const float* sl = xbuf + (size_t)(u.pm * 256 + rowl) * 4;
            const float a = __hip_atomic_load(sl, __ATOMIC_RELAXED, __HIP_MEMORY_SCOPE_AGENT), b = __hip_atomic_load(sl + 1, __ATOMIC_RELAXED, __HIP_MEMORY_SCOPE_AGENT),
                        c = __hip_atomic_load(sl + 2, __ATOMIC_RELAXED, __HIP_MEMORY_SCOPE_AGENT), d = __hip_atomic_load(sl + 3, __ATOMIC_RELAXED, __HIP_MEMORY_SCOPE_AGENT);
            Sl[rowl] = rsqrtf(((a + b) + (c + d)) * (1.f / 1024.f) + EPS_); }
        asm volatile("s_waitcnt vmcnt(0) lgkmcnt(0)" ::: "memory"); __builtin_amdgcn_s_barrier(); asm volatile("" ::: "memory");
#pragma unroll
        for (int ai = 0; ai < 2; ++ai)
#pragma unroll
            for (int m = 0; m < 4; ++m) { const int rl = ai * 128 + wr * 64 + m * 16 + fr; const float r = Sl[rl]; const size_t row = (size_t)(u.pm * 256 + rl);
#pragma unroll
                for (int bj = 0; bj < 2; ++bj) { const int col = col0 + bj * 128; const accv g0 = *(const accv*)(gain + col), g1 = *(const accv*)(gain + col + 4);
                    *(accv*)(out + row * 1024 + col) = acc[ai][bj][m][0] * r * g0; *(accv*)(out + row * 1024 + col + 4) = acc[ai][bj][m][1] * r * g1; } }
    }
};
struct EpiFfn1 {
    static constexpr bool PERM = true, AFTER_DRAIN = false;
    bf16* HID; const float* SS;
    __device__ __forceinline__ void operator()(const accv (&acc)[2][2][4][2], const pg8::Unit& u, int wr, int wc, int fr, int fq) const {
        const int row0 = u.pm * 256 + wr * 64 + fr, col0 = u.pn * 256 + wc * 32 + 8 * fq;
#pragma unroll
        for (int ai = 0; ai < 2; ++ai)
#pragma unroll
            for (int m = 0; m < 4; ++m) { const size_t row = (size_t)(row0 + ai * 128 + m * 16);
                const accv s0 = *(const accv*)(SS + row * 16), s1 = *(const accv*)(SS + row * 16 + 4), s2 = *(const accv*)(SS + row * 16 + 8), s3 = *(const accv*)(SS + row * 16 + 12);
                const float tot = ((s0[0] + s0[1]) + (s0[2] + s0[3])) + ((s1[0] + s1[1]) + (s1[2] + s1[3])) + ((s2[0] + s2[1]) + (s2[2] + s2[3])) + ((s3[0] + s3[1]) + (s3[2] + s3[3]));
                const float r = rsqrtf(tot * (1.f / 1024.f) + EPS_);
#pragma unroll
                for (int bj = 0; bj < 2; ++bj) { accv v0 = acc[ai][bj][m][0] * r, v1 = acc[ai][bj][m][1] * r;
#pragma unroll
                    for (int j = 0; j < 4; ++j) { const float a = fmaxf(v0[j], 0.f), b = fmaxf(v1[j], 0.f); v0[j] = a * a; v1[j] = b * b; }
                    v4u w; w.x = pg8::cvt_pk_bf16(v0[0], v0[1]); w.y = pg8::cvt_pk_bf16(v0[2], v0[3]); w.z = pg8::cvt_pk_bf16(v1[0], v1[1]); w.w = pg8::cvt_pk_bf16(v1[2], v1[3]);
                    *(v4u*)(HID + row * 4096 + col0 + bj * 128) = w; } }
    }
};

constexpr int GP = 144;
__device__ __forceinline__ void gla_a_unit(const Ptrs& P, LAS unsigned char* lds, int n, int h, int wv) {
    const int tid = fresh_tid(wv), lane = tid & 63, g = wv, r32 = lane & 31, hh = lane >> 5;
    LAS unsigned char* QP = lds; LAS unsigned char* QN = lds + 9216; LAS unsigned char* KN = lds + 18432; LAS unsigned char* KP = lds + 27648;
    LAS unsigned char* KLT = lds + 36864; LAS unsigned char* AT = lds + 46080; LAS unsigned char* VT = lds + 55296; LAS float* TOT = (LAS float*)(lds + 73728);
    bf16* GQ = (bf16*)(P.ws + WS_GQ); const bf16* GK = (const bf16*)(P.ws + WS_GK); bf16* GV = (bf16*)(P.ws + WS_GV);
    const float* GA = (const float*)(P.ws + WS_GA); float* DEC = (float*)(P.ws + WS_DEC); bf16* STATE = (bf16*)((unsigned char*)P.out + OUT_STATE);
    const int c = h * 64 + lane, t0 = n * 64;
#ifdef PROBE_PHASE
#define GSTAMP(k) do { if (n == 64 && h == 0 && tid == 0) ((unsigned long long*)(P.ws + 253 * MiB))[(k)] = __builtin_amdgcn_s_memrealtime(); } while (0)
#else
#define GSTAMP(k) do {} while (0)
#endif
    GSTAMP(60);
    float wup[16];
#pragma unroll
    for (int j = 0; j < 16; ++j) wup[j] = P.w_alpha_up[j * 256 + c];
    const float ba = P.b_alpha[c];
    unsigned short qraw[8], kraw[8];
#pragma unroll
    for (int i = 0; i < 8; ++i) { const size_t gi = (size_t)(t0 + 8 * g + i) * 256 + c; qraw[i] = GQ[gi]; kraw[i] = GK[gi]; }
    float bl[8]; float run = 0.f;
#pragma unroll
    for (int i = 0; i < 8; ++i) { const f32x4* gar = (const f32x4*)(GA + (size_t)(t0 + 8 * g + i) * 16); float z = ba;
#pragma unroll
        for (int j4 = 0; j4 < 4; ++j4) { const f32x4 a = gar[j4]; z += a[0] * wup[4 * j4] + a[1] * wup[4 * j4 + 1] + a[2] * wup[4 * j4 + 2] + a[3] * wup[4 * j4 + 3]; }
        run += logsigmoid_fast(z) * (1.f / 16.f); bl[i] = run; }
    TOT[g * 64 + lane] = run;
    { const int s = tid >> 3, vc = tid & 7; const v4u a = *(const v4u*)(GV + (size_t)(t0 + s) * 512 + h * 128 + vc * 16), b = *(const v4u*)(GV + (size_t)(t0 + s) * 512 + h * 128 + vc * 16 + 8);
      LAS bf16* vt = (LAS bf16*)VT; const unsigned w[8] = {a.x, a.y, a.z, a.w, b.x, b.y, b.z, b.w};
#pragma unroll
      for (int j = 0; j < 8; ++j) { vt[(vc * 16 + 2 * j) * 72 + s] = (bf16)(w[j] & 0xffffu); vt[(vc * 16 + 2 * j + 1) * 72 + s] = (bf16)(w[j] >> 16); } }
    LBAR(); GSTAMP(61);
    float off = 0.f, blast = 0.f;
#pragma unroll
    for (int gg = 0; gg < 8; ++gg) { const float tv = TOT[gg * 64 + lane]; if (gg < g) off += tv; blast += tv; }
    unsigned kl[8];
#pragma unroll
    for (int i = 0; i < 8; ++i) { const int t = 8 * g + i; const float b = off + bl[i]; const size_t gi = (size_t)(t0 + t) * 256 + c;
        const float q = bf2f(qraw[i]), k = bf2f(kraw[i]); const float ep = __expf(b), en = __expf(-b), el = __expf(blast - b);
        const unsigned qp = f2bf(q * ep); GQ[gi] = (bf16)qp;
        ((LAS bf16*)QP)[t * 72 + lane] = (bf16)qp; ((LAS bf16*)QN)[t * 72 + lane] = (bf16)f2bf(q * en);
        ((LAS bf16*)KN)[t * 72 + lane] = (bf16)f2bf(k * en); ((LAS bf16*)KP)[t * 72 + lane] = (bf16)f2bf(k * ep); kl[i] = f2bf(k * el); }
    *(LAS v4u*)(KLT + lane * GP + 16 * g) = (v4u){kl[0] | (kl[1] << 16), kl[2] | (kl[3] << 16), kl[4] | (kl[5] << 16), kl[6] | (kl[7] << 16)};
    if (g == 0) DEC[(n * 4 + h) * 64 + lane] = __expf(blast);
    LBAR(); GSTAMP(62);
    const f32x16 zero = {};
    if (g < 4) {
        const int ti = g >> 1, si = g & 1; f32x16 ac = zero, an = zero;
        if (ti >= si) {
#pragma unroll
            for (int ks = 0; ks < 4; ++ks) ac = MFMA32(ldfrag(QP, 32 * ti + r32, GP, 32 * ks + 16 * hh), ldfrag(KN, 32 * si + r32, GP, 32 * ks + 16 * hh), ac); }
        if (ti <= si) {
#pragma unroll
            for (int ks = 0; ks < 4; ++ks) an = MFMA32(ldfrag(QN, 32 * ti + r32, GP, 32 * ks + 16 * hh), ldfrag(KP, 32 * si + r32, GP, 32 * ks + 16 * hh), an); }
#pragma unroll
        for (int i = 0; i < 16; ++i) { const int t = 32 * ti + crow_(i, hh), s = 32 * si + r32; ((LAS bf16*)AT)[t * 72 + s] = (bf16)f2bf(t >= s ? ac[i] : an[i]); }
    } else {
        const int vi = g - 4;
#pragma unroll
        for (int dj = 0; dj < 2; ++dj) { f32x16 st = zero;
#pragma unroll
            for (int ks = 0; ks < 4; ++ks) st = MFMA32(ldfrag(KLT, 32 * dj + r32, GP, 32 * ks + 16 * hh), ldfrag(VT, 32 * vi + r32, GP, 32 * ks + 16 * hh), st);
#pragma unroll
            for (int i4 = 0; i4 < 4; ++i4) *(v2u*)(STATE + (size_t)(n * 4 + h) * 8192 + (size_t)(((vi * 4 + 2 * dj + (i4 >> 1)) * 64 + r32 + 32 * (i4 & 1)) * 8 + 4 * hh)) = (v2u){pk2(st[4 * i4], st[4 * i4 + 1]), pk2(st[4 * i4 + 2], st[4 * i4 + 3])}; }
    }
    LBAR(); GSTAMP(63);
    { const int ti = g >> 2, vj = g & 3; f32x16 oi = zero;
#pragma unroll
      for (int ks = 0; ks < 4; ++ks) oi = MFMA32(ldfrag(AT, 32 * ti + r32, GP, 32 * ks + 16 * hh), ldfrag(VT, 32 * vj + r32, GP, 32 * ks + 16 * hh), oi);
#pragma unroll
      for (int i = 0; i < 16; ++i) GV[(size_t)(t0 + 32 * ti + crow_(i, hh)) * 512 + h * 128 + 32 * vj + r32] = (bf16)f2bf(oi[i]); }
    LBAR(); GSTAMP(64);
}
__device__ __forceinline__ void gla_scan_unit(const Ptrs& P, LAS unsigned char* lds, int u, int wv) {
    const int tid = fresh_tid(wv), lane = tid & 63, w = wv;
    const int h = u >> 6, e0 = (u & 63) * 128;
    const int dch = 16 * ((e0 >> 9) & 3) + 8 * ((e0 >> 8) & 1) + ((2 * lane) & 7);
    unsigned* STATE = (unsigned*)((unsigned char*)P.out + OUT_STATE); const float* DEC = (const float*)(P.ws + WS_DEC);
    LAS float* segS = (LAS float*)lds; LAS float* segP = (LAS float*)(lds + 8192);
    float kv[2][32], dc[2][32];
#pragma unroll
    for (int i = 0; i < 32; ++i) { const int n = 32 * w + i; const unsigned wd = STATE[((size_t)(n * 4 + h) * 8192 + e0) / 2 + lane]; kv[0][i] = bflo(wd); kv[1][i] = bfhi(wd);
        const float2 d2 = *(const float2*)(DEC + (n * 4 + h) * 64 + dch); dc[0][i] = d2.x; dc[1][i] = d2.y; }
    float s[2] = {0.f, 0.f}, pr[2] = {1.f, 1.f};
#pragma unroll
    for (int i = 0; i < 32; ++i) {
#pragma unroll
        for (int e = 0; e < 2; ++e) { const float pv = s[e]; s[e] = s[e] * dc[e][i] + kv[e][i]; kv[e][i] = pv; pr[e] *= dc[e][i]; } }
    segS[w * 64 + lane] = s[0]; segS[512 + w * 64 + lane] = s[1]; segP[w * 64 + lane] = pr[0]; segP[512 + w * 64 + lane] = pr[1];
    LBAR();
    float sin_[2] = {0.f, 0.f};
#pragma unroll
    for (int ww = 0; ww < 8; ++ww) { const float a0 = segS[ww * 64 + lane], a1 = segS[512 + ww * 64 + lane], b0 = segP[ww * 64 + lane], b1 = segP[512 + ww * 64 + lane]; if (ww < w) { sin_[0] = sin_[0] * b0 + a0; sin_[1] = sin_[1] * b1 + a1; } }
    float cp[2] = {1.f, 1.f};
#pragma unroll
    for (int i = 0; i < 32; ++i) { const int n = 32 * w + i;
        STATE[((size_t)(n * 4 + h) * 8192 + e0) / 2 + lane] = pk2(kv[0][i] + cp[0] * sin_[0], kv[1][i] + cp[1] * sin_[1]);
        cp[0] *= dc[0][i]; cp[1] *= dc[1][i]; }
    LBAR();
}
__device__ __forceinline__ void gla_b_task(const Ptrs& P, int task, int lane) {
    const int r32 = lane & 31, hh = lane >> 5;
    const int ti = task & 1, h = (task >> 1) & 3, n = task >> 3;
    const bf16* GQ = (const bf16*)(P.ws + WS_GQ); const bf16* GV = (const bf16*)(P.ws + WS_GV); bf16* GG = (bf16*)(P.ws + WS_GG);
    const bf16* SB = (const bf16*)((unsigned char*)P.out + OUT_STATE) + (size_t)(n * 4 + h) * 8192;
    const size_t t = (size_t)n * 64 + 32 * ti + r32;
    bf16x8 qf[4];
#pragma unroll
    for (int ks = 0; ks < 4; ++ks) qf[ks] = *(const bf16x8*)(GQ + t * 256 + h * 64 + 16 * ks + 8 * hh);
    f32x16 o[4];
#pragma unroll
    for (int vj = 0; vj < 4; ++vj) { o[vj] = (f32x16){};
#pragma unroll
        for (int ks = 0; ks < 4; ++ks) { const bf16x8 af = *(const bf16x8*)(SB + ((vj * 4 + ks) * 64 + lane) * 8);
            o[vj] = MFMA32(af, qf[ks], o[vj]); }
        asm volatile("" ::: "memory"); }
    float ov[64]; float ss = 0.f;
#pragma unroll
    for (int vj = 0; vj < 4; ++vj) {
#pragma unroll
        for (int g4 = 0; g4 < 4; ++g4) { const v2u w = *(const v2u*)(GV + t * 512 + h * 128 + 32 * vj + 8 * g4 + 4 * hh);
            const float a0 = o[vj][4 * g4] + bflo(w.x), a1 = o[vj][4 * g4 + 1] + bfhi(w.x), a2 = o[vj][4 * g4 + 2] + bflo(w.y), a3 = o[vj][4 * g4 + 3] + bfhi(w.y);
            ov[16 * vj + 4 * g4] = a0; ov[16 * vj + 4 * g4 + 1] = a1; ov[16 * vj + 4 * g4 + 2] = a2; ov[16 * vj + 4 * g4 + 3] = a3;
            ss += (a0 * a0 + a1 * a1) + (a2 * a2 + a3 * a3); } }
    ss += __shfl_xor(ss, 32);
    const float r = rsqrtf(ss * (1.f / 128.f) + EPS_);
#pragma unroll
    for (int vj = 0; vj < 4; ++vj) {
#pragma unroll
        for (int g4 = 0; g4 < 4; ++g4) { const int vc = h * 128 + 32 * vj + 8 * g4 + 4 * hh; const v2u gw = *(const v2u*)(GG + t * 512 + vc); const f32x4 gn = *(const f32x4*)(P.g_gla_head + vc);
            const float g0 = bflo(gw.x), g1 = bfhi(gw.x), g2 = bflo(gw.y), g3 = bfhi(gw.y);
            v2u ow; ow.x = pk2(ov[16 * vj + 4 * g4] * r * gn[0] * (g0 * sigmoidf_(g0)), ov[16 * vj + 4 * g4 + 1] * r * gn[1] * (g1 * sigmoidf_(g1)));
            ow.y = pk2(ov[16 * vj + 4 * g4 + 2] * r * gn[2] * (g2 * sigmoidf_(g2)), ov[16 * vj + 4 * g4 + 3] * r * gn[3] * (g3 * sigmoidf_(g3)));
            *(v2u*)(GG + t * 512 + vc) = ow; }
        asm volatile("" ::: "memory"); }
}
__device__ __forceinline__ void memattn_unit(const Ptrs& P, LAS unsigned char* lds, int hm, int qb, int wv) {
    const int tid = fresh_tid(wv), lane = tid & 63, w = wv, r32 = lane & 31, hh = lane >> 5;
    constexpr int KPB = 272, VPB = 536;
    LAS unsigned char* KM = lds; LAS unsigned char* VTM = lds + 69632; LAS float* LSUM = (LAS float*)(lds + 139264);
    const bf16* MK = (const bf16*)(P.ws + WS_MK); const bf16* MVT = (const bf16*)(P.ws + WS_MVT); bf16* MQ = (bf16*)(P.ws + WS_MQ);
#pragma unroll
    for (int j = 0; j < 8; ++j) { const int idx = tid + 512 * j; const int key = idx >> 4, ch = idx & 15; *(LAS v4u*)(KM + key * KPB + ch * 16) = *(const v4u*)(MK + (size_t)key * 512 + hm * 128 + ch * 8);
    }
    { const int dc = tid & 15, key0 = (tid >> 4) * 8; v4u in[8];
#pragma unroll
      for (int k = 0; k < 8; ++k) in[k] = *(const v4u*)(MVT + (size_t)(key0 + k) * 512 + hm * 128 + dc * 8);
#pragma unroll
      for (int jp = 0; jp < 4; ++jp) {
          unsigned e[8];
#pragma unroll
          for (int k = 0; k < 8; ++k) e[k] = jp == 0 ? in[k].x : (jp == 1 ? in[k].y : (jp == 2 ? in[k].z : in[k].w));
          const v4u lo = (v4u){(e[0] & 0xffffu) | (e[1] << 16), (e[2] & 0xffffu) | (e[3] << 16), (e[4] & 0xffffu) | (e[5] << 16), (e[6] & 0xffffu) | (e[7] << 16)};
          const v4u hi = (v4u){(e[0] >> 16) | (e[1] & 0xffff0000u), (e[2] >> 16) | (e[3] & 0xffff0000u), (e[4] >> 16) | (e[5] & 0xffff0000u), (e[6] >> 16) | (e[7] & 0xffff0000u)};
          *(LAS v4u*)(VTM + (8 * dc + 2 * jp) * VPB + key0 * 2) = lo; *(LAS v4u*)(VTM + (8 * dc + 2 * jp + 1) * VPB + key0 * 2) = hi; } }
    LBAR();
    for (int qq = 0; qq < 2; ++qq) { const int qbb = 2 * qb + qq;
    const size_t qrow = (size_t)qbb * 256 + 32 * w + r32;
    bf16x8 qr[8];
#pragma unroll
    for (int ks = 0; ks < 8; ++ks) qr[ks] = *(const bf16x8*)(MQ + qrow * 512 + hm * 128 + 16 * ks + 8 * hh);
    f32x16 p[8];
#pragma unroll
    for (int kb = 0; kb < 8; ++kb) { p[kb] = (f32x16){};
#pragma unroll
        for (int ks = 0; ks < 8; ++ks) p[kb] = MFMA32(ldfrag(KM, 32 * kb + r32, KPB, 32 * ks + 16 * hh), qr[ks], p[kb]); }
    float mx = -INFINITY;
#pragma unroll
    for (int kb = 0; kb < 8; ++kb)
#pragma unroll
        for (int i = 0; i < 16; ++i) mx = fmaxf(mx, p[kb][i]);
    mx = fmaxf(mx, __shfl_xor(mx, 32));
    float l = 0.f; v4u pk[8][2];
#pragma unroll
    for (int kb = 0; kb < 8; ++kb) {
#pragma unroll
        for (int i = 0; i < 16; ++i) { p[kb][i] = __builtin_amdgcn_exp2f(p[kb][i] - mx); l += p[kb][i]; }
#pragma unroll
        for (int s = 0; s < 2; ++s) pk[kb][s] = (v4u){pk2(p[kb][8 * s], p[kb][8 * s + 1]), pk2(p[kb][8 * s + 2], p[kb][8 * s + 3]), pk2(p[kb][8 * s + 4], p[kb][8 * s + 5]), pk2(p[kb][8 * s + 6], p[kb][8 * s + 7])}; }
    l += __shfl_xor(l, 32);
    if (hh == 0) LSUM[w * 32 + r32] = l;
    f32x16 o[4];
#pragma unroll
    for (int db = 0; db < 4; ++db) { o[db] = (f32x16){};
#pragma unroll
        for (int kb = 0; kb < 8; ++kb)
#pragma unroll
            for (int s = 0; s < 2; ++s) { const LAS unsigned char* vp = VTM + (32 * db + r32) * VPB + 64 * kb + 32 * s + 8 * hh;
                const s16x4 lo = *(const LAS s16x4*)vp, hi = *(const LAS s16x4*)(vp + 16);
                const bf16x8 bfr = (bf16x8){lo[0], lo[1], lo[2], lo[3], hi[0], hi[1], hi[2], hi[3]};
                o[db] = MFMA32(__builtin_bit_cast(bf16x8, pk[kb][s]), bfr, o[db]); } }
    LDS_WAIT(); asm volatile("" ::: "memory");
#pragma unroll
    for (int i = 0; i < 16; ++i) { const int ql = crow_(i, hh); const float rl = __builtin_amdgcn_rcpf(LSUM[w * 32 + ql]);
#pragma unroll
        for (int db = 0; db < 4; ++db) MQ[((size_t)qbb * 256 + 32 * w + ql) * 512 + hm * 128 + 32 * db + r32] = (bf16)f2bf(o[db][i] * rl); }
    LDS_WAIT(); asm volatile("" ::: "memory"); }
    LBAR();
}
__device__ __forceinline__ float lse2f(float a, float b) { const float m = fmaxf(a, b), d = fminf(a, b) - m; return (m == -INFINITY) ? m : m + __log2f(1.f + __builtin_amdgcn_exp2f(d)); }
__device__ __forceinline__ void fcumsum_unit(const Ptrs& P, LAS unsigned char* lds, int hf, int wv) {
    const int tid = fresh_tid(wv), lane = tid & 63, w = wv;
    const float* LF = (const float*)(P.ws + WS_LOGF) + (size_t)hf * S_; float* F = (float*)(P.ws + WS_F) + (size_t)hf * S_;
    LAS float* X = (LAS float*)lds; LAS float* WT = (LAS float*)(lds + 69632);
#pragma unroll 8
    for (int j = 0; j < 32; ++j) { const int t = j * 512 + tid; X[t + (t >> 5)] = LF[t]; }
    LBAR();
    float loc[32]; float s = 0.f;
#pragma unroll
    for (int i = 0; i < 32; ++i) { s += X[tid * 33 + i]; loc[i] = s; }
    float incl = s;
#pragma unroll
    for (int o = 1; o < 64; o <<= 1) { const float y = __shfl_up(incl, o); if (lane >= o) incl += y; }
    if (lane == 63) WT[w] = incl;
    LBAR();
    float woff = 0.f;
#pragma unroll
    for (int ww = 0; ww < 8; ++ww) { const float a = WT[ww]; if (ww < w) woff += a; }
    const float off = woff + incl - s;
#pragma unroll
    for (int i = 0; i < 32; ++i) { loc[i] = off + loc[i]; X[tid * 33 + i] = loc[i]; }
    LBAR();
#pragma unroll 8
    for (int j = 0; j < 32; ++j) { const int t = j * 512 + tid; F[t] = X[t + (t >> 5)]; }
    LBAR();
    const float ref = loc[0]; float accl = 0.f;
#pragma unroll
    for (int i = 0; i < 32; ++i) accl += __builtin_amdgcn_exp2f((ref - loc[i]) * LOG2E_);
    float linc = __log2f(accl) - ref * LOG2E_;
#pragma unroll
    for (int o = 1; o < 64; o <<= 1) { const float y = __shfl_up(linc, o); if (lane >= o) linc = lse2f(linc, y); }
    if (lane == 63) WT[w] = linc;
    LBAR();
    float wpre = -INFINITY;
#pragma unroll
    for (int ww = 0; ww < 8; ++ww) { const float a = WT[ww]; if (ww < w) wpre = lse2f(wpre, a); }
    if ((tid & 3) == 3) ((float*)(P.ws + WS_LSEF))[hf * 128 + (tid >> 2)] = lse2f(wpre, linc);
    LBAR();
}

__device__ __forceinline__ void normmax_unit(const Ptrs& P, LAS unsigned char* lds, int j, int wv) {
    const int tid = fresh_tid(wv), r = tid >> 3, h = tid & 7;
    const bf16* FQ = (const bf16*)(P.ws + WS_FQ); const bf16* FK = (const bf16*)(P.ws + WS_FK); LAS float* RED = (LAS float*)lds;
    const v4u* qp = (const v4u*)(FQ + (size_t)(64 * j + r) * 512 + h * 64); const v4u* kp = (const v4u*)(FK + (size_t)(64 * j + r) * 512 + h * 64);
    float sq = 0.f, sk = 0.f, sd = 0.f;
#pragma unroll
    for (int c = 0; c < 8; ++c) { const v4u a = qp[c], b = kp[c];
        sq += bflo(a.x) * bflo(a.x) + bfhi(a.x) * bfhi(a.x) + bflo(a.y) * bflo(a.y) + bfhi(a.y) * bfhi(a.y) + bflo(a.z) * bflo(a.z) + bfhi(a.z) * bfhi(a.z) + bflo(a.w) * bflo(a.w) + bfhi(a.w) * bfhi(a.w);
        sk += bflo(b.x) * bflo(b.x) + bfhi(b.x) * bfhi(b.x) + bflo(b.y) * bflo(b.y) + bfhi(b.y) * bfhi(b.y) + bflo(b.z) * bflo(b.z) + bfhi(b.z) * bfhi(b.z) + bflo(b.w) * bflo(b.w) + bfhi(b.w) * bfhi(b.w);
        sd += bflo(a.x) * bflo(b.x) + bfhi(a.x) * bfhi(b.x) + bflo(a.y) * bflo(b.y) + bfhi(a.y) * bfhi(b.y) + bflo(a.z) * bflo(b.z) + bfhi(a.z) * bfhi(b.z) + bflo(a.w) * bflo(b.w) + bfhi(a.w) * bfhi(b.w); }
    RED[tid] = sq; RED[512 + tid] = sk; RED[1024 + tid] = -sd;
    LBAR();
    if (tid < 16) { const int hh = tid & 7, which = tid >> 3; float m = 0.f;
        for (int rr = 0; rr < 64; ++rr) m = fmaxf(m, RED[which * 512 + rr * 8 + hh]);
        atomicMax((unsigned*)P.ws + which * 8 + hh, __float_as_uint(m));
        if (which == 0) ((float*)(P.ws + WS_QB2))[j * 8 + hh] = m; }
    else if (tid < 24) { const int hh = tid & 7; float m = -INFINITY;
        for (int rr = 0; rr < 64; ++rr) m = fmaxf(m, RED[1024 + rr * 8 + hh]);
        ((float*)(P.ws + WS_NDOT))[j * 8 + hh] = m; }
    LBAR();
}
#define RLX_AGENT __ATOMIC_RELAXED, __HIP_MEMORY_SCOPE_AGENT
#define XB_TMO      128
#define XB_XCNT(j)  (256  + 64 * (j))
#define XB_XSUB(j)  (1280 + 64 * (j))
#define XB_XGEN(j)  (2304 + 64 * (j))
#define XB_TOP      3328
#define XB_TOPGEN   3392
#define XCD_BAR_WORDS 3456
#define XB_SPIN_CAP (1u << 18)

__device__ __forceinline__ unsigned xb_ld(unsigned* p)              { return __hip_atomic_load(p, __ATOMIC_RELAXED, __HIP_MEMORY_SCOPE_AGENT); }
__device__ __forceinline__ unsigned xb_add(unsigned* p, unsigned v) { return __hip_atomic_fetch_add(p, v, __ATOMIC_RELAXED, __HIP_MEMORY_SCOPE_AGENT); }
__device__ __forceinline__ unsigned xb_xcc_id() { return (unsigned)__builtin_amdgcn_s_getreg((3 << 11) | 20) & 0xFu; }
#define XB_SPIN(cond, bar) do { unsigned _sp = 0; while (cond) { __builtin_amdgcn_s_sleep(1); \
    if ((++_sp & 255u) == 0u) { if (xb_ld(&(bar)[XB_TMO])) break; if (_sp > XB_SPIN_CAP) { atomicAdd(&(bar)[XB_TMO], 1u); break; } } } } while (0)

struct XcdBarrier {
    unsigned* bar; unsigned x;
    volatile LAS unsigned* st;
};

__device__ __forceinline__ XcdBarrier xcd_barrier_post(unsigned* bar, volatile LAS unsigned* st, int wv) {
    XcdBarrier b; b.bar = bar; b.x = xb_xcc_id(); b.st = st;
    if (fresh_tid(wv) == 0) (void)xb_add(&bar[XB_XCNT(b.x)], 1u);
    return b;
}
__device__ __forceinline__ void xcd_barrier_complete(unsigned* bar, unsigned x, unsigned& nloc, unsigned& nx) {
    const unsigned G = gridDim.x * gridDim.y * gridDim.z;
    unsigned sum, cnt, mine, sp = 0u;
    for (;;) {
        sum = 0u; cnt = 0u; mine = 0u;
#pragma unroll
        for (unsigned j = 0; j < 16; ++j) { const unsigned c = xb_ld(&bar[XB_XCNT(j)]); sum += c; cnt += (c > 0u) ? 1u : 0u; mine = (j == x) ? c : mine; }
        if (sum == G) break;
        __builtin_amdgcn_s_sleep(1);
        if ((++sp & 255u) == 0u) { if (xb_ld(&bar[XB_TMO])) break; if (sp > XB_SPIN_CAP) { atomicAdd(&bar[XB_TMO], 1u); break; } }
    }
    nloc = mine > 0u ? mine : 1u; nx = cnt > 0u ? cnt : 1u;
}

__device__ __forceinline__ void xcd_barrier(const XcdBarrier& b, int wv) {
    asm volatile("s_waitcnt vmcnt(0)" ::: "memory");
    __syncthreads();
    if (fresh_tid(wv) == 0) {
        unsigned* bar = b.bar;
        __builtin_amdgcn_s_waitcnt(0);
        unsigned nloc = b.st[0], nx = b.st[1];
        if (nloc == 0u) { xcd_barrier_complete(bar, b.x, nloc, nx); b.st[0] = nloc; b.st[1] = nx; }
        const unsigned old = xb_add(&bar[XB_XSUB(b.x)], 1u);
        const unsigned gen = old / nloc;
        if (old + 1u == (gen + 1u) * nloc) {
            __builtin_amdgcn_fence(__ATOMIC_RELEASE, "agent");
            asm volatile("s_waitcnt vmcnt(0)" ::: "memory");
            const unsigned og = xb_add(&bar[XB_TOP], 1u);
            const unsigned tg = og / nx;
            if (og + 1u == (tg + 1u) * nx) xb_add(&bar[XB_TOPGEN], 1u);
            else XB_SPIN(xb_ld(&bar[XB_TOPGEN]) == tg, bar);
            __builtin_amdgcn_fence(__ATOMIC_ACQUIRE, "agent");
            xb_add(&bar[XB_XGEN(b.x)], 1u);
            asm volatile("s_waitcnt vmcnt(0)" ::: "memory");
        } else {
            XB_SPIN(xb_ld(&bar[XB_XGEN(b.x)]) == gen, bar);
            __builtin_amdgcn_fence(__ATOMIC_ACQUIRE, "agent");
            asm volatile("s_waitcnt vmcnt(0)" ::: "memory");
        }
    }
    __syncthreads();
}

constexpr int CW_BAR = 4096;
constexpr size_t CTL_ZERO_BYTES = 65536;
constexpr int MISC_OFF = 151552;
struct Args { const float* in[18]; float* out; unsigned char* ws; int ph_lo, ph_hi; };
constexpr int N_PHASES = 9;
__global__ void __launch_bounds__(NWAVES * 64, 2) hybrid_fwd(Args args) {
    extern __shared__ __attribute__((aligned(16))) unsigned char lds_raw[];
    cg::grid_group grid = cg::this_grid();
    LAS unsigned char* lds = (LAS unsigned char*)lds_raw;
    const int wv = __builtin_amdgcn_readfirstlane((int)(threadIdx.x >> 6));
    const int G = gridDim.x, bx = blockIdx.x; const int vcu = (G % 8 == 0) ? (bx % 8) * (G / 8) + bx / 8 : bx;
    Ptrs P;
    P.x = args.in[0]; P.mem = args.in[1]; P.g_mix = args.in[2]; P.w_in = args.in[3]; P.w_alpha_up = args.in[4]; P.b_alpha = args.in[5]; P.b_forget = args.in[6]; P.g_gla_head = args.in[7];
    P.g_mem = args.in[8]; P.w_mem_kv = args.in[9]; P.w_gla_o = args.in[10]; P.w_fox_o = args.in[11]; P.w_mem_o = args.in[12]; P.w_out = args.in[13]; P.g_ffn = args.in[14]; P.w_ff1 = args.in[15];
    P.w_ff2 = args.in[16]; P.g_final = args.in[17]; P.out = args.out; P.ws = args.ws;
    unsigned char* ws = args.ws;
    const int lo = args.ph_lo, hi = args.ph_hi;
    if (hi > 1000) grid.sync();
    volatile LAS unsigned* MISC = (volatile LAS unsigned*)(lds + MISC_OFF);
    { const int t_ = fresh_tid(wv); if (t_ < 2) MISC[t_] = 0u; }
    __syncthreads();
    const XcdBarrier bar = xcd_barrier_post((unsigned*)ws + CW_BAR, MISC, wv);
#ifndef PH_MASK
#define PH_MASK 0x3ff
#endif
#define IN(k) ((((PH_MASK) >> (k)) & 1) && lo <= (k) && (k) < hi)
#ifdef PROBE_PHASE
#define STAMP(k) do { if (bx == 0 && fresh_tid(wv) == 0) ((unsigned long long*)(ws + 253 * MiB))[(k)] = __builtin_amdgcn_s_memrealtime(); } while (0)
#else
#define STAMP(k) do {} while (0)
#endif
#define SEAM(k) do { if (lo <= (k) && (k) + 1 < hi) xcd_barrier(bar, wv); STAMP((k) + 1); } while (0)

    STAMP(0);
#define STAGGER() do { const int grp_ = (bx >> 3) & 3; for (int i_ = 0; i_ < grp_; ++i_) __builtin_amdgcn_s_sleep(127); } while (0)
    if (IN(0)) { p0_prologue(P, lds, vcu, G, wv); __syncthreads(); }
    SEAM(0);
    if (IN(1)) {
        ProjSched S{(const char*)P.out + OUT_U, (const char*)(ws + WS_MEMN), (const char*)(ws + WS_WIN), G, bx, wv};
        EpiProj E{ws, P.b_forget};
        pg8::gemm_phase<EpiProj, ProjSched, true, true>(lds, 1024, 1024, 1024, S, E);
    }
    SEAM(1);
    if (IN(2)) {
        if (bx < 8) fcumsum_unit(P, lds, bx, wv);
        else for (int u = bx - 8; u < 256; u += G - 8) normmax_unit(P, lds, u, wv);
    }
    SEAM(2);
    if (IN(3)) {
        const attn_body::AttnTensors AT{(const attn_body::bf16*)(ws + WS_FQ), (const attn_body::bf16*)(ws + WS_FK), (const attn_body::bf16*)(ws + WS_FV), (attn_body::bf16*)(ws + WS_FQ), (const float*)(ws + WS_F)};
        LAS float* THRU = (LAS float*)(lds + MISC_OFF + 128); volatile LAS unsigned* qslot = (volatile LAS unsigned*)(lds + MISC_OFF + 32);
        { const int i_ = fresh_tid(wv); const int h_ = i_ & 7, qb_ = i_ >> 3;
          const float* QB2 = (const float*)(ws + WS_QB2); const float* NDOT = (const float*)(ws + WS_NDOT); const float k2 = __uint_as_float(((const unsigned*)ws)[8 + h_]);
          float a2 = 0.f, b = -INFINITY;
#pragma unroll
          for (int bb = 0; bb < 4; ++bb) { a2 = fmaxf(a2, QB2[(4 * qb_ + bb) * 8 + h_]); b = fmaxf(b, NDOT[(4 * qb_ + bb) * 8 + h_]); }
          THRU[qb_ * 8 + h_] = -(24.1f + 1.01f * sqrtf(a2 * k2) + b); }
        __syncthreads();
        for (;;) {
            if (fresh_tid(wv) == 0) qslot[0] = __hip_atomic_fetch_add((unsigned*)ws + 64, 1u, __ATOMIC_RELAXED, __HIP_MEMORY_SCOPE_AGENT);
            asm volatile("s_waitcnt vmcnt(0) lgkmcnt(0)\n\ts_barrier" ::: "memory");
            const int idx = __builtin_amdgcn_readfirstlane((int)qslot[0]);
            if (idx >= 1664) break;
            if (idx < 512) { const int h = idx & 7, qb = 63 - (idx >> 3); attn_body::attn_unit<8>(0, h, qb, AT.Q, AT.K, AT.V, AT.O, AT.F + (size_t)h * S_, (const float*)(ws + WS_LSEF) + h * 128, THRU[qb * 8 + h], (char*)lds_raw, wv); }
            else if (idx < 640) memattn_unit(P, lds, (idx - 512) & 3, (idx - 512) >> 2, wv);
            else gla_a_unit(P, lds, (idx - 640) >> 2, (idx - 640) & 3, wv);
        }
    }
    SEAM(3);
    if (IN(3)) { for (int u = bx; u < 256; u += G) gla_scan_unit(P, lds, u, wv); }
    if (lo <= 3 && 4 < hi) xcd_barrier(bar, wv);
    STAMP(40);

    if (IN(4)) { for (int task = bx * NWAVES + wv; task < 2048; task += G * NWAVES) { const int lane_ = fresh_tid(wv) & 63; gla_b_task(P, task, lane_); } }
    SEAM(4);
    if (IN(5)) {
        static_assert(WS_FQ - WS_GG == 16 * MiB && WS_MQ - WS_FQ == 16 * MiB && WS_WFOXO - WS_WGLAO == MiB && WS_WMEMO - WS_WFOXO == MiB, "merge operand spacing");
        MergeSched S{(const char*)(ws + WS_GG), (const char*)(ws + WS_WGLAO), G, bx, wv, 16 * MiB - 1024, MiB - 1024};
        EpiMerge E{(bf16*)(ws + WS_MG), (const bf16*)(ws + WS_GT)};
        pg8::gemm_phase<EpiMerge, MergeSched, true, true, 8>(lds, 1536, 512, 512, S, E);
    }
    SEAM(5);
    if (IN(6)) {
        GemmSched S{(const char*)(ws + WS_MG), (const char*)(ws + WS_WOUT), 64, 4, 1024, 1024, G, bx, wv};
        EpiResid<true, false> E{P.x, (bf16*)(ws + WS_H0), (bf16*)(ws + WS_H1) - (size_t)8192 * 1024, (bf16*)(ws + WS_U2), P.g_ffn, (float*)(ws + WS_SS1)};
        pg8::gemm_phase<EpiResid<true, false>, GemmSched, true, true>(lds, 1024, 1024, 1024, S, E);
    }
    SEAM(6);
    if (IN(7)) {
        GemmSched S{(const char*)(ws + WS_U2), (const char*)(ws + WS_WFF1), 64, 16, 1024, 1024, G, bx, wv};
        EpiFfn1 E{(bf16*)(ws + WS_HID), (const float*)(ws + WS_SS1)};
        STAGGER();
        pg8::gemm_phase<EpiFfn1, GemmSched, true, true>(lds, 1024, 1024, 1024, S, E);
    }
    SEAM(7);
    if (IN(8)) {
        GemmSched S{(const char*)(ws + WS_HID), (const char*)(ws + WS_WFF2), 64, 4, 4096, 4096, G, bx, wv};
        EpiFinal E{(const bf16*)(ws + WS_H0), (const bf16*)(ws + WS_H1) - (size_t)8192 * 1024, P.out, P.g_final, (float*)(ws + WS_SS2), (unsigned*)ws + CW_PANEL};
        pg8::gemm_phase<EpiFinal, GemmSched, false, true>(lds, 4096, 4096, 4096, S, E);
    }
    STAMP(9);
#ifdef PROBE_PHASE
    __syncthreads(); xcd_barrier(bar, wv); STAMP(10);
    if (PROBE_PHASE == 200) { xcd_barrier(bar, wv); xcd_barrier(bar, wv); xcd_barrier(bar, wv); xcd_barrier(bar, wv); STAMP(11); }
    if (bx == 0) { __syncthreads(); const unsigned long long* ts = (const unsigned long long*)(ws + 253 * MiB);
        long K = (PROBE_PHASE < 0) ? 100000 : (PROBE_PHASE == 200) ? (long)(ts[11] - ts[10]) * 10 : (PROBE_PHASE == 777) ? (long)((ts[61] - ts[60]) / 5 + 540 * ((ts[62] - ts[61]) / 5)) : (PROBE_PHASE == 778) ? (long)((ts[63] - ts[62]) / 5 + 540 * ((ts[64] - ts[63]) / 5)) : (PROBE_PHASE >= 1000) ? (long)(ts[PROBE_PHASE % 1000] - ts[PROBE_PHASE / 1000]) : (PROBE_PHASE >= 100 ? (long)(ts[10] - ts[0]) / 10 : (long)(ts[PROBE_PHASE + 1] - ts[PROBE_PHASE]));
        if (K > 300000) K = 300000;
        for (long i = fresh_tid(wv); i < K; i += 512) P.out[i] += 0.1f; }
#endif
#undef IN
#undef SEAM
}

extern "C" void kernel_launch(void* const* d_in, const int* in_sizes, int n_in, void* d_out, int out_size, void* d_ws, size_t ws_size, hipStream_t stream) {
    static int grid = 0;
    if (grid == 0) {
        if (n_in != 18 || out_size != S_ * DM_ || ws_size < WS_END) { fprintf(stderr, "kernel_launch: unexpected shapes (n_in %d out %d ws %zu)\n", n_in, out_size, ws_size); grid = -1; return; }
        int dev = 0, cus = 0, per_cu = 0;
        (void)hipGetDevice(&dev); (void)hipDeviceGetAttribute(&cus, hipDeviceAttributeMultiprocessorCount, dev);
        (void)hipFuncSetAttribute((const void*)hybrid_fwd, hipFuncAttributeMaxDynamicSharedMemorySize, LDS_BYTES);
        (void)hipOccupancyMaxActiveBlocksPerMultiprocessor(&per_cu, (const void*)hybrid_fwd, NWAVES * 64, LDS_BYTES);
        (void)hipGetLastError();
        grid = 256;
        if (cus != 256 || per_cu < 1) fprintf(stderr, "kernel_launch: note: cus %d per_cu %d (built for 256 CUs, one workgroup each)\n", cus, per_cu);
    }
    if (grid < 0) return;
    (void)hipMemsetAsync(d_ws, 0, CTL_ZERO_BYTES, stream);
    Args a{};
    for (int i = 0; i < 18; ++i) a.in[i] = (const float*)d_in[i];
    a.out = (float*)d_out; a.ws = (unsigned char*)d_ws;
#ifndef MK_PER_PHASE
    a.ph_lo = 0; a.ph_hi = N_PHASES;
    { void* kargs[] = {&a}; hipError_t e = hipLaunchCooperativeKernel((const void*)hybrid_fwd, dim3(grid), dim3(NWAVES * 64), kargs, LDS_BYTES, stream);
      if (e != hipSuccess) fprintf(stderr, "cooperative launch failed: %s\n", hipGetErrorString(e)); }
#else
    for (int k = 0; k < N_PHASES; ++k) { a.ph_lo = k; a.ph_hi = k + 1; void* kargs[] = {&a};
        hipError_t e = hipLaunchCooperativeKernel((const void*)hybrid_fwd, dim3(grid), dim3(NWAVES * 64), kargs, LDS_BYTES, stream);
        if (e != hipSuccess) { fprintf(stderr, "cooperative launch %d failed: %s\n", k, hipGetErrorString(e)); break; } }
#endif
}
```
